# Optimizing an MI355X kernel written in HIP

```python
import jax, jax.numpy as jnp
from jax import lax
import numpy as np

D_MODEL = 1024
BATCH = 8
SEQ = 4096
DEPTH = 1

N_META = 16
LRU_WIDTH = D_MODEL // 2
LRU_HEADS = 8
LRU_HEAD_DIM = LRU_WIDTH // LRU_HEADS
CONV_WIDTH = 4
LRU_C = 8.0
POOL_WIDTH = D_MODEL - LRU_WIDTH
POOL_WINDOWS = (2, 4, 8, 16)
POOL_GROUP = POOL_WIDTH // len(POOL_WINDOWS)
MIX_WIDTH = LRU_WIDTH + POOL_WIDTH
IN_WIDTH = 2 * LRU_WIDTH + POOL_WIDTH
N_GROUPS = 4
EXPERTS_PER_GROUP = 8
N_EXPERTS = N_GROUPS * EXPERTS_PER_GROUP
TOP_K = 2
EXPERT_FF = D_MODEL // 2
MOE_BLOCK = 128
RMS_EPS = 1e-6

kernel_name = "hymba_rglru_multipool_hmoe_layer"


def rmsnorm(x, gain):
    xf = x.astype(jnp.float32)
    y = xf * lax.rsqrt(jnp.mean(xf * xf, axis=-1, keepdims=True) + RMS_EPS)
    return (y * gain.astype(jnp.float32)).astype(x.dtype)


def rg_lru_group(u_x, u_gate, conv_w, conv_b, wa, ba, wx, bx, lam):
    B, T, _ = u_x.shape
    xpad = jnp.pad(u_x, ((0, 0), (CONV_WIDTH - 1, 0), (0, 0)))
    xc = conv_b + sum(xpad[:, k:k + T] * conv_w[k] for k in range(CONV_WIDTH))
    xf = xc.astype(jnp.float32)
    xh = xf.reshape(B, T, LRU_HEADS, LRU_HEAD_DIM)
    r = jax.nn.sigmoid(jnp.einsum('bthi,hij->bthj', xh, wa.astype(jnp.float32)).reshape(B, T, LRU_WIDTH)
                       + ba.astype(jnp.float32))
    i = jax.nn.sigmoid(jnp.einsum('bthi,hij->bthj', xh, wx.astype(jnp.float32)).reshape(B, T, LRU_WIDTH)
                       + bx.astype(jnp.float32))
    log_a = LRU_C * r * jax.nn.log_sigmoid(lam.astype(jnp.float32))
    a = jnp.exp(log_a)
    b = jnp.sqrt(-jnp.expm1(2.0 * log_a)) * (i * xf)

    def combine(left, right):
        a1, b1 = left
        a2, b2 = right
        return a1 * a2, a2 * b1 + b2

    _, h = lax.associative_scan(combine, (a, b), axis=1)
    return h * jax.nn.gelu(u_gate.astype(jnp.float32))


def multiscale_pool_group(u, pool_w):
    uf = u.astype(jnp.float32)
    T = uf.shape[1]
    count_base = jnp.arange(1, T + 1, dtype=jnp.float32)[None, :, None]
    outs = []
    for g, w in enumerate(POOL_WINDOWS):
        ug = uf[..., g * POOL_GROUP:(g + 1) * POOL_GROUP]
        cs = jnp.cumsum(ug, axis=1)
        lag = jnp.pad(cs[:, :T - w], ((0, 0), (w, 0), (0, 0)))
        mean = (cs - lag) / jnp.minimum(count_base, float(w))
        outs.append(jnp.einsum('btc,cd->btd', mean - ug, pool_w[g].astype(jnp.float32)))
    return jnp.concatenate(outs, axis=-1)


def hierarchical_moe(h, w_group, b_group, w_router, b_router, w_gate, w_up, w_down):
    B, T, D = h.shape
    N = B * T
    xt = h.reshape(N, D)
    g_logits = (xt @ w_group).astype(jnp.float32) + b_group.astype(jnp.float32)
    p_groups = jax.nn.softmax(g_logits, axis=-1)
    g_idx = jnp.argmax(g_logits, axis=-1).astype(jnp.int32)
    p_g = jnp.take_along_axis(p_groups, g_idx[:, None], axis=-1)
    e_logits = ((xt @ w_router).astype(jnp.float32) + b_router.astype(jnp.float32)
                ).reshape(N, N_GROUPS, EXPERTS_PER_GROUP)
    e_sel = jnp.take_along_axis(e_logits, g_idx[:, None, None], axis=1)[:, 0]
    top_v, top_i = lax.top_k(e_sel, TOP_K)
    gate = p_g * jax.nn.softmax(top_v, axis=-1)
    eid = g_idx[:, None] * EXPERTS_PER_GROUP + top_i.astype(jnp.int32)

    A = N * TOP_K
    flat_e = eid.reshape(A)
    flat_tok = jnp.repeat(jnp.arange(N, dtype=jnp.int32), TOP_K)
    flat_gate = gate.reshape(A)
    order = jnp.argsort(flat_e)
    se, stok, sg = flat_e[order], flat_tok[order], flat_gate[order]
    counts = jnp.bincount(flat_e, length=N_EXPERTS)
    starts = jnp.cumsum(counts) - counts
    padded = ((counts + MOE_BLOCK - 1) // MOE_BLOCK) * MOE_BLOCK
    pends = jnp.cumsum(padded)
    pstarts = pends - padded
    dest = pstarts[se] + (jnp.arange(A, dtype=jnp.int32) - starts[se])
    n_blocks = -(-(A + N_EXPERTS * (MOE_BLOCK - 1)) // MOE_BLOCK)
    P = n_blocks * MOE_BLOCK
    buf = jnp.zeros((P, D), h.dtype).at[dest].set(xt[stok])
    block_e = jnp.clip(jnp.searchsorted(pends, jnp.arange(n_blocks) * MOE_BLOCK, side='right'),
                       0, N_EXPERTS - 1).astype(jnp.int32)

    def expert_block(args):
        xb, e = args
        hid = jax.nn.silu(xb @ w_gate[e]) * (xb @ w_up[e])
        return hid @ w_down[e]

    out = lax.map(expert_block, (buf.reshape(n_blocks, MOE_BLOCK, D), block_e)).reshape(P, D)
    contrib = (out[dest].astype(jnp.float32) * sg[:, None]).astype(h.dtype)
    y = jnp.zeros((N, D), h.dtype).at[stok].add(contrib)
    return y.reshape(B, T, D)


def setup_inputs(seed: int = 0) -> dict:
    key = jax.random.key(seed)
    ks = jax.random.split(key, 24)
    f32 = jnp.float32

    def nrm(k, shape, scale):
        return jax.random.normal(k, shape, f32) * scale

    u = jax.random.uniform(ks[10], (DEPTH, LRU_WIDTH), f32, minval=0.9, maxval=0.999)
    s = u ** (1.0 / LRU_C)
    lam = jnp.log(s) - jnp.log1p(-s)
    return {
        "x": nrm(ks[0], (BATCH, SEQ, D_MODEL), 1.0),
        "meta_tokens": nrm(ks[1], (N_META, D_MODEL), 1.0),
        "norm1_gain": 1.0 + nrm(ks[2], (DEPTH, D_MODEL), 0.05),
        "w_in": nrm(ks[3], (DEPTH, D_MODEL, IN_WIDTH), D_MODEL ** -0.5),
        "conv_w": nrm(ks[4], (DEPTH, CONV_WIDTH, LRU_WIDTH), CONV_WIDTH ** -0.5),
        "conv_b": nrm(ks[5], (DEPTH, LRU_WIDTH), 0.02),
        "lru_wa": nrm(ks[6], (DEPTH, LRU_HEADS, LRU_HEAD_DIM, LRU_HEAD_DIM), LRU_HEAD_DIM ** -0.5),
        "lru_ba": nrm(ks[7], (DEPTH, LRU_WIDTH), 0.02),
        "lru_wx": nrm(ks[8], (DEPTH, LRU_HEADS, LRU_HEAD_DIM, LRU_HEAD_DIM), LRU_HEAD_DIM ** -0.5),
        "lru_bx": nrm(ks[9], (DEPTH, LRU_WIDTH), 0.02),
        "lru_lambda": lam,
        "lru_out_gain": 1.0 + nrm(ks[11], (DEPTH, LRU_WIDTH), 0.05),
        "pool_w": nrm(ks[12], (DEPTH, len(POOL_WINDOWS), POOL_GROUP, POOL_GROUP), POOL_GROUP ** -0.5),
        "pool_scale": 1.0 + nrm(ks[13], (DEPTH, POOL_WIDTH), 0.1),
        "w_out": nrm(ks[14], (DEPTH, MIX_WIDTH, D_MODEL), MIX_WIDTH ** -0.5),
        "norm2_gain": 1.0 + nrm(ks[15], (DEPTH, D_MODEL), 0.05),
        "w_group": nrm(ks[16], (DEPTH, D_MODEL, N_GROUPS), D_MODEL ** -0.5),
        "b_group": nrm(ks[17], (DEPTH, N_GROUPS), 0.01),
        "w_router": nrm(ks[18], (DEPTH, D_MODEL, N_EXPERTS), D_MODEL ** -0.5),
        "b_router": nrm(ks[19], (DEPTH, N_EXPERTS), 0.01),
        "w_gate": nrm(ks[20], (DEPTH, N_EXPERTS, D_MODEL, EXPERT_FF), D_MODEL ** -0.5),
        "w_up": nrm(ks[21], (DEPTH, N_EXPERTS, D_MODEL, EXPERT_FF), D_MODEL ** -0.5),
        "w_down": nrm(ks[22], (DEPTH, N_EXPERTS, EXPERT_FF, D_MODEL), EXPERT_FF ** -0.5),
        "final_gain": 1.0 + nrm(ks[23], (D_MODEL,), 0.05),
    }


def reference(x, meta_tokens, norm1_gain, w_in, conv_w, conv_b, lru_wa, lru_ba, lru_wx, lru_bx,
              lru_lambda, lru_out_gain, pool_w, pool_scale, w_out, norm2_gain, w_group, b_group,
              w_router, b_router, w_gate, w_up, w_down, final_gain):
    B = x.shape[0]
    meta = jnp.broadcast_to(meta_tokens[None].astype(x.dtype), (B, N_META, D_MODEL))
    h = jnp.concatenate([meta, x], axis=1)
    for l in range(DEPTH):
        hn = rmsnorm(h, norm1_gain[l])
        proj = hn @ w_in[l]
        u_x = proj[..., :LRU_WIDTH]
        u_g = proj[..., LRU_WIDTH:2 * LRU_WIDTH]
        u_p = proj[..., 2 * LRU_WIDTH:]
        y_lru = rmsnorm(rg_lru_group(u_x, u_g, conv_w[l], conv_b[l], lru_wa[l], lru_ba[l],
                                     lru_wx[l], lru_bx[l], lru_lambda[l]), lru_out_gain[l])
        y_pool = rmsnorm(multiscale_pool_group(u_p, pool_w[l]), pool_scale[l])
        y = jnp.concatenate([y_lru, y_pool], axis=-1).astype(h.dtype) @ w_out[l]
        h = h + y
        hn = rmsnorm(h, norm2_gain[l])
        h = h + hierarchical_moe(hn, w_group[l], b_group[l], w_router[l], b_router[l],
                                 w_gate[l], w_up[l], w_down[l])
    h = rmsnorm(h, final_gain)
    return h[:, N_META:, :]
```

```cpp
#include <hip/hip_runtime.h>
#include <cstdio>
#include <cstdint>

#define GAS __attribute__((address_space(1)))
#define LAS __attribute__((address_space(3)))
typedef unsigned short bf16;
typedef short bf16x8 __attribute__((ext_vector_type(8)));
typedef _Float16 f16x8 __attribute__((ext_vector_type(8)));
typedef float f32x4 __attribute__((ext_vector_type(4)));
typedef float f32x2 __attribute__((ext_vector_type(2)));
typedef unsigned u32x4 __attribute__((ext_vector_type(4)));
typedef unsigned u32x2 __attribute__((ext_vector_type(2)));

#ifndef MK_N_LAUNCHES
#define MK_N_LAUNCHES 1
#endif
constexpr int N_PHASES = 9;

constexpr int D = 1024, NBATCH = 8, SEQ = 4096, NMETA = 16, TT = SEQ + NMETA, M = NBATCH * SEQ;
constexpr int LW = 512, INW = 1536, NE = 32, EFF = 512, NROUTE = 36;
constexpr int ECAP = 32768;
constexpr int MAXT = 288;
constexpr int MAXU = 6;
constexpr float RMS_EPS = 1e-6f;

constexpr size_t MiB = 1u << 20;
constexpr size_t WS_CTL = 0, CTL_ZERO_BYTES = 1 * MiB;
constexpr size_t WS_WIN = 2 * MiB, WS_WOUT = 5 * MiB, WS_WA = 7 * MiB, WS_WX = 7 * MiB + 65536, WS_PW = 7 * MiB + 131072, WS_WR = 7 * MiB + 262144;
constexpr size_t WS_AGG = 8 * MiB;
constexpr size_t WS_WGU = 10 * MiB, WS_WD = 74 * MiB, WS_RINFO = 106 * MiB, WS_HN1 = 122 * MiB  ;
constexpr size_t WS_PROJ = 186 * MiB  , WS_HID = 283 * MiB, WS_C = 356 * MiB, WS_END = 484 * MiB;
constexpr int CW_BAR = 4096, CW_CNT = 16384;

constexpr int LDS_BYTES = 147456;
constexpr int MISC_OFF = LDS_BYTES - 256;
constexpr int TAB_OFF = 131072 + 512;
constexpr int TAB_ROW = TAB_OFF;
constexpr int TAB_F = TAB_ROW + MAXU * 256 * 4;
constexpr int TAB_TE = TAB_F + MAXU * 256 * 4;
constexpr int TAB_TR = TAB_TE + MAXT * 4;
constexpr int TAB_CNT = TAB_TR + MAXT * 4;
static_assert(TAB_CNT + 80 * 4 <= MISC_OFF, "LDS map");

__device__ __forceinline__ unsigned f2bf(float f) { unsigned u = __builtin_bit_cast(unsigned, f); return (u + 0x7fffu + ((u >> 16) & 1u)) >> 16; }
__device__ __forceinline__ unsigned pk2(float lo, float hi) { return f2bf(lo) | (f2bf(hi) << 16); }
__device__ __forceinline__ float bf2f(unsigned h) { return __builtin_bit_cast(float, h << 16); }
__device__ __forceinline__ float bflo(unsigned w) { return __builtin_bit_cast(float, w << 16); }
__device__ __forceinline__ float bfhi(unsigned w) { return __builtin_bit_cast(float, w & 0xffff0000u); }
__device__ __forceinline__ float sigmoidf_(float x) { return __builtin_amdgcn_rcpf(1.0f + __expf(-x)); }
#define LDS_WAIT() asm volatile("s_waitcnt lgkmcnt(0)" ::: "memory")

#define XB_TMO      128
#define XB_XCNT(j)  (256  + 64 * (j))
#define XB_XSUB(j)  (1280 + 64 * (j))
#define XB_XGEN(j)  (2304 + 64 * (j))
#define XB_TOP      3328
#define XB_TOPGEN   3392
#define XCD_BAR_WORDS 3456
#define XB_SPIN_CAP (1u << 18)
__device__ __forceinline__ unsigned xb_ld(unsigned* p)              { return __hip_atomic_load(p, __ATOMIC_RELAXED, __HIP_MEMORY_SCOPE_AGENT); }
__device__ __forceinline__ unsigned xb_add(unsigned* p, unsigned v) { return __hip_atomic_fetch_add(p, v, __ATOMIC_RELAXED, __HIP_MEMORY_SCOPE_AGENT); }
__device__ __forceinline__ unsigned xb_xcc_id() { return (unsigned)__builtin_amdgcn_s_getreg((3 << 11) | 20) & 0xFu; }
#define XB_SPIN(cond, bar) do { unsigned _sp = 0; while (cond) { __builtin_amdgcn_s_sleep(1); \
    if ((++_sp & 255u) == 0u) { if (xb_ld(&(bar)[XB_TMO])) break; if (_sp > XB_SPIN_CAP) { atomicAdd(&(bar)[XB_TMO], 1u); break; } } } } while (0)
struct XcdBarrier { unsigned* bar; unsigned x; volatile LAS unsigned* st; };
__device__ __forceinline__ XcdBarrier xcd_barrier_post(unsigned* bar, volatile LAS unsigned* st) {
    XcdBarrier b; b.bar = bar; b.x = xb_xcc_id(); b.st = st;
    if (threadIdx.x == 0) (void)xb_add(&bar[XB_XCNT(b.x)], 1u);
    return b;
}
__device__ __forceinline__ void xcd_barrier_complete(unsigned* bar, unsigned x, unsigned& nloc, unsigned& nx) {
    const unsigned G = gridDim.x * gridDim.y * gridDim.z;
    unsigned sum, cnt, mine, sp = 0u;
    for (;;) {
        sum = 0u; cnt = 0u; mine = 0u;
#pragma unroll
        for (unsigned j = 0; j < 16; ++j) { const unsigned c = xb_ld(&bar[XB_XCNT(j)]); sum += c; cnt += (c > 0u) ? 1u : 0u; mine = (j == x) ? c : mine; }
        if (sum == G) break;
        __builtin_amdgcn_s_sleep(1);
        if ((++sp & 255u) == 0u) { if (xb_ld(&bar[XB_TMO])) break; if (sp > XB_SPIN_CAP) { atomicAdd(&bar[XB_TMO], 1u); break; } }
    }
    nloc = mine > 0u ? mine : 1u; nx = cnt > 0u ? cnt : 1u;
}
__device__ __forceinline__ void xcd_barrier(const XcdBarrier& b) {
    asm volatile("s_waitcnt vmcnt(0)" ::: "memory");
    __syncthreads();
    if (threadIdx.x == 0) {
        unsigned* bar = b.bar;
        __builtin_amdgcn_s_waitcnt(0);
        unsigned nloc = b.st[0], nx = b.st[1];
        if (nloc == 0u) { xcd_barrier_complete(bar, b.x, nloc, nx); b.st[0] = nloc; b.st[1] = nx; }
        const unsigned old = xb_add(&bar[XB_XSUB(b.x)], 1u);
        const unsigned gen = old / nloc;
        if (old + 1u == (gen + 1u) * nloc) {
            __builtin_amdgcn_fence(__ATOMIC_RELEASE, "agent");
            asm volatile("s_waitcnt vmcnt(0)" ::: "memory");
            const unsigned og = xb_add(&bar[XB_TOP], 1u);
            const unsigned tg = og / nx;
            if (og + 1u == (tg + 1u) * nx) xb_add(&bar[XB_TOPGEN], 1u);
            else XB_SPIN(xb_ld(&bar[XB_TOPGEN]) == tg, bar);
            __builtin_amdgcn_fence(__ATOMIC_ACQUIRE, "agent");
            xb_add(&bar[XB_XGEN(b.x)], 1u);
            asm volatile("s_waitcnt vmcnt(0)" ::: "memory");
        } else {
            XB_SPIN(xb_ld(&bar[XB_XGEN(b.x)]) == gen, bar);
            __builtin_amdgcn_fence(__ATOMIC_ACQUIRE, "agent");
            asm volatile("s_waitcnt vmcnt(0)" ::: "memory");
        }
    }
    __syncthreads();
}

namespace pg8 {
constexpr int BM = 256, BK = 64, HALF = 128, HTB = HALF * BK * 2, STAGE_BYTES = 8 * HTB, NXCD = 8, WGM = 8;
__host__ __device__ __forceinline__ int lds_byte(int r, int c) { const int st = (r >> 4) * 2 + (c >> 5), rr = r & 15, cc = c & 31, ob = rr * 64 + cc * 2; return st * 1024 + (ob ^ (((ob >> 9) & 1) << 5)); }
__host__ __device__ __forceinline__ void stage_rc(int b, int& R, int& C) { const int st = b / 1024, sb = b % 1024, swz = sb ^ (((sb >> 9) & 1) << 5); R = (st >> 1) * 16 + swz / 64; C = (st & 1) * 32 + (swz % 64) / 2; }
__host__ __device__ __forceinline__ int perm32(int rho) { const int n = rho >> 4, i = rho & 15; return 8 * (i >> 2) + 4 * n + (i & 3); }
struct Unit { int pm, pn; };
__device__ __forceinline__ bool static_next(int nM, int nN, int G, int c, int i, Unit& u) {
    const int nwg = nM * nN; const long L = (long)i * G + c; if (L >= nwg) return false;
    int wgid = (int)L; { const int q = nwg / NXCD, r = nwg % NXCD, xcd = wgid % NXCD, off = wgid / NXCD; wgid = (xcd < r ? xcd * (q + 1) : r * (q + 1) + (xcd - r) * q) + off; }
    const int nig = WGM * nN, gid = wgid / nig, fm = gid * WGM, gsz = (nM - fm) < WGM ? (nM - fm) : WGM;
    u.pm = fm + ((wgid % nig) % gsz); u.pn = (wgid % nig) / gsz; return true;
}
__device__ __forceinline__ unsigned cvt_pk_bf16(float lo, float hi) { unsigned r; asm volatile("v_cvt_pk_bf16_f32 %0, %1, %2" : "=v"(r) : "v"(lo), "v"(hi)); return r; }

template <class Epi, class Sched>
__device__ __forceinline__ void gemm_phase(LAS unsigned char* lds, const int K, const char* Abase, const Sched& S, const Epi& E) {
    const int tid = threadIdx.x, wid = __builtin_amdgcn_readfirstlane(tid >> 6), lane = tid & 63, wr = wid >> 2, wc = wid & 3, fr = lane & 15, fq = lane >> 4;
    const int nt = K / BK;
    int Rl[2]; unsigned Cb[2], voffB[2];
#pragma unroll
    for (int i = 0; i < 2; ++i) { int R, C; stage_rc(tid * 16 + i * 8192, R, C); const int Rb = Epi::PERM ? ((R & ~31) + perm32(R & 31)) : R;
        Rl[i] = R; Cb[i] = (unsigned)C * 2u; voffB[i] = (unsigned)(Rb * K + C) * 2u; }
    const size_t kstep = (size_t)(BK * 2);
    const size_t hstepB = (size_t)HALF * K * 2;
    const unsigned ldsw = (unsigned)wid * 1024u;
    const int aoff = lds_byte(wr * 64 + fr, fq * 8), boff = lds_byte(wc * 32 + fr, fq * 8);
#define PG8_SA(b, h) (((b) * 2 + (h)) * HTB)
#define PG8_SB(b, h) ((4 + (b) * 2 + (h)) * HTB)
#define PG8_STAGE(bufoff, gbase, voff) do { _Pragma("unroll") for (int _i = 0; _i < 2; ++_i) \
        __builtin_amdgcn_global_load_lds((const unsigned*)((const char*)(gbase) + (voff)[_i]), (LAS unsigned*)(lds + (bufoff) + ldsw + _i * 8192), 16, 0, 0); } while (0)
#define PG8_LDA(dst, b, h) do { _Pragma("unroll") for (int m = 0; m < 4; ++m) _Pragma("unroll") for (int k = 0; k < 2; ++k) dst[m][k] = *(const LAS bf16x8*)(lds + PG8_SA(b, h) + aoff + m * 2048 + k * 1024); } while (0)
#define PG8_LDB(dst, b, h) do { _Pragma("unroll") for (int n = 0; n < 2; ++n) _Pragma("unroll") for (int k = 0; k < 2; ++k) dst[n][k] = *(const LAS bf16x8*)(lds + PG8_SB(b, h) + boff + n * 2048 + k * 1024); } while (0)
#define PG8_MMA(ai, bj, At, Bt) do { __builtin_amdgcn_s_setprio(1); _Pragma("unroll") for (int m = 0; m < 4; ++m) _Pragma("unroll") for (int n = 0; n < 2; ++n) _Pragma("unroll") for (int k = 0; k < 2; ++k) \
        acc[ai][bj][m][n] = __builtin_amdgcn_mfma_f32_16x16x32_bf16(Bt[n][k], At[m][k], acc[ai][bj][m][n], 0, 0, 0); __builtin_amdgcn_s_setprio(0); } while (0)
#define PG8_WAIT_V(n) asm volatile("s_waitcnt vmcnt(" #n ")" ::: "memory")
#define PG8_WAIT_L(n) asm volatile("s_waitcnt lgkmcnt(" #n ")" ::: "memory")
#define PG8_BAR __builtin_amdgcn_s_barrier()
#define PG8_SCHED __builtin_amdgcn_sched_barrier(0)
    Unit cur, nxt; int ui = 0;
    if (!S.next(0, cur)) return;
    f32x4 acc[2][2][4][2];
#pragma unroll
    for (int a = 0; a < 2; ++a)
#pragma unroll
        for (int b = 0; b < 2; ++b)
#pragma unroll
            for (int m = 0; m < 4; ++m)
#pragma unroll
                for (int n = 0; n < 2; ++n) acc[a][b][m][n] = (f32x4){0.f, 0.f, 0.f, 0.f};
    bf16x8 At[4][2], B0[2][2], B1[2][2];
    unsigned cO0[2], cO1[2], nO0[2], nO1[2];
#pragma unroll
    for (int i = 0; i < 2; ++i) { cO0[i] = S.a_off(0, cur, Rl[i]) + Cb[i]; cO1[i] = S.a_off(0, cur, HALF + Rl[i]) + Cb[i]; }
    const char* cB = S.b_base(cur);
    PG8_STAGE(PG8_SB(0, 0), cB, voffB); PG8_STAGE(PG8_SB(0, 1), cB + hstepB, voffB); PG8_STAGE(PG8_SA(0, 0), Abase, cO0); PG8_STAGE(PG8_SA(0, 1), Abase, cO1);
    if (wr == 1) PG8_BAR;
    PG8_WAIT_V(2); PG8_BAR;
    PG8_STAGE(PG8_SB(1, 0), cB + kstep, voffB); PG8_STAGE(PG8_SA(1, 0), Abase + kstep, cO0); PG8_STAGE(PG8_SB(1, 1), cB + hstepB + kstep, voffB);
    PG8_WAIT_V(6); PG8_BAR;
    for (;;) {
        const bool has_next = S.next(ui + 1, nxt);
        const char* nB = cB;
#pragma unroll
        for (int i = 0; i < 2; ++i) { nO0[i] = cO0[i]; nO1[i] = cO1[i]; }
        if (has_next) { nB = S.b_base(nxt);
#pragma unroll
            for (int i = 0; i < 2; ++i) { nO0[i] = S.a_off(ui + 1, nxt, Rl[i]) + Cb[i]; nO1[i] = S.a_off(ui + 1, nxt, HALF + Rl[i]) + Cb[i]; } }
        for (int t = 0; t < nt; t += 2) {
            const bool last = (t == nt - 2);
            const char* a1 = Abase + (size_t)(t + 1) * kstep;
            const char* a2 = last ? Abase : Abase + (size_t)(t + 2) * kstep; const char* b2 = last ? nB : cB + (size_t)(t + 2) * kstep;
            const char* a3 = a2 + kstep; const char* b3 = b2 + kstep;
            unsigned o0[2], o1[2];
#pragma unroll
            for (int i = 0; i < 2; ++i) { o0[i] = last ? nO0[i] : cO0[i]; o1[i] = last ? nO1[i] : cO1[i]; }
            PG8_LDB(B0, 0, 0); PG8_LDB(B1, 0, 1); PG8_SCHED; PG8_LDA(At, 0, 0); PG8_STAGE(PG8_SA(1, 1), a1, cO1);
            PG8_WAIT_V(8); PG8_WAIT_L(0); PG8_BAR; PG8_MMA(0, 0, At, B0); PG8_MMA(0, 1, At, B1); PG8_BAR; PG8_SCHED;
            PG8_LDA(At, 0, 1); PG8_STAGE(PG8_SB(0, 0), b2, voffB); PG8_STAGE(PG8_SB(0, 1), b2 + hstepB, voffB); PG8_STAGE(PG8_SA(0, 0), a2, o0);
            PG8_WAIT_V(8); PG8_WAIT_L(0); PG8_BAR; PG8_MMA(1, 0, At, B0); PG8_MMA(1, 1, At, B1); PG8_BAR; PG8_SCHED;
            PG8_LDB(B0, 1, 0); PG8_LDB(B1, 1, 1); PG8_SCHED; PG8_LDA(At, 1, 0); PG8_STAGE(PG8_SA(0, 1), a2, o1);
            PG8_WAIT_V(8); PG8_WAIT_L(0); PG8_BAR; PG8_MMA(0, 0, At, B0); PG8_MMA(0, 1, At, B1); PG8_BAR; PG8_SCHED;
            PG8_LDA(At, 1, 1); PG8_STAGE(PG8_SB(1, 0), b3, voffB); PG8_STAGE(PG8_SB(1, 1), b3 + hstepB, voffB); PG8_STAGE(PG8_SA(1, 0), a3, o0);
            PG8_WAIT_V(8); PG8_WAIT_L(0); PG8_BAR; PG8_MMA(1, 0, At, B0); PG8_MMA(1, 1, At, B1); PG8_BAR; PG8_SCHED;
        }
        if (wr == 0) PG8_BAR;
        E(acc, cur, ui, wr, wc, fr, fq);
        if (!has_next) break;
#pragma unroll
        for (int a = 0; a < 2; ++a)
#pragma unroll
            for (int b = 0; b < 2; ++b)
#pragma unroll
                for (int m = 0; m < 4; ++m)
#pragma unroll
                    for (int n = 0; n < 2; ++n) acc[a][b][m][n] = (f32x4){0.f, 0.f, 0.f, 0.f};
        cur = nxt; cB = nB; ++ui;
#pragma unroll
        for (int i = 0; i < 2; ++i) { cO0[i] = nO0[i]; cO1[i] = nO1[i]; }
        if (wr == 1) PG8_BAR;
    }
    PG8_WAIT_V(0);
    PG8_BAR;
#undef PG8_SA
#undef PG8_SB
#undef PG8_STAGE
#undef PG8_LDA
#undef PG8_LDB
#undef PG8_MMA
#undef PG8_WAIT_V
#undef PG8_WAIT_L
#undef PG8_BAR
#undef PG8_SCHED
}

struct DenseSched {
    int nM, nN, G, c, K2; const char* B;
    __device__ __forceinline__ bool next(int i, Unit& u) const { return static_next(nM, nN, G, c, i, u); }
    __device__ __forceinline__ const char* b_base(const Unit& u) const { return B + (size_t)u.pn * BM * K2; }
    __device__ __forceinline__ unsigned a_off(int, const Unit& u, int r) const { return (unsigned)(u.pm * BM + r) * (unsigned)K2; }
};
struct MoeSched {
    int NT, nN, G, c, K2; const char* B; size_t estride; bool gather;
    const LAS int* tile_e; const LAS unsigned* rowtab;
    __device__ __forceinline__ bool next(int i, Unit& u) const { return static_next(NT, nN, G, c, i, u); }
    __device__ __forceinline__ const char* b_base(const Unit& u) const { return B + (size_t)tile_e[u.pm] * estride + (size_t)u.pn * BM * K2; }
    __device__ __forceinline__ unsigned a_off(int ui, const Unit& u, int r) const { return gather ? rowtab[ui * 256 + r] : (unsigned)(u.pm * BM + r) * (unsigned)K2; }
};

struct EpiProj {
    static constexpr bool PERM = true;
    bf16* O;
    __device__ __forceinline__ void operator()(const f32x4 (&acc)[2][2][4][2], const Unit& u, int, int wr, int wc, int fr, int fq) const {
        const int row0 = u.pm * BM + 16 * ((u.pm >> 4) + 1) + wr * 64 + fr, col0 = u.pn * BM + wc * 32 + 8 * fq;
#pragma unroll
        for (int ai = 0; ai < 2; ++ai)
#pragma unroll
            for (int m = 0; m < 4; ++m) { bf16* rowp = O + (size_t)(row0 + ai * HALF + m * 16) * INW + col0;
#pragma unroll
                for (int bj = 0; bj < 2; ++bj) { const f32x4 v0 = acc[ai][bj][m][0], v1 = acc[ai][bj][m][1];
                    u32x4 w; w.x = cvt_pk_bf16(v0[0], v0[1]); w.y = cvt_pk_bf16(v0[2], v0[3]); w.z = cvt_pk_bf16(v1[0], v1[1]); w.w = cvt_pk_bf16(v1[2], v1[3]);
                    *(u32x4*)(rowp + bj * HALF) = w; } }
    }
};
struct EpiResid {
    static constexpr bool PERM = false;
    const float* X; float* O;
    __device__ __forceinline__ void operator()(const f32x4 (&acc)[2][2][4][2], const Unit& u, int, int wr, int wc, int fr, int fq) const {
        const int row0 = u.pm * BM + wr * 64 + fr, col0 = u.pn * BM + wc * 32 + 4 * fq;
#pragma unroll
        for (int ai = 0; ai < 2; ++ai)
#pragma unroll
            for (int m = 0; m < 4; ++m) { const size_t off = (size_t)(row0 + ai * HALF + m * 16) * D + col0;
#pragma unroll
                for (int bj = 0; bj < 2; ++bj)
#pragma unroll
                    for (int n = 0; n < 2; ++n) { const f32x4 xv = *(const f32x4*)(X + off + bj * HALF + n * 16); *(f32x4*)(O + off + bj * HALF + n * 16) = acc[ai][bj][m][n] + xv; }
                asm volatile("" ::: "memory"); }
    }
};
struct EpiGateUp {
    static constexpr bool PERM = true;
    bf16* H; const LAS float* rstd;
    __device__ __forceinline__ void operator()(const f32x4 (&acc)[2][2][4][2], const Unit& u, int ui, int wr, int wc, int fr, int fq) const {
        const int r0 = wr * 64 + fr, col0 = u.pn * HALF + wc * 32 + 8 * fq;
#pragma unroll
        for (int ai = 0; ai < 2; ++ai)
#pragma unroll
            for (int m = 0; m < 4; ++m) { const int r = r0 + ai * HALF + m * 16; const float rs = rstd[ui * 256 + r];
                float h[8];
#pragma unroll
                for (int n = 0; n < 2; ++n)
#pragma unroll
                    for (int j = 0; j < 4; ++j) { const float g = acc[ai][0][m][n][j] * rs, up = acc[ai][1][m][n][j] * rs; h[n * 4 + j] = g * sigmoidf_(g) * up; }
                u32x4 w; w.x = cvt_pk_bf16(h[0], h[1]); w.y = cvt_pk_bf16(h[2], h[3]); w.z = cvt_pk_bf16(h[4], h[5]); w.w = cvt_pk_bf16(h[6], h[7]);
                *(u32x4*)(H + (size_t)(u.pm * BM + r) * EFF + col0) = w; }
    }
};
struct EpiDown {
    static constexpr bool PERM = true;
    bf16* C; const LAS int* slot; const LAS float* gate;
    __device__ __forceinline__ void operator()(const f32x4 (&acc)[2][2][4][2], const Unit& u, int ui, int wr, int wc, int fr, int fq) const {
        const int r0 = wr * 64 + fr, col0 = u.pn * BM + wc * 32 + 8 * fq;
#pragma unroll
        for (int ai = 0; ai < 2; ++ai)
#pragma unroll
            for (int m = 0; m < 4; ++m) { const int r = r0 + ai * HALF + m * 16; const int sl = slot[ui * 256 + r]; const float gt = gate[ui * 256 + r];
                if (sl >= 0) { bf16* rowp = C + (size_t)sl * D + col0;
#pragma unroll
                    for (int bj = 0; bj < 2; ++bj) { const f32x4 v0 = acc[ai][bj][m][0] * gt, v1 = acc[ai][bj][m][1] * gt;
                        u32x4 w; w.x = cvt_pk_bf16(v0[0], v0[1]); w.y = cvt_pk_bf16(v0[2], v0[3]); w.z = cvt_pk_bf16(v1[0], v1[1]); w.w = cvt_pk_bf16(v1[2], v1[3]);
                        *(u32x4*)(rowp + bj * HALF) = w; } } }
    }
};
}

struct Frame {
    LAS unsigned char* lds; int tid, lane, wave, G, bx;
    const float *x, *meta, *g1, *w_in, *conv_w, *conv_b, *wa, *ba, *wx, *bx_, *lam, *lru_gain, *pool_w, *pool_scale, *w_out, *g2, *w_group, *b_group, *w_router, *b_router, *w_gate, *w_up, *w_down, *final_gain;
    float* out; unsigned char* ws; unsigned* ctl;
    bf16 *WinT, *WoutT, *WaT, *WxT, *PwT, *WguT, *WdT, *HN1, *YMIX, *PROJ, *HN2, *HID, *C;
    _Float16* WrH; float* AGG; f32x4* RINFO;
};
__device__ __forceinline__ float wave_sum(float v) {
#pragma unroll
    for (int o = 1; o < 64; o <<= 1) v += __shfl_xor(v, o);
    return v;
}

__device__ __forceinline__ void transpose_tile(const float* W, int ldw, int k0, int n0, bf16* WT, int ldt, int drow0, LAS float* scr, int lane) {
#pragma unroll 8
    for (int i = 0; i < 32; ++i) { const int kk = 2 * i + (lane >> 5); scr[kk * 33 + (lane & 31)] = W[(size_t)(k0 + kk) * ldw + n0 + (lane & 31)]; }
    LDS_WAIT(); asm volatile("" ::: "memory");
    const int c = lane & 7;
#pragma unroll
    for (int j = 0; j < 4; ++j) { const int n = (lane >> 3) + 8 * j; const LAS float* s = scr + (8 * c) * 33 + n;
        u32x4 o; o.x = pk2(s[0 * 33], s[1 * 33]); o.y = pk2(s[2 * 33], s[3 * 33]); o.z = pk2(s[4 * 33], s[5 * 33]); o.w = pk2(s[6 * 33], s[7 * 33]);
        *(u32x4*)(WT + (size_t)(drow0 + n) * ldt + k0 + 8 * c) = o; }
    LDS_WAIT(); asm volatile("" ::: "memory");
}
__device__ __forceinline__ void p0_prologue(Frame& F) {
    if (F.bx < INW / 8) {
        LAS float* hnm = (LAS float*)F.lds;
        LAS float* part = (LAS float*)(F.lds + 65536);
        for (int r = F.wave * 2; r < F.wave * 2 + 2; ++r) {
            const f32x4* xr = (const f32x4*)(F.meta + (size_t)r * D) + F.lane; f32x4 v[4]; float s = 0.f;
#pragma unroll
            for (int j = 0; j < 4; ++j) { v[j] = xr[64 * j]; s += (v[j].x * v[j].x + v[j].y * v[j].y) + (v[j].z * v[j].z + v[j].w * v[j].w); }
            const float rstd = rsqrtf(wave_sum(s) * (1.f / D) + RMS_EPS);
#pragma unroll
            for (int j = 0; j < 4; ++j) { const f32x4 g = ((const f32x4*)F.g1)[F.lane + 64 * j]; *(LAS f32x4*)(hnm + r * D + 4 * F.lane + 256 * j) = v[j] * rstd * g; }
        }
        __syncthreads();
        { const int cc = F.tid & 7, ks = F.tid >> 3, col = F.bx * 8 + cc; float a[16];
#pragma unroll
            for (int r = 0; r < 16; ++r) a[r] = 0.f;
            for (int k = ks * 16; k < ks * 16 + 16; ++k) { const float w = F.w_in[(size_t)k * INW + col];
#pragma unroll
                for (int r = 0; r < 16; ++r) a[r] += hnm[r * D + k] * w; }
#pragma unroll
            for (int r = 0; r < 16; ++r) part[(ks * 16 + r) * 8 + cc] = a[r]; }
        __syncthreads();
        if (F.tid < 128) { const int r = F.tid >> 3, cc = F.tid & 7; float s = 0.f;
            for (int ks = 0; ks < 64; ++ks) s += part[(ks * 16 + r) * 8 + cc];
            const bf16 h = (bf16)f2bf(s);
            for (int b = 0; b < NBATCH; ++b) F.PROJ[(size_t)(b * TT + r) * INW + F.bx * 8 + cc] = h; }
        __syncthreads();
    }
    LAS float* scr = (LAS float*)(F.lds + F.wave * 16384);
    const int gw = F.bx * 8 + F.wave, NGW = F.G * 8;
    constexpr int I_IN = 16 * 48, I_OUT = 16 * 32, I_G = NE * 16 * 16, I_D = NE * 8 * 32, I_A = 8 * 2, I_P = 4 * 2 * 4;
    constexpr int NITEMS = I_IN + I_OUT + 2 * I_G + I_D + 2 * I_A + I_P;
    for (int it = gw; it < NITEMS; it += NGW) {
        int r = it;
        if (r < I_IN) { const int kb = r / 48, nb = r % 48; transpose_tile(F.w_in, INW, 64 * kb, 32 * nb, F.WinT, D, 32 * nb, scr, F.lane); continue; } r -= I_IN;
        if (r < I_OUT) { const int kb = r / 32, nb = r % 32; transpose_tile(F.w_out, D, 64 * kb, 32 * nb, F.WoutT, D, 32 * nb, scr, F.lane); continue; } r -= I_OUT;
        if (r < 2 * I_G) { const int up = r >= I_G; if (up) r -= I_G; const int e = r >> 8, kb = (r >> 4) & 15, nb = r & 15, n0 = 32 * nb;
            transpose_tile((up ? F.w_up : F.w_gate) + (size_t)e * D * EFF, EFF, 64 * kb, n0, F.WguT + (size_t)e * 1024 * D, D, (n0 >> 7) * 256 + up * 128 + (n0 & 127), scr, F.lane); continue; } r -= 2 * I_G;
        if (r < I_D) { const int e = r >> 8, kb = (r >> 5) & 7, nb = r & 31; transpose_tile(F.w_down + (size_t)e * EFF * D, D, 64 * kb, 32 * nb, F.WdT + (size_t)e * D * EFF, EFF, 32 * nb, scr, F.lane); continue; } r -= I_D;
        if (r < 2 * I_A) { const int x = r >= I_A; if (x) r -= I_A; const int h = r >> 1, nb = r & 1; transpose_tile((x ? F.wx : F.wa) + (size_t)h * 4096, 64, 0, 32 * nb, (x ? F.WxT : F.WaT) + (size_t)h * 4096, 64, 32 * nb, scr, F.lane); continue; } r -= 2 * I_A;
        { const int g = r >> 3, kb = (r >> 2) & 1, nb = r & 3; transpose_tile(F.pool_w + (size_t)g * 16384, 128, 64 * kb, 32 * nb, F.PwT + (size_t)g * 16384, 128, 32 * nb, scr, F.lane); }
    }
    for (int i = F.bx * 512 + F.tid; i < NROUTE * D; i += F.G * 512) { const int n = i >> 10, k = i & 1023;
        const float w = n < 4 ? F.w_group[k * 4 + n] : F.w_router[k * 32 + (n - 4)]; F.WrH[i] = (_Float16)(w * 256.0f); }
    for (int m = gw; m < M; m += NGW) {
        const f32x4* xr = (const f32x4*)(F.x + (size_t)m * D) + F.lane; f32x4 v[4]; float s = 0.f;
#pragma unroll
        for (int j = 0; j < 4; ++j) { v[j] = xr[64 * j]; s += (v[j].x * v[j].x + v[j].y * v[j].y) + (v[j].z * v[j].z + v[j].w * v[j].w); }
        const float rstd = rsqrtf(wave_sum(s) * (1.f / D) + RMS_EPS);
        u32x2* o8 = (u32x2*)(F.HN1 + (size_t)m * D) + F.lane;
#pragma unroll
        for (int j = 0; j < 4; ++j) { const f32x4 g = ((const f32x4*)F.g1)[F.lane + 64 * j]; const f32x4 y = v[j] * rstd * g; u32x2 w; w.x = pk2(y.x, y.y); w.y = pk2(y.z, y.w); o8[64 * j] = w; }
    }
}

constexpr int XC_STRIDE = 68, UG_STRIDE = 72;
struct LruWave {
    const bf16 *waP, *wxP;
    float ba[4], bxv[4], lam8[4];
    LAS float* cw;
    LAS float* xcT; LAS bf16* ugT;
};
__device__ __forceinline__ void lru_setup(const Frame& F, LruWave& L, LAS unsigned char* wbase) {
    const int hd = F.wave, c16 = F.lane & 15, q = F.lane >> 4;
    L.waP = F.WaT + (size_t)hd * 4096 + (size_t)c16 * 64 + 8 * q; L.wxP = F.WxT + (size_t)hd * 4096 + (size_t)c16 * 64 + 8 * q;
    L.cw = (LAS float*)wbase; L.xcT = (LAS float*)(wbase + 1280); L.ugT = (LAS bf16*)(wbase + 1280 + 16 * XC_STRIDE * 4);
    for (int i = F.lane; i < 320; i += 64) { const int tap = i >> 6, ch = i & 63; L.cw[i] = tap < 4 ? F.conv_w[tap * LW + hd * 64 + ch] : F.conv_b[hd * 64 + ch]; }
#pragma unroll
    for (int nb = 0; nb < 4; ++nb) {
        const int ch = hd * 64 + 16 * nb + c16; L.ba[nb] = F.ba[ch]; L.bxv[nb] = F.bx_[ch];
        const float lm = F.lam[ch]; L.lam8[nb] = 8.0f * (fminf(lm, 0.f) - log1pf(__expf(-fabsf(lm))));
    }
    LDS_WAIT();
}
template <bool WITH_UG>
__device__ __forceinline__ void lru_block_load(const Frame& F, const LruWave& L, int b, int tt0, bf16x8 (&af)[2]) {
    const int hd = F.wave, row = F.lane & 15, q = F.lane >> 4, tt = tt0 + row;
    const bf16* prow = F.PROJ + (size_t)(b * TT + tt) * INW + hd * 64 + 8 * q;
#pragma unroll
    for (int kb = 0; kb < 2; ++kb) {
        float xc[8];
        { const f32x4 c0 = *(const LAS f32x4*)(L.cw + 256 + 32 * kb + 8 * q), c1 = *(const LAS f32x4*)(L.cw + 256 + 32 * kb + 8 * q + 4);
          xc[0] = c0.x; xc[1] = c0.y; xc[2] = c0.z; xc[3] = c0.w; xc[4] = c1.x; xc[5] = c1.y; xc[6] = c1.z; xc[7] = c1.w; }
#pragma unroll
        for (int k = 0; k < 4; ++k) {
            u32x4 u = (u32x4){0u, 0u, 0u, 0u};
            if (tt - 3 + k >= 0) u = *(const u32x4*)(prow + (ptrdiff_t)(k - 3) * INW + 32 * kb);
            const f32x4 w0 = *(const LAS f32x4*)(L.cw + 64 * k + 32 * kb + 8 * q), w1 = *(const LAS f32x4*)(L.cw + 64 * k + 32 * kb + 8 * q + 4);
            xc[0] += w0.x * bflo(u.x); xc[1] += w0.y * bfhi(u.x); xc[2] += w0.z * bflo(u.y); xc[3] += w0.w * bfhi(u.y);
            xc[4] += w1.x * bflo(u.z); xc[5] += w1.y * bfhi(u.z); xc[6] += w1.z * bflo(u.w); xc[7] += w1.w * bfhi(u.w);
        }
        *(LAS f32x4*)(L.xcT + row * XC_STRIDE + 32 * kb + 8 * q) = (f32x4){xc[0], xc[1], xc[2], xc[3]};
        *(LAS f32x4*)(L.xcT + row * XC_STRIDE + 32 * kb + 8 * q + 4) = (f32x4){xc[4], xc[5], xc[6], xc[7]};
        u32x4 p; p.x = pk2(xc[0], xc[1]); p.y = pk2(xc[2], xc[3]); p.z = pk2(xc[4], xc[5]); p.w = pk2(xc[6], xc[7]);
        af[kb] = __builtin_bit_cast(bf16x8, p);
        if (WITH_UG) { const u32x4 g = *(const u32x4*)(prow + LW + 32 * kb); *(LAS u32x4*)(L.ugT + row * UG_STRIDE + 32 * kb + 8 * q) = g; }
    }
    LDS_WAIT();
}
__device__ __forceinline__ void lru_block_gates(const Frame& F, const LruWave& L, const bf16x8 (&af)[2], int nb, float (&a)[4], float (&bb)[4]) {
    const int c16 = F.lane & 15, q = F.lane >> 4;
    f32x4 ra = (f32x4){0.f, 0.f, 0.f, 0.f}, rx = ra;
#pragma unroll
    for (int kb = 0; kb < 2; ++kb) { const bf16x8 wa = *(const bf16x8*)(L.waP + nb * 1024 + kb * 32), wx = *(const bf16x8*)(L.wxP + nb * 1024 + kb * 32);
        ra = __builtin_amdgcn_mfma_f32_16x16x32_bf16(af[kb], wa, ra, 0, 0, 0); rx = __builtin_amdgcn_mfma_f32_16x16x32_bf16(af[kb], wx, rx, 0, 0, 0); }
#pragma unroll
    for (int j = 0; j < 4; ++j) {
        const float xcv = L.xcT[(4 * q + j) * XC_STRIDE + 16 * nb + c16];
        const float r = sigmoidf_(ra[j] + L.ba[nb]), ig = sigmoidf_(rx[j] + L.bxv[nb]);
        const float la = L.lam8[nb] * r, z = 2.0f * la;
        const float om = z > -0.05f ? -z * (1.0f + z * (0.5f + z * (0.16666667f + z * 0.041666667f))) : 1.0f - __expf(z);
        a[j] = __expf(la); bb[j] = sqrtf(om) * (ig * xcv);
    }
}
__device__ __forceinline__ void lru_block_fold(const float (&a)[4], const float (&bb)[4], int lane, float& Ab, float& Bb) {
    float A = a[0], B = bb[0];
#pragma unroll
    for (int j = 1; j < 4; ++j) { B = a[j] * B + bb[j]; A *= a[j]; }
    const int q = lane >> 4;
    { const float Ap = __shfl_up(A, 16), Bp = __shfl_up(B, 16); if (q >= 1) { B = A * Bp + B; A = Ap * A; } }
    { const float Ap = __shfl_up(A, 32), Bp = __shfl_up(B, 32); if (q >= 2) { B = A * Bp + B; A = Ap * A; } }
    Ab = __shfl(A, (lane & 15) + 48); Bb = __shfl(B, (lane & 15) + 48);
}
__device__ __forceinline__ void p2_aggregates(Frame& F) {
    LruWave L; lru_setup(F, L, F.lds + F.wave * 8192);
    for (int ch = F.bx; ch < 256; ch += F.G) {
        const int b = ch >> 5, ci = ch & 31; float Ac[4], Bc[4];
#pragma unroll
        for (int nb = 0; nb < 4; ++nb) { Ac[nb] = 1.f; Bc[nb] = 0.f; }
        for (int blk = (ci == 0 ? -1 : 0); blk < 8; ++blk) {
            const int tt0 = NMETA + 128 * ci + 16 * blk; bf16x8 af[2];
            lru_block_load<false>(F, L, b, tt0, af);
#pragma unroll
            for (int nb = 0; nb < 4; ++nb) { float a[4], bb[4], Ab, Bb; lru_block_gates(F, L, af, nb, a, bb); lru_block_fold(a, bb, F.lane, Ab, Bb); Bc[nb] = Ab * Bc[nb] + Bb; Ac[nb] *= Ab; }
            LDS_WAIT();
        }
        if (F.lane < 16) {
#pragma unroll
            for (int nb = 0; nb < 4; ++nb) *(f32x2*)(F.AGG + ((size_t)ch * LW + F.wave * 64 + 16 * nb + F.lane) * 2) = (f32x2){Ac[nb], Bc[nb]}; }
    }
}

constexpr int YT_STRIDE = 520;
template <int G> __device__ __forceinline__ void pool_group(const Frame& F, const bf16* prow  , LAS bf16* yt  , float (&ssq)[4]) {
    constexpr int W = 2 << G; const int c16 = F.lane & 15, q = F.lane >> 4;
    bf16x8 af[4];
#pragma unroll
    for (int kb = 0; kb < 4; ++kb) {
        const bf16* p = prow + 128 * G + 32 * kb; const u32x4 c = *(const u32x4*)p; float cur[8], s[8];
        cur[0] = bflo(c.x); cur[1] = bfhi(c.x); cur[2] = bflo(c.y); cur[3] = bfhi(c.y); cur[4] = bflo(c.z); cur[5] = bfhi(c.z); cur[6] = bflo(c.w); cur[7] = bfhi(c.w);
#pragma unroll
        for (int j = 0; j < 8; ++j) s[j] = cur[j];
#pragma unroll
        for (int d = 1; d < W; ++d) { const u32x4 u = *(const u32x4*)(p - (ptrdiff_t)d * INW);
            s[0] += bflo(u.x); s[1] += bfhi(u.x); s[2] += bflo(u.y); s[3] += bfhi(u.y); s[4] += bflo(u.z); s[5] += bfhi(u.z); s[6] += bflo(u.w); s[7] += bfhi(u.w);
            if ((d & 3) == 3) asm volatile("" ::: "memory"); }
        float z[8];
#pragma unroll
        for (int j = 0; j < 8; ++j) z[j] = s[j] * (1.0f / W) - cur[j];
        u32x4 pz; pz.x = pk2(z[0], z[1]); pz.y = pk2(z[2], z[3]); pz.z = pk2(z[4], z[5]); pz.w = pk2(z[6], z[7]);
        af[kb] = __builtin_bit_cast(bf16x8, pz);
    }
#pragma unroll 2
    for (int nb = 0; nb < 8; ++nb) {
        f32x4 acc = (f32x4){0.f, 0.f, 0.f, 0.f};
#pragma unroll
        for (int kb = 0; kb < 4; ++kb) { const bf16x8 bfr = *(const bf16x8*)(F.PwT + (size_t)G * 16384 + (size_t)(16 * nb + c16) * 128 + 32 * kb + 8 * q); acc = __builtin_amdgcn_mfma_f32_16x16x32_bf16(af[kb], bfr, acc, 0, 0, 0); }
#pragma unroll
        for (int j = 0; j < 4; ++j) { ssq[j] += acc[j] * acc[j]; yt[(4 * q + j) * YT_STRIDE + 128 * G + 16 * nb + c16] = (bf16)f2bf(acc[j]); }
        asm volatile("" ::: "memory");
    }
}
__device__ __forceinline__ void p3_mixer(Frame& F) {
    LAS bf16* Y = (LAS bf16*)F.lds;
    LAS unsigned char* wbase = F.lds + 66560 + F.wave * 8192;
    LAS float* SSQ = (LAS float*)(F.lds + 66560 + 65536);
    LAS float* RSTD = SSQ + 512;
    LAS float* PRS = (LAS float*)(F.lds + 133120);
    const int c16 = F.lane & 15, q = F.lane >> 4;
    for (int ch = F.bx; ch < 256; ch += F.G) {
        LruWave L; lru_setup(F, L, wbase);
        const int b = ch >> 5, ci = ch & 31; const int m0 = ch * 128;
        float H[4] = {0.f, 0.f, 0.f, 0.f};
        for (int k = 0; k < ci; ++k) {
#pragma unroll
            for (int nb = 0; nb < 4; ++nb) { const f32x2 ab = *(const f32x2*)(F.AGG + ((size_t)(b * 32 + k) * LW + F.wave * 64 + 16 * nb + c16) * 2); H[nb] = ab.x * H[nb] + ab.y; } }
        if (ci == 0) {
            bf16x8 af[2]; lru_block_load<false>(F, L, b, 0, af);
#pragma unroll
            for (int nb = 0; nb < 4; ++nb) { float a[4], bb[4], Ab, Bb; lru_block_gates(F, L, af, nb, a, bb); lru_block_fold(a, bb, F.lane, Ab, Bb); H[nb] = Ab * H[nb] + Bb; }
            LDS_WAIT();
        }
#ifndef P3_NO_LRU
        for (int half = 0; half < 2; ++half) {
            for (int blk = 0; blk < 4; ++blk) {
                const int rb = 16 * blk;
                const int tt0 = NMETA + 128 * ci + 64 * half + rb; bf16x8 af[2];
                lru_block_load<true>(F, L, b, tt0, af);
                float ss[4] = {0.f, 0.f, 0.f, 0.f};
#pragma unroll
                for (int nb = 0; nb < 4; ++nb) {
                    float a[4], bb[4]; lru_block_gates(F, L, af, nb, a, bb);
                    float A = a[0], B = bb[0];
#pragma unroll
                    for (int j = 1; j < 4; ++j) { B = a[j] * B + bb[j]; A *= a[j]; }
                    { const float Ap = __shfl_up(A, 16), Bp = __shfl_up(B, 16); if (q >= 1) { B = A * Bp + B; A = Ap * A; } }
                    { const float Ap = __shfl_up(A, 32), Bp = __shfl_up(B, 32); if (q >= 2) { B = A * Bp + B; A = Ap * A; } }
                    float Ae = __shfl_up(A, 16), Be = __shfl_up(B, 16); if (q == 0) { Ae = 1.f; Be = 0.f; }
                    float h = Ae * H[nb] + Be;
                    const float Hn = __shfl(A, c16 + 48) * H[nb] + __shfl(B, c16 + 48);
#pragma unroll
                    for (int j = 0; j < 4; ++j) {
                        h = a[j] * h + bb[j];
                        const float ug = bf2f(L.ugT[(4 * q + j) * UG_STRIDE + 16 * nb + c16]);
                        const float gl = ug * sigmoidf_(1.5957691216f * (ug + 0.044715f * ug * ug * ug));
                        const float y = h * gl; ss[j] += y * y;
                        Y[(rb + 4 * q + j) * YT_STRIDE + F.wave * 64 + 16 * nb + c16] = (bf16)f2bf(y);
                    }
                    H[nb] = Hn;
                }
#pragma unroll
                for (int j = 0; j < 4; ++j) { float s = ss[j]; s += __shfl_xor(s, 1); s += __shfl_xor(s, 2); s += __shfl_xor(s, 4); s += __shfl_xor(s, 8); if (c16 == 0) SSQ[(rb + 4 * q + j) * 8 + F.wave] = s; }
                LDS_WAIT();
            }
            __syncthreads();
            if (F.tid < 64) { float s = 0.f;
#pragma unroll
                for (int w = 0; w < 8; ++w) s += SSQ[F.tid * 8 + w];
                RSTD[F.tid] = rsqrtf(s * (1.0f / LW) + RMS_EPS); }
            __syncthreads();
#pragma unroll
            for (int s = 0; s < 8; ++s) { const int p = F.tid + 512 * s, row = p >> 6, cp = p & 63; const float rs = RSTD[row];
                const u32x4 v = *(const LAS u32x4*)(Y + row * YT_STRIDE + 8 * cp); const f32x4 g0 = *(const f32x4*)(F.lru_gain + 8 * cp), g1 = *(const f32x4*)(F.lru_gain + 8 * cp + 4);
                u32x4 o; o.x = pk2(bflo(v.x) * rs * g0.x, bfhi(v.x) * rs * g0.y); o.y = pk2(bflo(v.y) * rs * g0.z, bfhi(v.y) * rs * g0.w);
                o.z = pk2(bflo(v.z) * rs * g1.x, bfhi(v.z) * rs * g1.y); o.w = pk2(bflo(v.w) * rs * g1.z, bfhi(v.w) * rs * g1.w);
                *(u32x4*)(F.YMIX + (size_t)(m0 + 64 * half + row) * D + 8 * cp) = o; }
            __syncthreads();
        }
#endif
#ifndef P3_NO_POOL
        {
            const int tt = NMETA + 128 * ci + 16 * F.wave + c16;
            const bf16* prow = F.PROJ + (size_t)(b * TT + tt) * INW + 1024 + 8 * q;
            LAS bf16* yt = Y + (16 * F.wave) * YT_STRIDE; float ssq[4] = {0.f, 0.f, 0.f, 0.f};
            pool_group<0>(F, prow, yt, ssq); pool_group<1>(F, prow, yt, ssq); pool_group<2>(F, prow, yt, ssq); pool_group<3>(F, prow, yt, ssq);
#pragma unroll
            for (int j = 0; j < 4; ++j) { float s = ssq[j]; s += __shfl_xor(s, 1); s += __shfl_xor(s, 2); s += __shfl_xor(s, 4); s += __shfl_xor(s, 8); if (c16 == 0) PRS[F.wave * 16 + 4 * q + j] = rsqrtf(s * (1.0f / 512.0f) + RMS_EPS); }
            LDS_WAIT();
            const f32x4 g0 = *(const f32x4*)(F.pool_scale + 8 * F.lane), g1 = *(const f32x4*)(F.pool_scale + 8 * F.lane + 4);
#pragma unroll 4
            for (int s = 0; s < 16; ++s) { const float rs = PRS[F.wave * 16 + s]; const u32x4 v = *(const LAS u32x4*)(yt + s * YT_STRIDE + 8 * F.lane);
                u32x4 o; o.x = pk2(bflo(v.x) * rs * g0.x, bfhi(v.x) * rs * g0.y); o.y = pk2(bflo(v.y) * rs * g0.z, bfhi(v.y) * rs * g0.w);
                o.z = pk2(bflo(v.z) * rs * g1.x, bfhi(v.z) * rs * g1.y); o.w = pk2(bflo(v.w) * rs * g1.z, bfhi(v.w) * rs * g1.w);
                *(u32x4*)(F.YMIX + (size_t)(m0 + 16 * F.wave + s) * D + LW + 8 * F.lane) = o; }
        }
#endif
        __syncthreads();
    }
}

constexpr int WR_STRIDE = 1032;
__device__ __forceinline__ void p5_route(Frame& F) {
    LAS _Float16* WR = (LAS _Float16*)F.lds;
    LAS float* LG = (LAS float*)(F.lds + 36 * WR_STRIDE * 2) + F.wave * 16 * 40;
    LAS int* LCNT = (LAS int*)(F.lds + 36 * WR_STRIDE * 2 + 8 * 16 * 40 * 4);
    LAS float* G2 = (LAS float*)(LCNT + 64);
    const int c16 = F.lane & 15, q = F.lane >> 4;
    for (int i = F.tid; i < NROUTE * 128; i += 512) { const int n = i >> 7, k8 = i & 127; *(LAS u32x4*)(WR + n * WR_STRIDE + 8 * k8) = *(const u32x4*)(F.WrH + n * D + 8 * k8); }
    for (int i = F.tid; i < D; i += 512) G2[i] = F.g2[i];
    for (int ch = F.bx; ch < 256; ch += F.G) {
        if (F.tid < 64) LCNT[F.tid] = 0;
        __syncthreads();
        const int row = ch * 128 + 16 * F.wave + c16;
        const float* hrow = F.out + (size_t)row * D + 8 * q; bf16* orow = F.HN2 + (size_t)row * D + 8 * q;
        f32x4 acc[3]; float ss = 0.f;
#pragma unroll
        for (int nb = 0; nb < 3; ++nb) acc[nb] = (f32x4){0.f, 0.f, 0.f, 0.f};
#pragma unroll 2
        for (int i = 0; i < 32; ++i) {
            const f32x4 h0 = *(const f32x4*)(hrow + 32 * i), h1 = *(const f32x4*)(hrow + 32 * i + 4);
            const f32x4 g0 = *(const LAS f32x4*)(G2 + 32 * i + 8 * q), g1 = *(const LAS f32x4*)(G2 + 32 * i + 8 * q + 4);
            ss += (h0.x * h0.x + h0.y * h0.y) + (h0.z * h0.z + h0.w * h0.w) + (h1.x * h1.x + h1.y * h1.y) + (h1.z * h1.z + h1.w * h1.w);
            const f32x4 t0 = h0 * g0, t1 = h1 * g1;
            u32x4 p; p.x = pk2(t0.x, t0.y); p.y = pk2(t0.z, t0.w); p.z = pk2(t1.x, t1.y); p.w = pk2(t1.z, t1.w);
            *(u32x4*)(orow + 32 * i) = p;
            f16x8 a; a[0] = (_Float16)t0.x; a[1] = (_Float16)t0.y; a[2] = (_Float16)t0.z; a[3] = (_Float16)t0.w; a[4] = (_Float16)t1.x; a[5] = (_Float16)t1.y; a[6] = (_Float16)t1.z; a[7] = (_Float16)t1.w;
#pragma unroll
            for (int nb = 0; nb < 3; ++nb) { const int col = 16 * nb + c16; f16x8 bw;
#pragma unroll
                for (int j = 0; j < 8; ++j) bw[j] = (_Float16)0.f;
                if (col < NROUTE) bw = *(const LAS f16x8*)(WR + col * WR_STRIDE + 32 * i + 8 * q);
                acc[nb] = __builtin_amdgcn_mfma_f32_16x16x32_f16(a, bw, acc[nb], 0, 0, 0); }
        }
        ss += __shfl_xor(ss, 16); ss += __shfl_xor(ss, 32);
        const float rstd = rsqrtf(ss * (1.0f / D) + RMS_EPS);
#pragma unroll
        for (int nb = 0; nb < 3; ++nb)
#pragma unroll
            for (int j = 0; j < 4; ++j) { const int col = 16 * nb + c16; if (col < 40) LG[(4 * q + j) * 40 + col] = acc[nb][j]; }
        LDS_WAIT();
        int e0 = 0, e1 = 0, rk0 = 0, rk1 = 0; float gt0 = 0.f, gt1 = 0.f;
        if (F.lane < 16) {
            const LAS float* lg = LG + F.lane * 40; const float sc = rstd * (1.0f / 256.0f);
            float gl[4]; int gi = 0;
#pragma unroll
            for (int j = 0; j < 4; ++j) gl[j] = lg[j] * sc + F.b_group[j];
            float gm = gl[0];
#pragma unroll
            for (int j = 1; j < 4; ++j) if (gl[j] > gm) { gm = gl[j]; gi = j; }
            float den = 0.f;
#pragma unroll
            for (int j = 0; j < 4; ++j) den += __expf(gl[j] - gm);
            const float pg = 1.0f / den;
            float v0 = -3.0e38f, v1 = -3.0e38f; int i0 = 0, i1 = 0;
            for (int j = 0; j < 8; ++j) { const float v = lg[4 + gi * 8 + j] * sc + F.b_router[gi * 8 + j];
                if (v > v0) { v1 = v0; i1 = i0; v0 = v; i0 = j; } else if (v > v1) { v1 = v; i1 = j; } }
            const float ex = __expf(v1 - v0), s0 = 1.0f / (1.0f + ex);
            gt0 = pg * s0; gt1 = pg * (ex * s0); e0 = gi * 8 + i0; e1 = gi * 8 + i1;
            rk0 = __hip_atomic_fetch_add(&LCNT[e0], 1, __ATOMIC_RELAXED, __HIP_MEMORY_SCOPE_WORKGROUP); rk1 = __hip_atomic_fetch_add(&LCNT[e1], 1, __ATOMIC_RELAXED, __HIP_MEMORY_SCOPE_WORKGROUP);
        }
        __syncthreads();
        if (F.tid < 32) LCNT[32 + F.tid] = (int)__hip_atomic_fetch_add(F.ctl + CW_CNT + 64 * F.tid, (unsigned)LCNT[F.tid], __ATOMIC_RELAXED, __HIP_MEMORY_SCOPE_AGENT);
        __syncthreads();
        if (F.lane < 16) { const int tok = ch * 128 + 16 * F.wave + F.lane;
            F.RINFO[(size_t)e0 * ECAP + LCNT[32 + e0] + rk0] = (f32x4){__builtin_bit_cast(float, tok * 2), gt0, rstd, 0.f};
            F.RINFO[(size_t)e1 * ECAP + LCNT[32 + e1] + rk1] = (f32x4){__builtin_bit_cast(float, tok * 2 + 1), gt1, rstd, 0.f}; }
        __syncthreads();
    }
}

__device__ __forceinline__ int moe_tables(Frame& F) {
    LAS int* TE = (LAS int*)(F.lds + TAB_TE); LAS int* TR = (LAS int*)(F.lds + TAB_TR); LAS int* CNT = (LAS int*)(F.lds + TAB_CNT); LAS int* PRE = CNT + 32;
    if (F.tid < 32) CNT[F.tid] = (int)__hip_atomic_load(F.ctl + CW_CNT + 64 * F.tid, __ATOMIC_RELAXED, __HIP_MEMORY_SCOPE_AGENT);
    __syncthreads();
    if (F.tid == 0) { int s = 0; for (int e = 0; e < NE; ++e) { PRE[e] = s; s += (CNT[e] + 255) >> 8; } PRE[NE] = s; }
    __syncthreads();
    const int NT = PRE[NE];
    for (int t = F.tid; t < NT; t += 512) { int e = 0; while (e < NE - 1 && PRE[e + 1] <= t) ++e; TE[t] = e; TR[t] = (t - PRE[e]) * 256; }
    __syncthreads();
    return NT;
}
__device__ __forceinline__ void moe_unit_tables(Frame& F, const pg8::MoeSched& S, int mode) {
    LAS int* TE = (LAS int*)(F.lds + TAB_TE); LAS int* TR = (LAS int*)(F.lds + TAB_TR); LAS int* CNT = (LAS int*)(F.lds + TAB_CNT);
    LAS unsigned* ROW = (LAS unsigned*)(F.lds + TAB_ROW); LAS float* FT = (LAS float*)(F.lds + TAB_F);
    pg8::Unit u;
    for (int i = 0; i < MAXU && S.next(i, u); ++i) {
        if (F.tid < 256) { const int e = TE[u.pm], pos = TR[u.pm] + F.tid; const bool valid = pos < CNT[e];
            f32x4 ri = (f32x4){0.f, 0.f, 0.f, 0.f}; if (valid) ri = F.RINFO[(size_t)e * ECAP + pos];
            const int slot = __builtin_bit_cast(int, ri.x);
            if (mode == 0) { ROW[i * 256 + F.tid] = valid ? (unsigned)(slot >> 1) * (unsigned)(D * 2) : 0u; FT[i * 256 + F.tid] = valid ? ri.z : 0.f; }
            else { ROW[i * 256 + F.tid] = valid ? (unsigned)slot : 0xffffffffu; FT[i * 256 + F.tid] = ri.y; } }
    }
    __syncthreads();
}

__device__ __forceinline__ void p8_final(Frame& F) {
    const int gw = F.bx * 8 + F.wave, NGW = F.G * 8;
    for (int m = gw; m < M; m += NGW) {
        f32x4* hr = (f32x4*)(F.out + (size_t)m * D) + F.lane; const u32x2* c0 = (const u32x2*)(F.C + (size_t)(2 * m) * D) + F.lane; const u32x2* c1 = (const u32x2*)(F.C + (size_t)(2 * m + 1) * D) + F.lane;
        f32x4 v[4]; float s = 0.f;
#pragma unroll
        for (int j = 0; j < 4; ++j) { const f32x4 h = hr[64 * j]; const u32x2 a = c0[64 * j], b = c1[64 * j];
            v[j] = (f32x4){h.x + (bflo(a.x) + bflo(b.x)), h.y + (bfhi(a.x) + bfhi(b.x)), h.z + (bflo(a.y) + bflo(b.y)), h.w + (bfhi(a.y) + bfhi(b.y))};
            s += (v[j].x * v[j].x + v[j].y * v[j].y) + (v[j].z * v[j].z + v[j].w * v[j].w); }
        const float rstd = rsqrtf(wave_sum(s) * (1.f / D) + RMS_EPS);
#pragma unroll
        for (int j = 0; j < 4; ++j) { const f32x4 g = ((const f32x4*)F.final_gain)[F.lane + 64 * j]; hr[64 * j] = v[j] * rstd * g; }
    }
}

struct Args { const float* in[24]; float* out; unsigned char* ws; int ph_lo, ph_hi; };
__global__ void __launch_bounds__(512, 2) hymba_fwd(Args args) {
    extern __shared__ __attribute__((aligned(16))) unsigned char lds[];
    Frame F;
    F.lds = (LAS unsigned char*)lds; F.tid = threadIdx.x; F.lane = F.tid & 63; F.wave = __builtin_amdgcn_readfirstlane(F.tid >> 6); F.G = gridDim.x; F.bx = blockIdx.x;
    F.x = args.in[0]; F.meta = args.in[1]; F.g1 = args.in[2]; F.w_in = args.in[3]; F.conv_w = args.in[4]; F.conv_b = args.in[5]; F.wa = args.in[6]; F.ba = args.in[7]; F.wx = args.in[8]; F.bx_ = args.in[9];
    F.lam = args.in[10]; F.lru_gain = args.in[11]; F.pool_w = args.in[12]; F.pool_scale = args.in[13]; F.w_out = args.in[14]; F.g2 = args.in[15]; F.w_group = args.in[16]; F.b_group = args.in[17];
    F.w_router = args.in[18]; F.b_router = args.in[19]; F.w_gate = args.in[20]; F.w_up = args.in[21]; F.w_down = args.in[22]; F.final_gain = args.in[23];
    F.out = args.out; F.ws = args.ws; F.ctl = (unsigned*)(args.ws + WS_CTL);
    unsigned char* ws = args.ws;
    F.WinT = (bf16*)(ws + WS_WIN); F.WoutT = (bf16*)(ws + WS_WOUT); F.WaT = (bf16*)(ws + WS_WA); F.WxT = (bf16*)(ws + WS_WX); F.PwT = (bf16*)(ws + WS_PW); F.WrH = (_Float16*)(ws + WS_WR);
    F.AGG = (float*)(ws + WS_AGG); F.WguT = (bf16*)(ws + WS_WGU); F.WdT = (bf16*)(ws + WS_WD); F.RINFO = (f32x4*)(ws + WS_RINFO); F.HN1 = (bf16*)(ws + WS_HN1); F.YMIX = (bf16*)(ws + WS_HN1);
    F.PROJ = (bf16*)(ws + WS_PROJ); F.HN2 = (bf16*)(ws + WS_PROJ); F.HID = (bf16*)(ws + WS_HID); F.C = (bf16*)(ws + WS_C);
    volatile LAS unsigned* MISC = (volatile LAS unsigned*)(F.lds + MISC_OFF);
    if (F.tid < 64) MISC[F.tid] = 0u;
    __syncthreads();
    XcdBarrier bar; bar.bar = F.ctl + CW_BAR; bar.x = 0; bar.st = nullptr;
    if (MK_N_LAUNCHES == 1) bar = xcd_barrier_post(F.ctl + CW_BAR, MISC + 8);
    const int lo = args.ph_lo, hi = args.ph_hi;
#ifndef PH_MASK
#define PH_MASK 0x1ff
#endif
#define IN(k) (((PH_MASK >> (k)) & 1) && lo <= (k) && (k) < hi)
#define SEAM(k) do { if (IN(k) && IN((k) + 1)) xcd_barrier(bar); } while (0)

    if (IN(0)) { p0_prologue(F); } SEAM(0);
    if (IN(1)) { pg8::DenseSched S{M / 256, INW / 256, F.G, F.bx, D * 2, (const char*)F.WinT}; pg8::EpiProj E{F.PROJ};
        pg8::gemm_phase(F.lds, D, (const char*)F.HN1, S, E); } SEAM(1);
    if (IN(2)) { p2_aggregates(F); } SEAM(2);
    if (IN(3)) { p3_mixer(F); } SEAM(3);
    if (IN(4)) { pg8::DenseSched S{M / 256, D / 256, F.G, F.bx, D * 2, (const char*)F.WoutT}; pg8::EpiResid E{F.x, F.out};
        pg8::gemm_phase(F.lds, D, (const char*)F.YMIX, S, E); } SEAM(4);
    if (IN(5)) { p5_route(F); } SEAM(5);
    if (IN(6)) { const int NT = moe_tables(F);
        pg8::MoeSched S{NT, 4, F.G, F.bx, D * 2, (const char*)F.WguT, (size_t)1024 * D * 2, true, (const LAS int*)(F.lds + TAB_TE), (const LAS unsigned*)(F.lds + TAB_ROW)};
        moe_unit_tables(F, S, 0);
        pg8::EpiGateUp E{F.HID, (const LAS float*)(F.lds + TAB_F)};
        pg8::gemm_phase(F.lds, D, (const char*)F.HN2, S, E); } SEAM(6);
    if (IN(7)) { const int NT = moe_tables(F);
        pg8::MoeSched S{NT, 4, F.G, F.bx, EFF * 2, (const char*)F.WdT, (size_t)D * EFF * 2, false, (const LAS int*)(F.lds + TAB_TE), (const LAS unsigned*)(F.lds + TAB_ROW)};
        moe_unit_tables(F, S, 1);
        pg8::EpiDown E{F.C, (const LAS int*)(F.lds + TAB_ROW), (const LAS float*)(F.lds + TAB_F)};
        pg8::gemm_phase(F.lds, EFF, (const char*)F.HID, S, E); } SEAM(7);
    if (IN(8)) { p8_final(F); }
#undef IN
#undef SEAM
}

extern "C" void kernel_launch(void* const* d_in, const int* in_sizes, int n_in, void* d_out, int out_size, void* d_ws, size_t ws_size, hipStream_t stream) {
    static int grid = 0;
    if (grid == 0) {
        if (n_in != 24 || in_sizes[0] != M * D || out_size != M * D || ws_size < WS_END) { fprintf(stderr, "kernel_launch: unexpected shapes (n_in %d, in0 %d, out %d, ws %zu)\n", n_in, n_in > 0 ? in_sizes[0] : -1, out_size, ws_size); grid = -1; return; }
        int dev = 0, cus = 0, per_cu = 0;
        if (hipGetDevice(&dev) != hipSuccess || hipDeviceGetAttribute(&cus, hipDeviceAttributeMultiprocessorCount, dev) != hipSuccess) { grid = -1; return; }
        if (hipFuncSetAttribute((const void*)hymba_fwd, hipFuncAttributeMaxDynamicSharedMemorySize, LDS_BYTES) != hipSuccess) { fprintf(stderr, "kernel_launch: hipFuncSetAttribute failed\n"); grid = -1; return; }
        if (hipOccupancyMaxActiveBlocksPerMultiprocessor(&per_cu, (const void*)hymba_fwd, 512, LDS_BYTES) != hipSuccess || per_cu < 1) fprintf(stderr, "kernel_launch: occupancy query says %d\n", per_cu);
        (void)hipGetLastError();
        grid = cus;
    }
    if (grid < 0) return;
    if (hipMemsetAsync((char*)d_ws + WS_CTL, 0, CTL_ZERO_BYTES, stream) != hipSuccess) return;
    Args a{};
    for (int i = 0; i < 24; ++i) a.in[i] = (const float*)d_in[i];
    a.out = (float*)d_out; a.ws = (unsigned char*)d_ws;
    if (MK_N_LAUNCHES == 1) { a.ph_lo = 0; a.ph_hi = N_PHASES; hipLaunchKernelGGL(hymba_fwd, dim3(grid), dim3(512), LDS_BYTES, stream, a); }
    else for (int p = 0; p < N_PHASES; ++p) { a.ph_lo = p; a.ph_hi = p + 1; hipLaunchKernelGGL(hymba_fwd, dim3(grid), dim3(512), LDS_BYTES, stream, a); }
}
```

```cpp
#include <hip/hip_runtime.h>
#include <cstdio>
#include <cstdint>

#define GAS __attribute__((address_space(1)))
#define LAS __attribute__((address_space(3)))
typedef unsigned short bf16;
typedef short bf16x8 __attribute__((ext_vector_type(8)));
typedef _Float16 f16x8 __attribute__((ext_vector_type(8)));
typedef float f32x4 __attribute__((ext_vector_type(4)));
typedef float f32x2 __attribute__((ext_vector_type(2)));
typedef unsigned u32x4 __attribute__((ext_vector_type(4)));
typedef unsigned u32x2 __attribute__((ext_vector_type(2)));

#ifndef MK_N_LAUNCHES
#define MK_N_LAUNCHES 1
#endif
constexpr int N_PHASES = 9;

constexpr int D = 1024, NBATCH = 8, SEQ = 4096, NMETA = 16, TT = SEQ + NMETA, M = NBATCH * SEQ;
constexpr int LW = 512, INW = 1536, NE = 32, EFF = 512, NROUTE = 36;
constexpr int ECAP = 32768;
constexpr int MAXT = 288;
constexpr int MAXU = 6;
constexpr float RMS_EPS = 1e-6f;

constexpr size_t MiB = 1u << 20;
constexpr size_t WS_CTL = 0, CTL_ZERO_BYTES = 1 * MiB;
constexpr size_t WS_WIN = 2 * MiB, WS_WOUT = 5 * MiB, WS_WA = 7 * MiB, WS_WX = 7 * MiB + 65536, WS_PW = 7 * MiB + 131072, WS_WR = 7 * MiB + 262144;
constexpr size_t WS_AGG = 8 * MiB;
constexpr size_t WS_WGU = 10 * MiB  , WS_WD = 42 * MiB  , WS_RINFO = 58 * MiB, WS_HN1 = 74 * MiB  ;
constexpr size_t WS_PROJ = 138 * MiB  , WS_HID = 235 * MiB  , WS_C = 272 * MiB, WS_END = 400 * MiB;
constexpr float WGU_SCALE = 64.f, WD_SCALE = 32.f, HID_SCALE = 8.f;
constexpr int CW_BAR = 4096, CW_CNT = 16384;

constexpr int LDS_BYTES = 147456;
constexpr int MISC_OFF = LDS_BYTES - 256;
constexpr int TAB_OFF = 131072 + 512;
constexpr int TAB_ROW = TAB_OFF;
constexpr int TAB_F = TAB_ROW + MAXU * 256 * 4;
constexpr int TAB_TE = TAB_F + MAXU * 256 * 4;
constexpr int TAB_TR = TAB_TE + MAXT * 4;
constexpr int TAB_CNT = TAB_TR + MAXT * 4;
static_assert(TAB_CNT + 80 * 4 <= MISC_OFF, "LDS map");

__device__ __forceinline__ unsigned f2bf(float f) { unsigned u = __builtin_bit_cast(unsigned, f); return (u + 0x7fffu + ((u >> 16) & 1u)) >> 16; }
__device__ __forceinline__ unsigned pk2(float lo, float hi) { return f2bf(lo) | (f2bf(hi) << 16); }
__device__ __forceinline__ float bf2f(unsigned h) { return __builtin_bit_cast(float, h << 16); }
__device__ __forceinline__ float bflo(unsigned w) { return __builtin_bit_cast(float, w << 16); }
__device__ __forceinline__ float bfhi(unsigned w) { return __builtin_bit_cast(float, w & 0xffff0000u); }
__device__ __forceinline__ float sigmoidf_(float x) { return __builtin_amdgcn_rcpf(1.0f + __expf(-x)); }
#define LDS_WAIT() asm volatile("s_waitcnt lgkmcnt(0)" ::: "memory")
typedef int i32x4 __attribute__((ext_vector_type(4)));
typedef int i32x8 __attribute__((ext_vector_type(8)));
__device__ __forceinline__ float clamp448(float v) { return fminf(fmaxf(v, -448.f), 448.f); }
__device__ __forceinline__ unsigned pk4_fp8(float a, float b, float c, float d) {
    int v = __builtin_amdgcn_cvt_pk_fp8_f32(a, b, 0, false); v = __builtin_amdgcn_cvt_pk_fp8_f32(c, d, v, true); return (unsigned)v; }

#define XB_TMO      128
#define XB_XCNT(j)  (256  + 64 * (j))
#define XB_XSUB(j)  (1280 + 64 * (j))
#define XB_XGEN(j)  (2304 + 64 * (j))
#define XB_TOP      3328
#define XB_TOPGEN   3392
#define XCD_BAR_WORDS 3456
#define XB_SPIN_CAP (1u << 18)
__device__ __forceinline__ unsigned xb_ld(unsigned* p)              { return __hip_atomic_load(p, __ATOMIC_RELAXED, __HIP_MEMORY_SCOPE_AGENT); }
__device__ __forceinline__ unsigned xb_add(unsigned* p, unsigned v) { return __hip_atomic_fetch_add(p, v, __ATOMIC_RELAXED, __HIP_MEMORY_SCOPE_AGENT); }
__device__ __forceinline__ unsigned xb_xcc_id() { return (unsigned)__builtin_amdgcn_s_getreg((3 << 11) | 20) & 0xFu; }
#define XB_SPIN(cond, bar) do { unsigned _sp = 0; while (cond) { __builtin_amdgcn_s_sleep(1); \
    if ((++_sp & 255u) == 0u) { if (xb_ld(&(bar)[XB_TMO])) break; if (_sp > XB_SPIN_CAP) { atomicAdd(&(bar)[XB_TMO], 1u); break; } } } } while (0)
struct XcdBarrier { unsigned* bar; unsigned x; volatile LAS unsigned* st; };
__device__ __forceinline__ XcdBarrier xcd_barrier_post(unsigned* bar, volatile LAS unsigned* st) {
    XcdBarrier b; b.bar = bar; b.x = xb_xcc_id(); b.st = st;
    if (threadIdx.x == 0) (void)xb_add(&bar[XB_XCNT(b.x)], 1u);
    return b;
}
__device__ __forceinline__ void xcd_barrier_complete(unsigned* bar, unsigned x, unsigned& nloc, unsigned& nx) {
    const unsigned G = gridDim.x * gridDim.y * gridDim.z;
    unsigned sum, cnt, mine, sp = 0u;
    for (;;) {
        sum = 0u; cnt = 0u; mine = 0u;
#pragma unroll
        for (unsigned j = 0; j < 16; ++j) { const unsigned c = xb_ld(&bar[XB_XCNT(j)]); sum += c; cnt += (c > 0u) ? 1u : 0u; mine = (j == x) ? c : mine; }
        if (sum == G) break;
        __builtin_amdgcn_s_sleep(1);
        if ((++sp & 255u) == 0u) { if (xb_ld(&bar[XB_TMO])) break; if (sp > XB_SPIN_CAP) { atomicAdd(&bar[XB_TMO], 1u); break; } }
    }
    nloc = mine > 0u ? mine : 1u; nx = cnt > 0u ? cnt : 1u;
}
__device__ __forceinline__ void xcd_barrier(const XcdBarrier& b) {
    asm volatile("s_waitcnt vmcnt(0)" ::: "memory");
    __syncthreads();
    if (threadIdx.x == 0) {
        unsigned* bar = b.bar;
        __builtin_amdgcn_s_waitcnt(0);
        unsigned nloc = b.st[0], nx = b.st[1];
        if (nloc == 0u) { xcd_barrier_complete(bar, b.x, nloc, nx); b.st[0] = nloc; b.st[1] = nx; }
        const unsigned old = xb_add(&bar[XB_XSUB(b.x)], 1u);
        const unsigned gen = old / nloc;
        if (old + 1u == (gen + 1u) * nloc) {
            __builtin_amdgcn_fence(__ATOMIC_RELEASE, "agent");
            asm volatile("s_waitcnt vmcnt(0)" ::: "memory");
            const unsigned og = xb_add(&bar[XB_TOP], 1u);
            const unsigned tg = og / nx;
            if (og + 1u == (tg + 1u) * nx) xb_add(&bar[XB_TOPGEN], 1u);
            else XB_SPIN(xb_ld(&bar[XB_TOPGEN]) == tg, bar);
            __builtin_amdgcn_fence(__ATOMIC_ACQUIRE, "agent");
            xb_add(&bar[XB_XGEN(b.x)], 1u);
            asm volatile("s_waitcnt vmcnt(0)" ::: "memory");
        } else {
            XB_SPIN(xb_ld(&bar[XB_XGEN(b.x)]) == gen, bar);
            __builtin_amdgcn_fence(__ATOMIC_ACQUIRE, "agent");
            asm volatile("s_waitcnt vmcnt(0)" ::: "memory");
        }
    }
    __syncthreads();
}

namespace pg8 {
constexpr int BM = 256, BK = 64, HALF = 128, HTB = HALF * BK * 2, STAGE_BYTES = 8 * HTB, NXCD = 8, WGM = 8;
__host__ __device__ __forceinline__ int lds_byte(int r, int c) { const int st = (r >> 4) * 2 + (c >> 5), rr = r & 15, cc = c & 31, ob = rr * 64 + cc * 2; return st * 1024 + (ob ^ (((ob >> 9) & 1) << 5)); }
__host__ __device__ __forceinline__ void stage_rc(int b, int& R, int& C) { const int st = b / 1024, sb = b % 1024, swz = sb ^ (((sb >> 9) & 1) << 5); R = (st >> 1) * 16 + swz / 64; C = (st & 1) * 32 + (swz % 64) / 2; }
__host__ __device__ __forceinline__ int perm32(int rho) { const int n = rho >> 4, i = rho & 15; return 8 * (i >> 2) + 4 * n + (i & 3); }
struct Unit { int pm, pn; };
__device__ __forceinline__ bool static_next(int nM, int nN, int G, int c, int i, Unit& u) {
    const int nwg = nM * nN; const long L = (long)i * G + c; if (L >= nwg) return false;
    int wgid = (int)L; { const int q = nwg / NXCD, r = nwg % NXCD, xcd = wgid % NXCD, off = wgid / NXCD; wgid = (xcd < r ? xcd * (q + 1) : r * (q + 1) + (xcd - r) * q) + off; }
    const int nig = WGM * nN, gid = wgid / nig, fm = gid * WGM, gsz = (nM - fm) < WGM ? (nM - fm) : WGM;
    u.pm = fm + ((wgid % nig) % gsz); u.pn = (wgid % nig) / gsz; return true;
}
__device__ __forceinline__ unsigned cvt_pk_bf16(float lo, float hi) { unsigned r; asm volatile("v_cvt_pk_bf16_f32 %0, %1, %2" : "=v"(r) : "v"(lo), "v"(hi)); return r; }

template <class Epi, class Sched, bool FP8 = false>
__device__ __forceinline__ void gemm_phase(LAS unsigned char* lds, const int KB, const char* Abase, const Sched& S, const Epi& E) {
    const int tid = threadIdx.x, wid = __builtin_amdgcn_readfirstlane(tid >> 6), lane = tid & 63, wr = wid >> 2, wc = wid & 3, fr = lane & 15, fq = lane >> 4;
    const int nt = KB / (BK * 2);
    int Rl[2]; unsigned Cb[2], voffB[2];
#pragma unroll
    for (int i = 0; i < 2; ++i) { int R, C; stage_rc(tid * 16 + i * 8192, R, C); const int Rb = Epi::PERM ? ((R & ~31) + perm32(R & 31)) : R;
        Rl[i] = R; Cb[i] = (unsigned)C * 2u; voffB[i] = (unsigned)(Rb * KB + C * 2); }
    const size_t kstep = (size_t)(BK * 2);
    const size_t hstepB = (size_t)HALF * KB;
    const unsigned ldsw = (unsigned)wid * 1024u;
    const int aoff = lds_byte(wr * 64 + fr, fq * 8), boff = lds_byte(wc * 32 + fr, fq * 8);
#define PG8_SA(b, h) (((b) * 2 + (h)) * HTB)
#define PG8_SB(b, h) ((4 + (b) * 2 + (h)) * HTB)
#define PG8_STAGE(bufoff, gbase, voff) do { _Pragma("unroll") for (int _i = 0; _i < 2; ++_i) \
        __builtin_amdgcn_global_load_lds((const unsigned*)((const char*)(gbase) + (voff)[_i]), (LAS unsigned*)(lds + (bufoff) + ldsw + _i * 8192), 16, 0, 0); } while (0)
#define PG8_LD32(p) __builtin_shufflevector(*(const LAS i32x4*)(p), *(const LAS i32x4*)((p) + 1024), 0, 1, 2, 3, 4, 5, 6, 7)
#define PG8_LDA(dst, b, h) do { _Pragma("unroll") for (int m = 0; m < 4; ++m) dst[m] = PG8_LD32(lds + PG8_SA(b, h) + aoff + m * 2048); } while (0)
#define PG8_LDB(dst, b, h) do { _Pragma("unroll") for (int n = 0; n < 2; ++n) dst[n] = PG8_LD32(lds + PG8_SB(b, h) + boff + n * 2048); } while (0)
#define PG8_LO(v) __builtin_bit_cast(bf16x8, __builtin_shufflevector((v), (v), 0, 1, 2, 3))
#define PG8_HI(v) __builtin_bit_cast(bf16x8, __builtin_shufflevector((v), (v), 4, 5, 6, 7))
#define PG8_MMA(ai, bj, At, Bt) do { __builtin_amdgcn_s_setprio(1); _Pragma("unroll") for (int m = 0; m < 4; ++m) _Pragma("unroll") for (int n = 0; n < 2; ++n) { \
        if constexpr (FP8) asm volatile("v_mfma_f32_16x16x128_f8f6f4 %0, %1, %2, %0" : "+v"(acc[ai][bj][m][n]) : "v"(Bt[n]), "v"(At[m])); \
        else { acc[ai][bj][m][n] = __builtin_amdgcn_mfma_f32_16x16x32_bf16(PG8_LO(Bt[n]), PG8_LO(At[m]), acc[ai][bj][m][n], 0, 0, 0); \
               acc[ai][bj][m][n] = __builtin_amdgcn_mfma_f32_16x16x32_bf16(PG8_HI(Bt[n]), PG8_HI(At[m]), acc[ai][bj][m][n], 0, 0, 0); } } \
        __builtin_amdgcn_s_setprio(0); } while (0)
#define PG8_WAIT_V(n) asm volatile("s_waitcnt vmcnt(" #n ")" ::: "memory")
#define PG8_WAIT_L(n) asm volatile("s_waitcnt lgkmcnt(" #n ")" ::: "memory")
#define PG8_BAR __builtin_amdgcn_s_barrier()
#define PG8_SCHED __builtin_amdgcn_sched_barrier(0)
    Unit cur, nxt; int ui = 0;
    if (!S.next(0, cur)) return;
    f32x4 acc[2][2][4][2];
#pragma unroll
    for (int a = 0; a < 2; ++a)
#pragma unroll
        for (int b = 0; b < 2; ++b)
#pragma unroll
            for (int m = 0; m < 4; ++m)
#pragma unroll
                for (int n = 0; n < 2; ++n) acc[a][b][m][n] = (f32x4){0.f, 0.f, 0.f, 0.f};
    i32x8 At[4], B0[2], B1[2];
    unsigned cO0[2], cO1[2], nO0[2], nO1[2];
#pragma unroll
    for (int i = 0; i < 2; ++i) { cO0[i] = S.a_off(0, cur, Rl[i]) + Cb[i]; cO1[i] = S.a_off(0, cur, HALF + Rl[i]) + Cb[i]; }
    const char* cB = S.b_base(cur);
    PG8_STAGE(PG8_SB(0, 0), cB, voffB); PG8_STAGE(PG8_SB(0, 1), cB + hstepB, voffB); PG8_STAGE(PG8_SA(0, 0), Abase, cO0); PG8_STAGE(PG8_SA(0, 1), Abase, cO1);
    if (wr == 1) PG8_BAR;
    PG8_WAIT_V(2); PG8_BAR;
    PG8_STAGE(PG8_SB(1, 0), cB + kstep, voffB); PG8_STAGE(PG8_SA(1, 0), Abase + kstep, cO0); PG8_STAGE(PG8_SB(1, 1), cB + hstepB + kstep, voffB);
    PG8_WAIT_V(6); PG8_BAR;
    for (;;) {
        const bool has_next = S.next(ui + 1, nxt);
        const char* nB = cB;
#pragma unroll
        for (int i = 0; i < 2; ++i) { nO0[i] = cO0[i]; nO1[i] = cO1[i]; }
        if (has_next) { nB = S.b_base(nxt);
#pragma unroll
            for (int i = 0; i < 2; ++i) { nO0[i] = S.a_off(ui + 1, nxt, Rl[i]) + Cb[i]; nO1[i] = S.a_off(ui + 1, nxt, HALF + Rl[i]) + Cb[i]; } }
#pragma nounroll
        for (int t = 0; t < nt; t += 2) {
            const bool last = (t == nt - 2);
            const char* a1 = Abase + (size_t)(t + 1) * kstep;
            const char* a2 = last ? Abase : Abase + (size_t)(t + 2) * kstep; const char* b2 = last ? nB : cB + (size_t)(t + 2) * kstep;
            const char* a3 = a2 + kstep; const char* b3 = b2 + kstep;
            unsigned o0[2], o1[2];
#pragma unroll
            for (int i = 0; i < 2; ++i) { o0[i] = last ? nO0[i] : cO0[i]; o1[i] = last ? nO1[i] : cO1[i]; }
            PG8_LDB(B0, 0, 0); PG8_LDB(B1, 0, 1); PG8_SCHED; PG8_LDA(At, 0, 0); PG8_STAGE(PG8_SA(1, 1), a1, cO1);
            PG8_WAIT_V(8); PG8_WAIT_L(0); PG8_BAR; PG8_MMA(0, 0, At, B0); PG8_MMA(0, 1, At, B1); PG8_BAR; PG8_SCHED;
            PG8_LDA(At, 0, 1); PG8_STAGE(PG8_SB(0, 0), b2, voffB); PG8_STAGE(PG8_SB(0, 1), b2 + hstepB, voffB); PG8_STAGE(PG8_SA(0, 0), a2, o0);
            PG8_WAIT_V(8); PG8_WAIT_L(0); PG8_BAR; PG8_MMA(1, 0, At, B0); PG8_MMA(1, 1, At, B1); PG8_BAR; PG8_SCHED;
            PG8_LDB(B0, 1, 0); PG8_LDB(B1, 1, 1); PG8_SCHED; PG8_LDA(At, 1, 0); PG8_STAGE(PG8_SA(0, 1), a2, o1);
            PG8_WAIT_V(8); PG8_WAIT_L(0); PG8_BAR; PG8_MMA(0, 0, At, B0); PG8_MMA(0, 1, At, B1); PG8_BAR; PG8_SCHED;
            PG8_LDA(At, 1, 1); PG8_STAGE(PG8_SB(1, 0), b3, voffB); PG8_STAGE(PG8_SB(1, 1), b3 + hstepB, voffB); PG8_STAGE(PG8_SA(1, 0), a3, o0);
            PG8_WAIT_V(8); PG8_WAIT_L(0); PG8_BAR; PG8_MMA(1, 0, At, B0); PG8_MMA(1, 1, At, B1); PG8_BAR; PG8_SCHED;
        }
        if (wr == 0) PG8_BAR;
        if constexpr (FP8) asm volatile("s_nop 15\n\ts_nop 15" ::: "memory");
        E(acc, cur, ui, wr, wc, fr, fq);
        if (!has_next) break;
#pragma unroll
        for (int a = 0; a < 2; ++a)
#pragma unroll
            for (int b = 0; b < 2; ++b)
#pragma unroll
                for (int m = 0; m < 4; ++m)
#pragma unroll
                    for (int n = 0; n < 2; ++n) acc[a][b][m][n] = (f32x4){0.f, 0.f, 0.f, 0.f};
        cur = nxt; cB = nB; ++ui;
#pragma unroll
        for (int i = 0; i < 2; ++i) { cO0[i] = nO0[i]; cO1[i] = nO1[i]; }
        if (wr == 1) PG8_BAR;
    }
    PG8_WAIT_V(0);
    PG8_BAR;
#undef PG8_SA
#undef PG8_SB
#undef PG8_STAGE
#undef PG8_LDA
#undef PG8_LDB
#undef PG8_MMA
#undef PG8_LO
#undef PG8_HI
#undef PG8_LD32
#undef PG8_WAIT_V
#undef PG8_WAIT_L
#undef PG8_BAR
#undef PG8_SCHED
}

struct DenseSched {
    int nM, nN, G, c, K2; const char* B; int reps;
    __device__ __forceinline__ bool next(int i, Unit& u) const { const int rounds = (nM * nN + G - 1) / G; if (i >= rounds * reps) return false; return static_next(nM, nN, G, c, i % rounds, u); }
    __device__ __forceinline__ const char* b_base(const Unit& u) const { return B + (size_t)u.pn * BM * K2; }
    __device__ __forceinline__ unsigned a_off(int, const Unit& u, int r) const { return (unsigned)(u.pm * BM + r) * (unsigned)K2; }
};
struct MoeSched {
    int NT, nN, G, c, K2; const char* B; size_t estride; bool gather;
    const LAS int* tile_e; const LAS unsigned* rowtab;
    __device__ __forceinline__ bool next(int i, Unit& u) const { return static_next(NT, nN, G, c, i, u); }
    __device__ __forceinline__ const char* b_base(const Unit& u) const { return B + (size_t)tile_e[u.pm] * estride + (size_t)u.pn * BM * K2; }
    __device__ __forceinline__ unsigned a_off(int ui, const Unit& u, int r) const { return gather ? rowtab[ui * 256 + r] : (unsigned)(u.pm * BM + r) * (unsigned)K2; }
};

struct EpiProj {
    static constexpr bool PERM = true;
    bf16* O;
    __device__ __forceinline__ void operator()(const f32x4 (&acc)[2][2][4][2], const Unit& u, int, int wr, int wc, int fr, int fq) const {
        const int row0 = u.pm * BM + 16 * ((u.pm >> 4) + 1) + wr * 64 + fr, col0 = u.pn * BM + wc * 32 + 8 * fq;
#pragma unroll
        for (int ai = 0; ai < 2; ++ai)
#pragma unroll
            for (int m = 0; m < 4; ++m) { bf16* rowp = O + (size_t)(row0 + ai * HALF + m * 16) * INW + col0;
#pragma unroll
                for (int bj = 0; bj < 2; ++bj) { const f32x4 v0 = acc[ai][bj][m][0], v1 = acc[ai][bj][m][1];
                    u32x4 w; w.x = cvt_pk_bf16(v0[0], v0[1]); w.y = cvt_pk_bf16(v0[2], v0[3]); w.z = cvt_pk_bf16(v1[0], v1[1]); w.w = cvt_pk_bf16(v1[2], v1[3]);
                    *(u32x4*)(rowp + bj * HALF) = w; } }
    }
};
struct EpiResid {
    static constexpr bool PERM = false;
    const float* X; float* O;
    __device__ __forceinline__ void operator()(const f32x4 (&acc)[2][2][4][2], const Unit& u, int, int wr, int wc, int fr, int fq) const {
        const int row0 = u.pm * BM + wr * 64 + fr, col0 = u.pn * BM + wc * 32 + 4 * fq;
#pragma unroll
        for (int ai = 0; ai < 2; ++ai)
#pragma unroll
            for (int m = 0; m < 4; ++m) { const size_t off = (size_t)(row0 + ai * HALF + m * 16) * D + col0;
#pragma unroll
                for (int bj = 0; bj < 2; ++bj)
#pragma unroll
                    for (int n = 0; n < 2; ++n) { const f32x4 xv = *(const f32x4*)(X + off + bj * HALF + n * 16); *(f32x4*)(O + off + bj * HALF + n * 16) = acc[ai][bj][m][n] + xv; }
                asm volatile("" ::: "memory"); }
    }
};
struct EpiGateUp {
    static constexpr bool PERM = true;
    unsigned char* H; const LAS float* rstd;
    __device__ __forceinline__ void operator()(const f32x4 (&acc)[2][2][4][2], const Unit& u, int ui, int wr, int wc, int fr, int fq) const {
        const int r0 = wr * 64 + fr, col0 = u.pn * HALF + wc * 32 + 8 * fq;
#pragma unroll
        for (int ai = 0; ai < 2; ++ai)
#pragma unroll
            for (int m = 0; m < 4; ++m) { const int r = r0 + ai * HALF + m * 16; const float rs = rstd[ui * 256 + r];
                float h[8];
#pragma unroll
                for (int n = 0; n < 2; ++n)
#pragma unroll
                    for (int j = 0; j < 4; ++j) { const float g = acc[ai][0][m][n][j] * rs, up = acc[ai][1][m][n][j] * rs; h[n * 4 + j] = g * sigmoidf_(g) * up; }
#pragma unroll
                for (int j = 0; j < 8; ++j) h[j] = clamp448(h[j] * HID_SCALE);
                u32x2 w; w.x = pk4_fp8(h[0], h[1], h[2], h[3]); w.y = pk4_fp8(h[4], h[5], h[6], h[7]);
                *(u32x2*)(H + (size_t)(u.pm * BM + r) * EFF + col0) = w; }
    }
};
struct EpiDown {
    static constexpr bool PERM = true;
    bf16* C; const LAS int* slot; const LAS float* gate;
    __device__ __forceinline__ void operator()(const f32x4 (&acc)[2][2][4][2], const Unit& u, int ui, int wr, int wc, int fr, int fq) const {
        const int r0 = wr * 64 + fr, col0 = u.pn * BM + wc * 32 + 8 * fq;
#pragma unroll
        for (int ai = 0; ai < 2; ++ai)
#pragma unroll
            for (int m = 0; m < 4; ++m) { const int r = r0 + ai * HALF + m * 16; const int sl = slot[ui * 256 + r]; const float gt = gate[ui * 256 + r];
                if (sl >= 0) { bf16* rowp = C + (size_t)sl * D + col0;
#pragma unroll
                    for (int bj = 0; bj < 2; ++bj) { const f32x4 v0 = acc[ai][bj][m][0] * gt, v1 = acc[ai][bj][m][1] * gt;
                        u32x4 w; w.x = cvt_pk_bf16(v0[0], v0[1]); w.y = cvt_pk_bf16(v0[2], v0[3]); w.z = cvt_pk_bf16(v1[0], v1[1]); w.w = cvt_pk_bf16(v1[2], v1[3]);
                        *(u32x4*)(rowp + bj * HALF) = w; } } }
    }
};
}

struct Frame {
    LAS unsigned char* lds; int tid, lane, wave, G, bx;
    const float *x, *meta, *g1, *w_in, *conv_w, *conv_b, *wa, *ba, *wx, *bx_, *lam, *lru_gain, *pool_w, *pool_scale, *w_out, *g2, *w_group, *b_group, *w_router, *b_router, *w_gate, *w_up, *w_down, *final_gain;
    float* out; unsigned char* ws; unsigned* ctl;
    bf16 *WinT, *WoutT, *WaT, *WxT, *PwT, *HN1, *YMIX, *PROJ, *C; unsigned char *WguT, *WdT, *HN2, *HID;
    _Float16* WrH; float* AGG; f32x4* RINFO;
};
__device__ __forceinline__ float wave_sum(float v) {
#pragma unroll
    for (int o = 1; o < 64; o <<= 1) v += __shfl_xor(v, o);
    return v;
}

__device__ __forceinline__ void transpose_tile(const float* W, int ldw, int k0, int n0, bf16* WT, int ldt, int drow0, LAS float* scr, int lane) {
#pragma unroll 8
    for (int i = 0; i < 32; ++i) { const int kk = 2 * i + (lane >> 5); scr[kk * 33 + (lane & 31)] = W[(size_t)(k0 + kk) * ldw + n0 + (lane & 31)]; }
    LDS_WAIT(); asm volatile("" ::: "memory");
    const int c = lane & 7;
#pragma unroll
    for (int j = 0; j < 4; ++j) { const int n = (lane >> 3) + 8 * j; const LAS float* s = scr + (8 * c) * 33 + n;
        u32x4 o; o.x = pk2(s[0 * 33], s[1 * 33]); o.y = pk2(s[2 * 33], s[3 * 33]); o.z = pk2(s[4 * 33], s[5 * 33]); o.w = pk2(s[6 * 33], s[7 * 33]);
        *(u32x4*)(WT + (size_t)(drow0 + n) * ldt + k0 + 8 * c) = o; }
    LDS_WAIT(); asm volatile("" ::: "memory");
}
__device__ __forceinline__ void transpose_tile_fp8(const float* W, int ldw, int k0, int n0, unsigned char* WT, int ldt, int drow0, float scale, LAS float* scr, int lane) {
#pragma unroll 8
    for (int i = 0; i < 64; ++i) { const int kk = 2 * i + (lane >> 5); scr[kk * 33 + (lane & 31)] = W[(size_t)(k0 + kk) * ldw + n0 + (lane & 31)]; }
    LDS_WAIT(); asm volatile("" ::: "memory");
    const int n = lane >> 1, kh = (lane & 1) * 64; const LAS float* sp = scr + kh * 33 + n;
#pragma unroll
    for (int c = 0; c < 4; ++c) { u32x4 o;
#pragma unroll
        for (int w = 0; w < 4; ++w) { const LAS float* q4 = sp + (16 * c + 4 * w) * 33; o[w] = pk4_fp8(q4[0] * scale, q4[33] * scale, q4[66] * scale, q4[99] * scale); }
        *(u32x4*)(WT + (size_t)(drow0 + n) * ldt + k0 + kh + 16 * c) = o; }
    LDS_WAIT(); asm volatile("" ::: "memory");
}
__device__ __forceinline__ void p0_prologue(Frame& F) {
    if (F.bx < INW / 8) {
        LAS float* hnm = (LAS float*)F.lds;
        LAS float* part = (LAS float*)(F.lds + 65536);
        for (int r = F.wave * 2; r < F.wave * 2 + 2; ++r) {
            const f32x4* xr = (const f32x4*)(F.meta + (size_t)r * D) + F.lane; f32x4 v[4]; float s = 0.f;
#pragma unroll
            for (int j = 0; j < 4; ++j) { v[j] = xr[64 * j]; s += (v[j].x * v[j].x + v[j].y * v[j].y) + (v[j].z * v[j].z + v[j].w * v[j].w); }
            const float rstd = rsqrtf(wave_sum(s) * (1.f / D) + RMS_EPS);
#pragma unroll
            for (int j = 0; j < 4; ++j) { const f32x4 g = ((const f32x4*)F.g1)[F.lane + 64 * j]; *(LAS f32x4*)(hnm + r * D + 4 * F.lane + 256 * j) = v[j] * rstd * g; }
        }
        __syncthreads();
        { const int cc = F.tid & 7, ks = F.tid >> 3, col = F.bx * 8 + cc; float a[16];
#pragma unroll
            for (int r = 0; r < 16; ++r) a[r] = 0.f;
            for (int k = ks * 16; k < ks * 16 + 16; ++k) { const float w = F.w_in[(size_t)k * INW + col];
#pragma unroll
                for (int r = 0; r < 16; ++r) a[r] += hnm[r * D + k] * w; }
#pragma unroll
            for (int r = 0; r < 16; ++r) part[(ks * 16 + r) * 8 + cc] = a[r]; }
        __syncthreads();
        if (F.tid < 128) { const int r = F.tid >> 3, cc = F.tid & 7; float s = 0.f;
            for (int ks = 0; ks < 64; ++ks) s += part[(ks * 16 + r) * 8 + cc];
            const bf16 h = (bf16)f2bf(s);
            for (int b = 0; b < NBATCH; ++b) F.PROJ[(size_t)(b * TT + r) * INW + F.bx * 8 + cc] = h; }
        __syncthreads();
    }
    LAS float* scr = (LAS float*)(F.lds + F.wave * 16896);
    const int gw = F.bx * 8 + F.wave, NGW = F.G * 8;
    constexpr int I_IN = 16 * 48, I_OUT = 16 * 32, I_G = NE * 8 * 16, I_D = NE * 4 * 32, I_A = 8 * 2, I_P = 4 * 2 * 4;
    constexpr int NITEMS = I_IN + I_OUT + 2 * I_G + I_D + 2 * I_A + I_P;
    for (int it = gw; it < NITEMS; it += NGW) {
        int r = it;
        if (r < I_IN) { const int kb = r / 48, nb = r % 48; transpose_tile(F.w_in, INW, 64 * kb, 32 * nb, F.WinT, D, 32 * nb, scr, F.lane); continue; } r -= I_IN;
        if (r < I_OUT) { const int kb = r / 32, nb = r % 32; transpose_tile(F.w_out, D, 64 * kb, 32 * nb, F.WoutT, D, 32 * nb, scr, F.lane); continue; } r -= I_OUT;
        if (r < 2 * I_G) { const int up = r >= I_G; if (up) r -= I_G; const int e = r >> 7, kb = (r >> 4) & 7, nb = r & 15, n0 = 32 * nb;
            transpose_tile_fp8((up ? F.w_up : F.w_gate) + (size_t)e * D * EFF, EFF, 128 * kb, n0, F.WguT + (size_t)e * 1024 * D, D, (n0 >> 7) * 256 + up * 128 + (n0 & 127), WGU_SCALE, scr, F.lane); continue; } r -= 2 * I_G;
        if (r < I_D) { const int e = r >> 7, kb = (r >> 5) & 3, nb = r & 31; transpose_tile_fp8(F.w_down + (size_t)e * EFF * D, D, 128 * kb, 32 * nb, F.WdT + (size_t)e * D * EFF, EFF, 32 * nb, WD_SCALE, scr, F.lane); continue; } r -= I_D;
        if (r < 2 * I_A) { const int x = r >= I_A; if (x) r -= I_A; const int h = r >> 1, nb = r & 1; transpose_tile((x ? F.wx : F.wa) + (size_t)h * 4096, 64, 0, 32 * nb, (x ? F.WxT : F.WaT) + (size_t)h * 4096, 64, 32 * nb, scr, F.lane); continue; } r -= 2 * I_A;
        { const int g = r >> 3, kb = (r >> 2) & 1, nb = r & 3; transpose_tile(F.pool_w + (size_t)g * 16384, 128, 64 * kb, 32 * nb, F.PwT + (size_t)g * 16384, 128, 32 * nb, scr, F.lane); }
    }
    for (int i = F.bx * 512 + F.tid; i < NROUTE * D; i += F.G * 512) { const int n = i >> 10, k = i & 1023;
        const float w = n < 4 ? F.w_group[k * 4 + n] : F.w_router[k * 32 + (n - 4)]; F.WrH[i] = (_Float16)(w * 256.0f); }
    for (int m = gw; m < M; m += NGW) {
        const f32x4* xr = (const f32x4*)(F.x + (size_t)m * D) + F.lane; f32x4 v[4]; float s = 0.f;
#pragma unroll
        for (int j = 0; j < 4; ++j) { v[j] = xr[64 * j]; s += (v[j].x * v[j].x + v[j].y * v[j].y) + (v[j].z * v[j].z + v[j].w * v[j].w); }
        const float rstd = rsqrtf(wave_sum(s) * (1.f / D) + RMS_EPS);
        u32x2* o8 = (u32x2*)(F.HN1 + (size_t)m * D) + F.lane;
#pragma unroll
        for (int j = 0; j < 4; ++j) { const f32x4 g = ((const f32x4*)F.g1)[F.lane + 64 * j]; const f32x4 y = v[j] * rstd * g; u32x2 w; w.x = pk2(y.x, y.y); w.y = pk2(y.z, y.w); o8[64 * j] = w; }
    }
}

constexpr int XC_STRIDE = 68, UG_STRIDE = 72;
struct LruWave {
    const bf16 *waP, *wxP;
    float ba[4], bxv[4], lam8[4];
    LAS float* cw;
    LAS float* xcT; LAS bf16* ugT;
};
__device__ __forceinline__ void lru_setup(const Frame& F, LruWave& L, LAS unsigned char* wbase) {
    const int hd = F.wave, c16 = F.lane & 15, q = F.lane >> 4;
    L.waP = F.WaT + (size_t)hd * 4096 + (size_t)c16 * 64 + 8 * q; L.wxP = F.WxT + (size_t)hd * 4096 + (size_t)c16 * 64 + 8 * q;
    L.cw = (LAS float*)wbase; L.xcT = (LAS float*)(wbase + 1280); L.ugT = (LAS bf16*)(wbase + 1280 + 16 * XC_STRIDE * 4);
    for (int i = F.lane; i < 320; i += 64) { const int tap = i >> 6, ch = i & 63; L.cw[i] = tap < 4 ? F.conv_w[tap * LW + hd * 64 + ch] : F.conv_b[hd * 64 + ch]; }
#pragma unroll
    for (int nb = 0; nb < 4; ++nb) {
        const int ch = hd * 64 + 16 * nb + c16; L.ba[nb] = F.ba[ch]; L.bxv[nb] = F.bx_[ch];
        const float lm = F.lam[ch]; L.lam8[nb] = 8.0f * (fminf(lm, 0.f) - log1pf(__expf(-fabsf(lm))));
    }
    LDS_WAIT();
}
template <bool WITH_UG>
__device__ __forceinline__ void lru_block_load(const Frame& F, const LruWave& L, int b, int tt0, bf16x8 (&af)[2]) {
    const int hd = F.wave, row = F.lane & 15, q = F.lane >> 4, tt = tt0 + row;
    const bf16* prow = F.PROJ + (size_t)(b * TT + tt) * INW + hd * 64 + 8 * q;
#pragma unroll
    for (int kb = 0; kb < 2; ++kb) {
        float xc[8];
        { const f32x4 c0 = *(const LAS f32x4*)(L.cw + 256 + 32 * kb + 8 * q), c1 = *(const LAS f32x4*)(L.cw + 256 + 32 * kb + 8 * q + 4);
          xc[0] = c0.x; xc[1] = c0.y; xc[2] = c0.z; xc[3] = c0.w; xc[4] = c1.x; xc[5] = c1.y; xc[6] = c1.z; xc[7] = c1.w; }
#pragma unroll
        for (int k = 0; k < 4; ++k) {
            u32x4 u = (u32x4){0u, 0u, 0u, 0u};
            if (tt - 3 + k >= 0) u = *(const u32x4*)(prow + (ptrdiff_t)(k - 3) * INW + 32 * kb);
            const f32x4 w0 = *(const LAS f32x4*)(L.cw + 64 * k + 32 * kb + 8 * q), w1 = *(const LAS f32x4*)(L.cw + 64 * k + 32 * kb + 8 * q + 4);
            xc[0] += w0.x * bflo(u.x); xc[1] += w0.y * bfhi(u.x); xc[2] += w0.z * bflo(u.y); xc[3] += w0.w * bfhi(u.y);
            xc[4] += w1.x * bflo(u.z); xc[5] += w1.y * bfhi(u.z); xc[6] += w1.z * bflo(u.w); xc[7] += w1.w * bfhi(u.w);
        }
        *(LAS f32x4*)(L.xcT + row * XC_STRIDE + 32 * kb + 8 * q) = (f32x4){xc[0], xc[1], xc[2], xc[3]};
        *(LAS f32x4*)(L.xcT + row * XC_STRIDE + 32 * kb + 8 * q + 4) = (f32x4){xc[4], xc[5], xc[6], xc[7]};
        u32x4 p; p.x = pk2(xc[0], xc[1]); p.y = pk2(xc[2], xc[3]); p.z = pk2(xc[4], xc[5]); p.w = pk2(xc[6], xc[7]);
        af[kb] = __builtin_bit_cast(bf16x8, p);
        if (WITH_UG) { const u32x4 g = *(const u32x4*)(prow + LW + 32 * kb); *(LAS u32x4*)(L.ugT + row * UG_STRIDE + 32 * kb + 8 * q) = g; }
    }
    LDS_WAIT();
}
__device__ __forceinline__ void lru_block_gates(const Frame& F, const LruWave& L, const bf16x8 (&af)[2], int nb, float (&a)[4], float (&bb)[4]) {
    const int c16 = F.lane & 15, q = F.lane >> 4;
    f32x4 ra = (f32x4){0.f, 0.f, 0.f, 0.f}, rx = ra;
#pragma unroll
    for (int kb = 0; kb < 2; ++kb) { const bf16x8 wa = *(const bf16x8*)(L.waP + nb * 1024 + kb * 32), wx = *(const bf16x8*)(L.wxP + nb * 1024 + kb * 32);
        ra = __builtin_amdgcn_mfma_f32_16x16x32_bf16(af[kb], wa, ra, 0, 0, 0); rx = __builtin_amdgcn_mfma_f32_16x16x32_bf16(af[kb], wx, rx, 0, 0, 0); }
#pragma unroll
    for (int j = 0; j < 4; ++j) {
        const float xcv = L.xcT[(4 * q + j) * XC_STRIDE + 16 * nb + c16];
        const float r = sigmoidf_(ra[j] + L.ba[nb]), ig = sigmoidf_(rx[j] + L.bxv[nb]);
        const float la = L.lam8[nb] * r, z = 2.0f * la;
        const float om = z > -0.05f ? -z * (1.0f + z * (0.5f + z * (0.16666667f + z * 0.041666667f))) : 1.0f - __expf(z);
        a[j] = __expf(la); bb[j] = sqrtf(om) * (ig * xcv);
    }
}
__device__ __forceinline__ void lru_block_fold(const float (&a)[4], const float (&bb)[4], int lane, float& Ab, float& Bb) {
    float A = a[0], B = bb[0];
#pragma unroll
    for (int j = 1; j < 4; ++j) { B = a[j] * B + bb[j]; A *= a[j]; }
    const int q = lane >> 4;
    { const float Ap = __shfl_up(A, 16), Bp = __shfl_up(B, 16); if (q >= 1) { B = A * Bp + B; A = Ap * A; } }
    { const float Ap = __shfl_up(A, 32), Bp = __shfl_up(B, 32); if (q >= 2) { B = A * Bp + B; A = Ap * A; } }
    Ab = __shfl(A, (lane & 15) + 48); Bb = __shfl(B, (lane & 15) + 48);
}
__device__ __forceinline__ void p2_aggregates(Frame& F) {
    LruWave L; lru_setup(F, L, F.lds + F.wave * 8192);
    for (int ch = F.bx; ch < 256; ch += F.G) {
        const int b = ch >> 5, ci = ch & 31; float Ac[4], Bc[4];
#pragma unroll
        for (int nb = 0; nb < 4; ++nb) { Ac[nb] = 1.f; Bc[nb] = 0.f; }
        for (int blk = (ci == 0 ? -1 : 0); blk < 8; ++blk) {
            const int tt0 = NMETA + 128 * ci + 16 * blk; bf16x8 af[2];
            lru_block_load<false>(F, L, b, tt0, af);
#pragma unroll
            for (int nb = 0; nb < 4; ++nb) { float a[4], bb[4], Ab, Bb; lru_block_gates(F, L, af, nb, a, bb); lru_block_fold(a, bb, F.lane, Ab, Bb); Bc[nb] = Ab * Bc[nb] + Bb; Ac[nb] *= Ab; }
            LDS_WAIT();
        }
        if (F.lane < 16) {
#pragma unroll
            for (int nb = 0; nb < 4; ++nb) *(f32x2*)(F.AGG + ((size_t)ch * LW + F.wave * 64 + 16 * nb + F.lane) * 2) = (f32x2){Ac[nb], Bc[nb]}; }
    }
}

constexpr int YT_STRIDE = 520;
template <int G> __device__ __forceinline__ void pool_group(const Frame& F, const bf16* prow  , LAS bf16* yt  , float (&ssq)[4]) {
    constexpr int W = 2 << G; const int c16 = F.lane & 15, q = F.lane >> 4;
    bf16x8 af[4];
#pragma unroll
    for (int kb = 0; kb < 4; ++kb) {
        const bf16* p = prow + 128 * G + 32 * kb; const u32x4 c = *(const u32x4*)p; float cur[8], s[8];
        cur[0] = bflo(c.x); cur[1] = bfhi(c.x); cur[2] = bflo(c.y); cur[3] = bfhi(c.y); cur[4] = bflo(c.z); cur[5] = bfhi(c.z); cur[6] = bflo(c.w); cur[7] = bfhi(c.w);
#pragma unroll
        for (int j = 0; j < 8; ++j) s[j] = cur[j];
#pragma unroll
        for (int d = 1; d < W; ++d) { const u32x4 u = *(const u32x4*)(p - (ptrdiff_t)d * INW);
            s[0] += bflo(u.x); s[1] += bfhi(u.x); s[2] += bflo(u.y); s[3] += bfhi(u.y); s[4] += bflo(u.z); s[5] += bfhi(u.z); s[6] += bflo(u.w); s[7] += bfhi(u.w);
            if ((d & 3) == 3) asm volatile("" ::: "memory"); }
        float z[8];
#pragma unroll
        for (int j = 0; j < 8; ++j) z[j] = s[j] * (1.0f / W) - cur[j];
        u32x4 pz; pz.x = pk2(z[0], z[1]); pz.y = pk2(z[2], z[3]); pz.z = pk2(z[4], z[5]); pz.w = pk2(z[6], z[7]);
        af[kb] = __builtin_bit_cast(bf16x8, pz);
    }
#pragma unroll 2
    for (int nb = 0; nb < 8; ++nb) {
        f32x4 acc = (f32x4){0.f, 0.f, 0.f, 0.f};
#pragma unroll
        for (int kb = 0; kb < 4; ++kb) { const bf16x8 bfr = *(const bf16x8*)(F.PwT + (size_t)G * 16384 + (size_t)(16 * nb + c16) * 128 + 32 * kb + 8 * q); acc = __builtin_amdgcn_mfma_f32_16x16x32_bf16(af[kb], bfr, acc, 0, 0, 0); }
#pragma unroll
        for (int j = 0; j < 4; ++j) { ssq[j] += acc[j] * acc[j]; yt[(4 * q + j) * YT_STRIDE + 128 * G + 16 * nb + c16] = (bf16)f2bf(acc[j]); }
        asm volatile("" ::: "memory");
    }
}
__device__ __forceinline__ void p3_mixer(Frame& F) {
    LAS bf16* Y = (LAS bf16*)F.lds;
    LAS unsigned char* wbase = F.lds + 66560 + F.wave * 8192;
    LAS float* SSQ = (LAS float*)(F.lds + 66560 + 65536);
    LAS float* RSTD = SSQ + 512;
    LAS float* PRS = (LAS float*)(F.lds + 133120);
    const int c16 = F.lane & 15, q = F.lane >> 4;
    for (int ch = F.bx; ch < 256; ch += F.G) {
        LruWave L; lru_setup(F, L, wbase);
        const int b = ch >> 5, ci = ch & 31; const int m0 = ch * 128;
        float H[4] = {0.f, 0.f, 0.f, 0.f};
        for (int k = 0; k < ci; ++k) {
#pragma unroll
            for (int nb = 0; nb < 4; ++nb) { const f32x2 ab = *(const f32x2*)(F.AGG + ((size_t)(b * 32 + k) * LW + F.wave * 64 + 16 * nb + c16) * 2); H[nb] = ab.x * H[nb] + ab.y; } }
        if (ci == 0) {
            bf16x8 af[2]; lru_block_load<false>(F, L, b, 0, af);
#pragma unroll
            for (int nb = 0; nb < 4; ++nb) { float a[4], bb[4], Ab, Bb; lru_block_gates(F, L, af, nb, a, bb); lru_block_fold(a, bb, F.lane, Ab, Bb); H[nb] = Ab * H[nb] + Bb; }
            LDS_WAIT();
        }
#ifndef P3_NO_LRU
        for (int half = 0; half < 2; ++half) {
            for (int blk = 0; blk < 4; ++blk) {
                const int rb = 16 * blk;
                const int tt0 = NMETA + 128 * ci + 64 * half + rb; bf16x8 af[2];
                lru_block_load<true>(F, L, b, tt0, af);
                float ss[4] = {0.f, 0.f, 0.f, 0.f};
#pragma unroll
                for (int nb = 0; nb < 4; ++nb) {
                    float a[4], bb[4]; lru_block_gates(F, L, af, nb, a, bb);
                    float A = a[0], B = bb[0];
#pragma unroll
                    for (int j = 1; j < 4; ++j) { B = a[j] * B + bb[j]; A *= a[j]; }
                    { const float Ap = __shfl_up(A, 16), Bp = __shfl_up(B, 16); if (q >= 1) { B = A * Bp + B; A = Ap * A; } }
                    { const float Ap = __shfl_up(A, 32), Bp = __shfl_up(B, 32); if (q >= 2) { B = A * Bp + B; A = Ap * A; } }
                    float Ae = __shfl_up(A, 16), Be = __shfl_up(B, 16); if (q == 0) { Ae = 1.f; Be = 0.f; }
                    float h = Ae * H[nb] + Be;
                    const float Hn = __shfl(A, c16 + 48) * H[nb] + __shfl(B, c16 + 48);
#pragma unroll
                    for (int j = 0; j < 4; ++j) {
                        h = a[j] * h + bb[j];
                        const float ug = bf2f(L.ugT[(4 * q + j) * UG_STRIDE + 16 * nb + c16]);
                        const float gl = ug * sigmoidf_(1.5957691216f * (ug + 0.044715f * ug * ug * ug));
                        const float y = h * gl; ss[j] += y * y;
                        Y[(rb + 4 * q + j) * YT_STRIDE + F.wave * 64 + 16 * nb + c16] = (bf16)f2bf(y);
                    }
                    H[nb] = Hn;
                }
#pragma unroll
                for (int j = 0; j < 4; ++j) { float s = ss[j]; s += __shfl_xor(s, 1); s += __shfl_xor(s, 2); s += __shfl_xor(s, 4); s += __shfl_xor(s, 8); if (c16 == 0) SSQ[(rb + 4 * q + j) * 8 + F.wave] = s; }
                LDS_WAIT();
            }
            __syncthreads();
            if (F.tid < 64) { float s = 0.f;
#pragma unroll
                for (int w = 0; w < 8; ++w) s += SSQ[F.tid * 8 + w];
                RSTD[F.tid] = rsqrtf(s * (1.0f / LW) + RMS_EPS); }
            __syncthreads();
#pragma unroll
            for (int s = 0; s < 8; ++s) { const int p = F.tid + 512 * s, row = p >> 6, cp = p & 63; const float rs = RSTD[row];
                const u32x4 v = *(const LAS u32x4*)(Y + row * YT_STRIDE + 8 * cp); const f32x4 g0 = *(const f32x4*)(F.lru_gain + 8 * cp), g1 = *(const f32x4*)(F.lru_gain + 8 * cp + 4);
                u32x4 o; o.x = pk2(bflo(v.x) * rs * g0.x, bfhi(v.x) * rs * g0.y); o.y = pk2(bflo(v.y) * rs * g0.z, bfhi(v.y) * rs * g0.w);
                o.z = pk2(bflo(v.z) * rs * g1.x, bfhi(v.z) * rs * g1.y); o.w = pk2(bflo(v.w) * rs * g1.z, bfhi(v.w) * rs * g1.w);
                *(u32x4*)(F.YMIX + (size_t)(m0 + 64 * half + row) * D + 8 * cp) = o; }
            __syncthreads();
        }
#endif
#ifndef P3_NO_POOL
        {
            const int tt = NMETA + 128 * ci + 16 * F.wave + c16;
            const bf16* prow = F.PROJ + (size_t)(b * TT + tt) * INW + 1024 + 8 * q;
            LAS bf16* yt = Y + (16 * F.wave) * YT_STRIDE; float ssq[4] = {0.f, 0.f, 0.f, 0.f};
            pool_group<0>(F, prow, yt, ssq); pool_group<1>(F, prow, yt, ssq); pool_group<2>(F, prow, yt, ssq); pool_group<3>(F, prow, yt, ssq);
#pragma unroll
            for (int j = 0; j < 4; ++j) { float s = ssq[j]; s += __shfl_xor(s, 1); s += __shfl_xor(s, 2); s += __shfl_xor(s, 4); s += __shfl_xor(s, 8); if (c16 == 0) PRS[F.wave * 16 + 4 * q + j] = rsqrtf(s * (1.0f / 512.0f) + RMS_EPS); }
            LDS_WAIT();
            const f32x4 g0 = *(const f32x4*)(F.pool_scale + 8 * F.lane), g1 = *(const f32x4*)(F.pool_scale + 8 * F.lane + 4);
#pragma unroll 4
            for (int s = 0; s < 16; ++s) { const float rs = PRS[F.wave * 16 + s]; const u32x4 v = *(const LAS u32x4*)(yt + s * YT_STRIDE + 8 * F.lane);
                u32x4 o; o.x = pk2(bflo(v.x) * rs * g0.x, bfhi(v.x) * rs * g0.y); o.y = pk2(bflo(v.y) * rs * g0.z, bfhi(v.y) * rs * g0.w);
                o.z = pk2(bflo(v.z) * rs * g1.x, bfhi(v.z) * rs * g1.y); o.w = pk2(bflo(v.w) * rs * g1.z, bfhi(v.w) * rs * g1.w);
                *(u32x4*)(F.YMIX + (size_t)(m0 + 16 * F.wave + s) * D + LW + 8 * F.lane) = o; }
        }
#endif
        __syncthreads();
    }
}

constexpr int WR_STRIDE = 1032;
__device__ __forceinline__ void p5_route(Frame& F, const bool dry = false) {
    LAS _Float16* WR = (LAS _Float16*)F.lds;
    LAS float* LG = (LAS float*)(F.lds + 36 * WR_STRIDE * 2) + F.wave * 16 * 40;
    LAS int* LCNT = (LAS int*)(F.lds + 36 * WR_STRIDE * 2 + 8 * 16 * 40 * 4);
    LAS float* G2 = (LAS float*)(LCNT + 64);
    const int c16 = F.lane & 15, q = F.lane >> 4;
    for (int i = F.tid; i < NROUTE * 128; i += 512) { const int n = i >> 7, k8 = i & 127; *(LAS u32x4*)(WR + n * WR_STRIDE + 8 * k8) = *(const u32x4*)(F.WrH + n * D + 8 * k8); }
    for (int i = F.tid; i < D; i += 512) G2[i] = F.g2[i];
    for (int ch = F.bx; ch < 256; ch += F.G) {
        if (F.tid < 64) LCNT[F.tid] = 0;
        __syncthreads();
        const int row = ch * 128 + 16 * F.wave + c16;
        const float* hrow = F.out + (size_t)row * D + 8 * q; unsigned char* orow = F.HN2 + (size_t)row * D + 8 * q;
        f32x4 acc[3]; float ss = 0.f;
#pragma unroll
        for (int nb = 0; nb < 3; ++nb) acc[nb] = (f32x4){0.f, 0.f, 0.f, 0.f};
#pragma unroll 2
        for (int i = 0; i < 32; ++i) {
            const f32x4 h0 = *(const f32x4*)(hrow + 32 * i), h1 = *(const f32x4*)(hrow + 32 * i + 4);
            const f32x4 g0 = *(const LAS f32x4*)(G2 + 32 * i + 8 * q), g1 = *(const LAS f32x4*)(G2 + 32 * i + 8 * q + 4);
            ss += (h0.x * h0.x + h0.y * h0.y) + (h0.z * h0.z + h0.w * h0.w) + (h1.x * h1.x + h1.y * h1.y) + (h1.z * h1.z + h1.w * h1.w);
            const f32x4 t0 = h0 * g0, t1 = h1 * g1;
            u32x2 p; p.x = pk4_fp8(clamp448(t0.x), clamp448(t0.y), clamp448(t0.z), clamp448(t0.w)); p.y = pk4_fp8(clamp448(t1.x), clamp448(t1.y), clamp448(t1.z), clamp448(t1.w));
            *(u32x2*)(orow + 32 * i) = p;
            f16x8 a; a[0] = (_Float16)t0.x; a[1] = (_Float16)t0.y; a[2] = (_Float16)t0.z; a[3] = (_Float16)t0.w; a[4] = (_Float16)t1.x; a[5] = (_Float16)t1.y; a[6] = (_Float16)t1.z; a[7] = (_Float16)t1.w;
#pragma unroll
            for (int nb = 0; nb < 3; ++nb) { const int col = 16 * nb + c16; f16x8 bw;
#pragma unroll
                for (int j = 0; j < 8; ++j) bw[j] = (_Float16)0.f;
                if (col < NROUTE) bw = *(const LAS f16x8*)(WR + col * WR_STRIDE + 32 * i + 8 * q);
                acc[nb] = __builtin_amdgcn_mfma_f32_16x16x32_f16(a, bw, acc[nb], 0, 0, 0); }
        }
        ss += __shfl_xor(ss, 16); ss += __shfl_xor(ss, 32);
        const float rstd = rsqrtf(ss * (1.0f / D) + RMS_EPS);
#pragma unroll
        for (int nb = 0; nb < 3; ++nb)
#pragma unroll
            for (int j = 0; j < 4; ++j) { const int col = 16 * nb + c16; if (col < 40) LG[(4 * q + j) * 40 + col] = acc[nb][j]; }
        LDS_WAIT();
        int e0 = 0, e1 = 0, rk0 = 0, rk1 = 0; float gt0 = 0.f, gt1 = 0.f;
        if (F.lane < 16) {
            const LAS float* lg = LG + F.lane * 40; const float sc = rstd * (1.0f / 256.0f);
            float gl[4]; int gi = 0;
#pragma unroll
            for (int j = 0; j < 4; ++j) gl[j] = lg[j] * sc + F.b_group[j];
            float gm = gl[0];
#pragma unroll
            for (int j = 1; j < 4; ++j) if (gl[j] > gm) { gm = gl[j]; gi = j; }
            float den = 0.f;
#pragma unroll
            for (int j = 0; j < 4; ++j) den += __expf(gl[j] - gm);
            const float pg = 1.0f / den;
            float v0 = -3.0e38f, v1 = -3.0e38f; int i0 = 0, i1 = 0;
            for (int j = 0; j < 8; ++j) { const float v = lg[4 + gi * 8 + j] * sc + F.b_router[gi * 8 + j];
                if (v > v0) { v1 = v0; i1 = i0; v0 = v; i0 = j; } else if (v > v1) { v1 = v; i1 = j; } }
            const float ex = __expf(v1 - v0), s0 = 1.0f / (1.0f + ex);
            gt0 = pg * s0; gt1 = pg * (ex * s0); e0 = gi * 8 + i0; e1 = gi * 8 + i1;
            rk0 = __hip_atomic_fetch_add(&LCNT[e0], 1, __ATOMIC_RELAXED, __HIP_MEMORY_SCOPE_WORKGROUP); rk1 = __hip_atomic_fetch_add(&LCNT[e1], 1, __ATOMIC_RELAXED, __HIP_MEMORY_SCOPE_WORKGROUP);
        }
        __syncthreads();
        if (F.tid < 32 && !dry) LCNT[32 + F.tid] = (int)__hip_atomic_fetch_add(F.ctl + CW_CNT + 64 * F.tid, (unsigned)LCNT[F.tid], __ATOMIC_RELAXED, __HIP_MEMORY_SCOPE_AGENT);
        __syncthreads();
        if (F.lane < 16 && !dry) { const int tok = ch * 128 + 16 * F.wave + F.lane;
            F.RINFO[(size_t)e0 * ECAP + LCNT[32 + e0] + rk0] = (f32x4){__builtin_bit_cast(float, tok * 2), gt0, rstd, 0.f};
            F.RINFO[(size_t)e1 * ECAP + LCNT[32 + e1] + rk1] = (f32x4){__builtin_bit_cast(float, tok * 2 + 1), gt1, rstd, 0.f}; }
        __syncthreads();
    }
}

__device__ __forceinline__ int moe_tables(Frame& F) {
    LAS int* TE = (LAS int*)(F.lds + TAB_TE); LAS int* TR = (LAS int*)(F.lds + TAB_TR); LAS int* CNT = (LAS int*)(F.lds + TAB_CNT); LAS int* PRE = CNT + 32;
    if (F.tid < 32) CNT[F.tid] = (int)__hip_atomic_load(F.ctl + CW_CNT + 64 * F.tid, __ATOMIC_RELAXED, __HIP_MEMORY_SCOPE_AGENT);
    __syncthreads();
    if (F.tid == 0) { int s = 0; for (int e = 0; e < NE; ++e) { PRE[e] = s; s += (CNT[e] + 255) >> 8; } PRE[NE] = s; }
    __syncthreads();
    const int NT = PRE[NE];
    for (int t = F.tid; t < NT; t += 512) { int e = 0; while (e < NE - 1 && PRE[e + 1] <= t) ++e; TE[t] = e; TR[t] = (t - PRE[e]) * 256; }
    __syncthreads();
    return NT;
}
__device__ __forceinline__ void moe_unit_tables(Frame& F, const pg8::MoeSched& S, int mode) {
    LAS int* TE = (LAS int*)(F.lds + TAB_TE); LAS int* TR = (LAS int*)(F.lds + TAB_TR); LAS int* CNT = (LAS int*)(F.lds + TAB_CNT);
    LAS unsigned* ROW = (LAS unsigned*)(F.lds + TAB_ROW); LAS float* FT = (LAS float*)(F.lds + TAB_F);
    pg8::Unit u;
    for (int i = 0; i < MAXU && S.next(i, u); ++i) {
        if (F.tid < 256) { const int e = TE[u.pm], pos = TR[u.pm] + F.tid; const bool valid = pos < CNT[e];
            f32x4 ri = (f32x4){0.f, 0.f, 0.f, 0.f}; if (valid) ri = F.RINFO[(size_t)e * ECAP + pos];
            const int slot = __builtin_bit_cast(int, ri.x);
            if (mode == 0) { ROW[i * 256 + F.tid] = valid ? (unsigned)(slot >> 1) * (unsigned)D : 0u; FT[i * 256 + F.tid] = valid ? ri.z * (1.0f / WGU_SCALE) : 0.f; }
            else { ROW[i * 256 + F.tid] = valid ? (unsigned)slot : 0xffffffffu; FT[i * 256 + F.tid] = ri.y * (1.0f / (WD_SCALE * HID_SCALE)); } }
    }
    __syncthreads();
}

__device__ __forceinline__ void p8_final(Frame& F) {
    const int gw = F.bx * 8 + F.wave, NGW = F.G * 8;
    for (int m = gw; m < M; m += NGW) {
        f32x4* hr = (f32x4*)(F.out + (size_t)m * D) + F.lane; const u32x2* c0 = (const u32x2*)(F.C + (size_t)(2 * m) * D) + F.lane; const u32x2* c1 = (const u32x2*)(F.C + (size_t)(2 * m + 1) * D) + F.lane;
        f32x4 v[4]; float s = 0.f;
#pragma unroll
        for (int j = 0; j < 4; ++j) { const f32x4 h = hr[64 * j]; const u32x2 a = c0[64 * j], b = c1[64 * j];
            v[j] = (f32x4){h.x + (bflo(a.x) + bflo(b.x)), h.y + (bfhi(a.x) + bfhi(b.x)), h.z + (bflo(a.y) + bflo(b.y)), h.w + (bfhi(a.y) + bfhi(b.y))};
            s += (v[j].x * v[j].x + v[j].y * v[j].y) + (v[j].z * v[j].z + v[j].w * v[j].w); }
        const float rstd = rsqrtf(wave_sum(s) * (1.f / D) + RMS_EPS);
#pragma unroll
        for (int j = 0; j < 4; ++j) { const f32x4 g = ((const f32x4*)F.final_gain)[F.lane + 64 * j]; hr[64 * j] = v[j] * rstd * g; }
    }
}

struct Args { const float* in[24]; float* out; unsigned char* ws; int ph_lo, ph_hi; };
__global__ void __launch_bounds__(512, 2) hymba_fwd(Args args) {
    extern __shared__ __attribute__((aligned(16))) unsigned char lds[];
    Frame F;
    F.lds = (LAS unsigned char*)lds; F.tid = threadIdx.x; F.lane = F.tid & 63; F.wave = __builtin_amdgcn_readfirstlane(F.tid >> 6); F.G = gridDim.x; F.bx = blockIdx.x;
    F.x = args.in[0]; F.meta = args.in[1]; F.g1 = args.in[2]; F.w_in = args.in[3]; F.conv_w = args.in[4]; F.conv_b = args.in[5]; F.wa = args.in[6]; F.ba = args.in[7]; F.wx = args.in[8]; F.bx_ = args.in[9];
    F.lam = args.in[10]; F.lru_gain = args.in[11]; F.pool_w = args.in[12]; F.pool_scale = args.in[13]; F.w_out = args.in[14]; F.g2 = args.in[15]; F.w_group = args.in[16]; F.b_group = args.in[17];
    F.w_router = args.in[18]; F.b_router = args.in[19]; F.w_gate = args.in[20]; F.w_up = args.in[21]; F.w_down = args.in[22]; F.final_gain = args.in[23];
    F.out = args.out; F.ws = args.ws; F.ctl = (unsigned*)(args.ws + WS_CTL);
    unsigned char* ws = args.ws;
    F.WinT = (bf16*)(ws + WS_WIN); F.WoutT = (bf16*)(ws + WS_WOUT); F.WaT = (bf16*)(ws + WS_WA); F.WxT = (bf16*)(ws + WS_WX); F.PwT = (bf16*)(ws + WS_PW); F.WrH = (_Float16*)(ws + WS_WR);
    F.AGG = (float*)(ws + WS_AGG); F.WguT = ws + WS_WGU; F.WdT = ws + WS_WD; F.RINFO = (f32x4*)(ws + WS_RINFO); F.HN1 = (bf16*)(ws + WS_HN1); F.YMIX = (bf16*)(ws + WS_HN1);
    F.PROJ = (bf16*)(ws + WS_PROJ); F.HN2 = ws + WS_PROJ; F.HID = ws + WS_HID; F.C = (bf16*)(ws + WS_C);
    volatile LAS unsigned* MISC = (volatile LAS unsigned*)(F.lds + MISC_OFF);
    if (F.tid < 64) MISC[F.tid] = 0u;
    __syncthreads();
    XcdBarrier bar; bar.bar = F.ctl + CW_BAR; bar.x = 0; bar.st = nullptr;
    if (MK_N_LAUNCHES == 1) bar = xcd_barrier_post(F.ctl + CW_BAR, MISC + 8);
    const int lo = args.ph_lo, hi = args.ph_hi;
#ifndef PH_MASK
#define PH_MASK 0x1ff
#endif
#define IN(k) (((PH_MASK >> (k)) & 1) && lo <= (k) && (k) < hi)
#define SEAM(k) do { if (IN(k) && IN((k) + 1)) xcd_barrier(bar); } while (0)
#ifndef REPEAT_MASK
#define REPEAT_MASK 0
#endif
#define REP(k) for (int rep_ = 0; rep_ <= ((REPEAT_MASK >> (k)) & 1); ++rep_)

    if (IN(0)) REP(0) { p0_prologue(F); } SEAM(0);
    if (IN(1)) { pg8::DenseSched S{M / 256, INW / 256, F.G, F.bx, D * 2, (const char*)F.WinT, 1 + ((REPEAT_MASK >> 1) & 1)}; pg8::EpiProj E{F.PROJ};
        pg8::gemm_phase(F.lds, D * 2, (const char*)F.HN1, S, E); } SEAM(1);
    if (IN(2)) REP(2) { p2_aggregates(F); } SEAM(2);
    if (IN(3)) REP(3) { p3_mixer(F); } SEAM(3);
    if (IN(4)) { pg8::DenseSched S{M / 256, D / 256, F.G, F.bx, D * 2, (const char*)F.WoutT, 1 + ((REPEAT_MASK >> 4) & 1)}; pg8::EpiResid E{F.x, F.out};
        pg8::gemm_phase(F.lds, D * 2, (const char*)F.YMIX, S, E); } SEAM(4);
    if (IN(5)) { if ((REPEAT_MASK >> 5) & 1) p5_route(F, true); p5_route(F); } SEAM(5);
    if (IN(6)) { const int NT = moe_tables(F);
        pg8::MoeSched S{NT, 4, F.G, F.bx, D, (const char*)F.WguT, (size_t)1024 * D, true, (const LAS int*)(F.lds + TAB_TE), (const LAS unsigned*)(F.lds + TAB_ROW)};
        moe_unit_tables(F, S, 0);
        pg8::EpiGateUp E{F.HID, (const LAS float*)(F.lds + TAB_F)};
        pg8::gemm_phase<pg8::EpiGateUp, pg8::MoeSched, true>(F.lds, D, (const char*)F.HN2, S, E); } SEAM(6);
    if (IN(7)) { const int NT = moe_tables(F);
        pg8::MoeSched S{NT, 4, F.G, F.bx, EFF, (const char*)F.WdT, (size_t)D * EFF, false, (const LAS int*)(F.lds + TAB_TE), (const LAS unsigned*)(F.lds + TAB_ROW)};
        moe_unit_tables(F, S, 1);
        pg8::EpiDown E{F.C, (const LAS int*)(F.lds + TAB_ROW), (const LAS float*)(F.lds + TAB_F)};
        pg8::gemm_phase<pg8::EpiDown, pg8::MoeSched, true>(F.lds, EFF, (const char*)F.HID, S, E); } SEAM(7);
    if (IN(8)) { p8_final(F); }
#undef IN
#undef SEAM
}

extern "C" void kernel_launch(void* const* d_in, const int* in_sizes, int n_in, void* d_out, int out_size, void* d_ws, size_t ws_size, hipStream_t stream) {
    static int grid = 0;
    if (grid == 0) {
        if (n_in != 24 || in_sizes[0] != M * D || out_size != M * D || ws_size < WS_END) { fprintf(stderr, "kernel_launch: unexpected shapes (n_in %d, in0 %d, out %d, ws %zu)\n", n_in, n_in > 0 ? in_sizes[0] : -1, out_size, ws_size); grid = -1; return; }
        int dev = 0, cus = 0, per_cu = 0;
        if (hipGetDevice(&dev) != hipSuccess || hipDeviceGetAttribute(&cus, hipDeviceAttributeMultiprocessorCount, dev) != hipSuccess) { grid = -1; return; }
        if (hipFuncSetAttribute((const void*)hymba_fwd, hipFuncAttributeMaxDynamicSharedMemorySize, LDS_BYTES) != hipSuccess) { fprintf(stderr, "kernel_launch: hipFuncSetAttribute failed\n"); grid = -1; return; }
        if (hipOccupancyMaxActiveBlocksPerMultiprocessor(&per_cu, (const void*)hymba_fwd, 512, LDS_BYTES) != hipSuccess || per_cu < 1) fprintf(stderr, "kernel_launch: occupancy query says %d\n", per_cu);
        (void)hipGetLastError();
        grid = cus;
    }
    if (grid < 0) return;
    if (hipMemsetAsync((char*)d_ws + WS_CTL, 0, CTL_ZERO_BYTES, stream) != hipSuccess) return;
    Args a{};
    for (int i = 0; i < 24; ++i) a.in[i] = (const float*)d_in[i];
    a.out = (float*)d_out; a.ws = (unsigned char*)d_ws;
    if (MK_N_LAUNCHES == 1) { a.ph_lo = 0; a.ph_hi = N_PHASES; hipLaunchKernelGGL(hymba_fwd, dim3(grid), dim3(512), LDS_BYTES, stream, a); }
    else for (int p = 0; p < N_PHASES; ++p) { a.ph_lo = p; a.ph_hi = p + 1; hipLaunchKernelGGL(hymba_fwd, dim3(grid), dim3(512), LDS_BYTES, stream, a); }
}
```

```cpp
#include <hip/hip_runtime.h>
#include <cstdio>
#include <cstdint>

#define GAS __attribute__((address_space(1)))
#define LAS __attribute__((address_space(3)))
typedef unsigned short bf16;
typedef short bf16x8 __attribute__((ext_vector_type(8)));
typedef _Float16 f16x8 __attribute__((ext_vector_type(8)));
typedef float f32x4 __attribute__((ext_vector_type(4)));
typedef float f32x2 __attribute__((ext_vector_type(2)));
typedef unsigned u32x4 __attribute__((ext_vector_type(4)));
typedef unsigned u32x2 __attribute__((ext_vector_type(2)));

#ifndef MK_N_LAUNCHES
#define MK_N_LAUNCHES 1
#endif
constexpr int N_PHASES = 9;

constexpr int D = 1024, NBATCH = 8, SEQ = 4096, NMETA = 16, TT = SEQ + NMETA, M = NBATCH * SEQ;
constexpr int LW = 512, INW = 1536, NE = 32, EFF = 512, NROUTE = 36;
constexpr int ECAP = 32768;
constexpr int MAXT = 288;
constexpr int MAXU = 6;
constexpr float RMS_EPS = 1e-6f;

constexpr size_t MiB = 1u << 20;
constexpr size_t WS_CTL = 0, CTL_ZERO_BYTES = 1 * MiB;
constexpr size_t WS_WIN = 2 * MiB, WS_WOUT = 5 * MiB, WS_WA = 7 * MiB, WS_WX = 7 * MiB + 65536, WS_PW = 7 * MiB + 131072, WS_WR = 7 * MiB + 262144;
constexpr size_t WS_AGG = 8 * MiB;
constexpr size_t WS_WGU = 10 * MiB  , WS_WD = 42 * MiB  , WS_RINFO = 58 * MiB, WS_HN1 = 74 * MiB  ;
constexpr size_t WS_PROJ = 138 * MiB  , WS_HID = 235 * MiB  , WS_C = 272 * MiB, WS_END = 400 * MiB;
constexpr float WGU_SCALE = 64.f, WD_SCALE = 32.f, HID_SCALE = 8.f;
constexpr int CW_BAR = 4096, CW_CNT = 16384;

constexpr int LDS_BYTES = 147456;
constexpr int MISC_OFF = LDS_BYTES - 256;
constexpr int TAB_OFF = 131072 + 512;
constexpr int TAB_ROW = TAB_OFF;
constexpr int TAB_F = TAB_ROW + MAXU * 256 * 4;
constexpr int TAB_TE = TAB_F + MAXU * 256 * 4;
constexpr int TAB_TR = TAB_TE + MAXT * 4;
constexpr int TAB_CNT = TAB_TR + MAXT * 4;
static_assert(TAB_CNT + 80 * 4 <= MISC_OFF, "LDS map");

__device__ __forceinline__ unsigned f2bf(float f) { unsigned u = __builtin_bit_cast(unsigned, f); return (u + 0x7fffu + ((u >> 16) & 1u)) >> 16; }
__device__ __forceinline__ unsigned pk2(float lo, float hi) { return f2bf(lo) | (f2bf(hi) << 16); }
__device__ __forceinline__ float bf2f(unsigned h) { return __builtin_bit_cast(float, h << 16); }
__device__ __forceinline__ float bflo(unsigned w) { return __builtin_bit_cast(float, w << 16); }
__device__ __forceinline__ float bfhi(unsigned w) { return __builtin_bit_cast(float, w & 0xffff0000u); }
__device__ __forceinline__ float sigmoidf_(float x) { return __builtin_amdgcn_rcpf(1.0f + __expf(-x)); }
#define LDS_WAIT() asm volatile("s_waitcnt lgkmcnt(0)" ::: "memory")
typedef int i32x4 __attribute__((ext_vector_type(4)));
typedef int i32x8 __attribute__((ext_vector_type(8)));
__device__ __forceinline__ float clamp448(float v) { return fminf(fmaxf(v, -448.f), 448.f); }
__device__ __forceinline__ unsigned pk4_fp8(float a, float b, float c, float d) {
    int v = __builtin_amdgcn_cvt_pk_fp8_f32(a, b, 0, false); v = __builtin_amdgcn_cvt_pk_fp8_f32(c, d, v, true); return (unsigned)v; }

#define XB_TMO      128
#define XB_XCNT(j)  (256  + 64 * (j))
#define XB_XSUB(j)  (1280 + 64 * (j))
#define XB_XGEN(j)  (2304 + 64 * (j))
#define XB_TOP      3328
#define XB_TOPGEN   3392
#define XCD_BAR_WORDS 3456
#define XB_SPIN_CAP (1u << 18)
__device__ __forceinline__ unsigned xb_ld(unsigned* p)              { return __hip_atomic_load(p, __ATOMIC_RELAXED, __HIP_MEMORY_SCOPE_AGENT); }
__device__ __forceinline__ unsigned xb_add(unsigned* p, unsigned v) { return __hip_atomic_fetch_add(p, v, __ATOMIC_RELAXED, __HIP_MEMORY_SCOPE_AGENT); }
__device__ __forceinline__ unsigned xb_xcc_id() { return (unsigned)__builtin_amdgcn_s_getreg((3 << 11) | 20) & 0xFu; }
#define XB_SPIN(cond, bar) do { unsigned _sp = 0; while (cond) { __builtin_amdgcn_s_sleep(1); \
    if ((++_sp & 255u) == 0u) { if (xb_ld(&(bar)[XB_TMO])) break; if (_sp > XB_SPIN_CAP) { atomicAdd(&(bar)[XB_TMO], 1u); break; } } } } while (0)
struct XcdBarrier { unsigned* bar; unsigned x; volatile LAS unsigned* st; };
__device__ __forceinline__ XcdBarrier xcd_barrier_post(unsigned* bar, volatile LAS unsigned* st) {
    XcdBarrier b; b.bar = bar; b.x = xb_xcc_id(); b.st = st;
    if (threadIdx.x == 0) (void)xb_add(&bar[XB_XCNT(b.x)], 1u);
    return b;
}
__device__ __forceinline__ void xcd_barrier_complete(unsigned* bar, unsigned x, unsigned& nloc, unsigned& nx) {
    const unsigned G = gridDim.x * gridDim.y * gridDim.z;
    unsigned sum, cnt, mine, sp = 0u;
    for (;;) {
        sum = 0u; cnt = 0u; mine = 0u;
#pragma unroll
        for (unsigned j = 0; j < 16; ++j) { const unsigned c = xb_ld(&bar[XB_XCNT(j)]); sum += c; cnt += (c > 0u) ? 1u : 0u; mine = (j == x) ? c : mine; }
        if (sum == G) break;
        __builtin_amdgcn_s_sleep(1);
        if ((++sp & 255u) == 0u) { if (xb_ld(&bar[XB_TMO])) break; if (sp > XB_SPIN_CAP) { atomicAdd(&bar[XB_TMO], 1u); break; } }
    }
    nloc = mine > 0u ? mine : 1u; nx = cnt > 0u ? cnt : 1u;
}
__device__ __forceinline__ void xcd_barrier(const XcdBarrier& b) {
    asm volatile("s_waitcnt vmcnt(0)" ::: "memory");
    __syncthreads();
    if (threadIdx.x == 0) {
        unsigned* bar = b.bar;
        __builtin_amdgcn_s_waitcnt(0);
        unsigned nloc = b.st[0], nx = b.st[1];
        if (nloc == 0u) { xcd_barrier_complete(bar, b.x, nloc, nx); b.st[0] = nloc; b.st[1] = nx; }
        const unsigned old = xb_add(&bar[XB_XSUB(b.x)], 1u);
        const unsigned gen = old / nloc;
        if (old + 1u == (gen + 1u) * nloc) {
            __builtin_amdgcn_fence(__ATOMIC_RELEASE, "agent");
            asm volatile("s_waitcnt vmcnt(0)" ::: "memory");
            const unsigned og = xb_add(&bar[XB_TOP], 1u);
            const unsigned tg = og / nx;
            if (og + 1u == (tg + 1u) * nx) xb_add(&bar[XB_TOPGEN], 1u);
            else XB_SPIN(xb_ld(&bar[XB_TOPGEN]) == tg, bar);
            __builtin_amdgcn_fence(__ATOMIC_ACQUIRE, "agent");
            xb_add(&bar[XB_XGEN(b.x)], 1u);
            asm volatile("s_waitcnt vmcnt(0)" ::: "memory");
        } else {
            XB_SPIN(xb_ld(&bar[XB_XGEN(b.x)]) == gen, bar);
            __builtin_amdgcn_fence(__ATOMIC_ACQUIRE, "agent");
            asm volatile("s_waitcnt vmcnt(0)" ::: "memory");
        }
    }
    __syncthreads();
}

namespace pg8 {
constexpr int BM = 256, BK = 64, HALF = 128, HTB = HALF * BK * 2, STAGE_BYTES = 8 * HTB, NXCD = 8, WGM = 8;
__host__ __device__ __forceinline__ int lds_byte(int r, int c) { const int st = (r >> 4) * 2 + (c >> 5), rr = r & 15, cc = c & 31, ob = rr * 64 + cc * 2; return st * 1024 + (ob ^ (((ob >> 9) & 1) << 5)); }
__host__ __device__ __forceinline__ void stage_rc(int b, int& R, int& C) { const int st = b / 1024, sb = b % 1024, swz = sb ^ (((sb >> 9) & 1) << 5); R = (st >> 1) * 16 + swz / 64; C = (st & 1) * 32 + (swz % 64) / 2; }
__host__ __device__ __forceinline__ int perm32(int rho) { const int n = rho >> 4, i = rho & 15; return 8 * (i >> 2) + 4 * n + (i & 3); }
struct Unit { int pm, pn; };
__device__ __forceinline__ bool static_next(int nM, int nN, int G, int c, int i, Unit& u) {
    const int nwg = nM * nN; const long L = (long)i * G + c; if (L >= nwg) return false;
    int wgid = (int)L; { const int q = nwg / NXCD, r = nwg % NXCD, xcd = wgid % NXCD, off = wgid / NXCD; wgid = (xcd < r ? xcd * (q + 1) : r * (q + 1) + (xcd - r) * q) + off; }
    const int nig = WGM * nN, gid = wgid / nig, fm = gid * WGM, gsz = (nM - fm) < WGM ? (nM - fm) : WGM;
    u.pm = fm + ((wgid % nig) % gsz); u.pn = (wgid % nig) / gsz; return true;
}
__device__ __forceinline__ unsigned cvt_pk_bf16(float lo, float hi) { unsigned r; asm volatile("v_cvt_pk_bf16_f32 %0, %1, %2" : "=v"(r) : "v"(lo), "v"(hi)); return r; }

template <class Epi, class Sched, bool FP8 = false>
__device__ __forceinline__ void gemm_phase(LAS unsigned char* lds, const int KB, const char* Abase, const Sched& S, const Epi& E) {
    const int tid = threadIdx.x, wid = __builtin_amdgcn_readfirstlane(tid >> 6), lane = tid & 63, wr = wid >> 2, wc = wid & 3, fr = lane & 15, fq = lane >> 4;
    const int nt = KB / (BK * 2);
    int Rl[2]; unsigned Cb[2], voffB[2];
#pragma unroll
    for (int i = 0; i < 2; ++i) { int R, C; stage_rc(tid * 16 + i * 8192, R, C); const int Rb = Epi::PERM ? ((R & ~31) + perm32(R & 31)) : R;
        Rl[i] = R; Cb[i] = (unsigned)C * 2u; voffB[i] = (unsigned)(Rb * KB + C * 2); }
    const size_t kstep = (size_t)(BK * 2);
    const size_t hstepB = (size_t)HALF * KB;
    const unsigned ldsw = (unsigned)wid * 1024u;
    const int aoff = lds_byte(wr * 64 + fr, fq * 8), boff = lds_byte(wc * 32 + fr, fq * 8);
#define PG8_SA(b, h) (((b) * 2 + (h)) * HTB)
#define PG8_SB(b, h) ((4 + (b) * 2 + (h)) * HTB)
#define PG8_STAGE(bufoff, gbase, voff) do { _Pragma("unroll") for (int _i = 0; _i < 2; ++_i) \
        __builtin_amdgcn_global_load_lds((const unsigned*)((const char*)(gbase) + (voff)[_i]), (LAS unsigned*)(lds + (bufoff) + ldsw + _i * 8192), 16, 0, 0); } while (0)
#define PG8_LD32(p) __builtin_shufflevector(*(const LAS i32x4*)(p), *(const LAS i32x4*)((p) + 1024), 0, 1, 2, 3, 4, 5, 6, 7)
#define PG8_LDA(dst, b, h) do { _Pragma("unroll") for (int m = 0; m < 4; ++m) dst[m] = PG8_LD32(lds + PG8_SA(b, h) + aoff + m * 2048); } while (0)
#define PG8_LDB(dst, b, h) do { _Pragma("unroll") for (int n = 0; n < 2; ++n) dst[n] = PG8_LD32(lds + PG8_SB(b, h) + boff + n * 2048); } while (0)
#define PG8_LO(v) __builtin_bit_cast(bf16x8, __builtin_shufflevector((v), (v), 0, 1, 2, 3))
#define PG8_HI(v) __builtin_bit_cast(bf16x8, __builtin_shufflevector((v), (v), 4, 5, 6, 7))
#define PG8_MMA(ai, bj, At, Bt) do { __builtin_amdgcn_s_setprio(1); _Pragma("unroll") for (int m = 0; m < 4; ++m) _Pragma("unroll") for (int n = 0; n < 2; ++n) { \
        if constexpr (FP8) asm volatile("v_mfma_f32_16x16x128_f8f6f4 %0, %1, %2, %0" : "+v"(acc[ai][bj][m][n]) : "v"(Bt[n]), "v"(At[m])); \
        else { acc[ai][bj][m][n] = __builtin_amdgcn_mfma_f32_16x16x32_bf16(PG8_LO(Bt[n]), PG8_LO(At[m]), acc[ai][bj][m][n], 0, 0, 0); \
               acc[ai][bj][m][n] = __builtin_amdgcn_mfma_f32_16x16x32_bf16(PG8_HI(Bt[n]), PG8_HI(At[m]), acc[ai][bj][m][n], 0, 0, 0); } } \
        __builtin_amdgcn_s_setprio(0); } while (0)
#define PG8_WAIT_V(n) asm volatile("s_waitcnt vmcnt(" #n ")" ::: "memory")
#define PG8_WAIT_L(n) asm volatile("s_waitcnt lgkmcnt(" #n ")" ::: "memory")
#define PG8_BAR __builtin_amdgcn_s_barrier()
#define PG8_SCHED __builtin_amdgcn_sched_barrier(0)
    Unit cur, nxt; int ui = 0;
    if (!S.next(0, cur)) return;
    f32x4 acc[2][2][4][2];
#pragma unroll
    for (int a = 0; a < 2; ++a)
#pragma unroll
        for (int b = 0; b < 2; ++b)
#pragma unroll
            for (int m = 0; m < 4; ++m)
#pragma unroll
                for (int n = 0; n < 2; ++n) acc[a][b][m][n] = (f32x4){0.f, 0.f, 0.f, 0.f};
    i32x8 At[4], B0[2], B1[2];
    unsigned cO0[2], cO1[2], nO0[2], nO1[2];
#pragma unroll
    for (int i = 0; i < 2; ++i) { cO0[i] = S.a_off(0, cur, Rl[i]) + Cb[i]; cO1[i] = S.a_off(0, cur, HALF + Rl[i]) + Cb[i]; }
    const char* cB = S.b_base(cur);
    PG8_STAGE(PG8_SB(0, 0), cB, voffB); PG8_STAGE(PG8_SB(0, 1), cB + hstepB, voffB); PG8_STAGE(PG8_SA(0, 0), Abase, cO0); PG8_STAGE(PG8_SA(0, 1), Abase, cO1);
    if (wr == 1) PG8_BAR;
    PG8_WAIT_V(2); PG8_BAR;
    PG8_STAGE(PG8_SB(1, 0), cB + kstep, voffB); PG8_STAGE(PG8_SA(1, 0), Abase + kstep, cO0); PG8_STAGE(PG8_SB(1, 1), cB + hstepB + kstep, voffB);
    PG8_WAIT_V(6); PG8_BAR;
    for (;;) {
        const bool has_next = S.next(ui + 1, nxt);
        const char* nB = cB;
#pragma unroll
        for (int i = 0; i < 2; ++i) { nO0[i] = cO0[i]; nO1[i] = cO1[i]; }
        if (has_next) { nB = S.b_base(nxt);
#pragma unroll
            for (int i = 0; i < 2; ++i) { nO0[i] = S.a_off(ui + 1, nxt, Rl[i]) + Cb[i]; nO1[i] = S.a_off(ui + 1, nxt, HALF + Rl[i]) + Cb[i]; } }
#pragma nounroll
        for (int t = 0; t < nt; t += 2) {
            const bool last = (t == nt - 2);
            const char* a1 = Abase + (size_t)(t + 1) * kstep;
            const char* a2 = last ? Abase : Abase + (size_t)(t + 2) * kstep; const char* b2 = last ? nB : cB + (size_t)(t + 2) * kstep;
            const char* a3 = a2 + kstep; const char* b3 = b2 + kstep;
            unsigned o0[2], o1[2];
#pragma unroll
            for (int i = 0; i < 2; ++i) { o0[i] = last ? nO0[i] : cO0[i]; o1[i] = last ? nO1[i] : cO1[i]; }
            PG8_LDB(B0, 0, 0); PG8_LDB(B1, 0, 1); PG8_SCHED; PG8_LDA(At, 0, 0); PG8_STAGE(PG8_SA(1, 1), a1, cO1);
            PG8_WAIT_V(8); PG8_WAIT_L(0); PG8_BAR; PG8_MMA(0, 0, At, B0); PG8_MMA(0, 1, At, B1); PG8_BAR; PG8_SCHED;
            PG8_LDA(At, 0, 1); PG8_STAGE(PG8_SB(0, 0), b2, voffB); PG8_STAGE(PG8_SB(0, 1), b2 + hstepB, voffB); PG8_STAGE(PG8_SA(0, 0), a2, o0);
            PG8_WAIT_V(8); PG8_WAIT_L(0); PG8_BAR; PG8_MMA(1, 0, At, B0); PG8_MMA(1, 1, At, B1); PG8_BAR; PG8_SCHED;
            PG8_LDB(B0, 1, 0); PG8_LDB(B1, 1, 1); PG8_SCHED; PG8_LDA(At, 1, 0); PG8_STAGE(PG8_SA(0, 1), a2, o1);
            PG8_WAIT_V(8); PG8_WAIT_L(0); PG8_BAR; PG8_MMA(0, 0, At, B0); PG8_MMA(0, 1, At, B1); PG8_BAR; PG8_SCHED;
            PG8_LDA(At, 1, 1); PG8_STAGE(PG8_SB(1, 0), b3, voffB); PG8_STAGE(PG8_SB(1, 1), b3 + hstepB, voffB); PG8_STAGE(PG8_SA(1, 0), a3, o0);
            PG8_WAIT_V(8); PG8_WAIT_L(0); PG8_BAR; PG8_MMA(1, 0, At, B0); PG8_MMA(1, 1, At, B1); PG8_BAR; PG8_SCHED;
        }
        if (wr == 0) PG8_BAR;
        if constexpr (FP8) asm volatile("s_nop 15\n\ts_nop 15" ::: "memory");
        E(acc, cur, ui, wr, wc, fr, fq);
        if (!has_next) break;
#pragma unroll
        for (int a = 0; a < 2; ++a)
#pragma unroll
            for (int b = 0; b < 2; ++b)
#pragma unroll
                for (int m = 0; m < 4; ++m)
#pragma unroll
                    for (int n = 0; n < 2; ++n) acc[a][b][m][n] = (f32x4){0.f, 0.f, 0.f, 0.f};
        cur = nxt; cB = nB; ++ui;
#pragma unroll
        for (int i = 0; i < 2; ++i) { cO0[i] = nO0[i]; cO1[i] = nO1[i]; }
        if (wr == 1) PG8_BAR;
    }
    PG8_WAIT_V(0);
    PG8_BAR;
#undef PG8_SA
#undef PG8_SB
#undef PG8_STAGE
#undef PG8_LDA
#undef PG8_LDB
#undef PG8_MMA
#undef PG8_LO
#undef PG8_HI
#undef PG8_LD32
#undef PG8_WAIT_V
#undef PG8_WAIT_L
#undef PG8_BAR
#undef PG8_SCHED
}

struct DenseSched {
    int nM, nN, G, c, K2; const char* B; int reps;
    __device__ __forceinline__ bool next(int i, Unit& u) const { const int rounds = (nM * nN + G - 1) / G; if (i >= rounds * reps) return false; return static_next(nM, nN, G, c, i % rounds, u); }
    __device__ __forceinline__ const char* b_base(const Unit& u) const { return B + (size_t)u.pn * BM * K2; }
    __device__ __forceinline__ unsigned a_off(int, const Unit& u, int r) const { return (unsigned)(u.pm * BM + r) * (unsigned)K2; }
};
struct MoeSched {
    int NT, nN, G, c, K2; const char* B; size_t estride; bool gather;
    const LAS int* tile_e; const LAS unsigned* rowtab;
    __device__ __forceinline__ bool next(int i, Unit& u) const { return static_next(NT, nN, G, c, i, u); }
    __device__ __forceinline__ const char* b_base(const Unit& u) const { return B + (size_t)tile_e[u.pm] * estride + (size_t)u.pn * BM * K2; }
    __device__ __forceinline__ unsigned a_off(int ui, const Unit& u, int r) const { return gather ? rowtab[ui * 256 + r] : (unsigned)(u.pm * BM + r) * (unsigned)K2; }
};

struct EpiProj {
    static constexpr bool PERM = true;
    bf16* O;
    __device__ __forceinline__ void operator()(const f32x4 (&acc)[2][2][4][2], const Unit& u, int, int wr, int wc, int fr, int fq) const {
        const int row0 = u.pm * BM + 16 * ((u.pm >> 4) + 1) + wr * 64 + fr, col0 = u.pn * BM + wc * 32 + 8 * fq;
#pragma unroll
        for (int ai = 0; ai < 2; ++ai)
#pragma unroll
            for (int m = 0; m < 4; ++m) { bf16* rowp = O + (size_t)(row0 + ai * HALF + m * 16) * INW + col0;
#pragma unroll
                for (int bj = 0; bj < 2; ++bj) { const f32x4 v0 = acc[ai][bj][m][0], v1 = acc[ai][bj][m][1];
                    u32x4 w; w.x = cvt_pk_bf16(v0[0], v0[1]); w.y = cvt_pk_bf16(v0[2], v0[3]); w.z = cvt_pk_bf16(v1[0], v1[1]); w.w = cvt_pk_bf16(v1[2], v1[3]);
                    *(u32x4*)(rowp + bj * HALF) = w; } }
    }
};
struct EpiResid {
    static constexpr bool PERM = false;
    const float* X; float* O;
    __device__ __forceinline__ void operator()(const f32x4 (&acc)[2][2][4][2], const Unit& u, int, int wr, int wc, int fr, int fq) const {
        const int row0 = u.pm * BM + wr * 64 + fr, col0 = u.pn * BM + wc * 32 + 4 * fq;
#pragma unroll
        for (int ai = 0; ai < 2; ++ai)
#pragma unroll
            for (int m = 0; m < 4; ++m) { const size_t off = (size_t)(row0 + ai * HALF + m * 16) * D + col0;
#pragma unroll
                for (int bj = 0; bj < 2; ++bj)
#pragma unroll
                    for (int n = 0; n < 2; ++n) { const f32x4 xv = *(const f32x4*)(X + off + bj * HALF + n * 16); *(f32x4*)(O + off + bj * HALF + n * 16) = acc[ai][bj][m][n] + xv; }
                asm volatile("" ::: "memory"); }
    }
};
struct EpiGateUp {
    static constexpr bool PERM = true;
    unsigned char* H; const LAS float* rstd;
    __device__ __forceinline__ void operator()(const f32x4 (&acc)[2][2][4][2], const Unit& u, int ui, int wr, int wc, int fr, int fq) const {
        const int r0 = wr * 64 + fr, col0 = u.pn * HALF + wc * 32 + 8 * fq;
#pragma unroll
        for (int ai = 0; ai < 2; ++ai)
#pragma unroll
            for (int m = 0; m < 4; ++m) { const int r = r0 + ai * HALF + m * 16; const float rs = rstd[ui * 256 + r];
                float h[8];
#pragma unroll
                for (int n = 0; n < 2; ++n)
#pragma unroll
                    for (int j = 0; j < 4; ++j) { const float g = acc[ai][0][m][n][j] * rs, up = acc[ai][1][m][n][j] * rs; h[n * 4 + j] = g * sigmoidf_(g) * up; }
#pragma unroll
                for (int j = 0; j < 8; ++j) h[j] = clamp448(h[j] * HID_SCALE);
                u32x2 w; w.x = pk4_fp8(h[0], h[1], h[2], h[3]); w.y = pk4_fp8(h[4], h[5], h[6], h[7]);
                *(u32x2*)(H + (size_t)(u.pm * BM + r) * EFF + col0) = w; }
    }
};
struct EpiDown {
    static constexpr bool PERM = true;
    bf16* C; const LAS int* slot; const LAS float* gate;
    __device__ __forceinline__ void operator()(const f32x4 (&acc)[2][2][4][2], const Unit& u, int ui, int wr, int wc, int fr, int fq) const {
        const int r0 = wr * 64 + fr, col0 = u.pn * BM + wc * 32 + 8 * fq;
#pragma unroll
        for (int ai = 0; ai < 2; ++ai)
#pragma unroll
            for (int m = 0; m < 4; ++m) { const int r = r0 + ai * HALF + m * 16; const int sl = slot[ui * 256 + r]; const float gt = gate[ui * 256 + r];
                if (sl >= 0) { bf16* rowp = C + (size_t)sl * D + col0;
#pragma unroll
                    for (int bj = 0; bj < 2; ++bj) { const f32x4 v0 = acc[ai][bj][m][0] * gt, v1 = acc[ai][bj][m][1] * gt;
                        u32x4 w; w.x = cvt_pk_bf16(v0[0], v0[1]); w.y = cvt_pk_bf16(v0[2], v0[3]); w.z = cvt_pk_bf16(v1[0], v1[1]); w.w = cvt_pk_bf16(v1[2], v1[3]);
                        *(u32x4*)(rowp + bj * HALF) = w; } } }
    }
};
}

struct Frame {
    LAS unsigned char* lds; int tid, lane, wave, G, bx;
    const float *x, *meta, *g1, *w_in, *conv_w, *conv_b, *wa, *ba, *wx, *bx_, *lam, *lru_gain, *pool_w, *pool_scale, *w_out, *g2, *w_group, *b_group, *w_router, *b_router, *w_gate, *w_up, *w_down, *final_gain;
    float* out; unsigned char* ws; unsigned* ctl;
    bf16 *WinT, *WoutT, *WaT, *WxT, *PwT, *HN1, *YMIX, *PROJ, *C; unsigned char *WguT, *WdT, *HN2, *HID;
    _Float16* WrH; float* AGG; f32x4* RINFO;
};
__device__ __forceinline__ float wave_sum(float v) {
#pragma unroll
    for (int o = 1; o < 64; o <<= 1) v += __shfl_xor(v, o);
    return v;
}

__device__ __forceinline__ void transpose_tile(const float* W, int ldw, int k0, int n0, bf16* WT, int ldt, int drow0, LAS float* scr, int lane) {
#pragma unroll 8
    for (int i = 0; i < 32; ++i) { const int kk = 2 * i + (lane >> 5); scr[kk * 33 + (lane & 31)] = W[(size_t)(k0 + kk) * ldw + n0 + (lane & 31)]; }
    LDS_WAIT(); asm volatile("" ::: "memory");
    const int c = lane & 7;
#pragma unroll
    for (int j = 0; j < 4; ++j) { const int n = (lane >> 3) + 8 * j; const LAS float* s = scr + (8 * c) * 33 + n;
        u32x4 o; o.x = pk2(s[0 * 33], s[1 * 33]); o.y = pk2(s[2 * 33], s[3 * 33]); o.z = pk2(s[4 * 33], s[5 * 33]); o.w = pk2(s[6 * 33], s[7 * 33]);
        *(u32x4*)(WT + (size_t)(drow0 + n) * ldt + k0 + 8 * c) = o; }
    LDS_WAIT(); asm volatile("" ::: "memory");
}
__device__ __forceinline__ void transpose_tile_fp8(const float* W, int ldw, int k0, int n0, unsigned char* WT, int ldt, int drow0, float scale, LAS float* scr, int lane) {
#pragma unroll 8
    for (int i = 0; i < 64; ++i) { const int kk = 2 * i + (lane >> 5); scr[kk * 33 + (lane & 31)] = W[(size_t)(k0 + kk) * ldw + n0 + (lane & 31)]; }
    LDS_WAIT(); asm volatile("" ::: "memory");
    const int n = lane >> 1, kh = (lane & 1) * 64; const LAS float* sp = scr + kh * 33 + n;
#pragma unroll
    for (int c = 0; c < 4; ++c) { u32x4 o;
#pragma unroll
        for (int w = 0; w < 4; ++w) { const LAS float* q4 = sp + (16 * c + 4 * w) * 33; o[w] = pk4_fp8(q4[0] * scale, q4[33] * scale, q4[66] * scale, q4[99] * scale); }
        *(u32x4*)(WT + (size_t)(drow0 + n) * ldt + k0 + kh + 16 * c) = o; }
    LDS_WAIT(); asm volatile("" ::: "memory");
}
__device__ __forceinline__ void p0_prologue(Frame& F) {
    if (F.bx < INW / 8) {
        LAS float* hnm = (LAS float*)F.lds;
        LAS float* part = (LAS float*)(F.lds + 65536);
        for (int r = F.wave * 2; r < F.wave * 2 + 2; ++r) {
            const f32x4* xr = (const f32x4*)(F.meta + (size_t)r * D) + F.lane; f32x4 v[4]; float s = 0.f;
#pragma unroll
            for (int j = 0; j < 4; ++j) { v[j] = xr[64 * j]; s += (v[j].x * v[j].x + v[j].y * v[j].y) + (v[j].z * v[j].z + v[j].w * v[j].w); }
            const float rstd = rsqrtf(wave_sum(s) * (1.f / D) + RMS_EPS);
#pragma unroll
            for (int j = 0; j < 4; ++j) { const f32x4 g = ((const f32x4*)F.g1)[F.lane + 64 * j]; *(LAS f32x4*)(hnm + r * D + 4 * F.lane + 256 * j) = v[j] * rstd * g; }
        }
        __syncthreads();
        { const int cc = F.tid & 7, ks = F.tid >> 3, col = F.bx * 8 + cc; float a[16];
#pragma unroll
            for (int r = 0; r < 16; ++r) a[r] = 0.f;
            for (int k = ks * 16; k < ks * 16 + 16; ++k) { const float w = F.w_in[(size_t)k * INW + col];
#pragma unroll
                for (int r = 0; r < 16; ++r) a[r] += hnm[r * D + k] * w; }
#pragma unroll
            for (int r = 0; r < 16; ++r) part[(ks * 16 + r) * 8 + cc] = a[r]; }
        __syncthreads();
        if (F.tid < 128) { const int r = F.tid >> 3, cc = F.tid & 7; float s = 0.f;
            for (int ks = 0; ks < 64; ++ks) s += part[(ks * 16 + r) * 8 + cc];
            const bf16 h = (bf16)f2bf(s);
            for (int b = 0; b < NBATCH; ++b) F.PROJ[(size_t)(b * TT + r) * INW + F.bx * 8 + cc] = h; }
        __syncthreads();
    }
    LAS float* scr = (LAS float*)(F.lds + F.wave * 16896);
    const int gw = F.bx * 8 + F.wave, NGW = F.G * 8;
    constexpr int I_IN = 16 * 48, I_OUT = 16 * 32, I_G = NE * 8 * 16, I_D = NE * 4 * 32, I_A = 8 * 2, I_P = 4 * 2 * 4;
    constexpr int NITEMS = I_IN + I_OUT + 2 * I_G + I_D + 2 * I_A + I_P;
    for (int it = gw; it < NITEMS; it += NGW) {
        int r = it;
        if (r < I_IN) { const int kb = r / 48, nb = r % 48; transpose_tile(F.w_in, INW, 64 * kb, 32 * nb, F.WinT, D, 32 * nb, scr, F.lane); continue; } r -= I_IN;
        if (r < I_OUT) { const int kb = r / 32, nb = r % 32; transpose_tile(F.w_out, D, 64 * kb, 32 * nb, F.WoutT, D, 32 * nb, scr, F.lane); continue; } r -= I_OUT;
        if (r < 2 * I_G) { const int up = r >= I_G; if (up) r -= I_G; const int e = r >> 7, kb = (r >> 4) & 7, nb = r & 15, n0 = 32 * nb;
            transpose_tile_fp8((up ? F.w_up : F.w_gate) + (size_t)e * D * EFF, EFF, 128 * kb, n0, F.WguT + (size_t)e * 1024 * D, D, (n0 >> 7) * 256 + up * 128 + (n0 & 127), WGU_SCALE, scr, F.lane); continue; } r -= 2 * I_G;
        if (r < I_D) { const int e = r >> 7, kb = (r >> 5) & 3, nb = r & 31; transpose_tile_fp8(F.w_down + (size_t)e * EFF * D, D, 128 * kb, 32 * nb, F.WdT + (size_t)e * D * EFF, EFF, 32 * nb, WD_SCALE, scr, F.lane); continue; } r -= I_D;
        if (r < 2 * I_A) { const int x = r >= I_A; if (x) r -= I_A; const int h = r >> 1, nb = r & 1; transpose_tile((x ? F.wx : F.wa) + (size_t)h * 4096, 64, 0, 32 * nb, (x ? F.WxT : F.WaT) + (size_t)h * 4096, 64, 32 * nb, scr, F.lane); continue; } r -= 2 * I_A;
        { const int g = r >> 3, kb = (r >> 2) & 1, nb = r & 3; transpose_tile(F.pool_w + (size_t)g * 16384, 128, 64 * kb, 32 * nb, F.PwT + (size_t)g * 16384, 128, 32 * nb, scr, F.lane); }
    }
    for (int i = F.bx * 512 + F.tid; i < NROUTE * D; i += F.G * 512) { const int n = i >> 10, k = i & 1023;
        const float w = n < 4 ? F.w_group[k * 4 + n] : F.w_router[k * 32 + (n - 4)]; F.WrH[i] = (_Float16)(w * 256.0f); }
    for (int m = gw; m < M; m += NGW) {
        const f32x4* xr = (const f32x4*)(F.x + (size_t)m * D) + F.lane; f32x4 v[4]; float s = 0.f;
#pragma unroll
        for (int j = 0; j < 4; ++j) { v[j] = xr[64 * j]; s += (v[j].x * v[j].x + v[j].y * v[j].y) + (v[j].z * v[j].z + v[j].w * v[j].w); }
        const float rstd = rsqrtf(wave_sum(s) * (1.f / D) + RMS_EPS);
        u32x2* o8 = (u32x2*)(F.HN1 + (size_t)m * D) + F.lane;
#pragma unroll
        for (int j = 0; j < 4; ++j) { const f32x4 g = ((const f32x4*)F.g1)[F.lane + 64 * j]; const f32x4 y = v[j] * rstd * g; u32x2 w; w.x = pk2(y.x, y.y); w.y = pk2(y.z, y.w); o8[64 * j] = w; }
    }
}

template <int CTRL> __device__ __forceinline__ float dpp_f(float old, float src) {
    return __builtin_bit_cast(float, __builtin_amdgcn_update_dpp(__builtin_bit_cast(int, old), __builtin_bit_cast(int, src), CTRL, 0xf, 0xf, false)); }
#define DPP_BCAST15 0x15F
__device__ __forceinline__ void row_scan(float& A, float& B) {
    { const float Ap = dpp_f<0x111>(1.0f, A), Bp = dpp_f<0x111>(0.0f, B); B = A * Bp + B; A = A * Ap; }
    { const float Ap = dpp_f<0x112>(1.0f, A), Bp = dpp_f<0x112>(0.0f, B); B = A * Bp + B; A = A * Ap; }
    { const float Ap = dpp_f<0x114>(1.0f, A), Bp = dpp_f<0x114>(0.0f, B); B = A * Bp + B; A = A * Ap; }
    { const float Ap = dpp_f<0x118>(1.0f, A), Bp = dpp_f<0x118>(0.0f, B); B = A * Bp + B; A = A * Ap; }
}
struct LruW { LAS float* cst; const bf16 *waP, *wxP; };
__device__ __forceinline__ void lru_setup(const Frame& F, LruW& L, LAS unsigned char* wbase) {
    const int hd = F.wave; L.cst = (LAS float*)wbase;
    for (int i = F.lane; i < 512; i += 64) { const int t = i >> 6, ch = hd * 64 + (i & 63); float v;
        if (t < 4) v = F.conv_w[t * LW + ch]; else if (t == 4) v = F.conv_b[ch]; else if (t == 5) v = F.ba[ch]; else if (t == 6) v = F.bx_[ch];
        else { const float lm = F.lam[ch]; v = 8.0f * (fminf(lm, 0.f) - log1pf(__expf(-fabsf(lm)))); }
        L.cst[i] = v; }
    const int i = F.lane & 15, qw = F.lane >> 4; const size_t o = (size_t)hd * 4096 + (size_t)(8 * (i >> 2) + (i & 3)) * 64 + 8 * qw;
    L.waP = F.WaT + o; L.wxP = F.WxT + o;
    LDS_WAIT();
}
template <bool WITH_UG>
__device__ __forceinline__ void lru_block(const Frame& F, const LruW& L, int b, int tt0, float (&Av)[16], float (&Bv)[16], u32x4 (&ugp)[2]) {
    const int hd = F.wave, row = F.lane & 15, q = F.lane >> 4, tt = tt0 + row;
    const bf16* prow = F.PROJ + (size_t)(b * TT + tt) * INW + hd * 64 + 8 * q;
    float xc[16]; bf16x8 xf[2];
#pragma unroll
    for (int kb = 0; kb < 2; ++kb) {
        const LAS float* cs = L.cst + 32 * kb + 8 * q;
        { const f32x4 c0 = *(const LAS f32x4*)(cs + 256), c1 = *(const LAS f32x4*)(cs + 260);
          xc[8 * kb + 0] = c0.x; xc[8 * kb + 1] = c0.y; xc[8 * kb + 2] = c0.z; xc[8 * kb + 3] = c0.w; xc[8 * kb + 4] = c1.x; xc[8 * kb + 5] = c1.y; xc[8 * kb + 6] = c1.z; xc[8 * kb + 7] = c1.w; }
#pragma unroll
        for (int k = 0; k < 4; ++k) {
            u32x4 u = (u32x4){0u, 0u, 0u, 0u};
            if (tt - 3 + k >= 0) u = *(const u32x4*)(prow + (ptrdiff_t)(k - 3) * INW + 32 * kb);
            const f32x4 w0 = *(const LAS f32x4*)(cs + 64 * k), w1 = *(const LAS f32x4*)(cs + 64 * k + 4);
            xc[8 * kb + 0] += w0.x * bflo(u.x); xc[8 * kb + 1] += w0.y * bfhi(u.x); xc[8 * kb + 2] += w0.z * bflo(u.y); xc[8 * kb + 3] += w0.w * bfhi(u.y);
            xc[8 * kb + 4] += w1.x * bflo(u.z); xc[8 * kb + 5] += w1.y * bfhi(u.z); xc[8 * kb + 6] += w1.z * bflo(u.w); xc[8 * kb + 7] += w1.w * bfhi(u.w);
        }
        asm volatile("" : "+v"(xc[8 * kb + 0]), "+v"(xc[8 * kb + 1]), "+v"(xc[8 * kb + 2]), "+v"(xc[8 * kb + 3]), "+v"(xc[8 * kb + 4]), "+v"(xc[8 * kb + 5]), "+v"(xc[8 * kb + 6]), "+v"(xc[8 * kb + 7]));
        u32x4 p; p.x = pk2(xc[8 * kb + 0], xc[8 * kb + 1]); p.y = pk2(xc[8 * kb + 2], xc[8 * kb + 3]); p.z = pk2(xc[8 * kb + 4], xc[8 * kb + 5]); p.w = pk2(xc[8 * kb + 6], xc[8 * kb + 7]);
        xf[kb] = __builtin_bit_cast(bf16x8, p);
        if (WITH_UG) ugp[kb] = *(const u32x4*)(prow + LW + 32 * kb);
        asm volatile("" ::: "memory");
    }
#pragma unroll
    for (int nb = 0; nb < 4; ++nb) {
        const int kb = nb >> 1, hf = nb & 1;
        f32x4 ra = (f32x4){0.f, 0.f, 0.f, 0.f}, rx = ra;
#pragma unroll
        for (int kk = 0; kk < 2; ++kk) { const bf16x8 wa = *(const bf16x8*)(L.waP + (32 * kb + 4 * hf) * 64 + 32 * kk), wx = *(const bf16x8*)(L.wxP + (32 * kb + 4 * hf) * 64 + 32 * kk);
            ra = __builtin_amdgcn_mfma_f32_16x16x32_bf16(wa, xf[kk], ra, 0, 0, 0); rx = __builtin_amdgcn_mfma_f32_16x16x32_bf16(wx, xf[kk], rx, 0, 0, 0); }
        const LAS float* cs = L.cst + 32 * kb + 8 * q + 4 * hf;
        const f32x4 ba4 = *(const LAS f32x4*)(cs + 320), bx4 = *(const LAS f32x4*)(cs + 384), lm4 = *(const LAS f32x4*)(cs + 448);
#pragma unroll
        for (int j = 0; j < 4; ++j) { const int c = 8 * kb + 4 * hf + j;
            const float r = sigmoidf_(ra[j] + ba4[j]), ig = sigmoidf_(rx[j] + bx4[j]);
            const float a = __expf(lm4[j] * r);
            Av[c] = a; Bv[c] = __builtin_amdgcn_sqrtf(fmaf(-a, a, 1.0f)) * (ig * xc[c]); }
        asm volatile("" ::: "memory");
    }
#pragma unroll
    for (int c = 0; c < 16; ++c) row_scan(Av[c], Bv[c]);
}
__device__ __forceinline__ void p2_aggregates(Frame& F) {
    LruW L; lru_setup(F, L, F.lds + F.wave * 2048);
    const int row = F.lane & 15, q = F.lane >> 4;
    for (int ch = F.bx; ch < 256; ch += F.G) {
        const int b = ch >> 5, ci = ch & 31; float Ac[16], Bc[16];
#pragma unroll
        for (int c = 0; c < 16; ++c) { Ac[c] = 1.f; Bc[c] = 0.f; }
        for (int blk = (ci == 0 ? -1 : 0); blk < 8; ++blk) {
            float Av[16], Bv[16]; u32x4 ug[2];
            lru_block<false>(F, L, b, NMETA + 128 * ci + 16 * blk, Av, Bv, ug);
#pragma unroll
            for (int c = 0; c < 16; ++c) { Bc[c] = Av[c] * Bc[c] + Bv[c]; Ac[c] *= Av[c]; }
        }
        if (row == 15) {
#pragma unroll
            for (int kb = 0; kb < 2; ++kb) { float* o = F.AGG + ((size_t)ch * LW + F.wave * 64 + 32 * kb + 8 * q) * 2;
#pragma unroll
                for (int j = 0; j < 8; j += 2) *(f32x4*)(o + 2 * j) = (f32x4){Ac[8 * kb + j], Bc[8 * kb + j], Ac[8 * kb + j + 1], Bc[8 * kb + j + 1]}; }
        }
    }
}

constexpr int YT_STRIDE = 520;
constexpr int US_STRIDE = 264;
constexpr int PW_STRIDE = 136;
template <int G> __device__ __forceinline__ void pool_z(const LAS bf16* ub  , bf16x8 (&zf)[4]) {
    constexpr int W = 2 << G;
    asm volatile("" : "+v"(ub));
#pragma unroll
    for (int kb = 0; kb < 4; ++kb) {
        const LAS bf16* p = ub + 15 * US_STRIDE + 32 * kb; const u32x4 c = *(const LAS u32x4*)p; float cur[8], s[8];
        cur[0] = bflo(c.x); cur[1] = bfhi(c.x); cur[2] = bflo(c.y); cur[3] = bfhi(c.y); cur[4] = bflo(c.z); cur[5] = bfhi(c.z); cur[6] = bflo(c.w); cur[7] = bfhi(c.w);
#pragma unroll
        for (int j = 0; j < 8; ++j) s[j] = cur[j];
#pragma unroll
        for (int d = 1; d < W; ++d) { const u32x4 u = *(const LAS u32x4*)(ub + (15 - d) * US_STRIDE + 32 * kb);
            s[0] += bflo(u.x); s[1] += bfhi(u.x); s[2] += bflo(u.y); s[3] += bfhi(u.y); s[4] += bflo(u.z); s[5] += bfhi(u.z); s[6] += bflo(u.w); s[7] += bfhi(u.w);
            if ((d & 3) == 3) asm volatile("" : "+v"(s[0]), "+v"(s[1]), "+v"(s[2]), "+v"(s[3]), "+v"(s[4]), "+v"(s[5]), "+v"(s[6]), "+v"(s[7]) :: "memory"); }
        asm volatile("" : "+v"(s[0]), "+v"(s[1]), "+v"(s[2]), "+v"(s[3]), "+v"(s[4]), "+v"(s[5]), "+v"(s[6]), "+v"(s[7]) :: "memory");
        u32x4 pz; pz.x = pk2(s[0] * (1.0f / W) - cur[0], s[1] * (1.0f / W) - cur[1]); pz.y = pk2(s[2] * (1.0f / W) - cur[2], s[3] * (1.0f / W) - cur[3]);
        pz.z = pk2(s[4] * (1.0f / W) - cur[4], s[5] * (1.0f / W) - cur[5]); pz.w = pk2(s[6] * (1.0f / W) - cur[6], s[7] * (1.0f / W) - cur[7]);
        asm volatile("" : "+v"(pz) :: "memory");
        zf[kb] = __builtin_bit_cast(bf16x8, pz);
    }
}
__device__ __forceinline__ void p3_mixer(Frame& F) {
    LAS bf16* Y = (LAS bf16*)F.lds;
    LAS unsigned char* wbase = F.lds + 66560 + F.wave * 2048;
    LAS float* SSQ = (LAS float*)(F.lds + 66560 + 16384);
    LAS float* RSTD = SSQ + 512;
    LAS bf16* US = (LAS bf16*)F.lds;
    const int row = F.lane & 15, q = F.lane >> 4;
    for (int ch = F.bx; ch < 256; ch += F.G) {
        const int b = ch >> 5, ci = ch & 31; const int m0 = ch * 128;
#ifndef P3_NO_LRU
        {
        LruW L; lru_setup(F, L, wbase);
        float H[16];
        { float Ar[16], Br[16];
#pragma unroll
            for (int c = 0; c < 16; ++c) { Ar[c] = 1.f; Br[c] = 0.f; }
#pragma unroll
            for (int t = 0; t < 2; ++t) { const int k = 2 * row + t;
                if (k < ci) {
#pragma unroll
                    for (int kb = 0; kb < 2; ++kb) { const float* o = F.AGG + ((size_t)(b * 32 + k) * LW + F.wave * 64 + 32 * kb + 8 * q) * 2;
#pragma unroll
                        for (int j = 0; j < 8; j += 2) { const f32x4 v = *(const f32x4*)(o + 2 * j); const int c = 8 * kb + j;
                            Br[c] = v.x * Br[c] + v.y; Ar[c] *= v.x; Br[c + 1] = v.z * Br[c + 1] + v.w; Ar[c + 1] *= v.z; } } } }
#pragma unroll
            for (int c = 0; c < 16; ++c) { row_scan(Ar[c], Br[c]); H[c] = dpp_f<DPP_BCAST15>(0.f, Br[c]); } }
        if (ci == 0) {
            float Av[16], Bv[16]; u32x4 ug[2]; lru_block<false>(F, L, b, 0, Av, Bv, ug);
#pragma unroll
            for (int c = 0; c < 16; ++c) H[c] = dpp_f<DPP_BCAST15>(0.f, Av[c] * H[c] + Bv[c]);
        }
        for (int half = 0; half < 2; ++half) {
            for (int blk = 0; blk < 4; ++blk) {
                const int rb = 16 * blk; float Av[16], Bv[16]; u32x4 ug[2];
                lru_block<true>(F, L, b, NMETA + 128 * ci + 64 * half + rb, Av, Bv, ug);
                float ss = 0.f;
#pragma unroll
                for (int kb = 0; kb < 2; ++kb) { float y[8];
#pragma unroll
                    for (int j = 0; j < 8; ++j) { const int c = 8 * kb + j;
                        const float h = Av[c] * H[c] + Bv[c];
                        const unsigned w = ug[kb][j >> 1]; const float g = (j & 1) ? bfhi(w) : bflo(w);
                        const float gl = g * sigmoidf_(1.5957691216f * (g + 0.044715f * g * g * g));
                        y[j] = h * gl; ss += y[j] * y[j];
                        H[c] = dpp_f<DPP_BCAST15>(0.f, h); }
                    u32x4 p; p.x = pk2(y[0], y[1]); p.y = pk2(y[2], y[3]); p.z = pk2(y[4], y[5]); p.w = pk2(y[6], y[7]);
                    *(LAS u32x4*)(Y + (rb + row) * YT_STRIDE + F.wave * 64 + 32 * kb + 8 * q) = p;
                    asm volatile("" : "+v"(ss) :: "memory"); }
                ss += __shfl_xor(ss, 16); ss += __shfl_xor(ss, 32);
                if (q == 0) SSQ[(rb + row) * 8 + F.wave] = ss;
            }
            __syncthreads();
            if (F.tid < 64) { float s = 0.f;
#pragma unroll
                for (int w = 0; w < 8; ++w) s += SSQ[F.tid * 8 + w];
                RSTD[F.tid] = rsqrtf(s * (1.0f / LW) + RMS_EPS); }
            __syncthreads();
#pragma unroll
            for (int s = 0; s < 8; ++s) { const int p = F.tid + 512 * s, rw = p >> 6, cp = p & 63; const float rs = RSTD[rw];
                const u32x4 v = *(const LAS u32x4*)(Y + rw * YT_STRIDE + 8 * cp); const f32x4 g0 = *(const f32x4*)(F.lru_gain + 8 * cp), g1 = *(const f32x4*)(F.lru_gain + 8 * cp + 4);
                u32x4 o; o.x = pk2(bflo(v.x) * rs * g0.x, bfhi(v.x) * rs * g0.y); o.y = pk2(bflo(v.y) * rs * g0.z, bfhi(v.y) * rs * g0.w);
                o.z = pk2(bflo(v.z) * rs * g1.x, bfhi(v.z) * rs * g1.y); o.w = pk2(bflo(v.w) * rs * g1.z, bfhi(v.w) * rs * g1.w);
                *(u32x4*)(F.YMIX + (size_t)(m0 + 64 * half + rw) * D + 8 * cp) = o; }
            __syncthreads();
        }
        }
#endif
#ifndef P3_NO_POOL
        {
            bf16x8 zf[4][4];
            const int T0 = b * TT + NMETA + 128 * ci - 15;
#pragma unroll
            for (int gp = 0; gp < 2; ++gp) {
                for (int i = F.tid; i < 143 * 32; i += 512) { const int ri = i >> 5, cpc = i & 31;
                    *(LAS u32x4*)(US + ri * US_STRIDE + 8 * cpc) = *(const u32x4*)(F.PROJ + (size_t)(T0 + ri) * INW + 1024 + 256 * gp + 8 * cpc); }
                __syncthreads();
                const LAS bf16* urow = US + (16 * F.wave + row) * US_STRIDE + 8 * q;
                if (gp == 0) { pool_z<0>(urow, zf[0]); pool_z<1>(urow + 128, zf[1]); } else { pool_z<2>(urow, zf[2]); pool_z<3>(urow + 128, zf[3]); }
                __syncthreads();
            }
            for (int i = F.tid; i < 4 * 128 * 16; i += 512) { const int n = i >> 4, pc = i & 15; *(LAS u32x4*)(US + n * PW_STRIDE + 8 * pc) = *(const u32x4*)(F.PwT + (size_t)n * 128 + 8 * pc); }
            __syncthreads();
            const LAS bf16* wl = US + row * PW_STRIDE + 8 * q;
            float ssq = 0.f;
#pragma unroll
            for (int g = 0; g < 4; ++g) { const LAS bf16* wg = wl + g * 128 * PW_STRIDE; asm volatile("" : "+v"(wg));
#pragma unroll 2
                for (int nb = 0; nb < 8; ++nb) { f32x4 acc = (f32x4){0.f, 0.f, 0.f, 0.f}; const LAS bf16* wn = wg + 16 * nb * PW_STRIDE;
#pragma unroll
                    for (int kb = 0; kb < 4; ++kb) acc = __builtin_amdgcn_mfma_f32_16x16x32_bf16(*(const LAS bf16x8*)(wn + 32 * kb), zf[g][kb], acc, 0, 0, 0);
                    ssq += (acc[0] * acc[0] + acc[1] * acc[1]) + (acc[2] * acc[2] + acc[3] * acc[3]); } }
            ssq += __shfl_xor(ssq, 16); ssq += __shfl_xor(ssq, 32);
            const float rs = rsqrtf(ssq * (1.0f / 512.0f) + RMS_EPS);
            bf16* orow = F.YMIX + (size_t)(m0 + 16 * F.wave + row) * D + LW + 4 * q;
#pragma unroll
            for (int g = 0; g < 4; ++g) { const LAS bf16* wg = wl + g * 128 * PW_STRIDE; asm volatile("" : "+v"(wg));
#pragma unroll 2
                for (int nb = 0; nb < 8; ++nb) { f32x4 acc = (f32x4){0.f, 0.f, 0.f, 0.f}; const LAS bf16* wn = wg + 16 * nb * PW_STRIDE;
#pragma unroll
                    for (int kb = 0; kb < 4; ++kb) acc = __builtin_amdgcn_mfma_f32_16x16x32_bf16(*(const LAS bf16x8*)(wn + 32 * kb), zf[g][kb], acc, 0, 0, 0);
                    const f32x4 sc = *(const f32x4*)(F.pool_scale + 128 * g + 16 * nb + 4 * q);
                    u32x2 o; o.x = pk2(acc[0] * rs * sc.x, acc[1] * rs * sc.y); o.y = pk2(acc[2] * rs * sc.z, acc[3] * rs * sc.w);
                    *(u32x2*)(orow + 128 * g + 16 * nb) = o; } }
        }
#endif
        __syncthreads();
    }
}

constexpr int WR_STRIDE = 1032;
__device__ __forceinline__ void p5_route(Frame& F, const bool dry = false) {
    LAS _Float16* WR = (LAS _Float16*)F.lds;
    LAS float* LG = (LAS float*)(F.lds + 36 * WR_STRIDE * 2) + F.wave * 16 * 40;
    LAS int* LCNT = (LAS int*)(F.lds + 36 * WR_STRIDE * 2 + 8 * 16 * 40 * 4);
    LAS float* G2 = (LAS float*)(LCNT + 64);
    const int c16 = F.lane & 15, q = F.lane >> 4;
    for (int i = F.tid; i < NROUTE * 128; i += 512) { const int n = i >> 7, k8 = i & 127; *(LAS u32x4*)(WR + n * WR_STRIDE + 8 * k8) = *(const u32x4*)(F.WrH + n * D + 8 * k8); }
    for (int i = F.tid; i < D; i += 512) G2[i] = F.g2[i];
    for (int ch = F.bx; ch < 256; ch += F.G) {
        if (F.tid < 64) LCNT[F.tid] = 0;
        __syncthreads();
        const int row = ch * 128 + 16 * F.wave + c16;
        const float* hrow = F.out + (size_t)row * D + 8 * q; unsigned char* orow = F.HN2 + (size_t)row * D + 8 * q;
        f32x4 acc[3]; float ss = 0.f;
#pragma unroll
        for (int nb = 0; nb < 3; ++nb) acc[nb] = (f32x4){0.f, 0.f, 0.f, 0.f};
#pragma unroll 2
        for (int i = 0; i < 32; ++i) {
            const f32x4 h0 = *(const f32x4*)(hrow + 32 * i), h1 = *(const f32x4*)(hrow + 32 * i + 4);
            const f32x4 g0 = *(const LAS f32x4*)(G2 + 32 * i + 8 * q), g1 = *(const LAS f32x4*)(G2 + 32 * i + 8 * q + 4);
            ss += (h0.x * h0.x + h0.y * h0.y) + (h0.z * h0.z + h0.w * h0.w) + (h1.x * h1.x + h1.y * h1.y) + (h1.z * h1.z + h1.w * h1.w);
            const f32x4 t0 = h0 * g0, t1 = h1 * g1;
            u32x2 p; p.x = pk4_fp8(clamp448(t0.x), clamp448(t0.y), clamp448(t0.z), clamp448(t0.w)); p.y = pk4_fp8(clamp448(t1.x), clamp448(t1.y), clamp448(t1.z), clamp448(t1.w));
            *(u32x2*)(orow + 32 * i) = p;
            f16x8 a; a[0] = (_Float16)t0.x; a[1] = (_Float16)t0.y; a[2] = (_Float16)t0.z; a[3] = (_Float16)t0.w; a[4] = (_Float16)t1.x; a[5] = (_Float16)t1.y; a[6] = (_Float16)t1.z; a[7] = (_Float16)t1.w;
#pragma unroll
            for (int nb = 0; nb < 3; ++nb) { const int col = 16 * nb + c16; f16x8 bw;
#pragma unroll
                for (int j = 0; j < 8; ++j) bw[j] = (_Float16)0.f;
                if (col < NROUTE) bw = *(const LAS f16x8*)(WR + col * WR_STRIDE + 32 * i + 8 * q);
                acc[nb] = __builtin_amdgcn_mfma_f32_16x16x32_f16(a, bw, acc[nb], 0, 0, 0); }
        }
        ss += __shfl_xor(ss, 16); ss += __shfl_xor(ss, 32);
        const float rstd = rsqrtf(ss * (1.0f / D) + RMS_EPS);
#pragma unroll
        for (int nb = 0; nb < 3; ++nb)
#pragma unroll
            for (int j = 0; j < 4; ++j) { const int col = 16 * nb + c16; if (col < 40) LG[(4 * q + j) * 40 + col] = acc[nb][j]; }
        LDS_WAIT();
        int e0 = 0, e1 = 0, rk0 = 0, rk1 = 0; float gt0 = 0.f, gt1 = 0.f;
        if (F.lane < 16) {
            const LAS float* lg = LG + F.lane * 40; const float sc = rstd * (1.0f / 256.0f);
            float gl[4]; int gi = 0;
#pragma unroll
            for (int j = 0; j < 4; ++j) gl[j] = lg[j] * sc + F.b_group[j];
            float gm = gl[0];
#pragma unroll
            for (int j = 1; j < 4; ++j) if (gl[j] > gm) { gm = gl[j]; gi = j; }
            float den = 0.f;
#pragma unroll
            for (int j = 0; j < 4; ++j) den += __expf(gl[j] - gm);
            const float pg = 1.0f / den;
            float v0 = -3.0e38f, v1 = -3.0e38f; int i0 = 0, i1 = 0;
            for (int j = 0; j < 8; ++j) { const float v = lg[4 + gi * 8 + j] * sc + F.b_router[gi * 8 + j];
                if (v > v0) { v1 = v0; i1 = i0; v0 = v; i0 = j; } else if (v > v1) { v1 = v; i1 = j; } }
            const float ex = __expf(v1 - v0), s0 = 1.0f / (1.0f + ex);
            gt0 = pg * s0; gt1 = pg * (ex * s0); e0 = gi * 8 + i0; e1 = gi * 8 + i1;
            rk0 = __hip_atomic_fetch_add(&LCNT[e0], 1, __ATOMIC_RELAXED, __HIP_MEMORY_SCOPE_WORKGROUP); rk1 = __hip_atomic_fetch_add(&LCNT[e1], 1, __ATOMIC_RELAXED, __HIP_MEMORY_SCOPE_WORKGROUP);
        }
        __syncthreads();
        if (F.tid < 32 && !dry) LCNT[32 + F.tid] = (int)__hip_atomic_fetch_add(F.ctl + CW_CNT + 64 * F.tid, (unsigned)LCNT[F.tid], __ATOMIC_RELAXED, __HIP_MEMORY_SCOPE_AGENT);
        __syncthreads();
        if (F.lane < 16 && !dry) { const int tok = ch * 128 + 16 * F.wave + F.lane;
            F.RINFO[(size_t)e0 * ECAP + LCNT[32 + e0] + rk0] = (f32x4){__builtin_bit_cast(float, tok * 2), gt0, rstd, 0.f};
            F.RINFO[(size_t)e1 * ECAP + LCNT[32 + e1] + rk1] = (f32x4){__builtin_bit_cast(float, tok * 2 + 1), gt1, rstd, 0.f}; }
        __syncthreads();
    }
}

__device__ __forceinline__ int moe_tables(Frame& F) {
    LAS int* TE = (LAS int*)(F.lds + TAB_TE); LAS int* TR = (LAS int*)(F.lds + TAB_TR); LAS int* CNT = (LAS int*)(F.lds + TAB_CNT); LAS int* PRE = CNT + 32;
    if (F.tid < 32) CNT[F.tid] = (int)__hip_atomic_load(F.ctl + CW_CNT + 64 * F.tid, __ATOMIC_RELAXED, __HIP_MEMORY_SCOPE_AGENT);
    __syncthreads();
    if (F.tid == 0) { int s = 0; for (int e = 0; e < NE; ++e) { PRE[e] = s; s += (CNT[e] + 255) >> 8; } PRE[NE] = s; }
    __syncthreads();
    const int NT = PRE[NE];
    for (int t = F.tid; t < NT; t += 512) { int e = 0; while (e < NE - 1 && PRE[e + 1] <= t) ++e; TE[t] = e; TR[t] = (t - PRE[e]) * 256; }
    __syncthreads();
    return NT;
}
__device__ __forceinline__ void moe_unit_tables(Frame& F, const pg8::MoeSched& S, int mode) {
    LAS int* TE = (LAS int*)(F.lds + TAB_TE); LAS int* TR = (LAS int*)(F.lds + TAB_TR); LAS int* CNT = (LAS int*)(F.lds + TAB_CNT);
    LAS unsigned* ROW = (LAS unsigned*)(F.lds + TAB_ROW); LAS float* FT = (LAS float*)(F.lds + TAB_F);
    pg8::Unit u;
    for (int i = 0; i < MAXU && S.next(i, u); ++i) {
        if (F.tid < 256) { const int e = TE[u.pm], pos = TR[u.pm] + F.tid; const bool valid = pos < CNT[e];
            f32x4 ri = (f32x4){0.f, 0.f, 0.f, 0.f}; if (valid) ri = F.RINFO[(size_t)e * ECAP + pos];
            const int slot = __builtin_bit_cast(int, ri.x);
            if (mode == 0) { ROW[i * 256 + F.tid] = valid ? (unsigned)(slot >> 1) * (unsigned)D : 0u; FT[i * 256 + F.tid] = valid ? ri.z * (1.0f / WGU_SCALE) : 0.f; }
            else { ROW[i * 256 + F.tid] = valid ? (unsigned)slot : 0xffffffffu; FT[i * 256 + F.tid] = ri.y * (1.0f / (WD_SCALE * HID_SCALE)); } }
    }
    __syncthreads();
}

__device__ __forceinline__ void p8_final(Frame& F) {
    const int gw = F.bx * 8 + F.wave, NGW = F.G * 8;
    for (int m = gw; m < M; m += NGW) {
        f32x4* hr = (f32x4*)(F.out + (size_t)m * D) + F.lane; const u32x2* c0 = (const u32x2*)(F.C + (size_t)(2 * m) * D) + F.lane; const u32x2* c1 = (const u32x2*)(F.C + (size_t)(2 * m + 1) * D) + F.lane;
        f32x4 v[4]; float s = 0.f;
#pragma unroll
        for (int j = 0; j < 4; ++j) { const f32x4 h = hr[64 * j]; const u32x2 a = c0[64 * j], b = c1[64 * j];
            v[j] = (f32x4){h.x + (bflo(a.x) + bflo(b.x)), h.y + (bfhi(a.x) + bfhi(b.x)), h.z + (bflo(a.y) + bflo(b.y)), h.w + (bfhi(a.y) + bfhi(b.y))};
            s += (v[j].x * v[j].x + v[j].y * v[j].y) + (v[j].z * v[j].z + v[j].w * v[j].w); }
        const float rstd = rsqrtf(wave_sum(s) * (1.f / D) + RMS_EPS);
#pragma unroll
        for (int j = 0; j < 4; ++j) { const f32x4 g = ((const f32x4*)F.final_gain)[F.lane + 64 * j]; hr[64 * j] = v[j] * rstd * g; }
    }
}

struct Args { const float* in[24]; float* out; unsigned char* ws; int ph_lo, ph_hi; };
__global__ void __launch_bounds__(512, 2) hymba_fwd(Args args) {
    extern __shared__ __attribute__((aligned(16))) unsigned char lds[];
    Frame F;
    F.lds = (LAS unsigned char*)lds; F.tid = threadIdx.x; F.lane = F.tid & 63; F.wave = __builtin_amdgcn_readfirstlane(F.tid >> 6); F.G = gridDim.x; F.bx = blockIdx.x;
    F.x = args.in[0]; F.meta = args.in[1]; F.g1 = args.in[2]; F.w_in = args.in[3]; F.conv_w = args.in[4]; F.conv_b = args.in[5]; F.wa = args.in[6]; F.ba = args.in[7]; F.wx = args.in[8]; F.bx_ = args.in[9];
    F.lam = args.in[10]; F.lru_gain = args.in[11]; F.pool_w = args.in[12]; F.pool_scale = args.in[13]; F.w_out = args.in[14]; F.g2 = args.in[15]; F.w_group = args.in[16]; F.b_group = args.in[17];
    F.w_router = args.in[18]; F.b_router = args.in[19]; F.w_gate = args.in[20]; F.w_up = args.in[21]; F.w_down = args.in[22]; F.final_gain = args.in[23];
    F.out = args.out; F.ws = args.ws; F.ctl = (unsigned*)(args.ws + WS_CTL);
    unsigned char* ws = args.ws;
    F.WinT = (bf16*)(ws + WS_WIN); F.WoutT = (bf16*)(ws + WS_WOUT); F.WaT = (bf16*)(ws + WS_WA); F.WxT = (bf16*)(ws + WS_WX); F.PwT = (bf16*)(ws + WS_PW); F.WrH = (_Float16*)(ws + WS_WR);
    F.AGG = (float*)(ws + WS_AGG); F.WguT = ws + WS_WGU; F.WdT = ws + WS_WD; F.RINFO = (f32x4*)(ws + WS_RINFO); F.HN1 = (bf16*)(ws + WS_HN1); F.YMIX = (bf16*)(ws + WS_HN1);
    F.PROJ = (bf16*)(ws + WS_PROJ); F.HN2 = ws + WS_PROJ; F.HID = ws + WS_HID; F.C = (bf16*)(ws + WS_C);
    volatile LAS unsigned* MISC = (volatile LAS unsigned*)(F.lds + MISC_OFF);
    if (F.tid < 64) MISC[F.tid] = 0u;
    __syncthreads();
    XcdBarrier bar; bar.bar = F.ctl + CW_BAR; bar.x = 0; bar.st = nullptr;
    if (MK_N_LAUNCHES == 1) bar = xcd_barrier_post(F.ctl + CW_BAR, MISC + 8);
    const int lo = args.ph_lo, hi = args.ph_hi;
#ifndef PH_MASK
#define PH_MASK 0x1ff
#endif
#define IN(k) (((PH_MASK >> (k)) & 1) && lo <= (k) && (k) < hi)
#define SEAM(k) do { if (IN(k) && IN((k) + 1)) xcd_barrier(bar); } while (0)
#ifndef REPEAT_MASK
#define REPEAT_MASK 0
#endif
#define REP(k) for (int rep_ = 0; rep_ <= ((REPEAT_MASK >> (k)) & 1); ++rep_)

    if (IN(0)) REP(0) { p0_prologue(F); } SEAM(0);
    if (IN(1)) { pg8::DenseSched S{M / 256, INW / 256, F.G, F.bx, D * 2, (const char*)F.WinT, 1 + ((REPEAT_MASK >> 1) & 1)}; pg8::EpiProj E{F.PROJ};
        pg8::gemm_phase(F.lds, D * 2, (const char*)F.HN1, S, E); } SEAM(1);
    if (IN(2)) REP(2) { p2_aggregates(F); } SEAM(2);
    if (IN(3)) REP(3) { p3_mixer(F); } SEAM(3);
    if (IN(4)) { pg8::DenseSched S{M / 256, D / 256, F.G, F.bx, D * 2, (const char*)F.WoutT, 1 + ((REPEAT_MASK >> 4) & 1)}; pg8::EpiResid E{F.x, F.out};
        pg8::gemm_phase(F.lds, D * 2, (const char*)F.YMIX, S, E); } SEAM(4);
    if (IN(5)) { if ((REPEAT_MASK >> 5) & 1) p5_route(F, true); p5_route(F); } SEAM(5);
    if (IN(6)) { const int NT = moe_tables(F);
        pg8::MoeSched S{NT, 4, F.G, F.bx, D, (const char*)F.WguT, (size_t)1024 * D, true, (const LAS int*)(F.lds + TAB_TE), (const LAS unsigned*)(F.lds + TAB_ROW)};
        moe_unit_tables(F, S, 0);
        pg8::EpiGateUp E{F.HID, (const LAS float*)(F.lds + TAB_F)};
        pg8::gemm_phase<pg8::EpiGateUp, pg8::MoeSched, true>(F.lds, D, (const char*)F.HN2, S, E); } SEAM(6);
    if (IN(7)) { const int NT = moe_tables(F);
        pg8::MoeSched S{NT, 4, F.G, F.bx, EFF, (const char*)F.WdT, (size_t)D * EFF, false, (const LAS int*)(F.lds + TAB_TE), (const LAS unsigned*)(F.lds + TAB_ROW)};
        moe_unit_tables(F, S, 1);
        pg8::EpiDown E{F.C, (const LAS int*)(F.lds + TAB_ROW), (const LAS float*)(F.lds + TAB_F)};
        pg8::gemm_phase<pg8::EpiDown, pg8::MoeSched, true>(F.lds, EFF, (const char*)F.HID, S, E); } SEAM(7);
    if (IN(8)) { p8_final(F); }
#undef IN
#undef SEAM
}

extern "C" void kernel_launch(void* const* d_in, const int* in_sizes, int n_in, void* d_out, int out_size, void* d_ws, size_t ws_size, hipStream_t stream) {
    static int grid = 0;
    if (grid == 0) {
        if (n_in != 24 || in_sizes[0] != M * D || out_size != M * D || ws_size < WS_END) { fprintf(stderr, "kernel_launch: unexpected shapes (n_in %d, in0 %d, out %d, ws %zu)\n", n_in, n_in > 0 ? in_sizes[0] : -1, out_size, ws_size); grid = -1; return; }
        int dev = 0, cus = 0, per_cu = 0;
        if (hipGetDevice(&dev) != hipSuccess || hipDeviceGetAttribute(&cus, hipDeviceAttributeMultiprocessorCount, dev) != hipSuccess) { grid = -1; return; }
        if (hipFuncSetAttribute((const void*)hymba_fwd, hipFuncAttributeMaxDynamicSharedMemorySize, LDS_BYTES) != hipSuccess) { fprintf(stderr, "kernel_launch: hipFuncSetAttribute failed\n"); grid = -1; return; }
        if (hipOccupancyMaxActiveBlocksPerMultiprocessor(&per_cu, (const void*)hymba_fwd, 512, LDS_BYTES) != hipSuccess || per_cu < 1) fprintf(stderr, "kernel_launch: occupancy query says %d\n", per_cu);
        (void)hipGetLastError();
        grid = cus;
    }
    if (grid < 0) return;
    if (hipMemsetAsync((char*)d_ws + WS_CTL, 0, CTL_ZERO_BYTES, stream) != hipSuccess) return;
    Args a{};
    for (int i = 0; i < 24; ++i) a.in[i] = (const float*)d_in[i];
    a.out = (float*)d_out; a.ws = (unsigned char*)d_ws;
    if (MK_N_LAUNCHES == 1) { a.ph_lo = 0; a.ph_hi = N_PHASES; hipLaunchKernelGGL(hymba_fwd, dim3(grid), dim3(512), LDS_BYTES, stream, a); }
    else for (int p = 0; p < N_PHASES; ++p) { a.ph_lo = p; a.ph_hi = p + 1; hipLaunchKernelGGL(hymba_fwd, dim3(grid), dim3(512), LDS_BYTES, stream, a); }
}
```

```cpp
#include <hip/hip_runtime.h>
#include <cstdio>
#include <cstdint>

#define GAS __attribute__((address_space(1)))
#define LAS __attribute__((address_space(3)))
typedef unsigned short bf16;
typedef short bf16x8 __attribute__((ext_vector_type(8)));
typedef _Float16 f16x8 __attribute__((ext_vector_type(8)));
typedef float f32x4 __attribute__((ext_vector_type(4)));
typedef float f32x2 __attribute__((ext_vector_type(2)));
typedef unsigned u32x4 __attribute__((ext_vector_type(4)));
typedef unsigned u32x2 __attribute__((ext_vector_type(2)));

#ifndef MK_N_LAUNCHES
#define MK_N_LAUNCHES 1
#endif
constexpr int N_PHASES = 9;

constexpr int D = 1024, NBATCH = 8, SEQ = 4096, NMETA = 16, TT = SEQ + NMETA, M = NBATCH * SEQ;
constexpr int LW = 512, INW = 1536, NE = 32, EFF = 512, NROUTE = 36;
constexpr int ECAP = 32768;
constexpr int MAXT = 288;
constexpr int MAXU = 6;
constexpr float RMS_EPS = 1e-6f;

constexpr size_t MiB = 1u << 20;
constexpr size_t WS_CTL = 0, CTL_ZERO_BYTES = 1 * MiB;
constexpr size_t WS_WIN = 2 * MiB, WS_WOUT = 5 * MiB, WS_WA = 7 * MiB, WS_WX = 7 * MiB + 65536, WS_PW = 7 * MiB + 131072, WS_WR = 7 * MiB + 262144;
constexpr size_t WS_AGG = 8 * MiB;
constexpr size_t WS_WGU = 10 * MiB  , WS_WD = 42 * MiB  , WS_RINFO = 58 * MiB, WS_HN1 = 74 * MiB  ;
constexpr size_t WS_PROJ = 138 * MiB  , WS_HID = 235 * MiB  , WS_C = 272 * MiB, WS_END = 400 * MiB;
constexpr float WGU_SCALE = 64.f, WD_SCALE = 32.f, HID_SCALE = 8.f;
constexpr int CW_BAR = 4096, CW_CNT = 16384;

constexpr int LDS_BYTES = 147456;
constexpr int MISC_OFF = LDS_BYTES - 256;
constexpr int TAB_OFF = 131072 + 512;
constexpr int TAB_ROW = TAB_OFF;
constexpr int TAB_F = TAB_ROW + MAXU * 256 * 4;
constexpr int TAB_TE = TAB_F + MAXU * 256 * 4;
constexpr int TAB_TR = TAB_TE + MAXT * 4;
constexpr int TAB_CNT = TAB_TR + MAXT * 4;
static_assert(TAB_CNT + 80 * 4 <= MISC_OFF, "LDS map");

__device__ __forceinline__ unsigned f2bf(float f) { unsigned u = __builtin_bit_cast(unsigned, f); return (u + 0x7fffu + ((u >> 16) & 1u)) >> 16; }
__device__ __forceinline__ unsigned pk2(float lo, float hi) { unsigned r; asm("v_cvt_pk_bf16_f32 %0, %1, %2" : "=v"(r) : "v"(lo), "v"(hi)); return r; }
__device__ __forceinline__ float bf2f(unsigned h) { return __builtin_bit_cast(float, h << 16); }
__device__ __forceinline__ float bflo(unsigned w) { return __builtin_bit_cast(float, w << 16); }
__device__ __forceinline__ float bfhi(unsigned w) { return __builtin_bit_cast(float, w & 0xffff0000u); }
__device__ __forceinline__ float sigmoidf_(float x) { return __builtin_amdgcn_rcpf(1.0f + __expf(-x)); }
#define LDS_WAIT() asm volatile("s_waitcnt lgkmcnt(0)" ::: "memory")
typedef int i32x4 __attribute__((ext_vector_type(4)));
typedef int i32x8 __attribute__((ext_vector_type(8)));
__device__ __forceinline__ float clamp448(float v) { return fminf(fmaxf(v, -448.f), 448.f); }
__device__ __forceinline__ unsigned pk4_fp8(float a, float b, float c, float d) {
    int v = __builtin_amdgcn_cvt_pk_fp8_f32(a, b, 0, false); v = __builtin_amdgcn_cvt_pk_fp8_f32(c, d, v, true); return (unsigned)v; }

#define XB_TMO      128
#define XB_XCNT(j)  (256  + 64 * (j))
#define XB_XSUB(j)  (1280 + 64 * (j))
#define XB_XGEN(j)  (2304 + 64 * (j))
#define XB_TOP      3328
#define XB_TOPGEN   3392
#define XCD_BAR_WORDS 3456
#define XB_SPIN_CAP (1u << 18)
__device__ __forceinline__ unsigned xb_ld(unsigned* p)              { return __hip_atomic_load(p, __ATOMIC_RELAXED, __HIP_MEMORY_SCOPE_AGENT); }
__device__ __forceinline__ unsigned xb_add(unsigned* p, unsigned v) { return __hip_atomic_fetch_add(p, v, __ATOMIC_RELAXED, __HIP_MEMORY_SCOPE_AGENT); }
__device__ __forceinline__ unsigned xb_xcc_id() { return (unsigned)__builtin_amdgcn_s_getreg((3 << 11) | 20) & 0xFu; }
#define XB_SPIN(cond, bar) do { unsigned _sp = 0; while (cond) { __builtin_amdgcn_s_sleep(1); \
    if ((++_sp & 255u) == 0u) { if (xb_ld(&(bar)[XB_TMO])) break; if (_sp > XB_SPIN_CAP) { atomicAdd(&(bar)[XB_TMO], 1u); break; } } } } while (0)
struct XcdBarrier { unsigned* bar; unsigned x; volatile LAS unsigned* st; };
__device__ __forceinline__ XcdBarrier xcd_barrier_post(unsigned* bar, volatile LAS unsigned* st) {
    XcdBarrier b; b.bar = bar; b.x = xb_xcc_id(); b.st = st;
    if (threadIdx.x == 0) (void)xb_add(&bar[XB_XCNT(b.x)], 1u);
    return b;
}
__device__ __forceinline__ void xcd_barrier_complete(unsigned* bar, unsigned x, unsigned& nloc, unsigned& nx) {
    const unsigned G = gridDim.x * gridDim.y * gridDim.z;
    unsigned sum, cnt, mine, sp = 0u;
    for (;;) {
        sum = 0u; cnt = 0u; mine = 0u;
#pragma unroll
        for (unsigned j = 0; j < 16; ++j) { const unsigned c = xb_ld(&bar[XB_XCNT(j)]); sum += c; cnt += (c > 0u) ? 1u : 0u; mine = (j == x) ? c : mine; }
        if (sum == G) break;
        __builtin_amdgcn_s_sleep(1);
        if ((++sp & 255u) == 0u) { if (xb_ld(&bar[XB_TMO])) break; if (sp > XB_SPIN_CAP) { atomicAdd(&bar[XB_TMO], 1u); break; } }
    }
    nloc = mine > 0u ? mine : 1u; nx = cnt > 0u ? cnt : 1u;
}
__device__ __forceinline__ void xcd_barrier(const XcdBarrier& b) {
    asm volatile("s_waitcnt vmcnt(0)" ::: "memory");
    __syncthreads();
    if (threadIdx.x == 0) {
        unsigned* bar = b.bar;
        __builtin_amdgcn_s_waitcnt(0);
        unsigned nloc = b.st[0], nx = b.st[1];
        if (nloc == 0u) { xcd_barrier_complete(bar, b.x, nloc, nx); b.st[0] = nloc; b.st[1] = nx; }
        const unsigned old = xb_add(&bar[XB_XSUB(b.x)], 1u);
        const unsigned gen = old / nloc;
        if (old + 1u == (gen + 1u) * nloc) {
            __builtin_amdgcn_fence(__ATOMIC_RELEASE, "agent");
            asm volatile("s_waitcnt vmcnt(0)" ::: "memory");
            const unsigned og = xb_add(&bar[XB_TOP], 1u);
            const unsigned tg = og / nx;
            if (og + 1u == (tg + 1u) * nx) xb_add(&bar[XB_TOPGEN], 1u);
            else XB_SPIN(xb_ld(&bar[XB_TOPGEN]) == tg, bar);
            __builtin_amdgcn_fence(__ATOMIC_ACQUIRE, "agent");
            xb_add(&bar[XB_XGEN(b.x)], 1u);
            asm volatile("s_waitcnt vmcnt(0)" ::: "memory");
        } else {
            XB_SPIN(xb_ld(&bar[XB_XGEN(b.x)]) == gen, bar);
            __builtin_amdgcn_fence(__ATOMIC_ACQUIRE, "agent");
            asm volatile("s_waitcnt vmcnt(0)" ::: "memory");
        }
    }
    __syncthreads();
}

namespace pg8 {
constexpr int BM = 256, BK = 64, HALF = 128, HTB = HALF * BK * 2, STAGE_BYTES = 8 * HTB, NXCD = 8, WGM = 8;
__host__ __device__ __forceinline__ int lds_byte(int r, int c) { const int st = (r >> 4) * 2 + (c >> 5), rr = r & 15, cc = c & 31, ob = rr * 64 + cc * 2; return st * 1024 + (ob ^ (((ob >> 9) & 1) << 5)); }
__host__ __device__ __forceinline__ void stage_rc(int b, int& R, int& C) { const int st = b / 1024, sb = b % 1024, swz = sb ^ (((sb >> 9) & 1) << 5); R = (st >> 1) * 16 + swz / 64; C = (st & 1) * 32 + (swz % 64) / 2; }
__host__ __device__ __forceinline__ int perm32(int rho) { const int n = rho >> 4, i = rho & 15; return 8 * (i >> 2) + 4 * n + (i & 3); }
struct Unit { int pm, pn; };
__device__ __forceinline__ bool static_next(int nM, int nN, int G, int c, int i, Unit& u) {
    const int nwg = nM * nN; const long L = (long)i * G + c; if (L >= nwg) return false;
    int wgid = (int)L; { const int q = nwg / NXCD, r = nwg % NXCD, xcd = wgid % NXCD, off = wgid / NXCD; wgid = (xcd < r ? xcd * (q + 1) : r * (q + 1) + (xcd - r) * q) + off; }
    const int nig = WGM * nN, gid = wgid / nig, fm = gid * WGM, gsz = (nM - fm) < WGM ? (nM - fm) : WGM;
    u.pm = fm + ((wgid % nig) % gsz); u.pn = (wgid % nig) / gsz; return true;
}
__device__ __forceinline__ unsigned cvt_pk_bf16(float lo, float hi) { unsigned r; asm volatile("v_cvt_pk_bf16_f32 %0, %1, %2" : "=v"(r) : "v"(lo), "v"(hi)); return r; }

template <class Epi, class Sched, bool FP8 = false>
__device__ __forceinline__ void gemm_phase(LAS unsigned char* lds, const int KB, const char* Abase, const Sched& S, const Epi& E) {
    const int tid = threadIdx.x, wid = __builtin_amdgcn_readfirstlane(tid >> 6), lane = tid & 63, wr = wid >> 2, wc = wid & 3, fr = lane & 15, fq = lane >> 4;
    const int nt = KB / (BK * 2);
    int Rl[2]; unsigned Cb[2], voffB[2];
#pragma unroll
    for (int i = 0; i < 2; ++i) { int R, C; stage_rc(tid * 16 + i * 8192, R, C); const int Rb = Epi::PERM ? ((R & ~31) + perm32(R & 31)) : R;
        Rl[i] = R; Cb[i] = (unsigned)C * 2u; voffB[i] = (unsigned)(Rb * KB + C * 2); }
    const size_t kstep = (size_t)(BK * 2);
    const size_t hstepB = (size_t)HALF * KB;
    const unsigned ldsw = (unsigned)wid * 1024u;
    const int aoff = lds_byte(wr * 64 + fr, fq * 8), boff = lds_byte(wc * 32 + fr, fq * 8);
#define PG8_SA(b, h) (((b) * 2 + (h)) * HTB)
#define PG8_SB(b, h) ((4 + (b) * 2 + (h)) * HTB)
#define PG8_STAGE(bufoff, gbase, voff) do { _Pragma("unroll") for (int _i = 0; _i < 2; ++_i) \
        __builtin_amdgcn_global_load_lds((const unsigned*)((const char*)(gbase) + (voff)[_i]), (LAS unsigned*)(lds + (bufoff) + ldsw + _i * 8192), 16, 0, 0); } while (0)
#define PG8_LD32(p) __builtin_shufflevector(*(const LAS i32x4*)(p), *(const LAS i32x4*)((p) + 1024), 0, 1, 2, 3, 4, 5, 6, 7)
#define PG8_LDA(dst, b, h) do { _Pragma("unroll") for (int m = 0; m < 4; ++m) dst[m] = PG8_LD32(lds + PG8_SA(b, h) + aoff + m * 2048); } while (0)
#define PG8_LDB(dst, b, h) do { _Pragma("unroll") for (int n = 0; n < 2; ++n) dst[n] = PG8_LD32(lds + PG8_SB(b, h) + boff + n * 2048); } while (0)
#define PG8_LO(v) __builtin_bit_cast(bf16x8, __builtin_shufflevector((v), (v), 0, 1, 2, 3))
#define PG8_HI(v) __builtin_bit_cast(bf16x8, __builtin_shufflevector((v), (v), 4, 5, 6, 7))
#define PG8_MMA(ai, bj, At, Bt) do { __builtin_amdgcn_s_setprio(1); _Pragma("unroll") for (int m = 0; m < 4; ++m) _Pragma("unroll") for (int n = 0; n < 2; ++n) { \
        if constexpr (FP8) asm volatile("v_mfma_f32_16x16x128_f8f6f4 %0, %1, %2, %0" : "+v"(acc[ai][bj][m][n]) : "v"(Bt[n]), "v"(At[m])); \
        else { acc[ai][bj][m][n] = __builtin_amdgcn_mfma_f32_16x16x32_bf16(PG8_LO(Bt[n]), PG8_LO(At[m]), acc[ai][bj][m][n], 0, 0, 0); \
               acc[ai][bj][m][n] = __builtin_amdgcn_mfma_f32_16x16x32_bf16(PG8_HI(Bt[n]), PG8_HI(At[m]), acc[ai][bj][m][n], 0, 0, 0); } } \
        __builtin_amdgcn_s_setprio(0); } while (0)
#define PG8_WAIT_V(n) asm volatile("s_waitcnt vmcnt(" #n ")" ::: "memory")
#define PG8_WAIT_L(n) asm volatile("s_waitcnt lgkmcnt(" #n ")" ::: "memory")
#define PG8_BAR __builtin_amdgcn_s_barrier()
#define PG8_SCHED __builtin_amdgcn_sched_barrier(0)
    Unit cur, nxt; int ui = 0;
    if (!S.next(0, cur)) return;
    f32x4 acc[2][2][4][2];
#pragma unroll
    for (int a = 0; a < 2; ++a)
#pragma unroll
        for (int b = 0; b < 2; ++b)
#pragma unroll
            for (int m = 0; m < 4; ++m)
#pragma unroll
                for (int n = 0; n < 2; ++n) acc[a][b][m][n] = (f32x4){0.f, 0.f, 0.f, 0.f};
    i32x8 At[4], B0[2], B1[2];
    unsigned cO0[2], cO1[2], nO0[2], nO1[2];
#pragma unroll
    for (int i = 0; i < 2; ++i) { cO0[i] = S.a_off(0, cur, Rl[i]) + Cb[i]; cO1[i] = S.a_off(0, cur, HALF + Rl[i]) + Cb[i]; }
    const char* cB = S.b_base(cur);
    PG8_STAGE(PG8_SB(0, 0), cB, voffB); PG8_STAGE(PG8_SB(0, 1), cB + hstepB, voffB); PG8_STAGE(PG8_SA(0, 0), Abase, cO0); PG8_STAGE(PG8_SA(0, 1), Abase, cO1);
    if (wr == 1) PG8_BAR;
    PG8_WAIT_V(2); PG8_BAR;
    PG8_STAGE(PG8_SB(1, 0), cB + kstep, voffB); PG8_STAGE(PG8_SA(1, 0), Abase + kstep, cO0); PG8_STAGE(PG8_SB(1, 1), cB + hstepB + kstep, voffB);
    PG8_WAIT_V(6); PG8_BAR;
    for (;;) {
        const bool has_next = S.next(ui + 1, nxt);
        const char* nB = cB;
#pragma unroll
        for (int i = 0; i < 2; ++i) { nO0[i] = cO0[i]; nO1[i] = cO1[i]; }
        if (has_next) { nB = S.b_base(nxt);
#pragma unroll
            for (int i = 0; i < 2; ++i) { nO0[i] = S.a_off(ui + 1, nxt, Rl[i]) + Cb[i]; nO1[i] = S.a_off(ui + 1, nxt, HALF + Rl[i]) + Cb[i]; } }
#pragma nounroll
        for (int t = 0; t < nt; t += 2) {
            const bool last = (t == nt - 2);
            const char* a1 = Abase + (size_t)(t + 1) * kstep;
            const char* a2 = last ? Abase : Abase + (size_t)(t + 2) * kstep; const char* b2 = last ? nB : cB + (size_t)(t + 2) * kstep;
            const char* a3 = a2 + kstep; const char* b3 = b2 + kstep;
            unsigned o0[2], o1[2];
#pragma unroll
            for (int i = 0; i < 2; ++i) { o0[i] = last ? nO0[i] : cO0[i]; o1[i] = last ? nO1[i] : cO1[i]; }
            PG8_LDB(B0, 0, 0); PG8_LDB(B1, 0, 1); PG8_SCHED; PG8_LDA(At, 0, 0); PG8_STAGE(PG8_SA(1, 1), a1, cO1);
            PG8_WAIT_V(8); PG8_WAIT_L(0); PG8_BAR; PG8_MMA(0, 0, At, B0); PG8_MMA(0, 1, At, B1); PG8_BAR; PG8_SCHED;
            PG8_LDA(At, 0, 1); PG8_STAGE(PG8_SB(0, 0), b2, voffB); PG8_STAGE(PG8_SB(0, 1), b2 + hstepB, voffB); PG8_STAGE(PG8_SA(0, 0), a2, o0);
            PG8_WAIT_V(8); PG8_WAIT_L(0); PG8_BAR; PG8_MMA(1, 0, At, B0); PG8_MMA(1, 1, At, B1); PG8_BAR; PG8_SCHED;
            PG8_LDB(B0, 1, 0); PG8_LDB(B1, 1, 1); PG8_SCHED; PG8_LDA(At, 1, 0); PG8_STAGE(PG8_SA(0, 1), a2, o1);
            PG8_WAIT_V(8); PG8_WAIT_L(0); PG8_BAR; PG8_MMA(0, 0, At, B0); PG8_MMA(0, 1, At, B1); PG8_BAR; PG8_SCHED;
            PG8_LDA(At, 1, 1); PG8_STAGE(PG8_SB(1, 0), b3, voffB); PG8_STAGE(PG8_SB(1, 1), b3 + hstepB, voffB); PG8_STAGE(PG8_SA(1, 0), a3, o0);
            PG8_WAIT_V(8); PG8_WAIT_L(0); PG8_BAR; PG8_MMA(1, 0, At, B0); PG8_MMA(1, 1, At, B1); PG8_BAR; PG8_SCHED;
        }
        if (wr == 0) PG8_BAR;
        if constexpr (FP8) asm volatile("s_nop 15\n\ts_nop 15" ::: "memory");
        E(acc, cur, ui, wr, wc, fr, fq);
        if (!has_next) break;
#pragma unroll
        for (int a = 0; a < 2; ++a)
#pragma unroll
            for (int b = 0; b < 2; ++b)
#pragma unroll
                for (int m = 0; m < 4; ++m)
#pragma unroll
                    for (int n = 0; n < 2; ++n) acc[a][b][m][n] = (f32x4){0.f, 0.f, 0.f, 0.f};
        cur = nxt; cB = nB; ++ui;
#pragma unroll
        for (int i = 0; i < 2; ++i) { cO0[i] = nO0[i]; cO1[i] = nO1[i]; }
        if (wr == 1) PG8_BAR;
    }
    PG8_WAIT_V(0);
    PG8_BAR;
#undef PG8_SA
#undef PG8_SB
#undef PG8_STAGE
#undef PG8_LDA
#undef PG8_LDB
#undef PG8_MMA
#undef PG8_LO
#undef PG8_HI
#undef PG8_LD32
#undef PG8_WAIT_V
#undef PG8_WAIT_L
#undef PG8_BAR
#undef PG8_SCHED
}

struct DenseSched {
    int nM, nN, G, c, K2; const char* B; int reps;
    __device__ __forceinline__ bool next(int i, Unit& u) const { const int rounds = (nM * nN + G - 1) / G; if (i >= rounds * reps) return false; return static_next(nM, nN, G, c, i % rounds, u); }
    __device__ __forceinline__ const char* b_base(const Unit& u) const { return B + (size_t)u.pn * BM * K2; }
    __device__ __forceinline__ unsigned a_off(int, const Unit& u, int r) const { return (unsigned)(u.pm * BM + r) * (unsigned)K2; }
};
struct MoeSched {
    int NT, nN, G, c, K2; const char* B; size_t estride; bool gather;
    const LAS int* tile_e; const LAS unsigned* rowtab;
    __device__ __forceinline__ bool next(int i, Unit& u) const { return static_next(NT, nN, G, c, i, u); }
    __device__ __forceinline__ const char* b_base(const Unit& u) const { return B + (size_t)tile_e[u.pm] * estride + (size_t)u.pn * BM * K2; }
    __device__ __forceinline__ unsigned a_off(int ui, const Unit& u, int r) const { return gather ? rowtab[ui * 256 + r] : (unsigned)(u.pm * BM + r) * (unsigned)K2; }
};

struct EpiProj {
    static constexpr bool PERM = true;
    bf16* O;
    __device__ __forceinline__ void operator()(const f32x4 (&acc)[2][2][4][2], const Unit& u, int, int wr, int wc, int fr, int fq) const {
        const int row0 = u.pm * BM + 16 * ((u.pm >> 4) + 1) + wr * 64 + fr, col0 = u.pn * BM + wc * 32 + 8 * fq;
#pragma unroll
        for (int ai = 0; ai < 2; ++ai)
#pragma unroll
            for (int m = 0; m < 4; ++m) { bf16* rowp = O + (size_t)(row0 + ai * HALF + m * 16) * INW + col0;
#pragma unroll
                for (int bj = 0; bj < 2; ++bj) { const f32x4 v0 = acc[ai][bj][m][0], v1 = acc[ai][bj][m][1];
                    u32x4 w; w.x = cvt_pk_bf16(v0[0], v0[1]); w.y = cvt_pk_bf16(v0[2], v0[3]); w.z = cvt_pk_bf16(v1[0], v1[1]); w.w = cvt_pk_bf16(v1[2], v1[3]);
                    *(u32x4*)(rowp + bj * HALF) = w; } }
    }
};
struct EpiResid {
    static constexpr bool PERM = false;
    const float* X; float* O;
    __device__ __forceinline__ void operator()(const f32x4 (&acc)[2][2][4][2], const Unit& u, int, int wr, int wc, int fr, int fq) const {
        const int row0 = u.pm * BM + wr * 64 + fr, col0 = u.pn * BM + wc * 32 + 4 * fq;
#pragma unroll
        for (int ai = 0; ai < 2; ++ai)
#pragma unroll
            for (int m = 0; m < 4; ++m) { const size_t off = (size_t)(row0 + ai * HALF + m * 16) * D + col0;
#pragma unroll
                for (int bj = 0; bj < 2; ++bj)
#pragma unroll
                    for (int n = 0; n < 2; ++n) { const f32x4 xv = *(const f32x4*)(X + off + bj * HALF + n * 16); *(f32x4*)(O + off + bj * HALF + n * 16) = acc[ai][bj][m][n] + xv; }
                asm volatile("" ::: "memory"); }
    }
};
struct EpiGateUp {
    static constexpr bool PERM = true;
    unsigned char* H; const LAS float* rstd;
    __device__ __forceinline__ void operator()(const f32x4 (&acc)[2][2][4][2], const Unit& u, int ui, int wr, int wc, int fr, int fq) const {
        const int r0 = wr * 64 + fr, col0 = u.pn * HALF + wc * 32 + 8 * fq;
#pragma unroll
        for (int ai = 0; ai < 2; ++ai)
#pragma unroll
            for (int m = 0; m < 4; ++m) { const int r = r0 + ai * HALF + m * 16; const float rs = rstd[ui * 256 + r];
                float h[8];
#pragma unroll
                for (int n = 0; n < 2; ++n)
#pragma unroll
                    for (int j = 0; j < 4; ++j) { const float g = acc[ai][0][m][n][j] * rs, up = acc[ai][1][m][n][j] * rs; h[n * 4 + j] = g * sigmoidf_(g) * up; }
#pragma unroll
                for (int j = 0; j < 8; ++j) h[j] = clamp448(h[j] * HID_SCALE);
                u32x2 w; w.x = pk4_fp8(h[0], h[1], h[2], h[3]); w.y = pk4_fp8(h[4], h[5], h[6], h[7]);
                *(u32x2*)(H + (size_t)(u.pm * BM + r) * EFF + col0) = w; }
    }
};
struct EpiDown {
    static constexpr bool PERM = true;
    bf16* C; const LAS int* slot; const LAS float* gate;
    __device__ __forceinline__ void operator()(const f32x4 (&acc)[2][2][4][2], const Unit& u, int ui, int wr, int wc, int fr, int fq) const {
        const int r0 = wr * 64 + fr, col0 = u.pn * BM + wc * 32 + 8 * fq;
#pragma unroll
        for (int ai = 0; ai < 2; ++ai)
#pragma unroll
            for (int m = 0; m < 4; ++m) { const int r = r0 + ai * HALF + m * 16; const int sl = slot[ui * 256 + r]; const float gt = gate[ui * 256 + r];
                if (sl >= 0) { bf16* rowp = C + (size_t)sl * D + col0;
#pragma unroll
                    for (int bj = 0; bj < 2; ++bj) { const f32x4 v0 = acc[ai][bj][m][0] * gt, v1 = acc[ai][bj][m][1] * gt;
                        u32x4 w; w.x = cvt_pk_bf16(v0[0], v0[1]); w.y = cvt_pk_bf16(v0[2], v0[3]); w.z = cvt_pk_bf16(v1[0], v1[1]); w.w = cvt_pk_bf16(v1[2], v1[3]);
                        *(u32x4*)(rowp + bj * HALF) = w; } } }
    }
};
}

struct Frame {
    LAS unsigned char* lds; int tid, lane, wave, G, bx;
    const float *x, *meta, *g1, *w_in, *conv_w, *conv_b, *wa, *ba, *wx, *bx_, *lam, *lru_gain, *pool_w, *pool_scale, *w_out, *g2, *w_group, *b_group, *w_router, *b_router, *w_gate, *w_up, *w_down, *final_gain;
    float* out; unsigned char* ws; unsigned* ctl;
    bf16 *WinT, *WoutT, *WaT, *WxT, *PwT, *HN1, *YMIX, *PROJ, *C; unsigned char *WguT, *WdT, *HN2, *HID;
    _Float16* WrH; float* AGG; f32x4* RINFO;
};
__device__ __forceinline__ float wave_sum(float v) {
#pragma unroll
    for (int o = 1; o < 64; o <<= 1) v += __shfl_xor(v, o);
    return v;
}

__device__ __forceinline__ void transpose_tile(const float* W, int ldw, int k0, int n0, bf16* WT, int ldt, int drow0, LAS float* scr, int lane) {
#pragma unroll 8
    for (int i = 0; i < 32; ++i) { const int kk = 2 * i + (lane >> 5); scr[kk * 33 + (lane & 31)] = W[(size_t)(k0 + kk) * ldw + n0 + (lane & 31)]; }
    LDS_WAIT(); asm volatile("" ::: "memory");
    const int c = lane & 7;
#pragma unroll
    for (int j = 0; j < 4; ++j) { const int n = (lane >> 3) + 8 * j; const LAS float* s = scr + (8 * c) * 33 + n;
        u32x4 o; o.x = pk2(s[0 * 33], s[1 * 33]); o.y = pk2(s[2 * 33], s[3 * 33]); o.z = pk2(s[4 * 33], s[5 * 33]); o.w = pk2(s[6 * 33], s[7 * 33]);
        *(u32x4*)(WT + (size_t)(drow0 + n) * ldt + k0 + 8 * c) = o; }
    LDS_WAIT(); asm volatile("" ::: "memory");
}
__device__ __forceinline__ void transpose_tile_fp8(const float* W, int ldw, int k0, int n0, unsigned char* WT, int ldt, int drow0, float scale, LAS float* scr, int lane) {
#pragma unroll 8
    for (int i = 0; i < 64; ++i) { const int kk = 2 * i + (lane >> 5); scr[kk * 33 + (lane & 31)] = W[(size_t)(k0 + kk) * ldw + n0 + (lane & 31)]; }
    LDS_WAIT(); asm volatile("" ::: "memory");
    const int n = lane >> 1, kh = (lane & 1) * 64; const LAS float* sp = scr + kh * 33 + n;
#pragma unroll
    for (int c = 0; c < 4; ++c) { u32x4 o;
#pragma unroll
        for (int w = 0; w < 4; ++w) { const LAS float* q4 = sp + (16 * c + 4 * w) * 33; o[w] = pk4_fp8(q4[0] * scale, q4[33] * scale, q4[66] * scale, q4[99] * scale); }
        *(u32x4*)(WT + (size_t)(drow0 + n) * ldt + k0 + kh + 16 * c) = o; }
    LDS_WAIT(); asm volatile("" ::: "memory");
}
__device__ __forceinline__ void p0_prologue(Frame& F) {
    if (F.bx < INW / 8) {
        LAS float* hnm = (LAS float*)F.lds;
        LAS float* part = (LAS float*)(F.lds + 65536);
        for (int r = F.wave * 2; r < F.wave * 2 + 2; ++r) {
            const f32x4* xr = (const f32x4*)(F.meta + (size_t)r * D) + F.lane; f32x4 v[4]; float s = 0.f;
#pragma unroll
            for (int j = 0; j < 4; ++j) { v[j] = xr[64 * j]; s += (v[j].x * v[j].x + v[j].y * v[j].y) + (v[j].z * v[j].z + v[j].w * v[j].w); }
            const float rstd = rsqrtf(wave_sum(s) * (1.f / D) + RMS_EPS);
#pragma unroll
            for (int j = 0; j < 4; ++j) { const f32x4 g = ((const f32x4*)F.g1)[F.lane + 64 * j]; *(LAS f32x4*)(hnm + r * D + 4 * F.lane + 256 * j) = v[j] * rstd * g; }
        }
        __syncthreads();
        { const int cc = F.tid & 7, ks = F.tid >> 3, col = F.bx * 8 + cc; float a[16];
#pragma unroll
            for (int r = 0; r < 16; ++r) a[r] = 0.f;
            for (int k = ks * 16; k < ks * 16 + 16; ++k) { const float w = F.w_in[(size_t)k * INW + col];
#pragma unroll
                for (int r = 0; r < 16; ++r) a[r] += hnm[r * D + k] * w; }
#pragma unroll
            for (int r = 0; r < 16; ++r) part[(ks * 16 + r) * 8 + cc] = a[r]; }
        __syncthreads();
        if (F.tid < 128) { const int r = F.tid >> 3, cc = F.tid & 7; float s = 0.f;
            for (int ks = 0; ks < 64; ++ks) s += part[(ks * 16 + r) * 8 + cc];
            const bf16 h = (bf16)f2bf(s);
            for (int b = 0; b < NBATCH; ++b) F.PROJ[(size_t)(b * TT + r) * INW + F.bx * 8 + cc] = h; }
        __syncthreads();
    }
    LAS float* scr = (LAS float*)(F.lds + F.wave * 16896);
    const int gw = F.bx * 8 + F.wave, NGW = F.G * 8;
    constexpr int I_IN = 16 * 48, I_OUT = 16 * 32, I_G = NE * 8 * 16, I_D = NE * 4 * 32, I_A = 8 * 2, I_P = 4 * 2 * 4;
    constexpr int NITEMS = I_IN + I_OUT + 2 * I_G + I_D + 2 * I_A + I_P;
    for (int it = gw; it < NITEMS; it += NGW) {
        int r = it;
        if (r < I_IN) { const int kb = r / 48, nb = r % 48; transpose_tile(F.w_in, INW, 64 * kb, 32 * nb, F.WinT, D, 32 * nb, scr, F.lane); continue; } r -= I_IN;
        if (r < I_OUT) { const int kb = r / 32, nb = r % 32; transpose_tile(F.w_out, D, 64 * kb, 32 * nb, F.WoutT, D, 32 * nb, scr, F.lane); continue; } r -= I_OUT;
        if (r < 2 * I_G) { const int up = r >= I_G; if (up) r -= I_G; const int e = r >> 7, kb = (r >> 4) & 7, nb = r & 15, n0 = 32 * nb;
            transpose_tile_fp8((up ? F.w_up : F.w_gate) + (size_t)e * D * EFF, EFF, 128 * kb, n0, F.WguT + (size_t)e * 1024 * D, D, (n0 >> 7) * 256 + up * 128 + (n0 & 127), WGU_SCALE, scr, F.lane); continue; } r -= 2 * I_G;
        if (r < I_D) { const int e = r >> 7, kb = (r >> 5) & 3, nb = r & 31; transpose_tile_fp8(F.w_down + (size_t)e * EFF * D, D, 128 * kb, 32 * nb, F.WdT + (size_t)e * D * EFF, EFF, 32 * nb, WD_SCALE, scr, F.lane); continue; } r -= I_D;
        if (r < 2 * I_A) { const int x = r >= I_A; if (x) r -= I_A; const int h = r >> 1, nb = r & 1; transpose_tile((x ? F.wx : F.wa) + (size_t)h * 4096, 64, 0, 32 * nb, (x ? F.WxT : F.WaT) + (size_t)h * 4096, 64, 32 * nb, scr, F.lane); continue; } r -= 2 * I_A;
        { const int g = r >> 3, kb = (r >> 2) & 1, nb = r & 3; transpose_tile(F.pool_w + (size_t)g * 16384, 128, 64 * kb, 32 * nb, F.PwT + (size_t)g * 16384, 128, 32 * nb, scr, F.lane); }
    }
    for (int i = F.bx * 512 + F.tid; i < NROUTE * D; i += F.G * 512) { const int n = i >> 10, k = i & 1023;
        const float w = n < 4 ? F.w_group[k * 4 + n] : F.w_router[k * 32 + (n - 4)]; F.WrH[i] = (_Float16)(w * 256.0f); }
    for (int m = gw; m < M; m += NGW) {
        const f32x4* xr = (const f32x4*)(F.x + (size_t)m * D) + F.lane; f32x4 v[4]; float s = 0.f;
#pragma unroll
        for (int j = 0; j < 4; ++j) { v[j] = xr[64 * j]; s += (v[j].x * v[j].x + v[j].y * v[j].y) + (v[j].z * v[j].z + v[j].w * v[j].w); }
        const float rstd = rsqrtf(wave_sum(s) * (1.f / D) + RMS_EPS);
        u32x2* o8 = (u32x2*)(F.HN1 + (size_t)m * D) + F.lane;
#pragma unroll
        for (int j = 0; j < 4; ++j) { const f32x4 g = ((const f32x4*)F.g1)[F.lane + 64 * j]; const f32x4 y = v[j] * rstd * g; u32x2 w; w.x = pk2(y.x, y.y); w.y = pk2(y.z, y.w); o8[64 * j] = w; }
    }
}

template <int CTRL> __device__ __forceinline__ float dpp_f(float old, float src) {
    return __builtin_bit_cast(float, __builtin_amdgcn_update_dpp(__builtin_bit_cast(int, old), __builtin_bit_cast(int, src), CTRL, 0xf, 0xf, false)); }
#define DPP_BCAST15 0x15F
__device__ __forceinline__ void row_scan(float& A, float& B) {
    { const float Ap = dpp_f<0x111>(1.0f, A), Bp = dpp_f<0x111>(0.0f, B); B = A * Bp + B; A = A * Ap; }
    { const float Ap = dpp_f<0x112>(1.0f, A), Bp = dpp_f<0x112>(0.0f, B); B = A * Bp + B; A = A * Ap; }
    { const float Ap = dpp_f<0x114>(1.0f, A), Bp = dpp_f<0x114>(0.0f, B); B = A * Bp + B; A = A * Ap; }
    { const float Ap = dpp_f<0x118>(1.0f, A), Bp = dpp_f<0x118>(0.0f, B); B = A * Bp + B; A = A * Ap; }
}
#define SCAN8_STR(D) "s_nop 1\n\t" \
    "v_fmac_f32_dpp %0, %0, %8 row_shr:" #D " row_mask:0xf bank_mask:0xf\n\tv_mul_f32_dpp %8, %8, %8 row_shr:" #D " row_mask:0xf bank_mask:0xf\n\t" \
    "v_fmac_f32_dpp %1, %1, %9 row_shr:" #D " row_mask:0xf bank_mask:0xf\n\tv_mul_f32_dpp %9, %9, %9 row_shr:" #D " row_mask:0xf bank_mask:0xf\n\t" \
    "v_fmac_f32_dpp %2, %2, %10 row_shr:" #D " row_mask:0xf bank_mask:0xf\n\tv_mul_f32_dpp %10, %10, %10 row_shr:" #D " row_mask:0xf bank_mask:0xf\n\t" \
    "v_fmac_f32_dpp %3, %3, %11 row_shr:" #D " row_mask:0xf bank_mask:0xf\n\tv_mul_f32_dpp %11, %11, %11 row_shr:" #D " row_mask:0xf bank_mask:0xf\n\t" \
    "v_fmac_f32_dpp %4, %4, %12 row_shr:" #D " row_mask:0xf bank_mask:0xf\n\tv_mul_f32_dpp %12, %12, %12 row_shr:" #D " row_mask:0xf bank_mask:0xf\n\t" \
    "v_fmac_f32_dpp %5, %5, %13 row_shr:" #D " row_mask:0xf bank_mask:0xf\n\tv_mul_f32_dpp %13, %13, %13 row_shr:" #D " row_mask:0xf bank_mask:0xf\n\t" \
    "v_fmac_f32_dpp %6, %6, %14 row_shr:" #D " row_mask:0xf bank_mask:0xf\n\tv_mul_f32_dpp %14, %14, %14 row_shr:" #D " row_mask:0xf bank_mask:0xf\n\t" \
    "v_fmac_f32_dpp %7, %7, %15 row_shr:" #D " row_mask:0xf bank_mask:0xf\n\tv_mul_f32_dpp %15, %15, %15 row_shr:" #D " row_mask:0xf bank_mask:0xf"
#define SCAN8(D, A, B, o) asm volatile(SCAN8_STR(D) : "+v"(B[o + 0]), "+v"(B[o + 1]), "+v"(B[o + 2]), "+v"(B[o + 3]), "+v"(B[o + 4]), "+v"(B[o + 5]), "+v"(B[o + 6]), "+v"(B[o + 7]), \
    "+v"(A[o + 0]), "+v"(A[o + 1]), "+v"(A[o + 2]), "+v"(A[o + 3]), "+v"(A[o + 4]), "+v"(A[o + 5]), "+v"(A[o + 6]), "+v"(A[o + 7]))
__device__ __forceinline__ void row_scan16(float (&A)[16], float (&B)[16]) {
    SCAN8(1, A, B, 0); SCAN8(1, A, B, 8); SCAN8(2, A, B, 0); SCAN8(2, A, B, 8); SCAN8(4, A, B, 0); SCAN8(4, A, B, 8); SCAN8(8, A, B, 0); SCAN8(8, A, B, 8);
}
struct LruW { LAS float* cst; const bf16 *waP, *wxP; };
__device__ __forceinline__ void lru_setup(const Frame& F, LruW& L, LAS unsigned char* wbase) {
    const int hd = F.wave; L.cst = (LAS float*)wbase;
    for (int i = F.lane; i < 512; i += 64) { const int t = i >> 6, ch = hd * 64 + (i & 63); float v;
        if (t < 4) v = F.conv_w[t * LW + ch]; else if (t == 4) v = F.conv_b[ch]; else if (t == 5) v = F.ba[ch]; else if (t == 6) v = F.bx_[ch];
        else { const float lm = F.lam[ch]; v = 8.0f * (fminf(lm, 0.f) - log1pf(__expf(-fabsf(lm)))); }
        L.cst[i] = v; }
    const int i = F.lane & 15, qw = F.lane >> 4; const size_t o = (size_t)hd * 4096 + (size_t)(8 * (i >> 2) + (i & 3)) * 64 + 8 * qw;
    L.waP = F.WaT + o; L.wxP = F.WxT + o;
    LDS_WAIT();
}
struct LruRaw { u32x4 u[2][4]; u32x4 ug[2]; };
template <bool WITH_UG>
__device__ __forceinline__ void lru_load(const Frame& F, int b, int tt0, LruRaw& R) {
    const int hd = F.wave, row = F.lane & 15, q = F.lane >> 4, tt = tt0 + row;
    const bf16* prow = F.PROJ + (size_t)(b * TT + tt) * INW + hd * 64 + 8 * q;
#pragma unroll
    for (int kb = 0; kb < 2; ++kb) {
#pragma unroll
        for (int k = 0; k < 4; ++k) { R.u[kb][k] = (u32x4){0u, 0u, 0u, 0u}; if (tt - 3 + k >= 0) R.u[kb][k] = *(const u32x4*)(prow + (ptrdiff_t)(k - 3) * INW + 32 * kb); }
        if (WITH_UG) R.ug[kb] = *(const u32x4*)(prow + LW + 32 * kb);
    }
}
__device__ __forceinline__ void lru_conv(const Frame& F, const LruW& L, const LruRaw& R, float (&xc)[16], bf16x8 (&xf)[2]) {
    const int q = F.lane >> 4;
#pragma unroll
    for (int kb = 0; kb < 2; ++kb) {
        const LAS float* cs = L.cst + 32 * kb + 8 * q;
        f32x2 x2[4];
        { const f32x4 c0 = *(const LAS f32x4*)(cs + 256), c1 = *(const LAS f32x4*)(cs + 260); x2[0] = (f32x2){c0.x, c0.y}; x2[1] = (f32x2){c0.z, c0.w}; x2[2] = (f32x2){c1.x, c1.y}; x2[3] = (f32x2){c1.z, c1.w}; }
#pragma unroll
        for (int k = 0; k < 4; ++k) {
            const u32x4 u = R.u[kb][k];
            const f32x4 w0 = *(const LAS f32x4*)(cs + 64 * k), w1 = *(const LAS f32x4*)(cs + 64 * k + 4);
            x2[0] = (f32x2){w0.x, w0.y} * (f32x2){bflo(u.x), bfhi(u.x)} + x2[0]; x2[1] = (f32x2){w0.z, w0.w} * (f32x2){bflo(u.y), bfhi(u.y)} + x2[1];
            x2[2] = (f32x2){w1.x, w1.y} * (f32x2){bflo(u.z), bfhi(u.z)} + x2[2]; x2[3] = (f32x2){w1.z, w1.w} * (f32x2){bflo(u.w), bfhi(u.w)} + x2[3];
        }
#pragma unroll
        for (int i = 0; i < 4; ++i) { xc[8 * kb + 2 * i] = x2[i].x; xc[8 * kb + 2 * i + 1] = x2[i].y; }
        asm volatile("" : "+v"(xc[8 * kb + 0]), "+v"(xc[8 * kb + 1]), "+v"(xc[8 * kb + 2]), "+v"(xc[8 * kb + 3]), "+v"(xc[8 * kb + 4]), "+v"(xc[8 * kb + 5]), "+v"(xc[8 * kb + 6]), "+v"(xc[8 * kb + 7]));
        u32x4 p; p.x = pk2(xc[8 * kb + 0], xc[8 * kb + 1]); p.y = pk2(xc[8 * kb + 2], xc[8 * kb + 3]); p.z = pk2(xc[8 * kb + 4], xc[8 * kb + 5]); p.w = pk2(xc[8 * kb + 6], xc[8 * kb + 7]);
        xf[kb] = __builtin_bit_cast(bf16x8, p);
    }
}
template <bool WPF  >
__device__ __forceinline__ void lru_gates(const Frame& F, const LruW& L, const float (&xc)[16], const bf16x8 (&xf)[2], float (&Av)[16], float (&Bv)[16]) {
    const int q = F.lane >> 4;
    bf16x8 wa[2], wx[2];
#pragma unroll
    for (int kk = 0; kk < 2; ++kk) { wa[kk] = *(const bf16x8*)(L.waP + 32 * kk); wx[kk] = *(const bf16x8*)(L.wxP + 32 * kk); }
#pragma unroll
    for (int nb = 0; nb < 4; ++nb) {
        const int kb = nb >> 1, hf = nb & 1;
        bf16x8 wan[2], wxn[2];
        if (!WPF && nb > 0) { const int o = (32 * kb + 4 * hf) * 64;
#pragma unroll
            for (int kk = 0; kk < 2; ++kk) { wa[kk] = *(const bf16x8*)(L.waP + o + 32 * kk); wx[kk] = *(const bf16x8*)(L.wxP + o + 32 * kk); } }
        if (WPF && nb < 3) { const int o = (32 * ((nb + 1) >> 1) + 4 * ((nb + 1) & 1)) * 64;
#pragma unroll
            for (int kk = 0; kk < 2; ++kk) { wan[kk] = *(const bf16x8*)(L.waP + o + 32 * kk); wxn[kk] = *(const bf16x8*)(L.wxP + o + 32 * kk); } }
        asm volatile("" ::: "memory");
        f32x4 ra = (f32x4){0.f, 0.f, 0.f, 0.f}, rx = ra;
#pragma unroll
        for (int kk = 0; kk < 2; ++kk) { ra = __builtin_amdgcn_mfma_f32_16x16x32_bf16(wa[kk], xf[kk], ra, 0, 0, 0); rx = __builtin_amdgcn_mfma_f32_16x16x32_bf16(wx[kk], xf[kk], rx, 0, 0, 0); }
        const LAS float* cs = L.cst + 32 * kb + 8 * q + 4 * hf;
        const f32x4 ba4 = *(const LAS f32x4*)(cs + 320), bx4 = *(const LAS f32x4*)(cs + 384), lm4 = *(const LAS f32x4*)(cs + 448);
#pragma unroll
        for (int j = 0; j < 4; ++j) { const int c = 8 * kb + 4 * hf + j;
            const float r = sigmoidf_(ra[j] + ba4[j]), ig = sigmoidf_(rx[j] + bx4[j]);
            const float a = __expf(lm4[j] * r);
            Av[c] = a; Bv[c] = __builtin_amdgcn_sqrtf(fmaf(-a, a, 1.0f)) * (ig * xc[c]); }
        if (WPF && nb < 3) {
#pragma unroll
            for (int kk = 0; kk < 2; ++kk) { wa[kk] = wan[kk]; wx[kk] = wxn[kk]; } }
    }
    row_scan16(Av, Bv);
}
__device__ __forceinline__ void p2_aggregates(Frame& F) {
    LruW L; lru_setup(F, L, F.lds + F.wave * 2048);
    const int row = F.lane & 15, q = F.lane >> 4;
    for (int ch = F.bx; ch < 256; ch += F.G) {
        const int b = ch >> 5, ci = ch & 31; float Ac[16], Bc[16];
#pragma unroll
        for (int c = 0; c < 16; ++c) { Ac[c] = 1.f; Bc[c] = 0.f; }
        const int blk0 = (ci == 0 ? -1 : 0);
        LruRaw R; lru_load<false>(F, b, NMETA + 128 * ci + 16 * blk0, R);
        for (int blk = blk0; blk < 8; ++blk) {
            float xc[16]; bf16x8 xf[2]; lru_conv(F, L, R, xc, xf);
            if (blk < 7) lru_load<false>(F, b, NMETA + 128 * ci + 16 * (blk + 1), R);
            asm volatile("" ::: "memory");
            float Av[16], Bv[16];
            lru_gates<true>(F, L, xc, xf, Av, Bv);
#pragma unroll
            for (int c = 0; c < 16; ++c) { Bc[c] = Av[c] * Bc[c] + Bv[c]; Ac[c] *= Av[c]; }
        }
        if (row == 15) {
#pragma unroll
            for (int kb = 0; kb < 2; ++kb) { float* o = F.AGG + ((size_t)ch * LW + F.wave * 64 + 32 * kb + 8 * q) * 2;
#pragma unroll
                for (int j = 0; j < 8; j += 2) *(f32x4*)(o + 2 * j) = (f32x4){Ac[8 * kb + j], Bc[8 * kb + j], Ac[8 * kb + j + 1], Bc[8 * kb + j + 1]}; }
        }
    }
}

constexpr int YT_STRIDE = 520;
constexpr int US_STRIDE = 264;
constexpr int PW_STRIDE = 136;
template <int G> __device__ __forceinline__ void pool_z(const LAS bf16* ub  , bf16x8 (&zf)[4]) {
    constexpr int W = 2 << G;
    asm volatile("" : "+v"(ub));
#pragma unroll
    for (int kb = 0; kb < 4; ++kb) {
        const LAS bf16* p = ub + 15 * US_STRIDE + 32 * kb; const u32x4 c = *(const LAS u32x4*)p; float cur[8], s[8];
        cur[0] = bflo(c.x); cur[1] = bfhi(c.x); cur[2] = bflo(c.y); cur[3] = bfhi(c.y); cur[4] = bflo(c.z); cur[5] = bfhi(c.z); cur[6] = bflo(c.w); cur[7] = bfhi(c.w);
#pragma unroll
        for (int j = 0; j < 8; ++j) s[j] = cur[j];
#pragma unroll
        for (int d = 1; d < W; ++d) { const u32x4 u = *(const LAS u32x4*)(ub + (15 - d) * US_STRIDE + 32 * kb);
            s[0] += bflo(u.x); s[1] += bfhi(u.x); s[2] += bflo(u.y); s[3] += bfhi(u.y); s[4] += bflo(u.z); s[5] += bfhi(u.z); s[6] += bflo(u.w); s[7] += bfhi(u.w);
            if ((d & 3) == 3) asm volatile("" : "+v"(s[0]), "+v"(s[1]), "+v"(s[2]), "+v"(s[3]), "+v"(s[4]), "+v"(s[5]), "+v"(s[6]), "+v"(s[7]) :: "memory"); }
        asm volatile("" : "+v"(s[0]), "+v"(s[1]), "+v"(s[2]), "+v"(s[3]), "+v"(s[4]), "+v"(s[5]), "+v"(s[6]), "+v"(s[7]) :: "memory");
        u32x4 pz; pz.x = pk2(s[0] * (1.0f / W) - cur[0], s[1] * (1.0f / W) - cur[1]); pz.y = pk2(s[2] * (1.0f / W) - cur[2], s[3] * (1.0f / W) - cur[3]);
        pz.z = pk2(s[4] * (1.0f / W) - cur[4], s[5] * (1.0f / W) - cur[5]); pz.w = pk2(s[6] * (1.0f / W) - cur[6], s[7] * (1.0f / W) - cur[7]);
        asm volatile("" : "+v"(pz) :: "memory");
        zf[kb] = __builtin_bit_cast(bf16x8, pz);
    }
}
__device__ __forceinline__ void p3_mixer(Frame& F) {
    LAS bf16* Y = (LAS bf16*)F.lds;
    LAS unsigned char* wbase = F.lds + 66560 + F.wave * 2048;
    LAS float* SSQ = (LAS float*)(F.lds + 66560 + 16384);
    LAS float* RSTD = SSQ + 512;
    LAS bf16* US = (LAS bf16*)F.lds;
    const int row = F.lane & 15, q = F.lane >> 4;
    for (int ch = F.bx; ch < 256; ch += F.G) {
        const int b = ch >> 5, ci = ch & 31; const int m0 = ch * 128;
#ifndef P3_NO_LRU
        {
        LruW L; lru_setup(F, L, wbase);
        float H[16];
        { float Ar[16], Br[16];
#pragma unroll
            for (int c = 0; c < 16; ++c) { Ar[c] = 1.f; Br[c] = 0.f; }
#pragma unroll
            for (int t = 0; t < 2; ++t) { const int k = 2 * row + t;
                if (k < ci) {
#pragma unroll
                    for (int kb = 0; kb < 2; ++kb) { const float* o = F.AGG + ((size_t)(b * 32 + k) * LW + F.wave * 64 + 32 * kb + 8 * q) * 2;
#pragma unroll
                        for (int j = 0; j < 8; j += 2) { const f32x4 v = *(const f32x4*)(o + 2 * j); const int c = 8 * kb + j;
                            Br[c] = v.x * Br[c] + v.y; Ar[c] *= v.x; Br[c + 1] = v.z * Br[c + 1] + v.w; Ar[c + 1] *= v.z; } } } }
            row_scan16(Ar, Br);
#pragma unroll
            for (int c = 0; c < 16; ++c) H[c] = dpp_f<DPP_BCAST15>(0.f, Br[c]); }
        if (ci == 0) {
            float Av[16], Bv[16]; LruRaw Rm; lru_load<false>(F, b, 0, Rm); { float xc[16]; bf16x8 xf[2]; lru_conv(F, L, Rm, xc, xf); lru_gates<false>(F, L, xc, xf, Av, Bv); }
#pragma unroll
            for (int c = 0; c < 16; ++c) H[c] = dpp_f<DPP_BCAST15>(0.f, Av[c] * H[c] + Bv[c]);
        }

        for (int half = 0; half < 2; ++half) {
            for (int blk = 0; blk < 4; ++blk) {
                const int rb = 16 * blk; float Av[16], Bv[16];
                u32x4 ug[2];
                { LruRaw R; lru_load<true>(F, b, NMETA + 128 * ci + 64 * half + rb, R); ug[0] = R.ug[0]; ug[1] = R.ug[1];
                  float xc[16]; bf16x8 xf[2]; lru_conv(F, L, R, xc, xf);
                  asm volatile("" ::: "memory");
                  lru_gates<false>(F, L, xc, xf, Av, Bv); }
                float ss = 0.f;
#pragma unroll
                for (int kb = 0; kb < 2; ++kb) { float y[8];
#pragma unroll
                    for (int j = 0; j < 8; ++j) { const int c = 8 * kb + j;
                        const float h = Av[c] * H[c] + Bv[c];
                        const unsigned w = ug[kb][j >> 1]; const float g = (j & 1) ? bfhi(w) : bflo(w);
                        const float gl = g * sigmoidf_(1.5957691216f * (g + 0.044715f * g * g * g));
                        y[j] = h * gl; ss += y[j] * y[j];
                        H[c] = dpp_f<DPP_BCAST15>(0.f, h); }
                    u32x4 p; p.x = pk2(y[0], y[1]); p.y = pk2(y[2], y[3]); p.z = pk2(y[4], y[5]); p.w = pk2(y[6], y[7]);
                    *(LAS u32x4*)(Y + (rb + row) * YT_STRIDE + F.wave * 64 + 32 * kb + 8 * q) = p;
                    asm volatile("" : "+v"(ss) :: "memory"); }
                ss += __shfl_xor(ss, 16); ss += __shfl_xor(ss, 32);
                if (q == 0) SSQ[(rb + row) * 8 + F.wave] = ss;
            }
            __syncthreads();
            if (F.tid < 64) { float s = 0.f;
#pragma unroll
                for (int w = 0; w < 8; ++w) s += SSQ[F.tid * 8 + w];
                RSTD[F.tid] = rsqrtf(s * (1.0f / LW) + RMS_EPS); }
            __syncthreads();
#pragma unroll
            for (int s = 0; s < 8; ++s) { const int p = F.tid + 512 * s, rw = p >> 6, cp = p & 63; const float rs = RSTD[rw];
                const u32x4 v = *(const LAS u32x4*)(Y + rw * YT_STRIDE + 8 * cp); const f32x4 g0 = *(const f32x4*)(F.lru_gain + 8 * cp), g1 = *(const f32x4*)(F.lru_gain + 8 * cp + 4);
                u32x4 o; o.x = pk2(bflo(v.x) * rs * g0.x, bfhi(v.x) * rs * g0.y); o.y = pk2(bflo(v.y) * rs * g0.z, bfhi(v.y) * rs * g0.w);
                o.z = pk2(bflo(v.z) * rs * g1.x, bfhi(v.z) * rs * g1.y); o.w = pk2(bflo(v.w) * rs * g1.z, bfhi(v.w) * rs * g1.w);
                *(u32x4*)(F.YMIX + (size_t)(m0 + 64 * half + rw) * D + 8 * cp) = o; }
            __syncthreads();
        }
        }
#endif
#ifndef P3_NO_POOL
        {
            bf16x8 zf[4][4];
            const int T0 = b * TT + NMETA + 128 * ci - 15;
#pragma unroll
            for (int gp = 0; gp < 2; ++gp) {
                for (int i = F.tid; i < 143 * 32; i += 512) { const int ri = i >> 5, cpc = i & 31;
                    *(LAS u32x4*)(US + ri * US_STRIDE + 8 * cpc) = *(const u32x4*)(F.PROJ + (size_t)(T0 + ri) * INW + 1024 + 256 * gp + 8 * cpc); }
                __syncthreads();
                const LAS bf16* urow = US + (16 * F.wave + row) * US_STRIDE + 8 * q;
                if (gp == 0) { pool_z<0>(urow, zf[0]); pool_z<1>(urow + 128, zf[1]); } else { pool_z<2>(urow, zf[2]); pool_z<3>(urow + 128, zf[3]); }
                __syncthreads();
            }
            for (int i = F.tid; i < 4 * 128 * 16; i += 512) { const int n = i >> 4, pc = i & 15; *(LAS u32x4*)(US + n * PW_STRIDE + 8 * pc) = *(const u32x4*)(F.PwT + (size_t)n * 128 + 8 * pc); }
            __syncthreads();
            const LAS bf16* wl = US + row * PW_STRIDE + 8 * q;
            float ssq = 0.f;
#pragma unroll
            for (int g = 0; g < 4; ++g) { const LAS bf16* wg = wl + g * 128 * PW_STRIDE; asm volatile("" : "+v"(wg));
#pragma unroll 2
                for (int nb = 0; nb < 8; ++nb) { f32x4 acc = (f32x4){0.f, 0.f, 0.f, 0.f}; const LAS bf16* wn = wg + 16 * nb * PW_STRIDE;
#pragma unroll
                    for (int kb = 0; kb < 4; ++kb) acc = __builtin_amdgcn_mfma_f32_16x16x32_bf16(*(const LAS bf16x8*)(wn + 32 * kb), zf[g][kb], acc, 0, 0, 0);
                    ssq += (acc[0] * acc[0] + acc[1] * acc[1]) + (acc[2] * acc[2] + acc[3] * acc[3]); } }
            ssq += __shfl_xor(ssq, 16); ssq += __shfl_xor(ssq, 32);
            const float rs = rsqrtf(ssq * (1.0f / 512.0f) + RMS_EPS);
            bf16* orow = F.YMIX + (size_t)(m0 + 16 * F.wave + row) * D + LW + 4 * q;
#pragma unroll
            for (int g = 0; g < 4; ++g) { const LAS bf16* wg = wl + g * 128 * PW_STRIDE; asm volatile("" : "+v"(wg));
#pragma unroll 2
                for (int nb = 0; nb < 8; ++nb) { f32x4 acc = (f32x4){0.f, 0.f, 0.f, 0.f}; const LAS bf16* wn = wg + 16 * nb * PW_STRIDE;
#pragma unroll
                    for (int kb = 0; kb < 4; ++kb) acc = __builtin_amdgcn_mfma_f32_16x16x32_bf16(*(const LAS bf16x8*)(wn + 32 * kb), zf[g][kb], acc, 0, 0, 0);
                    const f32x4 sc = *(const f32x4*)(F.pool_scale + 128 * g + 16 * nb + 4 * q);
                    u32x2 o; o.x = pk2(acc[0] * rs * sc.x, acc[1] * rs * sc.y); o.y = pk2(acc[2] * rs * sc.z, acc[3] * rs * sc.w);
                    *(u32x2*)(orow + 128 * g + 16 * nb) = o; } }
        }
#endif
        __syncthreads();
    }
}

constexpr int WR_STRIDE = 1032;
__device__ __forceinline__ void p5_route(Frame& F, const bool dry = false) {
    LAS _Float16* WR = (LAS _Float16*)F.lds;
    LAS float* LG = (LAS float*)(F.lds + 36 * WR_STRIDE * 2) + F.wave * 16 * 40;
    LAS int* LCNT = (LAS int*)(F.lds + 36 * WR_STRIDE * 2 + 8 * 16 * 40 * 4);
    LAS float* G2 = (LAS float*)(LCNT + 64);
    const int c16 = F.lane & 15, q = F.lane >> 4;
    for (int i = F.tid; i < NROUTE * 128; i += 512) { const int n = i >> 7, k8 = i & 127; *(LAS u32x4*)(WR + n * WR_STRIDE + 8 * k8) = *(const u32x4*)(F.WrH + n * D + 8 * k8); }
    for (int i = F.tid; i < D; i += 512) G2[i] = F.g2[i];
    for (int ch = F.bx; ch < 256; ch += F.G) {
        if (F.tid < 64) LCNT[F.tid] = 0;
        __syncthreads();
        const int row = ch * 128 + 16 * F.wave + c16;
        const float* hrow = F.out + (size_t)row * D + 8 * q; unsigned char* orow = F.HN2 + (size_t)row * D + 8 * q;
        f32x4 acc[3]; float ss = 0.f;
#pragma unroll
        for (int nb = 0; nb < 3; ++nb) acc[nb] = (f32x4){0.f, 0.f, 0.f, 0.f};
#pragma unroll 2
        for (int i = 0; i < 32; ++i) {
            const f32x4 h0 = *(const f32x4*)(hrow + 32 * i), h1 = *(const f32x4*)(hrow + 32 * i + 4);
            const f32x4 g0 = *(const LAS f32x4*)(G2 + 32 * i + 8 * q), g1 = *(const LAS f32x4*)(G2 + 32 * i + 8 * q + 4);
            ss += (h0.x * h0.x + h0.y * h0.y) + (h0.z * h0.z + h0.w * h0.w) + (h1.x * h1.x + h1.y * h1.y) + (h1.z * h1.z + h1.w * h1.w);
            const f32x4 t0 = h0 * g0, t1 = h1 * g1;
            u32x2 p; p.x = pk4_fp8(clamp448(t0.x), clamp448(t0.y), clamp448(t0.z), clamp448(t0.w)); p.y = pk4_fp8(clamp448(t1.x), clamp448(t1.y), clamp448(t1.z), clamp448(t1.w));
            *(u32x2*)(orow + 32 * i) = p;
            f16x8 a; a[0] = (_Float16)t0.x; a[1] = (_Float16)t0.y; a[2] = (_Float16)t0.z; a[3] = (_Float16)t0.w; a[4] = (_Float16)t1.x; a[5] = (_Float16)t1.y; a[6] = (_Float16)t1.z; a[7] = (_Float16)t1.w;
#pragma unroll
            for (int nb = 0; nb < 3; ++nb) { const int col = 16 * nb + c16; f16x8 bw;
#pragma unroll
                for (int j = 0; j < 8; ++j) bw[j] = (_Float16)0.f;
                if (col < NROUTE) bw = *(const LAS f16x8*)(WR + col * WR_STRIDE + 32 * i + 8 * q);
                acc[nb] = __builtin_amdgcn_mfma_f32_16x16x32_f16(a, bw, acc[nb], 0, 0, 0); }
        }
        ss += __shfl_xor(ss, 16); ss += __shfl_xor(ss, 32);
        const float rstd = rsqrtf(ss * (1.0f / D) + RMS_EPS);
#pragma unroll
        for (int nb = 0; nb < 3; ++nb)
#pragma unroll
            for (int j = 0; j < 4; ++j) { const int col = 16 * nb + c16; if (col < 40) LG[(4 * q + j) * 40 + col] = acc[nb][j]; }
        LDS_WAIT();
        int e0 = 0, e1 = 0, rk0 = 0, rk1 = 0; float gt0 = 0.f, gt1 = 0.f;
        if (F.lane < 16) {
            const LAS float* lg = LG + F.lane * 40; const float sc = rstd * (1.0f / 256.0f);
            float gl[4]; int gi = 0;
#pragma unroll
            for (int j = 0; j < 4; ++j) gl[j] = lg[j] * sc + F.b_group[j];
            float gm = gl[0];
#pragma unroll
            for (int j = 1; j < 4; ++j) if (gl[j] > gm) { gm = gl[j]; gi = j; }
            float den = 0.f;
#pragma unroll
            for (int j = 0; j < 4; ++j) den += __expf(gl[j] - gm);
            const float pg = 1.0f / den;
            float v0 = -3.0e38f, v1 = -3.0e38f; int i0 = 0, i1 = 0;
            for (int j = 0; j < 8; ++j) { const float v = lg[4 + gi * 8 + j] * sc + F.b_router[gi * 8 + j];
                if (v > v0) { v1 = v0; i1 = i0; v0 = v; i0 = j; } else if (v > v1) { v1 = v; i1 = j; } }
            const float ex = __expf(v1 - v0), s0 = 1.0f / (1.0f + ex);
            gt0 = pg * s0; gt1 = pg * (ex * s0); e0 = gi * 8 + i0; e1 = gi * 8 + i1;
            rk0 = __hip_atomic_fetch_add(&LCNT[e0], 1, __ATOMIC_RELAXED, __HIP_MEMORY_SCOPE_WORKGROUP); rk1 = __hip_atomic_fetch_add(&LCNT[e1], 1, __ATOMIC_RELAXED, __HIP_MEMORY_SCOPE_WORKGROUP);
        }
        __syncthreads();
        if (F.tid < 32 && !dry) LCNT[32 + F.tid] = (int)__hip_atomic_fetch_add(F.ctl + CW_CNT + 64 * F.tid, (unsigned)LCNT[F.tid], __ATOMIC_RELAXED, __HIP_MEMORY_SCOPE_AGENT);
        __syncthreads();
        if (F.lane < 16 && !dry) { const int tok = ch * 128 + 16 * F.wave + F.lane;
            F.RINFO[(size_t)e0 * ECAP + LCNT[32 + e0] + rk0] = (f32x4){__builtin_bit_cast(float, tok * 2), gt0, rstd, 0.f};
            F.RINFO[(size_t)e1 * ECAP + LCNT[32 + e1] + rk1] = (f32x4){__builtin_bit_cast(float, tok * 2 + 1), gt1, rstd, 0.f}; }
        __syncthreads();
    }
}

__device__ __forceinline__ int moe_tables(Frame& F) {
    LAS int* TE = (LAS int*)(F.lds + TAB_TE); LAS int* TR = (LAS int*)(F.lds + TAB_TR); LAS int* CNT = (LAS int*)(F.lds + TAB_CNT); LAS int* PRE = CNT + 32;
    if (F.tid < 32) CNT[F.tid] = (int)__hip_atomic_load(F.ctl + CW_CNT + 64 * F.tid, __ATOMIC_RELAXED, __HIP_MEMORY_SCOPE_AGENT);
    __syncthreads();
    if (F.tid == 0) { int s = 0; for (int e = 0; e < NE; ++e) { PRE[e] = s; s += (CNT[e] + 255) >> 8; } PRE[NE] = s; }
    __syncthreads();
    const int NT = PRE[NE];
    for (int t = F.tid; t < NT; t += 512) { int e = 0; while (e < NE - 1 && PRE[e + 1] <= t) ++e; TE[t] = e; TR[t] = (t - PRE[e]) * 256; }
    __syncthreads();
    return NT;
}
__device__ __forceinline__ void moe_unit_tables(Frame& F, const pg8::MoeSched& S, int mode) {
    LAS int* TE = (LAS int*)(F.lds + TAB_TE); LAS int* TR = (LAS int*)(F.lds + TAB_TR); LAS int* CNT = (LAS int*)(F.lds + TAB_CNT);
    LAS unsigned* ROW = (LAS unsigned*)(F.lds + TAB_ROW); LAS float* FT = (LAS float*)(F.lds + TAB_F);
    pg8::Unit u;
    for (int i = 0; i < MAXU && S.next(i, u); ++i) {
        if (F.tid < 256) { const int e = TE[u.pm], pos = TR[u.pm] + F.tid; const bool valid = pos < CNT[e];
            f32x4 ri = (f32x4){0.f, 0.f, 0.f, 0.f}; if (valid) ri = F.RINFO[(size_t)e * ECAP + pos];
            const int slot = __builtin_bit_cast(int, ri.x);
            if (mode == 0) { ROW[i * 256 + F.tid] = valid ? (unsigned)(slot >> 1) * (unsigned)D : 0u; FT[i * 256 + F.tid] = valid ? ri.z * (1.0f / WGU_SCALE) : 0.f; }
            else { ROW[i * 256 + F.tid] = valid ? (unsigned)slot : 0xffffffffu; FT[i * 256 + F.tid] = ri.y * (1.0f / (WD_SCALE * HID_SCALE)); } }
    }
    __syncthreads();
}

__device__ __forceinline__ void p8_final(Frame& F) {
    const int gw = F.bx * 8 + F.wave, NGW = F.G * 8;
    for (int m = gw; m < M; m += NGW) {
        f32x4* hr = (f32x4*)(F.out + (size_t)m * D) + F.lane; const u32x2* c0 = (const u32x2*)(F.C + (size_t)(2 * m) * D) + F.lane; const u32x2* c1 = (const u32x2*)(F.C + (size_t)(2 * m + 1) * D) + F.lane;
        f32x4 v[4]; float s = 0.f;
#pragma unroll
        for (int j = 0; j < 4; ++j) { const f32x4 h = hr[64 * j]; const u32x2 a = c0[64 * j], b = c1[64 * j];
            v[j] = (f32x4){h.x + (bflo(a.x) + bflo(b.x)), h.y + (bfhi(a.x) + bfhi(b.x)), h.z + (bflo(a.y) + bflo(b.y)), h.w + (bfhi(a.y) + bfhi(b.y))};
            s += (v[j].x * v[j].x + v[j].y * v[j].y) + (v[j].z * v[j].z + v[j].w * v[j].w); }
        const float rstd = rsqrtf(wave_sum(s) * (1.f / D) + RMS_EPS);
#pragma unroll
        for (int j = 0; j < 4; ++j) { const f32x4 g = ((const f32x4*)F.final_gain)[F.lane + 64 * j]; hr[64 * j] = v[j] * rstd * g; }
    }
}

struct Args { const float* in[24]; float* out; unsigned char* ws; int ph_lo, ph_hi; };
__global__ void __launch_bounds__(512, 2) hymba_fwd(Args args) {
    extern __shared__ __attribute__((aligned(16))) unsigned char lds[];
    Frame F;
    F.lds = (LAS unsigned char*)lds; F.tid = threadIdx.x; F.lane = F.tid & 63; F.wave = __builtin_amdgcn_readfirstlane(F.tid >> 6); F.G = gridDim.x; F.bx = blockIdx.x;
    F.x = args.in[0]; F.meta = args.in[1]; F.g1 = args.in[2]; F.w_in = args.in[3]; F.conv_w = args.in[4]; F.conv_b = args.in[5]; F.wa = args.in[6]; F.ba = args.in[7]; F.wx = args.in[8]; F.bx_ = args.in[9];
    F.lam = args.in[10]; F.lru_gain = args.in[11]; F.pool_w = args.in[12]; F.pool_scale = args.in[13]; F.w_out = args.in[14]; F.g2 = args.in[15]; F.w_group = args.in[16]; F.b_group = args.in[17];
    F.w_router = args.in[18]; F.b_router = args.in[19]; F.w_gate = args.in[20]; F.w_up = args.in[21]; F.w_down = args.in[22]; F.final_gain = args.in[23];
    F.out = args.out; F.ws = args.ws; F.ctl = (unsigned*)(args.ws + WS_CTL);
    unsigned char* ws = args.ws;
    F.WinT = (bf16*)(ws + WS_WIN); F.WoutT = (bf16*)(ws + WS_WOUT); F.WaT = (bf16*)(ws + WS_WA); F.WxT = (bf16*)(ws + WS_WX); F.PwT = (bf16*)(ws + WS_PW); F.WrH = (_Float16*)(ws + WS_WR);
    F.AGG = (float*)(ws + WS_AGG); F.WguT = ws + WS_WGU; F.WdT = ws + WS_WD; F.RINFO = (f32x4*)(ws + WS_RINFO); F.HN1 = (bf16*)(ws + WS_HN1); F.YMIX = (bf16*)(ws + WS_HN1);
    F.PROJ = (bf16*)(ws + WS_PROJ); F.HN2 = ws + WS_PROJ; F.HID = ws + WS_HID; F.C = (bf16*)(ws + WS_C);
    volatile LAS unsigned* MISC = (volatile LAS unsigned*)(F.lds + MISC_OFF);
    if (F.tid < 64) MISC[F.tid] = 0u;
    __syncthreads();
    XcdBarrier bar; bar.bar = F.ctl + CW_BAR; bar.x = 0; bar.st = nullptr;
    if (MK_N_LAUNCHES == 1) bar = xcd_barrier_post(F.ctl + CW_BAR, MISC + 8);
    const int lo = args.ph_lo, hi = args.ph_hi;
#ifndef PH_MASK
#define PH_MASK 0x1ff
#endif
#define IN(k) (((PH_MASK >> (k)) & 1) && lo <= (k) && (k) < hi)
#define SEAM(k) do { if (IN(k) && IN((k) + 1)) xcd_barrier(bar); } while (0)
#ifndef REPEAT_MASK
#define REPEAT_MASK 0
#endif
#define REP(k) for (int rep_ = 0; rep_ <= ((REPEAT_MASK >> (k)) & 1); ++rep_)

    if (IN(0)) REP(0) { p0_prologue(F); } SEAM(0);
    if (IN(1)) { pg8::DenseSched S{M / 256, INW / 256, F.G, F.bx, D * 2, (const char*)F.WinT, 1 + ((REPEAT_MASK >> 1) & 1)}; pg8::EpiProj E{F.PROJ};
        pg8::gemm_phase(F.lds, D * 2, (const char*)F.HN1, S, E); } SEAM(1);
    if (IN(2)) REP(2) { p2_aggregates(F); } SEAM(2);
    if (IN(3)) REP(3) { p3_mixer(F); } SEAM(3);
    if (IN(4)) { pg8::DenseSched S{M / 256, D / 256, F.G, F.bx, D * 2, (const char*)F.WoutT, 1 + ((REPEAT_MASK >> 4) & 1)}; pg8::EpiResid E{F.x, F.out};
        pg8::gemm_phase(F.lds, D * 2, (const char*)F.YMIX, S, E); } SEAM(4);
    if (IN(5)) { if ((REPEAT_MASK >> 5) & 1) p5_route(F, true); p5_route(F); } SEAM(5);
    if (IN(6)) { const int NT = moe_tables(F);
        pg8::MoeSched S{NT, 4, F.G, F.bx, D, (const char*)F.WguT, (size_t)1024 * D, true, (const LAS int*)(F.lds + TAB_TE), (const LAS unsigned*)(F.lds + TAB_ROW)};
        moe_unit_tables(F, S, 0);
        pg8::EpiGateUp E{F.HID, (const LAS float*)(F.lds + TAB_F)};
        pg8::gemm_phase<pg8::EpiGateUp, pg8::MoeSched, true>(F.lds, D, (const char*)F.HN2, S, E); } SEAM(6);
    if (IN(7)) { const int NT = moe_tables(F);
        pg8::MoeSched S{NT, 4, F.G, F.bx, EFF, (const char*)F.WdT, (size_t)D * EFF, false, (const LAS int*)(F.lds + TAB_TE), (const LAS unsigned*)(F.lds + TAB_ROW)};
        moe_unit_tables(F, S, 1);
        pg8::EpiDown E{F.C, (const LAS int*)(F.lds + TAB_ROW), (const LAS float*)(F.lds + TAB_F)};
        pg8::gemm_phase<pg8::EpiDown, pg8::MoeSched, true>(F.lds, EFF, (const char*)F.HID, S, E); } SEAM(7);
    if (IN(8)) { p8_final(F); }
#undef IN
#undef SEAM
}

extern "C" void kernel_launch(void* const* d_in, const int* in_sizes, int n_in, void* d_out, int out_size, void* d_ws, size_t ws_size, hipStream_t stream) {
    static int grid = 0;
    if (grid == 0) {
        if (n_in != 24 || in_sizes[0] != M * D || out_size != M * D || ws_size < WS_END) { fprintf(stderr, "kernel_launch: unexpected shapes (n_in %d, in0 %d, out %d, ws %zu)\n", n_in, n_in > 0 ? in_sizes[0] : -1, out_size, ws_size); grid = -1; return; }
        int dev = 0, cus = 0, per_cu = 0;
        if (hipGetDevice(&dev) != hipSuccess || hipDeviceGetAttribute(&cus, hipDeviceAttributeMultiprocessorCount, dev) != hipSuccess) { grid = -1; return; }
        if (hipFuncSetAttribute((const void*)hymba_fwd, hipFuncAttributeMaxDynamicSharedMemorySize, LDS_BYTES) != hipSuccess) { fprintf(stderr, "kernel_launch: hipFuncSetAttribute failed\n"); grid = -1; return; }
        if (hipOccupancyMaxActiveBlocksPerMultiprocessor(&per_cu, (const void*)hymba_fwd, 512, LDS_BYTES) != hipSuccess || per_cu < 1) fprintf(stderr, "kernel_launch: occupancy query says %d\n", per_cu);
        (void)hipGetLastError();
        grid = cus;
    }
    if (grid < 0) return;
    if (hipMemsetAsync((char*)d_ws + WS_CTL, 0, CTL_ZERO_BYTES, stream) != hipSuccess) return;
    Args a{};
    for (int i = 0; i < 24; ++i) a.in[i] = (const float*)d_in[i];
    a.out = (float*)d_out; a.ws = (unsigned char*)d_ws;
    if (MK_N_LAUNCHES == 1) { a.ph_lo = 0; a.ph_hi = N_PHASES; hipLaunchKernelGGL(hymba_fwd, dim3(grid), dim3(512), LDS_BYTES, stream, a); }
    else for (int p = 0; p < N_PHASES; ++p) { a.ph_lo = p; a.ph_hi = p + 1; hipLaunchKernelGGL(hymba_fwd, dim3(grid), dim3(512), LDS_BYTES, stream, a); }
}
```

```cpp
#include <hip/hip_runtime.h>
#include <cstdio>
#include <cstdint>

#define GAS __attribute__((address_space(1)))
#define LAS __attribute__((address_space(3)))
typedef unsigned short bf16;
typedef short bf16x8 __attribute__((ext_vector_type(8)));
typedef _Float16 f16x8 __attribute__((ext_vector_type(8)));
typedef float f32x4 __attribute__((ext_vector_type(4)));
typedef float f32x2 __attribute__((ext_vector_type(2)));
typedef unsigned u32x4 __attribute__((ext_vector_type(4)));
typedef unsigned u32x2 __attribute__((ext_vector_type(2)));

#ifndef MK_N_LAUNCHES
#define MK_N_LAUNCHES 1
#endif
constexpr int N_PHASES = 9;
#ifndef REPEAT_MASK
#define REPEAT_MASK 0
#endif

constexpr int D = 1024, NBATCH = 8, SEQ = 4096, NMETA = 16, TT = SEQ + NMETA, M = NBATCH * SEQ;
constexpr int LW = 512, INW = 1536, NE = 32, EFF = 512, NROUTE = 36;
constexpr int ECAP = 32768;
constexpr int MAXT = 288;
constexpr int MAXU = 6;
constexpr float RMS_EPS = 1e-6f;

constexpr size_t MiB = 1u << 20;
constexpr size_t WS_CTL = 0, CTL_ZERO_BYTES = 1 * MiB;
constexpr size_t WS_WIN = 2 * MiB, WS_WOUT = 5 * MiB, WS_WA = 7 * MiB, WS_WX = 7 * MiB + 65536, WS_PW = 7 * MiB + 131072, WS_WR = 7 * MiB + 262144;
constexpr size_t WS_AGG = 8 * MiB;
constexpr size_t WS_WGU = 10 * MiB  , WS_WD = 42 * MiB  , WS_RINFO = 58 * MiB, WS_HN1 = 74 * MiB  ;
constexpr size_t WS_PROJ = 138 * MiB  , WS_HID = 235 * MiB  , WS_C = 272 * MiB, WS_H1 = 400 * MiB  , WS_END = 464 * MiB;
constexpr float WGU_SCALE = 64.f, WD_SCALE = 32.f, HID_SCALE = 8.f;
constexpr int CW_BAR = 4096, CW_CNT = 16384;

constexpr int LDS_BYTES = 147456;
constexpr int MISC_OFF = LDS_BYTES - 256;
constexpr int TAB_OFF = 131072 + 512;
constexpr int TAB_ROW = TAB_OFF;
constexpr int TAB_F = TAB_ROW + MAXU * 256 * 4;
constexpr int TAB_TE = TAB_F + MAXU * 256 * 4;
constexpr int TAB_TR = TAB_TE + MAXT * 4;
constexpr int TAB_CNT = TAB_TR + MAXT * 4;
static_assert(TAB_CNT + 80 * 4 <= MISC_OFF, "LDS map");

__device__ __forceinline__ unsigned f2bf(float f) { unsigned u = __builtin_bit_cast(unsigned, f); return (u + 0x7fffu + ((u >> 16) & 1u)) >> 16; }
__device__ __forceinline__ unsigned pk2(float lo, float hi) { unsigned r; asm("v_cvt_pk_bf16_f32 %0, %1, %2" : "=v"(r) : "v"(lo), "v"(hi)); return r; }
__device__ __forceinline__ float bf2f(unsigned h) { return __builtin_bit_cast(float, h << 16); }
__device__ __forceinline__ float bflo(unsigned w) { return __builtin_bit_cast(float, w << 16); }
__device__ __forceinline__ float bfhi(unsigned w) { return __builtin_bit_cast(float, w & 0xffff0000u); }
__device__ __forceinline__ float sigmoidf_(float x) { return __builtin_amdgcn_rcpf(1.0f + __expf(-x)); }
#define LDS_WAIT() asm volatile("s_waitcnt lgkmcnt(0)" ::: "memory")
typedef int i32x4 __attribute__((ext_vector_type(4)));
typedef int i32x8 __attribute__((ext_vector_type(8)));
__device__ __forceinline__ float clamp448(float v) { return fminf(fmaxf(v, -448.f), 448.f); }
__device__ __forceinline__ unsigned pk4_fp8(float a, float b, float c, float d) {
    int v = __builtin_amdgcn_cvt_pk_fp8_f32(a, b, 0, false); v = __builtin_amdgcn_cvt_pk_fp8_f32(c, d, v, true); return (unsigned)v; }

#define XB_TMO      128
#define XB_XCNT(j)  (256  + 64 * (j))
#define XB_XSUB(j)  (1280 + 64 * (j))
#define XB_XGEN(j)  (2304 + 64 * (j))
#define XB_TOP      3328
#define XB_TOPGEN   3392
#define XCD_BAR_WORDS 3456
#define XB_SPIN_CAP (1u << 18)
__device__ __forceinline__ unsigned xb_ld(unsigned* p)              { return __hip_atomic_load(p, __ATOMIC_RELAXED, __HIP_MEMORY_SCOPE_AGENT); }
__device__ __forceinline__ unsigned xb_add(unsigned* p, unsigned v) { return __hip_atomic_fetch_add(p, v, __ATOMIC_RELAXED, __HIP_MEMORY_SCOPE_AGENT); }
__device__ __forceinline__ unsigned xb_xcc_id() { return (unsigned)__builtin_amdgcn_s_getreg((3 << 11) | 20) & 0xFu; }
#define XB_SPIN(cond, bar) do { unsigned _sp = 0; while (cond) { __builtin_amdgcn_s_sleep(1); \
    if ((++_sp & 255u) == 0u) { if (xb_ld(&(bar)[XB_TMO])) break; if (_sp > XB_SPIN_CAP) { atomicAdd(&(bar)[XB_TMO], 1u); break; } } } } while (0)
struct XcdBarrier { unsigned* bar; unsigned x; volatile LAS unsigned* st; };
__device__ __forceinline__ XcdBarrier xcd_barrier_post(unsigned* bar, volatile LAS unsigned* st) {
    XcdBarrier b; b.bar = bar; b.x = xb_xcc_id(); b.st = st;
    if (threadIdx.x == 0) (void)xb_add(&bar[XB_XCNT(b.x)], 1u);
    return b;
}
__device__ __forceinline__ void xcd_barrier_complete(unsigned* bar, unsigned x, unsigned& nloc, unsigned& nx) {
    const unsigned G = gridDim.x * gridDim.y * gridDim.z;
    unsigned sum, cnt, mine, sp = 0u;
    for (;;) {
        sum = 0u; cnt = 0u; mine = 0u;
#pragma unroll
        for (unsigned j = 0; j < 16; ++j) { const unsigned c = xb_ld(&bar[XB_XCNT(j)]); sum += c; cnt += (c > 0u) ? 1u : 0u; mine = (j == x) ? c : mine; }
        if (sum == G) break;
        __builtin_amdgcn_s_sleep(1);
        if ((++sp & 255u) == 0u) { if (xb_ld(&bar[XB_TMO])) break; if (sp > XB_SPIN_CAP) { atomicAdd(&bar[XB_TMO], 1u); break; } }
    }
    nloc = mine > 0u ? mine : 1u; nx = cnt > 0u ? cnt : 1u;
}
__device__ __forceinline__ void xcd_barrier(const XcdBarrier& b) {
    asm volatile("s_waitcnt vmcnt(0)" ::: "memory");
    __syncthreads();
    if (threadIdx.x == 0) {
        unsigned* bar = b.bar;
        __builtin_amdgcn_s_waitcnt(0);
        unsigned nloc = b.st[0], nx = b.st[1];
        if (nloc == 0u) { xcd_barrier_complete(bar, b.x, nloc, nx); b.st[0] = nloc; b.st[1] = nx; }
        const unsigned old = xb_add(&bar[XB_XSUB(b.x)], 1u);
        const unsigned gen = old / nloc;
        if (old + 1u == (gen + 1u) * nloc) {
            __builtin_amdgcn_fence(__ATOMIC_RELEASE, "agent");
            asm volatile("s_waitcnt vmcnt(0)" ::: "memory");
            const unsigned og = xb_add(&bar[XB_TOP], 1u);
            const unsigned tg = og / nx;
            if (og + 1u == (tg + 1u) * nx) xb_add(&bar[XB_TOPGEN], 1u);
            else XB_SPIN(xb_ld(&bar[XB_TOPGEN]) == tg, bar);
            __builtin_amdgcn_fence(__ATOMIC_ACQUIRE, "agent");
            xb_add(&bar[XB_XGEN(b.x)], 1u);
            asm volatile("s_waitcnt vmcnt(0)" ::: "memory");
        } else {
            XB_SPIN(xb_ld(&bar[XB_XGEN(b.x)]) == gen, bar);
            __builtin_amdgcn_fence(__ATOMIC_ACQUIRE, "agent");
            asm volatile("s_waitcnt vmcnt(0)" ::: "memory");
        }
    }
    __syncthreads();
}

namespace pg8 {
constexpr int BM = 256, BK = 64, HALF = 128, HTB = HALF * BK * 2, STAGE_BYTES = 8 * HTB, NXCD = 8, WGM = 8;
__host__ __device__ __forceinline__ int lds_byte(int r, int c) { const int st = (r >> 4) * 2 + (c >> 5), rr = r & 15, cc = c & 31, ob = rr * 64 + cc * 2; return st * 1024 + (ob ^ (((ob >> 9) & 1) << 5)); }
__host__ __device__ __forceinline__ void stage_rc(int b, int& R, int& C) { const int st = b / 1024, sb = b % 1024, swz = sb ^ (((sb >> 9) & 1) << 5); R = (st >> 1) * 16 + swz / 64; C = (st & 1) * 32 + (swz % 64) / 2; }
__host__ __device__ __forceinline__ int perm32(int rho) { const int n = rho >> 4, i = rho & 15; return 8 * (i >> 2) + 4 * n + (i & 3); }
struct Unit { int pm, pn; };
__device__ __forceinline__ bool static_next(int nM, int nN, int G, int c, int i, Unit& u) {
    const int nwg = nM * nN; const long L = (long)i * G + c; if (L >= nwg) return false;
    int wgid = (int)L; { const int q = nwg / NXCD, r = nwg % NXCD, xcd = wgid % NXCD, off = wgid / NXCD; wgid = (xcd < r ? xcd * (q + 1) : r * (q + 1) + (xcd - r) * q) + off; }
    const int nig = WGM * nN, gid = wgid / nig, fm = gid * WGM, gsz = (nM - fm) < WGM ? (nM - fm) : WGM;
    u.pm = fm + ((wgid % nig) % gsz); u.pn = (wgid % nig) / gsz; return true;
}
__device__ __forceinline__ unsigned cvt_pk_bf16(float lo, float hi) { unsigned r; asm volatile("v_cvt_pk_bf16_f32 %0, %1, %2" : "=v"(r) : "v"(lo), "v"(hi)); return r; }

template <class Epi, class Sched, bool FP8 = false>
__device__ __forceinline__ void gemm_phase(LAS unsigned char* lds, const int KB, const char* Abase, const Sched& S, const Epi& E) {
    const int tid = threadIdx.x, wid = __builtin_amdgcn_readfirstlane(tid >> 6), lane = tid & 63, wr = wid >> 2, wc = wid & 3, fr = lane & 15, fq = lane >> 4;
    const int nt = KB / (BK * 2);
    int Rl[2]; unsigned Cb[2], voffB[2];
#pragma unroll
    for (int i = 0; i < 2; ++i) { int R, C; stage_rc(tid * 16 + i * 8192, R, C); const int Rb = Epi::PERM ? ((R & ~31) + perm32(R & 31)) : R;
        Rl[i] = R; Cb[i] = (unsigned)C * 2u; voffB[i] = (unsigned)(Rb * KB + C * 2); }
    const size_t kstep = (size_t)(BK * 2);
    const size_t hstepB = (size_t)HALF * KB;
    const unsigned ldsw = (unsigned)wid * 1024u;
    const int aoff = lds_byte(wr * 64 + fr, fq * 8), boff = lds_byte(wc * 32 + fr, fq * 8);
#define PG8_SA(b, h) (((b) * 2 + (h)) * HTB)
#define PG8_SB(b, h) ((4 + (b) * 2 + (h)) * HTB)
#define PG8_STAGE(bufoff, gbase, voff) do { _Pragma("unroll") for (int _i = 0; _i < 2; ++_i) \
        __builtin_amdgcn_global_load_lds((const unsigned*)((const char*)(gbase) + (voff)[_i]), (LAS unsigned*)(lds + (bufoff) + ldsw + _i * 8192), 16, 0, 0); } while (0)
#define PG8_LD32(p) __builtin_shufflevector(*(const LAS i32x4*)(p), *(const LAS i32x4*)((p) + 1024), 0, 1, 2, 3, 4, 5, 6, 7)
#define PG8_LDA(dst, b, h) do { _Pragma("unroll") for (int m = 0; m < 4; ++m) dst[m] = PG8_LD32(lds + PG8_SA(b, h) + aoff + m * 2048); } while (0)
#define PG8_LDB(dst, b, h) do { _Pragma("unroll") for (int n = 0; n < 2; ++n) dst[n] = PG8_LD32(lds + PG8_SB(b, h) + boff + n * 2048); } while (0)
#define PG8_LO(v) __builtin_bit_cast(bf16x8, __builtin_shufflevector((v), (v), 0, 1, 2, 3))
#define PG8_HI(v) __builtin_bit_cast(bf16x8, __builtin_shufflevector((v), (v), 4, 5, 6, 7))
#define PG8_MMA(ai, bj, At, Bt) do { __builtin_amdgcn_s_setprio(1); _Pragma("unroll") for (int m = 0; m < 4; ++m) _Pragma("unroll") for (int n = 0; n < 2; ++n) { \
        if constexpr (FP8) asm volatile("v_mfma_f32_16x16x128_f8f6f4 %0, %1, %2, %0" : "+v"(acc[ai][bj][m][n]) : "v"(Bt[n]), "v"(At[m])); \
        else { acc[ai][bj][m][n] = __builtin_amdgcn_mfma_f32_16x16x32_bf16(PG8_LO(Bt[n]), PG8_LO(At[m]), acc[ai][bj][m][n], 0, 0, 0); \
               acc[ai][bj][m][n] = __builtin_amdgcn_mfma_f32_16x16x32_bf16(PG8_HI(Bt[n]), PG8_HI(At[m]), acc[ai][bj][m][n], 0, 0, 0); } } \
        __builtin_amdgcn_s_setprio(0); } while (0)
#define PG8_WAIT_V(n) asm volatile("s_waitcnt vmcnt(" #n ")" ::: "memory")
#define PG8_WAIT_L(n) asm volatile("s_waitcnt lgkmcnt(" #n ")" ::: "memory")
#define PG8_BAR __builtin_amdgcn_s_barrier()
#define PG8_SCHED __builtin_amdgcn_sched_barrier(0)
    Unit cur, nxt; int ui = 0;
    if (!S.next(0, cur)) return;
    f32x4 acc[2][2][4][2];
#pragma unroll
    for (int a = 0; a < 2; ++a)
#pragma unroll
        for (int b = 0; b < 2; ++b)
#pragma unroll
            for (int m = 0; m < 4; ++m)
#pragma unroll
                for (int n = 0; n < 2; ++n) acc[a][b][m][n] = (f32x4){0.f, 0.f, 0.f, 0.f};
    i32x8 At[4], B0[2], B1[2];
    unsigned cO0[2], cO1[2], nO0[2], nO1[2];
#pragma unroll
    for (int i = 0; i < 2; ++i) { cO0[i] = S.a_off(0, cur, Rl[i]) + Cb[i]; cO1[i] = S.a_off(0, cur, HALF + Rl[i]) + Cb[i]; }
    const char* cB = S.b_base(cur);
    PG8_STAGE(PG8_SB(0, 0), cB, voffB); PG8_STAGE(PG8_SB(0, 1), cB + hstepB, voffB); PG8_STAGE(PG8_SA(0, 0), Abase, cO0); PG8_STAGE(PG8_SA(0, 1), Abase, cO1);
    if (wr == 1) PG8_BAR;
    PG8_WAIT_V(2); PG8_BAR;
    PG8_STAGE(PG8_SB(1, 0), cB + kstep, voffB); PG8_STAGE(PG8_SA(1, 0), Abase + kstep, cO0); PG8_STAGE(PG8_SB(1, 1), cB + hstepB + kstep, voffB);
    PG8_WAIT_V(6); PG8_BAR;
    for (;;) {
        const bool has_next = S.next(ui + 1, nxt);
        const char* nB = cB;
#pragma unroll
        for (int i = 0; i < 2; ++i) { nO0[i] = cO0[i]; nO1[i] = cO1[i]; }
        if (has_next) { nB = S.b_base(nxt);
#pragma unroll
            for (int i = 0; i < 2; ++i) { nO0[i] = S.a_off(ui + 1, nxt, Rl[i]) + Cb[i]; nO1[i] = S.a_off(ui + 1, nxt, HALF + Rl[i]) + Cb[i]; } }
#pragma nounroll
        for (int t = 0; t < nt; t += 2) {
            const bool last = (t == nt - 2);
            const char* a1 = Abase + (size_t)(t + 1) * kstep;
            const char* a2 = last ? Abase : Abase + (size_t)(t + 2) * kstep; const char* b2 = last ? nB : cB + (size_t)(t + 2) * kstep;
            const char* a3 = a2 + kstep; const char* b3 = b2 + kstep;
            unsigned o0[2], o1[2];
#pragma unroll
            for (int i = 0; i < 2; ++i) { o0[i] = last ? nO0[i] : cO0[i]; o1[i] = last ? nO1[i] : cO1[i]; }
            PG8_LDB(B0, 0, 0); PG8_LDB(B1, 0, 1); PG8_SCHED; PG8_LDA(At, 0, 0); PG8_STAGE(PG8_SA(1, 1), a1, cO1);
            PG8_WAIT_V(8); PG8_WAIT_L(0); PG8_BAR; PG8_MMA(0, 0, At, B0); PG8_MMA(0, 1, At, B1); PG8_BAR; PG8_SCHED;
            PG8_LDA(At, 0, 1); PG8_STAGE(PG8_SB(0, 0), b2, voffB); PG8_STAGE(PG8_SB(0, 1), b2 + hstepB, voffB); PG8_STAGE(PG8_SA(0, 0), a2, o0);
            PG8_WAIT_V(8); PG8_WAIT_L(0); PG8_BAR; PG8_MMA(1, 0, At, B0); PG8_MMA(1, 1, At, B1); PG8_BAR; PG8_SCHED;
            PG8_LDB(B0, 1, 0); PG8_LDB(B1, 1, 1); PG8_SCHED; PG8_LDA(At, 1, 0); PG8_STAGE(PG8_SA(0, 1), a2, o1);
            PG8_WAIT_V(8); PG8_WAIT_L(0); PG8_BAR; PG8_MMA(0, 0, At, B0); PG8_MMA(0, 1, At, B1); PG8_BAR; PG8_SCHED;
            PG8_LDA(At, 1, 1); PG8_STAGE(PG8_SB(1, 0), b3, voffB); PG8_STAGE(PG8_SB(1, 1), b3 + hstepB, voffB); PG8_STAGE(PG8_SA(1, 0), a3, o0);
            PG8_WAIT_V(8); PG8_WAIT_L(0); PG8_BAR; PG8_MMA(1, 0, At, B0); PG8_MMA(1, 1, At, B1); PG8_BAR; PG8_SCHED;
        }
        if (wr == 0) PG8_BAR;
        if constexpr (FP8) asm volatile("s_nop 15\n\ts_nop 15" ::: "memory");
        E(acc, cur, ui, wr, wc, fr, fq);
        if (!has_next) break;
#pragma unroll
        for (int a = 0; a < 2; ++a)
#pragma unroll
            for (int b = 0; b < 2; ++b)
#pragma unroll
                for (int m = 0; m < 4; ++m)
#pragma unroll
                    for (int n = 0; n < 2; ++n) acc[a][b][m][n] = (f32x4){0.f, 0.f, 0.f, 0.f};
        cur = nxt; cB = nB; ++ui;
#pragma unroll
        for (int i = 0; i < 2; ++i) { cO0[i] = nO0[i]; cO1[i] = nO1[i]; }
        if (wr == 1) PG8_BAR;
    }
    PG8_WAIT_V(0);
    PG8_BAR;
#undef PG8_SA
#undef PG8_SB
#undef PG8_STAGE
#undef PG8_LDA
#undef PG8_LDB
#undef PG8_MMA
#undef PG8_LO
#undef PG8_HI
#undef PG8_LD32
#undef PG8_WAIT_V
#undef PG8_WAIT_L
#undef PG8_BAR
#undef PG8_SCHED
}

struct DenseSched {
    int nM, nN, G, c, K2; const char* B; int reps;
    __device__ __forceinline__ bool next(int i, Unit& u) const { const int rounds = (nM * nN + G - 1) / G; if (i >= rounds * reps) return false; return static_next(nM, nN, G, c, i % rounds, u); }
    __device__ __forceinline__ const char* b_base(const Unit& u) const { return B + (size_t)u.pn * BM * K2; }
    __device__ __forceinline__ unsigned a_off(int, const Unit& u, int r) const { return (unsigned)(u.pm * BM + r) * (unsigned)K2; }
};
struct MoeSched {
    int NT, nN, G, c, K2; const char* B; size_t estride; bool gather;
    const LAS int* tile_e; const LAS unsigned* rowtab; int reps;
    __device__ __forceinline__ int rounds() const { return (NT * nN + G - 1) / G; }
    __device__ __forceinline__ bool next(int i, Unit& u) const { const int r = rounds(); if (i >= r * reps) return false; return static_next(NT, nN, G, c, i % r, u); }
    __device__ __forceinline__ const char* b_base(const Unit& u) const { return B + (size_t)tile_e[u.pm] * estride + (size_t)u.pn * BM * K2; }
    __device__ __forceinline__ unsigned a_off(int ui, const Unit& u, int r) const { return gather ? rowtab[(ui % rounds()) * 256 + r] : (unsigned)(u.pm * BM + r) * (unsigned)K2; }
};

struct EpiProj {
    static constexpr bool PERM = true;
    bf16* O;
    __device__ __forceinline__ void operator()(const f32x4 (&acc)[2][2][4][2], const Unit& u, int, int wr, int wc, int fr, int fq) const {
        const int row0 = u.pm * BM + 16 * ((u.pm >> 4) + 1) + wr * 64 + fr, col0 = u.pn * BM + wc * 32 + 8 * fq;
#pragma unroll
        for (int ai = 0; ai < 2; ++ai)
#pragma unroll
            for (int m = 0; m < 4; ++m) { bf16* rowp = O + (size_t)(row0 + ai * HALF + m * 16) * INW + col0;
#pragma unroll
                for (int bj = 0; bj < 2; ++bj) { const f32x4 v0 = acc[ai][bj][m][0], v1 = acc[ai][bj][m][1];
                    u32x4 w; w.x = cvt_pk_bf16(v0[0], v0[1]); w.y = cvt_pk_bf16(v0[2], v0[3]); w.z = cvt_pk_bf16(v1[0], v1[1]); w.w = cvt_pk_bf16(v1[2], v1[3]);
                    *(u32x4*)(rowp + bj * HALF) = w; } }
    }
};
struct EpiResid {
    static constexpr bool PERM = true;
    const float* X; const float* G2; bf16* H1; unsigned char* HN2;
    __device__ __forceinline__ void operator()(const f32x4 (&acc)[2][2][4][2], const Unit& u, int, int wr, int wc, int fr, int fq) const {
        const int row0 = u.pm * BM + wr * 64 + fr, col0 = u.pn * BM + wc * 32 + 8 * fq;
        f32x4 gv[2][2];
#pragma unroll
        for (int bj = 0; bj < 2; ++bj)
#pragma unroll
            for (int n = 0; n < 2; ++n) gv[bj][n] = *(const f32x4*)(G2 + col0 + bj * HALF + 4 * n);
#pragma unroll
        for (int ai = 0; ai < 2; ++ai)
#pragma unroll
            for (int m = 0; m < 4; ++m) { const size_t off = (size_t)(row0 + ai * HALF + m * 16) * D + col0;
#pragma unroll
                for (int bj = 0; bj < 2; ++bj) { const f32x4 v0 = acc[ai][bj][m][0] + *(const f32x4*)(X + off + bj * HALF), v1 = acc[ai][bj][m][1] + *(const f32x4*)(X + off + bj * HALF + 4);
                    u32x4 w; w.x = cvt_pk_bf16(v0[0], v0[1]); w.y = cvt_pk_bf16(v0[2], v0[3]); w.z = cvt_pk_bf16(v1[0], v1[1]); w.w = cvt_pk_bf16(v1[2], v1[3]);
                    *(u32x4*)(H1 + off + bj * HALF) = w;
                    const f32x4 t0 = v0 * gv[bj][0], t1 = v1 * gv[bj][1];
                    u32x2 e; e.x = pk4_fp8(clamp448(t0[0]), clamp448(t0[1]), clamp448(t0[2]), clamp448(t0[3])); e.y = pk4_fp8(clamp448(t1[0]), clamp448(t1[1]), clamp448(t1[2]), clamp448(t1[3]));
                    *(u32x2*)(HN2 + off + bj * HALF) = e; }
                asm volatile("" ::: "memory"); }
    }
};
struct EpiGateUp {
    static constexpr bool PERM = true;
    unsigned char* H; const LAS float* rstd; int rounds;
    __device__ __forceinline__ void operator()(const f32x4 (&acc)[2][2][4][2], const Unit& u, int ui_, int wr, int wc, int fr, int fq) const {
        const int ui = ui_ % rounds;
        const int r0 = wr * 64 + fr, col0 = u.pn * HALF + wc * 32 + 8 * fq;
#pragma unroll
        for (int ai = 0; ai < 2; ++ai)
#pragma unroll
            for (int m = 0; m < 4; ++m) { const int r = r0 + ai * HALF + m * 16; const float rs = rstd[ui * 256 + r];
                float h[8];
#pragma unroll
                for (int n = 0; n < 2; ++n)
#pragma unroll
                    for (int j = 0; j < 4; ++j) { const float g = acc[ai][0][m][n][j] * rs, up = acc[ai][1][m][n][j] * rs; h[n * 4 + j] = g * sigmoidf_(g) * up; }
#pragma unroll
                for (int j = 0; j < 8; ++j) h[j] = clamp448(h[j] * HID_SCALE);
                u32x2 w; w.x = pk4_fp8(h[0], h[1], h[2], h[3]); w.y = pk4_fp8(h[4], h[5], h[6], h[7]);
                *(u32x2*)(H + (size_t)(u.pm * BM + r) * EFF + col0) = w; }
    }
};
struct EpiDown {
    static constexpr bool PERM = true;
    bf16* C; const LAS int* slot; const LAS float* gate; int rounds;
    __device__ __forceinline__ void operator()(const f32x4 (&acc)[2][2][4][2], const Unit& u, int ui_, int wr, int wc, int fr, int fq) const {
        const int ui = ui_ % rounds;
        const int r0 = wr * 64 + fr, col0 = u.pn * BM + wc * 32 + 8 * fq;
#pragma unroll
        for (int ai = 0; ai < 2; ++ai)
#pragma unroll
            for (int m = 0; m < 4; ++m) { const int r = r0 + ai * HALF + m * 16; const int sl = slot[ui * 256 + r]; const float gt = gate[ui * 256 + r];
                if (sl >= 0) { bf16* rowp = C + (size_t)sl * D + col0;
#pragma unroll
                    for (int bj = 0; bj < 2; ++bj) { const f32x4 v0 = acc[ai][bj][m][0] * gt, v1 = acc[ai][bj][m][1] * gt;
                        u32x4 w; w.x = cvt_pk_bf16(v0[0], v0[1]); w.y = cvt_pk_bf16(v0[2], v0[3]); w.z = cvt_pk_bf16(v1[0], v1[1]); w.w = cvt_pk_bf16(v1[2], v1[3]);
                        *(u32x4*)(rowp + bj * HALF) = w; } } }
    }
};
}

struct Frame {
    LAS unsigned char* lds; int tid, lane, wave, G, bx;
    const float *x, *meta, *g1, *w_in, *conv_w, *conv_b, *wa, *ba, *wx, *bx_, *lam, *lru_gain, *pool_w, *pool_scale, *w_out, *g2, *w_group, *b_group, *w_router, *b_router, *w_gate, *w_up, *w_down, *final_gain;
    float* out; unsigned char* ws; unsigned* ctl;
    bf16 *WinT, *WoutT, *WaT, *WxT, *PwT, *HN1, *YMIX, *PROJ, *C, *H1; unsigned char *WguT, *WdT, *HN2, *HID;
    _Float16* WrH; float* AGG; f32x4* RINFO;
};
__device__ __forceinline__ float wave_sum(float v) {
#pragma unroll
    for (int o = 1; o < 64; o <<= 1) v += __shfl_xor(v, o);
    return v;
}

__device__ __forceinline__ void transpose_tile(const float* W, int ldw, int k0, int n0, bf16* WT, int ldt, int drow0, LAS float* scr, int lane) {
    { float v[32];
#pragma unroll
      for (int i = 0; i < 32; ++i) v[i] = W[(size_t)(k0 + 2 * i + (lane >> 5)) * ldw + n0 + (lane & 31)];
#pragma unroll
      for (int i = 0; i < 32; ++i) scr[(2 * i + (lane >> 5)) * 33 + (lane & 31)] = v[i]; }
    LDS_WAIT(); asm volatile("" ::: "memory");
    const int c = lane & 7;
#pragma unroll
    for (int j = 0; j < 4; ++j) { const int n = (lane >> 3) + 8 * j; const LAS float* s = scr + (8 * c) * 33 + n;
        u32x4 o; o.x = pk2(s[0 * 33], s[1 * 33]); o.y = pk2(s[2 * 33], s[3 * 33]); o.z = pk2(s[4 * 33], s[5 * 33]); o.w = pk2(s[6 * 33], s[7 * 33]);
        *(u32x4*)(WT + (size_t)(drow0 + n) * ldt + k0 + 8 * c) = o; }
    LDS_WAIT(); asm volatile("" ::: "memory");
}
__device__ __forceinline__ void transpose_tile_fp8(const float* W, int ldw, int k0, int n0, unsigned char* WT, int ldt, int drow0, float scale, LAS float* scr, int lane) {
    { float v[64];
#pragma unroll
      for (int i = 0; i < 64; ++i) v[i] = W[(size_t)(k0 + 2 * i + (lane >> 5)) * ldw + n0 + (lane & 31)];
#pragma unroll
      for (int i = 0; i < 64; ++i) scr[(2 * i + (lane >> 5)) * 33 + (lane & 31)] = v[i]; }
    LDS_WAIT(); asm volatile("" ::: "memory");
    const int n = lane >> 1, kh = (lane & 1) * 64; const LAS float* sp = scr + kh * 33 + n;
#pragma unroll
    for (int c = 0; c < 4; ++c) { u32x4 o;
#pragma unroll
        for (int w = 0; w < 4; ++w) { const LAS float* q4 = sp + (16 * c + 4 * w) * 33; o[w] = pk4_fp8(q4[0] * scale, q4[33] * scale, q4[66] * scale, q4[99] * scale); }
        *(u32x4*)(WT + (size_t)(drow0 + n) * ldt + k0 + kh + 16 * c) = o; }
    LDS_WAIT(); asm volatile("" ::: "memory");
}
__device__ __forceinline__ void p0_prologue(Frame& F) {
    if (F.bx < INW / 8) {
        LAS float* hnm = (LAS float*)F.lds;
        LAS float* part = (LAS float*)(F.lds + 65536);
        for (int r = F.wave * 2; r < F.wave * 2 + 2; ++r) {
            const f32x4* xr = (const f32x4*)(F.meta + (size_t)r * D) + F.lane; f32x4 v[4]; float s = 0.f;
#pragma unroll
            for (int j = 0; j < 4; ++j) { v[j] = xr[64 * j]; s += (v[j].x * v[j].x + v[j].y * v[j].y) + (v[j].z * v[j].z + v[j].w * v[j].w); }
            const float rstd = rsqrtf(wave_sum(s) * (1.f / D) + RMS_EPS);
#pragma unroll
            for (int j = 0; j < 4; ++j) { const f32x4 g = ((const f32x4*)F.g1)[F.lane + 64 * j]; *(LAS f32x4*)(hnm + r * D + 4 * F.lane + 256 * j) = v[j] * rstd * g; }
        }
        __syncthreads();
        { const int cc = F.tid & 7, ks = F.tid >> 3, col = F.bx * 8 + cc; float a[16];
#pragma unroll
            for (int r = 0; r < 16; ++r) a[r] = 0.f;
            for (int k = ks * 16; k < ks * 16 + 16; ++k) { const float w = F.w_in[(size_t)k * INW + col];
#pragma unroll
                for (int r = 0; r < 16; ++r) a[r] += hnm[r * D + k] * w; }
#pragma unroll
            for (int r = 0; r < 16; ++r) part[(ks * 16 + r) * 8 + cc] = a[r]; }
        __syncthreads();
        if (F.tid < 128) { const int r = F.tid >> 3, cc = F.tid & 7; float s = 0.f;
            for (int ks = 0; ks < 64; ++ks) s += part[(ks * 16 + r) * 8 + cc];
            const bf16 h = (bf16)f2bf(s);
            for (int b = 0; b < NBATCH; ++b) F.PROJ[(size_t)(b * TT + r) * INW + F.bx * 8 + cc] = h; }
        __syncthreads();
    }
    LAS float* scr = (LAS float*)(F.lds + F.wave * 16896);
    const int gw = F.bx * 8 + F.wave, NGW = F.G * 8;
    constexpr int I_IN = 16 * 48, I_OUT = 16 * 32, I_G = NE * 8 * 16, I_D = NE * 4 * 32, I_A = 8 * 2, I_P = 4 * 2 * 4;
    constexpr int NITEMS = I_IN + I_OUT + 2 * I_G + I_D + 2 * I_A + I_P;
    for (int it = gw; it < NITEMS; it += NGW) {
        int r = it;
        if (r < I_IN) { const int kb = r / 48, nb = r % 48; transpose_tile(F.w_in, INW, 64 * kb, 32 * nb, F.WinT, D, 32 * nb, scr, F.lane); continue; } r -= I_IN;
        if (r < I_OUT) { const int kb = r / 32, nb = r % 32; transpose_tile(F.w_out, D, 64 * kb, 32 * nb, F.WoutT, D, 32 * nb, scr, F.lane); continue; } r -= I_OUT;
        if (r < 2 * I_G) { const int up = r >= I_G; if (up) r -= I_G; const int e = r >> 7, kb = (r >> 4) & 7, nb = r & 15, n0 = 32 * nb;
            transpose_tile_fp8((up ? F.w_up : F.w_gate) + (size_t)e * D * EFF, EFF, 128 * kb, n0, F.WguT + (size_t)e * 1024 * D, D, (n0 >> 7) * 256 + up * 128 + (n0 & 127), WGU_SCALE, scr, F.lane); continue; } r -= 2 * I_G;
        if (r < I_D) { const int e = r >> 7, kb = (r >> 5) & 3, nb = r & 31; transpose_tile_fp8(F.w_down + (size_t)e * EFF * D, D, 128 * kb, 32 * nb, F.WdT + (size_t)e * D * EFF, EFF, 32 * nb, WD_SCALE, scr, F.lane); continue; } r -= I_D;
        if (r < 2 * I_A) { const int x = r >= I_A; if (x) r -= I_A; const int h = r >> 1, nb = r & 1; transpose_tile((x ? F.wx : F.wa) + (size_t)h * 4096, 64, 0, 32 * nb, (x ? F.WxT : F.WaT) + (size_t)h * 4096, 64, 32 * nb, scr, F.lane); continue; } r -= 2 * I_A;
        { const int g = r >> 3, kb = (r >> 2) & 1, nb = r & 3; transpose_tile(F.pool_w + (size_t)g * 16384, 128, 64 * kb, 32 * nb, F.PwT + (size_t)g * 16384, 128, 32 * nb, scr, F.lane); }
    }
    for (int i = F.bx * 512 + F.tid; i < NROUTE * D; i += F.G * 512) { const int n = i >> 10, k = i & 1023;
        const float w = n < 4 ? F.w_group[k * 4 + n] : F.w_router[k * 32 + (n - 4)]; F.WrH[i] = (_Float16)(w * 256.0f); }
    for (int m = gw; m < M; m += NGW) {
        const f32x4* xr = (const f32x4*)(F.x + (size_t)m * D) + F.lane; f32x4 v[4]; float s = 0.f;
#pragma unroll
        for (int j = 0; j < 4; ++j) { v[j] = xr[64 * j]; s += (v[j].x * v[j].x + v[j].y * v[j].y) + (v[j].z * v[j].z + v[j].w * v[j].w); }
        const float rstd = rsqrtf(wave_sum(s) * (1.f / D) + RMS_EPS);
        u32x2* o8 = (u32x2*)(F.HN1 + (size_t)m * D) + F.lane;
#pragma unroll
        for (int j = 0; j < 4; ++j) { const f32x4 g = ((const f32x4*)F.g1)[F.lane + 64 * j]; const f32x4 y = v[j] * rstd * g; u32x2 w; w.x = pk2(y.x, y.y); w.y = pk2(y.z, y.w); o8[64 * j] = w; }
    }
}

template <int CTRL> __device__ __forceinline__ float dpp_f(float old, float src) {
    return __builtin_bit_cast(float, __builtin_amdgcn_update_dpp(__builtin_bit_cast(int, old), __builtin_bit_cast(int, src), CTRL, 0xf, 0xf, false)); }
#define DPP_BCAST15 0x15F
__device__ __forceinline__ void row_scan(float& A, float& B) {
    { const float Ap = dpp_f<0x111>(1.0f, A), Bp = dpp_f<0x111>(0.0f, B); B = A * Bp + B; A = A * Ap; }
    { const float Ap = dpp_f<0x112>(1.0f, A), Bp = dpp_f<0x112>(0.0f, B); B = A * Bp + B; A = A * Ap; }
    { const float Ap = dpp_f<0x114>(1.0f, A), Bp = dpp_f<0x114>(0.0f, B); B = A * Bp + B; A = A * Ap; }
    { const float Ap = dpp_f<0x118>(1.0f, A), Bp = dpp_f<0x118>(0.0f, B); B = A * Bp + B; A = A * Ap; }
}
#define SCAN8_STR(D) "s_nop 1\n\t" \
    "v_fmac_f32_dpp %0, %0, %8 row_shr:" #D " row_mask:0xf bank_mask:0xf\n\tv_mul_f32_dpp %8, %8, %8 row_shr:" #D " row_mask:0xf bank_mask:0xf\n\t" \
    "v_fmac_f32_dpp %1, %1, %9 row_shr:" #D " row_mask:0xf bank_mask:0xf\n\tv_mul_f32_dpp %9, %9, %9 row_shr:" #D " row_mask:0xf bank_mask:0xf\n\t" \
    "v_fmac_f32_dpp %2, %2, %10 row_shr:" #D " row_mask:0xf bank_mask:0xf\n\tv_mul_f32_dpp %10, %10, %10 row_shr:" #D " row_mask:0xf bank_mask:0xf\n\t" \
    "v_fmac_f32_dpp %3, %3, %11 row_shr:" #D " row_mask:0xf bank_mask:0xf\n\tv_mul_f32_dpp %11, %11, %11 row_shr:" #D " row_mask:0xf bank_mask:0xf\n\t" \
    "v_fmac_f32_dpp %4, %4, %12 row_shr:" #D " row_mask:0xf bank_mask:0xf\n\tv_mul_f32_dpp %12, %12, %12 row_shr:" #D " row_mask:0xf bank_mask:0xf\n\t" \
    "v_fmac_f32_dpp %5, %5, %13 row_shr:" #D " row_mask:0xf bank_mask:0xf\n\tv_mul_f32_dpp %13, %13, %13 row_shr:" #D " row_mask:0xf bank_mask:0xf\n\t" \
    "v_fmac_f32_dpp %6, %6, %14 row_shr:" #D " row_mask:0xf bank_mask:0xf\n\tv_mul_f32_dpp %14, %14, %14 row_shr:" #D " row_mask:0xf bank_mask:0xf\n\t" \
    "v_fmac_f32_dpp %7, %7, %15 row_shr:" #D " row_mask:0xf bank_mask:0xf\n\tv_mul_f32_dpp %15, %15, %15 row_shr:" #D " row_mask:0xf bank_mask:0xf"
#define SCAN8(D, A, B, o) asm volatile(SCAN8_STR(D) : "+v"(B[o + 0]), "+v"(B[o + 1]), "+v"(B[o + 2]), "+v"(B[o + 3]), "+v"(B[o + 4]), "+v"(B[o + 5]), "+v"(B[o + 6]), "+v"(B[o + 7]), \
    "+v"(A[o + 0]), "+v"(A[o + 1]), "+v"(A[o + 2]), "+v"(A[o + 3]), "+v"(A[o + 4]), "+v"(A[o + 5]), "+v"(A[o + 6]), "+v"(A[o + 7]))
__device__ __forceinline__ void row_scan16(float (&A)[16], float (&B)[16]) {
    SCAN8(1, A, B, 0); SCAN8(1, A, B, 8); SCAN8(2, A, B, 0); SCAN8(2, A, B, 8); SCAN8(4, A, B, 0); SCAN8(4, A, B, 8); SCAN8(8, A, B, 0); SCAN8(8, A, B, 8);
}
struct LruW { LAS float* cst; const bf16 *waP, *wxP; };
__device__ __forceinline__ void lru_setup(const Frame& F, LruW& L, LAS unsigned char* wbase) {
    const int hd = F.wave; L.cst = (LAS float*)wbase;
    for (int i = F.lane; i < 512; i += 64) { const int t = i >> 6, ch = hd * 64 + (i & 63); float v;
        if (t < 4) v = F.conv_w[t * LW + ch]; else if (t == 4) v = F.conv_b[ch]; else if (t == 5) v = F.ba[ch]; else if (t == 6) v = F.bx_[ch];
        else { const float lm = F.lam[ch]; v = 8.0f * (fminf(lm, 0.f) - log1pf(__expf(-fabsf(lm)))); }
        L.cst[i] = v; }
    const int i = F.lane & 15, qw = F.lane >> 4; const size_t o = (size_t)hd * 4096 + (size_t)(8 * (i >> 2) + (i & 3)) * 64 + 8 * qw;
    L.waP = F.WaT + o; L.wxP = F.WxT + o;
    LDS_WAIT();
}
struct LruRaw { u32x4 u[2][4]; u32x4 ug[2]; };
template <bool WITH_UG>
__device__ __forceinline__ void lru_load(const Frame& F, int b, int tt0, LruRaw& R) {
    const int hd = F.wave, row = F.lane & 15, q = F.lane >> 4, tt = tt0 + row;
    const bf16* prow = F.PROJ + (size_t)(b * TT + tt) * INW + hd * 64 + 8 * q;
#pragma unroll
    for (int kb = 0; kb < 2; ++kb) {
#pragma unroll
        for (int k = 0; k < 4; ++k) { R.u[kb][k] = (u32x4){0u, 0u, 0u, 0u}; if (tt - 3 + k >= 0) R.u[kb][k] = *(const u32x4*)(prow + (ptrdiff_t)(k - 3) * INW + 32 * kb); }
        if (WITH_UG) R.ug[kb] = *(const u32x4*)(prow + LW + 32 * kb);
    }
}
__device__ __forceinline__ void lru_conv(const Frame& F, const LruW& L, const LruRaw& R, float (&xc)[16], bf16x8 (&xf)[2]) {
    const int q = F.lane >> 4;
#pragma unroll
    for (int kb = 0; kb < 2; ++kb) {
        const LAS float* cs = L.cst + 32 * kb + 8 * q;
        f32x2 x2[4];
        { const f32x4 c0 = *(const LAS f32x4*)(cs + 256), c1 = *(const LAS f32x4*)(cs + 260); x2[0] = (f32x2){c0.x, c0.y}; x2[1] = (f32x2){c0.z, c0.w}; x2[2] = (f32x2){c1.x, c1.y}; x2[3] = (f32x2){c1.z, c1.w}; }
#pragma unroll
        for (int k = 0; k < 4; ++k) {
            const u32x4 u = R.u[kb][k];
            const f32x4 w0 = *(const LAS f32x4*)(cs + 64 * k), w1 = *(const LAS f32x4*)(cs + 64 * k + 4);
            x2[0] = (f32x2){w0.x, w0.y} * (f32x2){bflo(u.x), bfhi(u.x)} + x2[0]; x2[1] = (f32x2){w0.z, w0.w} * (f32x2){bflo(u.y), bfhi(u.y)} + x2[1];
            x2[2] = (f32x2){w1.x, w1.y} * (f32x2){bflo(u.z), bfhi(u.z)} + x2[2]; x2[3] = (f32x2){w1.z, w1.w} * (f32x2){bflo(u.w), bfhi(u.w)} + x2[3];
        }
#pragma unroll
        for (int i = 0; i < 4; ++i) { xc[8 * kb + 2 * i] = x2[i].x; xc[8 * kb + 2 * i + 1] = x2[i].y; }
        asm volatile("" : "+v"(xc[8 * kb + 0]), "+v"(xc[8 * kb + 1]), "+v"(xc[8 * kb + 2]), "+v"(xc[8 * kb + 3]), "+v"(xc[8 * kb + 4]), "+v"(xc[8 * kb + 5]), "+v"(xc[8 * kb + 6]), "+v"(xc[8 * kb + 7]));
        u32x4 p; p.x = pk2(xc[8 * kb + 0], xc[8 * kb + 1]); p.y = pk2(xc[8 * kb + 2], xc[8 * kb + 3]); p.z = pk2(xc[8 * kb + 4], xc[8 * kb + 5]); p.w = pk2(xc[8 * kb + 6], xc[8 * kb + 7]);
        xf[kb] = __builtin_bit_cast(bf16x8, p);
    }
}
template <bool WPF  >
__device__ __forceinline__ void lru_gates(const Frame& F, const LruW& L, const float (&xc)[16], const bf16x8 (&xf)[2], float (&Av)[16], float (&Bv)[16]) {
    const int q = F.lane >> 4;
    bf16x8 wa[2], wx[2];
#pragma unroll
    for (int kk = 0; kk < 2; ++kk) { wa[kk] = *(const bf16x8*)(L.waP + 32 * kk); wx[kk] = *(const bf16x8*)(L.wxP + 32 * kk); }
#pragma unroll
    for (int nb = 0; nb < 4; ++nb) {
        const int kb = nb >> 1, hf = nb & 1;
        bf16x8 wan[2], wxn[2];
        if (!WPF && nb > 0) { const int o = (32 * kb + 4 * hf) * 64;
#pragma unroll
            for (int kk = 0; kk < 2; ++kk) { wa[kk] = *(const bf16x8*)(L.waP + o + 32 * kk); wx[kk] = *(const bf16x8*)(L.wxP + o + 32 * kk); } }
        if (WPF && nb < 3) { const int o = (32 * ((nb + 1) >> 1) + 4 * ((nb + 1) & 1)) * 64;
#pragma unroll
            for (int kk = 0; kk < 2; ++kk) { wan[kk] = *(const bf16x8*)(L.waP + o + 32 * kk); wxn[kk] = *(const bf16x8*)(L.wxP + o + 32 * kk); } }
        asm volatile("" ::: "memory");
        f32x4 ra = (f32x4){0.f, 0.f, 0.f, 0.f}, rx = ra;
#pragma unroll
        for (int kk = 0; kk < 2; ++kk) { ra = __builtin_amdgcn_mfma_f32_16x16x32_bf16(wa[kk], xf[kk], ra, 0, 0, 0); rx = __builtin_amdgcn_mfma_f32_16x16x32_bf16(wx[kk], xf[kk], rx, 0, 0, 0); }
        const LAS float* cs = L.cst + 32 * kb + 8 * q + 4 * hf;
        const f32x4 ba4 = *(const LAS f32x4*)(cs + 320), bx4 = *(const LAS f32x4*)(cs + 384), lm4 = *(const LAS f32x4*)(cs + 448);
#pragma unroll
        for (int j = 0; j < 4; ++j) { const int c = 8 * kb + 4 * hf + j;
            const float r = sigmoidf_(ra[j] + ba4[j]), ig = sigmoidf_(rx[j] + bx4[j]);
            const float a = __expf(lm4[j] * r);
            Av[c] = a; Bv[c] = __builtin_amdgcn_sqrtf(fmaf(-a, a, 1.0f)) * (ig * xc[c]); }
        if (WPF && nb < 3) {
#pragma unroll
            for (int kk = 0; kk < 2; ++kk) { wa[kk] = wan[kk]; wx[kk] = wxn[kk]; } }
    }
    row_scan16(Av, Bv);
}
__device__ __forceinline__ void p2_aggregates(Frame& F) {
    LruW L; lru_setup(F, L, F.lds + F.wave * 2048);
    const int row = F.lane & 15, q = F.lane >> 4;
    for (int ch = F.bx; ch < 256; ch += F.G) {
        const int b = ch >> 5, ci = ch & 31; float Ac[16], Bc[16];
#pragma unroll
        for (int c = 0; c < 16; ++c) { Ac[c] = 1.f; Bc[c] = 0.f; }
        const int blk0 = (ci == 0 ? -1 : 0);
        LruRaw R; lru_load<false>(F, b, NMETA + 128 * ci + 16 * blk0, R);
        for (int blk = blk0; blk < 8; ++blk) {
            float xc[16]; bf16x8 xf[2]; lru_conv(F, L, R, xc, xf);
            if (blk < 7) lru_load<false>(F, b, NMETA + 128 * ci + 16 * (blk + 1), R);
            asm volatile("" ::: "memory");
            float Av[16], Bv[16];
            lru_gates<true>(F, L, xc, xf, Av, Bv);
#pragma unroll
            for (int c = 0; c < 16; ++c) { Bc[c] = Av[c] * Bc[c] + Bv[c]; Ac[c] *= Av[c]; }
        }
        if (row == 15) {
#pragma unroll
            for (int kb = 0; kb < 2; ++kb) { float* o = F.AGG + ((size_t)ch * LW + F.wave * 64 + 32 * kb + 8 * q) * 2;
#pragma unroll
                for (int j = 0; j < 8; j += 2) *(f32x4*)(o + 2 * j) = (f32x4){Ac[8 * kb + j], Bc[8 * kb + j], Ac[8 * kb + j + 1], Bc[8 * kb + j + 1]}; }
        }
    }
}

constexpr int YT_STRIDE = 520;
constexpr int US_STRIDE = 264;
constexpr int PW_STRIDE = 136;
template <int G> __device__ __forceinline__ void pool_z(const LAS bf16* ub  , bf16x8 (&zf)[4]) {
    constexpr int W = 2 << G;
    asm volatile("" : "+v"(ub));
#pragma unroll
    for (int kb = 0; kb < 4; ++kb) {
        const LAS bf16* p = ub + 15 * US_STRIDE + 32 * kb; const u32x4 c = *(const LAS u32x4*)p; float cur[8], s[8];
        cur[0] = bflo(c.x); cur[1] = bfhi(c.x); cur[2] = bflo(c.y); cur[3] = bfhi(c.y); cur[4] = bflo(c.z); cur[5] = bfhi(c.z); cur[6] = bflo(c.w); cur[7] = bfhi(c.w);
#pragma unroll
        for (int j = 0; j < 8; ++j) s[j] = cur[j];
#pragma unroll
        for (int d = 1; d < W; ++d) { const u32x4 u = *(const LAS u32x4*)(ub + (15 - d) * US_STRIDE + 32 * kb);
            s[0] += bflo(u.x); s[1] += bfhi(u.x); s[2] += bflo(u.y); s[3] += bfhi(u.y); s[4] += bflo(u.z); s[5] += bfhi(u.z); s[6] += bflo(u.w); s[7] += bfhi(u.w);
            if ((d & 3) == 3) asm volatile("" : "+v"(s[0]), "+v"(s[1]), "+v"(s[2]), "+v"(s[3]), "+v"(s[4]), "+v"(s[5]), "+v"(s[6]), "+v"(s[7]) :: "memory"); }
        asm volatile("" : "+v"(s[0]), "+v"(s[1]), "+v"(s[2]), "+v"(s[3]), "+v"(s[4]), "+v"(s[5]), "+v"(s[6]), "+v"(s[7]) :: "memory");
        u32x4 pz; pz.x = pk2(s[0] * (1.0f / W) - cur[0], s[1] * (1.0f / W) - cur[1]); pz.y = pk2(s[2] * (1.0f / W) - cur[2], s[3] * (1.0f / W) - cur[3]);
        pz.z = pk2(s[4] * (1.0f / W) - cur[4], s[5] * (1.0f / W) - cur[5]); pz.w = pk2(s[6] * (1.0f / W) - cur[6], s[7] * (1.0f / W) - cur[7]);
        asm volatile("" : "+v"(pz) :: "memory");
        zf[kb] = __builtin_bit_cast(bf16x8, pz);
    }
}
__device__ __forceinline__ void p3_mixer(Frame& F) {
    LAS bf16* Y = (LAS bf16*)F.lds;
    LAS unsigned char* wbase = F.lds + 66560 + F.wave * 2048;
    LAS float* SSQ = (LAS float*)(F.lds + 66560 + 16384);
    LAS float* RSTD = SSQ + 512;
    LAS bf16* US = (LAS bf16*)F.lds;
    const int row = F.lane & 15, q = F.lane >> 4;
    for (int ch = F.bx; ch < 256; ch += F.G) {
        const int b = ch >> 5, ci = ch & 31; const int m0 = ch * 128;
#ifndef P3_NO_LRU
        {
        LruW L; lru_setup(F, L, wbase);
        float H[16];
        { float Ar[16], Br[16];
#pragma unroll
            for (int c = 0; c < 16; ++c) { Ar[c] = 1.f; Br[c] = 0.f; }
#pragma unroll
            for (int t = 0; t < 2; ++t) { const int k = 2 * row + t;
                if (k < ci) {
#pragma unroll
                    for (int kb = 0; kb < 2; ++kb) { const float* o = F.AGG + ((size_t)(b * 32 + k) * LW + F.wave * 64 + 32 * kb + 8 * q) * 2;
#pragma unroll
                        for (int j = 0; j < 8; j += 2) { const f32x4 v = *(const f32x4*)(o + 2 * j); const int c = 8 * kb + j;
                            Br[c] = v.x * Br[c] + v.y; Ar[c] *= v.x; Br[c + 1] = v.z * Br[c + 1] + v.w; Ar[c + 1] *= v.z; } } } }
            row_scan16(Ar, Br);
#pragma unroll
            for (int c = 0; c < 16; ++c) H[c] = dpp_f<DPP_BCAST15>(0.f, Br[c]); }
        if (ci == 0) {
            float Av[16], Bv[16]; LruRaw Rm; lru_load<false>(F, b, 0, Rm); { float xc[16]; bf16x8 xf[2]; lru_conv(F, L, Rm, xc, xf); lru_gates<false>(F, L, xc, xf, Av, Bv); }
#pragma unroll
            for (int c = 0; c < 16; ++c) H[c] = dpp_f<DPP_BCAST15>(0.f, Av[c] * H[c] + Bv[c]);
        }

        for (int half = 0; half < 2; ++half) {
            for (int blk = 0; blk < 4; ++blk) {
                const int rb = 16 * blk; float Av[16], Bv[16];
                u32x4 ug[2];
                { LruRaw R; lru_load<true>(F, b, NMETA + 128 * ci + 64 * half + rb, R); ug[0] = R.ug[0]; ug[1] = R.ug[1];
                  float xc[16]; bf16x8 xf[2]; lru_conv(F, L, R, xc, xf);
                  asm volatile("" ::: "memory");
                  lru_gates<false>(F, L, xc, xf, Av, Bv); }
                float ss = 0.f;
#pragma unroll
                for (int kb = 0; kb < 2; ++kb) { float y[8];
#pragma unroll
                    for (int j = 0; j < 8; ++j) { const int c = 8 * kb + j;
                        const float h = Av[c] * H[c] + Bv[c];
                        const unsigned w = ug[kb][j >> 1]; const float g = (j & 1) ? bfhi(w) : bflo(w);
                        const float gl = g * sigmoidf_(1.5957691216f * (g + 0.044715f * g * g * g));
                        y[j] = h * gl; ss += y[j] * y[j];
                        H[c] = dpp_f<DPP_BCAST15>(0.f, h); }
                    u32x4 p; p.x = pk2(y[0], y[1]); p.y = pk2(y[2], y[3]); p.z = pk2(y[4], y[5]); p.w = pk2(y[6], y[7]);
                    *(LAS u32x4*)(Y + (rb + row) * YT_STRIDE + F.wave * 64 + 32 * kb + 8 * q) = p;
                    asm volatile("" : "+v"(ss) :: "memory"); }
                ss += __shfl_xor(ss, 16); ss += __shfl_xor(ss, 32);
                if (q == 0) SSQ[(rb + row) * 8 + F.wave] = ss;
            }
            __syncthreads();
            if (F.tid < 64) { float s = 0.f;
#pragma unroll
                for (int w = 0; w < 8; ++w) s += SSQ[F.tid * 8 + w];
                RSTD[F.tid] = rsqrtf(s * (1.0f / LW) + RMS_EPS); }
            __syncthreads();
#pragma unroll
            for (int s = 0; s < 8; ++s) { const int p = F.tid + 512 * s, rw = p >> 6, cp = p & 63; const float rs = RSTD[rw];
                const u32x4 v = *(const LAS u32x4*)(Y + rw * YT_STRIDE + 8 * cp); const f32x4 g0 = *(const f32x4*)(F.lru_gain + 8 * cp), g1 = *(const f32x4*)(F.lru_gain + 8 * cp + 4);
                u32x4 o; o.x = pk2(bflo(v.x) * rs * g0.x, bfhi(v.x) * rs * g0.y); o.y = pk2(bflo(v.y) * rs * g0.z, bfhi(v.y) * rs * g0.w);
                o.z = pk2(bflo(v.z) * rs * g1.x, bfhi(v.z) * rs * g1.y); o.w = pk2(bflo(v.w) * rs * g1.z, bfhi(v.w) * rs * g1.w);
                *(u32x4*)(F.YMIX + (size_t)(m0 + 64 * half + rw) * D + 8 * cp) = o; }
            __syncthreads();
        }
        }
#endif
#ifndef P3_NO_POOL
        {
            bf16x8 zf[4][4];
            const int T0 = b * TT + NMETA + 128 * ci - 15;
#pragma unroll
            for (int gp = 0; gp < 2; ++gp) {
                for (int i = F.tid; i < 143 * 32; i += 512) { const int ri = i >> 5, cpc = i & 31;
                    *(LAS u32x4*)(US + ri * US_STRIDE + 8 * cpc) = *(const u32x4*)(F.PROJ + (size_t)(T0 + ri) * INW + 1024 + 256 * gp + 8 * cpc); }
                __syncthreads();
                const LAS bf16* urow = US + (16 * F.wave + row) * US_STRIDE + 8 * q;
                if (gp == 0) { pool_z<0>(urow, zf[0]); pool_z<1>(urow + 128, zf[1]); } else { pool_z<2>(urow, zf[2]); pool_z<3>(urow + 128, zf[3]); }
                __syncthreads();
            }
            for (int i = F.tid; i < 4 * 128 * 16; i += 512) { const int n = i >> 4, pc = i & 15; *(LAS u32x4*)(US + n * PW_STRIDE + 8 * pc) = *(const u32x4*)(F.PwT + (size_t)n * 128 + 8 * pc); }
            __syncthreads();
            const LAS bf16* wl = US + row * PW_STRIDE + 8 * q;
            float ssq = 0.f;
#pragma unroll
            for (int g = 0; g < 4; ++g) { const LAS bf16* wg = wl + g * 128 * PW_STRIDE; asm volatile("" : "+v"(wg));
#pragma unroll 2
                for (int nb = 0; nb < 8; ++nb) { f32x4 acc = (f32x4){0.f, 0.f, 0.f, 0.f}; const LAS bf16* wn = wg + 16 * nb * PW_STRIDE;
#pragma unroll
                    for (int kb = 0; kb < 4; ++kb) acc = __builtin_amdgcn_mfma_f32_16x16x32_bf16(*(const LAS bf16x8*)(wn + 32 * kb), zf[g][kb], acc, 0, 0, 0);
                    ssq += (acc[0] * acc[0] + acc[1] * acc[1]) + (acc[2] * acc[2] + acc[3] * acc[3]); } }
            ssq += __shfl_xor(ssq, 16); ssq += __shfl_xor(ssq, 32);
            const float rs = rsqrtf(ssq * (1.0f / 512.0f) + RMS_EPS);
            bf16* orow = F.YMIX + (size_t)(m0 + 16 * F.wave + row) * D + LW + 4 * q;
#pragma unroll
            for (int g = 0; g < 4; ++g) { const LAS bf16* wg = wl + g * 128 * PW_STRIDE; asm volatile("" : "+v"(wg));
#pragma unroll 2
                for (int nb = 0; nb < 8; ++nb) { f32x4 acc = (f32x4){0.f, 0.f, 0.f, 0.f}; const LAS bf16* wn = wg + 16 * nb * PW_STRIDE;
#pragma unroll
                    for (int kb = 0; kb < 4; ++kb) acc = __builtin_amdgcn_mfma_f32_16x16x32_bf16(*(const LAS bf16x8*)(wn + 32 * kb), zf[g][kb], acc, 0, 0, 0);
                    const f32x4 sc = *(const f32x4*)(F.pool_scale + 128 * g + 16 * nb + 4 * q);
                    u32x2 o; o.x = pk2(acc[0] * rs * sc.x, acc[1] * rs * sc.y); o.y = pk2(acc[2] * rs * sc.z, acc[3] * rs * sc.w);
                    *(u32x2*)(orow + 128 * g + 16 * nb) = o; } }
        }
#endif
        __syncthreads();
    }
}

constexpr int WR_STRIDE = 1032;
__device__ __forceinline__ void p5_route(Frame& F, const bool dry = false) {
    LAS _Float16* WR = (LAS _Float16*)F.lds;
    LAS float* LG = (LAS float*)(F.lds + 36 * WR_STRIDE * 2) + F.wave * 16 * 40;
    LAS int* LCNT = (LAS int*)(F.lds + 36 * WR_STRIDE * 2 + 8 * 16 * 40 * 4);
    LAS float* G2 = (LAS float*)(LCNT + 64);
    const int c16 = F.lane & 15, q = F.lane >> 4;
    for (int i = F.tid; i < NROUTE * 128; i += 512) { const int n = i >> 7, k8 = i & 127; *(LAS u32x4*)(WR + n * WR_STRIDE + 8 * k8) = *(const u32x4*)(F.WrH + n * D + 8 * k8); }
    for (int i = F.tid; i < D; i += 512) G2[i] = F.g2[i];
    for (int ch = F.bx; ch < 256; ch += F.G) {
        if (F.tid < 64) LCNT[F.tid] = 0;
        __syncthreads();
        const int row = ch * 128 + 16 * F.wave + c16;
        const bf16* hrow = F.H1 + (size_t)row * D + 8 * q;
        f32x4 acc[3]; float ss = 0.f;
#pragma unroll
        for (int nb = 0; nb < 3; ++nb) acc[nb] = (f32x4){0.f, 0.f, 0.f, 0.f};
#pragma unroll 4
        for (int i = 0; i < 32; ++i) {
            const u32x4 hw = *(const u32x4*)(hrow + 32 * i);
            const f32x4 h0 = (f32x4){bflo(hw.x), bfhi(hw.x), bflo(hw.y), bfhi(hw.y)}, h1 = (f32x4){bflo(hw.z), bfhi(hw.z), bflo(hw.w), bfhi(hw.w)};
            const f32x4 g0 = *(const LAS f32x4*)(G2 + 32 * i + 8 * q), g1 = *(const LAS f32x4*)(G2 + 32 * i + 8 * q + 4);
            ss += (h0.x * h0.x + h0.y * h0.y) + (h0.z * h0.z + h0.w * h0.w) + (h1.x * h1.x + h1.y * h1.y) + (h1.z * h1.z + h1.w * h1.w);
            const f32x4 t0 = h0 * g0, t1 = h1 * g1;
            f16x8 a; a[0] = (_Float16)t0.x; a[1] = (_Float16)t0.y; a[2] = (_Float16)t0.z; a[3] = (_Float16)t0.w; a[4] = (_Float16)t1.x; a[5] = (_Float16)t1.y; a[6] = (_Float16)t1.z; a[7] = (_Float16)t1.w;
#pragma unroll
            for (int nb = 0; nb < 3; ++nb) { const int col = 16 * nb + c16; f16x8 bw;
#pragma unroll
                for (int j = 0; j < 8; ++j) bw[j] = (_Float16)0.f;
                if (col < NROUTE) bw = *(const LAS f16x8*)(WR + col * WR_STRIDE + 32 * i + 8 * q);
                acc[nb] = __builtin_amdgcn_mfma_f32_16x16x32_f16(a, bw, acc[nb], 0, 0, 0); }
        }
        ss += __shfl_xor(ss, 16); ss += __shfl_xor(ss, 32);
        const float rstd = rsqrtf(ss * (1.0f / D) + RMS_EPS);
#pragma unroll
        for (int nb = 0; nb < 3; ++nb)
#pragma unroll
            for (int j = 0; j < 4; ++j) { const int col = 16 * nb + c16; if (col < 40) LG[(4 * q + j) * 40 + col] = acc[nb][j]; }
        LDS_WAIT();
        int e0 = 0, e1 = 0, rk0 = 0, rk1 = 0; float gt0 = 0.f, gt1 = 0.f;
        if (F.lane < 16) {
            const LAS float* lg = LG + F.lane * 40; const float sc = rstd * (1.0f / 256.0f);
            float gl[4]; int gi = 0;
#pragma unroll
            for (int j = 0; j < 4; ++j) gl[j] = lg[j] * sc + F.b_group[j];
            float gm = gl[0];
#pragma unroll
            for (int j = 1; j < 4; ++j) if (gl[j] > gm) { gm = gl[j]; gi = j; }
            float den = 0.f;
#pragma unroll
            for (int j = 0; j < 4; ++j) den += __expf(gl[j] - gm);
            const float pg = 1.0f / den;
            float v0 = -3.0e38f, v1 = -3.0e38f; int i0 = 0, i1 = 0;
            for (int j = 0; j < 8; ++j) { const float v = lg[4 + gi * 8 + j] * sc + F.b_router[gi * 8 + j];
                if (v > v0) { v1 = v0; i1 = i0; v0 = v; i0 = j; } else if (v > v1) { v1 = v; i1 = j; } }
            const float ex = __expf(v1 - v0), s0 = 1.0f / (1.0f + ex);
            gt0 = pg * s0; gt1 = pg * (ex * s0); e0 = gi * 8 + i0; e1 = gi * 8 + i1;
            rk0 = __hip_atomic_fetch_add(&LCNT[e0], 1, __ATOMIC_RELAXED, __HIP_MEMORY_SCOPE_WORKGROUP); rk1 = __hip_atomic_fetch_add(&LCNT[e1], 1, __ATOMIC_RELAXED, __HIP_MEMORY_SCOPE_WORKGROUP);
        }
        __syncthreads();
        if (F.tid < 32 && !dry) LCNT[32 + F.tid] = (int)__hip_atomic_fetch_add(F.ctl + CW_CNT + 64 * F.tid, (unsigned)LCNT[F.tid], __ATOMIC_RELAXED, __HIP_MEMORY_SCOPE_AGENT);
        __syncthreads();
        if (F.lane < 16 && !dry) { const int tok = ch * 128 + 16 * F.wave + F.lane;
            F.RINFO[(size_t)e0 * ECAP + LCNT[32 + e0] + rk0] = (f32x4){__builtin_bit_cast(float, tok * 2), gt0, rstd, 0.f};
            F.RINFO[(size_t)e1 * ECAP + LCNT[32 + e1] + rk1] = (f32x4){__builtin_bit_cast(float, tok * 2 + 1), gt1, rstd, 0.f}; }
        __syncthreads();
    }
}

__device__ __forceinline__ int moe_tables(Frame& F) {
    LAS int* TE = (LAS int*)(F.lds + TAB_TE); LAS int* TR = (LAS int*)(F.lds + TAB_TR); LAS int* CNT = (LAS int*)(F.lds + TAB_CNT); LAS int* PRE = CNT + 32;
    if (F.tid < 32) CNT[F.tid] = (int)__hip_atomic_load(F.ctl + CW_CNT + 64 * F.tid, __ATOMIC_RELAXED, __HIP_MEMORY_SCOPE_AGENT);
    __syncthreads();
    if (F.tid == 0) { int s = 0; for (int e = 0; e < NE; ++e) { PRE[e] = s; s += (CNT[e] + 255) >> 8; } PRE[NE] = s; }
    __syncthreads();
    const int NT = PRE[NE];
    for (int t = F.tid; t < NT; t += 512) { int e = 0; while (e < NE - 1 && PRE[e + 1] <= t) ++e; TE[t] = e; TR[t] = (t - PRE[e]) * 256; }
    __syncthreads();
    return NT;
}
__device__ __forceinline__ void moe_unit_tables(Frame& F, const pg8::MoeSched& S, int mode) {
    LAS int* TE = (LAS int*)(F.lds + TAB_TE); LAS int* TR = (LAS int*)(F.lds + TAB_TR); LAS int* CNT = (LAS int*)(F.lds + TAB_CNT);
    LAS unsigned* ROW = (LAS unsigned*)(F.lds + TAB_ROW); LAS float* FT = (LAS float*)(F.lds + TAB_F);
    pg8::Unit u;
    for (int i = 0; i < MAXU && i < S.rounds() && S.next(i, u); ++i) {
        if (F.tid < 256) { const int e = TE[u.pm], pos = TR[u.pm] + F.tid; const bool valid = pos < CNT[e];
            f32x4 ri = (f32x4){0.f, 0.f, 0.f, 0.f}; if (valid) ri = F.RINFO[(size_t)e * ECAP + pos];
            const int slot = __builtin_bit_cast(int, ri.x);
            if (mode == 0) { ROW[i * 256 + F.tid] = valid ? (unsigned)(slot >> 1) * (unsigned)D : 0u; FT[i * 256 + F.tid] = valid ? ri.z * (1.0f / WGU_SCALE) : 0.f; }
            else { ROW[i * 256 + F.tid] = valid ? (unsigned)slot : 0xffffffffu; FT[i * 256 + F.tid] = ri.y * (1.0f / (WD_SCALE * HID_SCALE)); } }
    }
    __syncthreads();
}

__device__ __forceinline__ void p8_final(Frame& F) {
    const int gw = F.bx * 8 + F.wave, NGW = F.G * 8;
    for (int m = gw; m < M; m += NGW) {
        f32x4* hr = (f32x4*)(F.out + (size_t)m * D) + F.lane; const u32x2* h1 = (const u32x2*)(F.H1 + (size_t)m * D) + F.lane; const u32x2* c0 = (const u32x2*)(F.C + (size_t)(2 * m) * D) + F.lane; const u32x2* c1 = (const u32x2*)(F.C + (size_t)(2 * m + 1) * D) + F.lane;
        f32x4 v[4]; float s = 0.f;
#pragma unroll
        for (int j = 0; j < 4; ++j) { const u32x2 hb = h1[64 * j]; const f32x4 h = (f32x4){bflo(hb.x), bfhi(hb.x), bflo(hb.y), bfhi(hb.y)}; const u32x2 a = c0[64 * j], b = c1[64 * j];
            v[j] = (f32x4){h.x + (bflo(a.x) + bflo(b.x)), h.y + (bfhi(a.x) + bfhi(b.x)), h.z + (bflo(a.y) + bflo(b.y)), h.w + (bfhi(a.y) + bfhi(b.y))};
            s += (v[j].x * v[j].x + v[j].y * v[j].y) + (v[j].z * v[j].z + v[j].w * v[j].w); }
        const float rstd = rsqrtf(wave_sum(s) * (1.f / D) + RMS_EPS);
#pragma unroll
        for (int j = 0; j < 4; ++j) { const f32x4 g = ((const f32x4*)F.final_gain)[F.lane + 64 * j]; hr[64 * j] = v[j] * rstd * g; }
    }
}

struct Args { const float* in[24]; float* out; unsigned char* ws; int ph_lo, ph_hi; };
__global__ void __launch_bounds__(512, 2) hymba_fwd(Args args) {
    extern __shared__ __attribute__((aligned(16))) unsigned char lds[];
    Frame F;
    F.lds = (LAS unsigned char*)lds; F.tid = threadIdx.x; F.lane = F.tid & 63; F.wave = __builtin_amdgcn_readfirstlane(F.tid >> 6); F.G = gridDim.x; F.bx = blockIdx.x;
    F.x = args.in[0]; F.meta = args.in[1]; F.g1 = args.in[2]; F.w_in = args.in[3]; F.conv_w = args.in[4]; F.conv_b = args.in[5]; F.wa = args.in[6]; F.ba = args.in[7]; F.wx = args.in[8]; F.bx_ = args.in[9];
    F.lam = args.in[10]; F.lru_gain = args.in[11]; F.pool_w = args.in[12]; F.pool_scale = args.in[13]; F.w_out = args.in[14]; F.g2 = args.in[15]; F.w_group = args.in[16]; F.b_group = args.in[17];
    F.w_router = args.in[18]; F.b_router = args.in[19]; F.w_gate = args.in[20]; F.w_up = args.in[21]; F.w_down = args.in[22]; F.final_gain = args.in[23];
    F.out = args.out; F.ws = args.ws; F.ctl = (unsigned*)(args.ws + WS_CTL);
    unsigned char* ws = args.ws;
    F.WinT = (bf16*)(ws + WS_WIN); F.WoutT = (bf16*)(ws + WS_WOUT); F.WaT = (bf16*)(ws + WS_WA); F.WxT = (bf16*)(ws + WS_WX); F.PwT = (bf16*)(ws + WS_PW); F.WrH = (_Float16*)(ws + WS_WR);
    F.AGG = (float*)(ws + WS_AGG); F.WguT = ws + WS_WGU; F.WdT = ws + WS_WD; F.RINFO = (f32x4*)(ws + WS_RINFO); F.HN1 = (bf16*)(ws + WS_HN1); F.YMIX = (bf16*)(ws + WS_HN1);
    F.PROJ = (bf16*)(ws + WS_PROJ); F.HN2 = ws + WS_PROJ; F.HID = ws + WS_HID; F.C = (bf16*)(ws + WS_C); F.H1 = (bf16*)(ws + WS_H1);
    volatile LAS unsigned* MISC = (volatile LAS unsigned*)(F.lds + MISC_OFF);
    if (F.tid < 64) MISC[F.tid] = 0u;
    __syncthreads();
    XcdBarrier bar; bar.bar = F.ctl + CW_BAR; bar.x = 0; bar.st = nullptr;
    if (MK_N_LAUNCHES == 1) bar = xcd_barrier_post(F.ctl + CW_BAR, MISC + 8);
    const int lo = args.ph_lo, hi = args.ph_hi;
#ifndef PH_MASK
#define PH_MASK 0x1ff
#endif
#define IN(k) (((PH_MASK >> (k)) & 1) && lo <= (k) && (k) < hi)
#define SEAM(k) do { if (IN(k) && IN((k) + 1)) xcd_barrier(bar); } while (0)
#define REP(k) for (int rep_ = 0; rep_ <= ((REPEAT_MASK >> (k)) & 1); ++rep_)

    if (IN(0)) REP(0) { p0_prologue(F); } SEAM(0);
    if (IN(1)) { pg8::DenseSched S{M / 256, INW / 256, F.G, F.bx, D * 2, (const char*)F.WinT, 1 + ((REPEAT_MASK >> 1) & 1)}; pg8::EpiProj E{F.PROJ};
        pg8::gemm_phase(F.lds, D * 2, (const char*)F.HN1, S, E); } SEAM(1);
    if (IN(2)) REP(2) { p2_aggregates(F); } SEAM(2);
    if (IN(3)) REP(3) { p3_mixer(F); } SEAM(3);
    if (IN(4)) { pg8::DenseSched S{M / 256, D / 256, F.G, F.bx, D * 2, (const char*)F.WoutT, 1 + ((REPEAT_MASK >> 4) & 1)}; pg8::EpiResid E{F.x, F.g2, F.H1, F.HN2};
        pg8::gemm_phase(F.lds, D * 2, (const char*)F.YMIX, S, E); } SEAM(4);
    if (IN(5)) { if ((REPEAT_MASK >> 5) & 1) p5_route(F, true); p5_route(F); } SEAM(5);
    if (IN(6)) { const int NT = moe_tables(F);
        pg8::MoeSched S{NT, 4, F.G, F.bx, D, (const char*)F.WguT, (size_t)1024 * D, true, (const LAS int*)(F.lds + TAB_TE), (const LAS unsigned*)(F.lds + TAB_ROW), 1 + ((REPEAT_MASK >> 6) & 1)};
        moe_unit_tables(F, S, 0);
        pg8::EpiGateUp E{F.HID, (const LAS float*)(F.lds + TAB_F), S.rounds()};
        pg8::gemm_phase<pg8::EpiGateUp, pg8::MoeSched, true>(F.lds, D, (const char*)F.HN2, S, E); } SEAM(6);
    if (IN(7)) { const int NT = moe_tables(F);
        pg8::MoeSched S{NT, 4, F.G, F.bx, EFF, (const char*)F.WdT, (size_t)D * EFF, false, (const LAS int*)(F.lds + TAB_TE), (const LAS unsigned*)(F.lds + TAB_ROW), 1 + ((REPEAT_MASK >> 7) & 1)};
        moe_unit_tables(F, S, 1);
        pg8::EpiDown E{F.C, (const LAS int*)(F.lds + TAB_ROW), (const LAS float*)(F.lds + TAB_F), S.rounds()};
        pg8::gemm_phase<pg8::EpiDown, pg8::MoeSched, true>(F.lds, EFF, (const char*)F.HID, S, E); } SEAM(7);
    if (IN(8)) { p8_final(F); }
#undef IN
#undef SEAM
}

extern "C" void kernel_launch(void* const* d_in, const int* in_sizes, int n_in, void* d_out, int out_size, void* d_ws, size_t ws_size, hipStream_t stream) {
    static int grid = 0;
    if (grid == 0) {
        if (n_in != 24 || in_sizes[0] != M * D || out_size != M * D || ws_size < WS_END) { fprintf(stderr, "kernel_launch: unexpected shapes (n_in %d, in0 %d, out %d, ws %zu)\n", n_in, n_in > 0 ? in_sizes[0] : -1, out_size, ws_size); grid = -1; return; }
        int dev = 0, cus = 0, per_cu = 0;
        if (hipGetDevice(&dev) != hipSuccess || hipDeviceGetAttribute(&cus, hipDeviceAttributeMultiprocessorCount, dev) != hipSuccess) { grid = -1; return; }
        if (hipFuncSetAttribute((const void*)hymba_fwd, hipFuncAttributeMaxDynamicSharedMemorySize, LDS_BYTES) != hipSuccess) { fprintf(stderr, "kernel_launch: hipFuncSetAttribute failed\n"); grid = -1; return; }
        if (hipOccupancyMaxActiveBlocksPerMultiprocessor(&per_cu, (const void*)hymba_fwd, 512, LDS_BYTES) != hipSuccess || per_cu < 1) fprintf(stderr, "kernel_launch: occupancy query says %d\n", per_cu);
        (void)hipGetLastError();
        grid = cus;
    }
    if (grid < 0) return;
    if (hipMemsetAsync((char*)d_ws + WS_CTL, 0, CTL_ZERO_BYTES, stream) != hipSuccess) return;
    Args a{};
    for (int i = 0; i < 24; ++i) a.in[i] = (const float*)d_in[i];
    a.out = (float*)d_out; a.ws = (unsigned char*)d_ws;
    if (MK_N_LAUNCHES == 1) { a.ph_lo = 0; a.ph_hi = N_PHASES; hipLaunchKernelGGL(hymba_fwd, dim3(grid), dim3(512), LDS_BYTES, stream, a); }
    else for (int p = 0; p < N_PHASES; ++p) { a.ph_lo = p; a.ph_hi = p + 1; hipLaunchKernelGGL(hymba_fwd, dim3(grid), dim3(512), LDS_BYTES, stream, a); }
}
```

```cpp
#include <hip/hip_runtime.h>
#include <cstdio>
#include <cstdint>

#define GAS __attribute__((address_space(1)))
#define LAS __attribute__((address_space(3)))
typedef unsigned short bf16;
typedef short bf16x8 __attribute__((ext_vector_type(8)));
typedef _Float16 f16x8 __attribute__((ext_vector_type(8)));
typedef float f32x4 __attribute__((ext_vector_type(4)));
typedef float f32x2 __attribute__((ext_vector_type(2)));
typedef unsigned u32x4 __attribute__((ext_vector_type(4)));
typedef unsigned u32x2 __attribute__((ext_vector_type(2)));

#ifndef MK_N_LAUNCHES
#define MK_N_LAUNCHES 1
#endif
constexpr int N_PHASES = 9;
#ifndef REPEAT_MASK
#define REPEAT_MASK 0
#endif

constexpr int D = 1024, NBATCH = 8, SEQ = 4096, NMETA = 16, TT = SEQ + NMETA, M = NBATCH * SEQ;
constexpr int LW = 512, INW = 1536, NE = 32, EFF = 512, NROUTE = 36;
constexpr int ECAP = 32768;
constexpr int MAXT = 288;
constexpr int MAXU = 6;
constexpr float RMS_EPS = 1e-6f;

constexpr size_t MiB = 1u << 20;
constexpr size_t WS_CTL = 0, CTL_ZERO_BYTES = 1 * MiB;
constexpr size_t WS_WIN = 2 * MiB, WS_WOUT = 5 * MiB, WS_WA = 7 * MiB, WS_WX = 7 * MiB + 65536, WS_PW = 7 * MiB + 131072, WS_WR = 7 * MiB + 262144;
constexpr size_t WS_AGG = 8 * MiB;
constexpr size_t WS_WGU = 10 * MiB  , WS_WD = 42 * MiB  , WS_RINFO = 58 * MiB, WS_HN1 = 74 * MiB  ;
constexpr size_t WS_PROJ = 138 * MiB  , WS_HID = 235 * MiB  , WS_C = 272 * MiB  , WS_H1 = 400 * MiB  , WS_END = 464 * MiB;
constexpr float WGU_SCALE = 64.f, WD_SCALE = 32.f, HID_SCALE = 8.f, C_SCALE = 32.f;
constexpr int CW_BAR = 4096, CW_CNT = 16384;

constexpr int LDS_BYTES = 147456;
constexpr int MISC_OFF = LDS_BYTES - 256;
constexpr int TAB_OFF = 131072 + 512;
constexpr int TAB_ROW = TAB_OFF;
constexpr int TAB_F = TAB_ROW + MAXU * 256 * 4;
constexpr int TAB_TE = TAB_F + MAXU * 256 * 4;
constexpr int TAB_TR = TAB_TE + MAXT * 4;
constexpr int TAB_CNT = TAB_TR + MAXT * 4;
static_assert(TAB_CNT + 80 * 4 <= MISC_OFF, "LDS map");

__device__ __forceinline__ unsigned f2bf(float f) { unsigned u = __builtin_bit_cast(unsigned, f); return (u + 0x7fffu + ((u >> 16) & 1u)) >> 16; }
__device__ __forceinline__ unsigned pk2(float lo, float hi) { unsigned r; asm("v_cvt_pk_bf16_f32 %0, %1, %2" : "=v"(r) : "v"(lo), "v"(hi)); return r; }
__device__ __forceinline__ float bf2f(unsigned h) { return __builtin_bit_cast(float, h << 16); }
__device__ __forceinline__ float bflo(unsigned w) { return __builtin_bit_cast(float, w << 16); }
__device__ __forceinline__ float bfhi(unsigned w) { return __builtin_bit_cast(float, w & 0xffff0000u); }
__device__ __forceinline__ float sigmoidf_(float x) { return __builtin_amdgcn_rcpf(1.0f + __expf(-x)); }
#define LDS_WAIT() asm volatile("s_waitcnt lgkmcnt(0)" ::: "memory")
typedef int i32x4 __attribute__((ext_vector_type(4)));
typedef int i32x8 __attribute__((ext_vector_type(8)));
__device__ __forceinline__ float clamp448(float v) { return fminf(fmaxf(v, -448.f), 448.f); }
__device__ __forceinline__ unsigned pk4_fp8(float a, float b, float c, float d) {
    int v = __builtin_amdgcn_cvt_pk_fp8_f32(a, b, 0, false); v = __builtin_amdgcn_cvt_pk_fp8_f32(c, d, v, true); return (unsigned)v; }

#define XB_TMO      128
#define XB_XCNT(j)  (256  + 64 * (j))
#define XB_XSUB(j)  (1280 + 64 * (j))
#define XB_XGEN(j)  (2304 + 64 * (j))
#define XB_TOP      3328
#define XB_TOPGEN   3392
#define XCD_BAR_WORDS 3456
#define XB_SPIN_CAP (1u << 18)
__device__ __forceinline__ unsigned xb_ld(unsigned* p)              { return __hip_atomic_load(p, __ATOMIC_RELAXED, __HIP_MEMORY_SCOPE_AGENT); }
__device__ __forceinline__ unsigned xb_add(unsigned* p, unsigned v) { return __hip_atomic_fetch_add(p, v, __ATOMIC_RELAXED, __HIP_MEMORY_SCOPE_AGENT); }
__device__ __forceinline__ unsigned xb_xcc_id() { return (unsigned)__builtin_amdgcn_s_getreg((3 << 11) | 20) & 0xFu; }
#define XB_SPIN(cond, bar) do { unsigned _sp = 0; while (cond) { __builtin_amdgcn_s_sleep(1); \
    if ((++_sp & 255u) == 0u) { if (xb_ld(&(bar)[XB_TMO])) break; if (_sp > XB_SPIN_CAP) { atomicAdd(&(bar)[XB_TMO], 1u); break; } } } } while (0)
struct XcdBarrier { unsigned* bar; unsigned x; volatile LAS unsigned* st; };
__device__ __forceinline__ XcdBarrier xcd_barrier_post(unsigned* bar, volatile LAS unsigned* st) {
    XcdBarrier b; b.bar = bar; b.x = xb_xcc_id(); b.st = st;
    if (threadIdx.x == 0) (void)xb_add(&bar[XB_XCNT(b.x)], 1u);
    return b;
}
__device__ __forceinline__ void xcd_barrier_complete(unsigned* bar, unsigned x, unsigned& nloc, unsigned& nx) {
    const unsigned G = gridDim.x * gridDim.y * gridDim.z;
    unsigned sum, cnt, mine, sp = 0u;
    for (;;) {
        sum = 0u; cnt = 0u; mine = 0u;
#pragma unroll
        for (unsigned j = 0; j < 16; ++j) { const unsigned c = xb_ld(&bar[XB_XCNT(j)]); sum += c; cnt += (c > 0u) ? 1u : 0u; mine = (j == x) ? c : mine; }
        if (sum == G) break;
        __builtin_amdgcn_s_sleep(1);
        if ((++sp & 255u) == 0u) { if (xb_ld(&bar[XB_TMO])) break; if (sp > XB_SPIN_CAP) { atomicAdd(&bar[XB_TMO], 1u); break; } }
    }
    nloc = mine > 0u ? mine : 1u; nx = cnt > 0u ? cnt : 1u;
}
__device__ __forceinline__ void xcd_barrier(const XcdBarrier& b) {
    asm volatile("s_waitcnt vmcnt(0)" ::: "memory");
    __syncthreads();
    if (threadIdx.x == 0) {
        unsigned* bar = b.bar;
        __builtin_amdgcn_s_waitcnt(0);
        unsigned nloc = b.st[0], nx = b.st[1];
        if (nloc == 0u) { xcd_barrier_complete(bar, b.x, nloc, nx); b.st[0] = nloc; b.st[1] = nx; }
        const unsigned old = xb_add(&bar[XB_XSUB(b.x)], 1u);
        const unsigned gen = old / nloc;
        if (old + 1u == (gen + 1u) * nloc) {
            __builtin_amdgcn_fence(__ATOMIC_RELEASE, "agent");
            asm volatile("s_waitcnt vmcnt(0)" ::: "memory");
            const unsigned og = xb_add(&bar[XB_TOP], 1u);
            const unsigned tg = og / nx;
            if (og + 1u == (tg + 1u) * nx) xb_add(&bar[XB_TOPGEN], 1u);
            else XB_SPIN(xb_ld(&bar[XB_TOPGEN]) == tg, bar);
            __builtin_amdgcn_fence(__ATOMIC_ACQUIRE, "agent");
            xb_add(&bar[XB_XGEN(b.x)], 1u);
            asm volatile("s_waitcnt vmcnt(0)" ::: "memory");
        } else {
            XB_SPIN(xb_ld(&bar[XB_XGEN(b.x)]) == gen, bar);
            __builtin_amdgcn_fence(__ATOMIC_ACQUIRE, "agent");
            asm volatile("s_waitcnt vmcnt(0)" ::: "memory");
        }
    }
    __syncthreads();
}

namespace pg8 {
constexpr int BM = 256, BK = 64, HALF = 128, HTB = HALF * BK * 2, STAGE_BYTES = 8 * HTB, NXCD = 8, WGM = 8;
__host__ __device__ __forceinline__ int lds_byte(int r, int c) { const int st = (r >> 4) * 2 + (c >> 5), rr = r & 15, cc = c & 31, ob = rr * 64 + cc * 2; return st * 1024 + (ob ^ (((ob >> 9) & 1) << 5)); }
__host__ __device__ __forceinline__ void stage_rc(int b, int& R, int& C) { const int st = b / 1024, sb = b % 1024, swz = sb ^ (((sb >> 9) & 1) << 5); R = (st >> 1) * 16 + swz / 64; C = (st & 1) * 32 + (swz % 64) / 2; }
__host__ __device__ __forceinline__ int perm32(int rho) { const int n = rho >> 4, i = rho & 15; return 8 * (i >> 2) + 4 * n + (i & 3); }
struct Unit { int pm, pn; };
__device__ __forceinline__ bool static_next(int nM, int nN, int G, int c, int i, Unit& u) {
    const int nwg = nM * nN; const long L = (long)i * G + c; if (L >= nwg) return false;
    int wgid = (int)L; { const int q = nwg / NXCD, r = nwg % NXCD, xcd = wgid % NXCD, off = wgid / NXCD; wgid = (xcd < r ? xcd * (q + 1) : r * (q + 1) + (xcd - r) * q) + off; }
    const int nig = WGM * nN, gid = wgid / nig, fm = gid * WGM, gsz = (nM - fm) < WGM ? (nM - fm) : WGM;
    u.pm = fm + ((wgid % nig) % gsz); u.pn = (wgid % nig) / gsz; return true;
}
__device__ __forceinline__ unsigned cvt_pk_bf16(float lo, float hi) { unsigned r; asm volatile("v_cvt_pk_bf16_f32 %0, %1, %2" : "=v"(r) : "v"(lo), "v"(hi)); return r; }

template <class Epi, class Sched, bool FP8 = false>
__device__ __forceinline__ void gemm_phase(LAS unsigned char* lds, const int KB, const char* Abase, const Sched& S, const Epi& E) {
    const int tid = threadIdx.x, wid = __builtin_amdgcn_readfirstlane(tid >> 6), lane = tid & 63, wr = wid >> 2, wc = wid & 3, fr = lane & 15, fq = lane >> 4;
    const int nt = KB / (BK * 2);
    int Rl[2]; unsigned Cb[2], voffB[2];
#pragma unroll
    for (int i = 0; i < 2; ++i) { int R, C; stage_rc(tid * 16 + i * 8192, R, C); const int Rb = Epi::PERM ? ((R & ~31) + perm32(R & 31)) : R;
        Rl[i] = R; Cb[i] = (unsigned)C * 2u; voffB[i] = (unsigned)(Rb * KB + C * 2); }
    const size_t kstep = (size_t)(BK * 2);
    const size_t hstepB = (size_t)HALF * KB;
    const unsigned ldsw = (unsigned)wid * 1024u;
    const int aoff = lds_byte(wr * 64 + fr, fq * 8), boff = lds_byte(wc * 32 + fr, fq * 8);
#define PG8_SA(b, h) (((b) * 2 + (h)) * HTB)
#define PG8_SB(b, h) ((4 + (b) * 2 + (h)) * HTB)
#define PG8_STAGE(bufoff, gbase, voff) do { _Pragma("unroll") for (int _i = 0; _i < 2; ++_i) \
        __builtin_amdgcn_global_load_lds((const unsigned*)((const char*)(gbase) + (voff)[_i]), (LAS unsigned*)(lds + (bufoff) + ldsw + _i * 8192), 16, 0, 0); } while (0)
#define PG8_LD32(p) __builtin_shufflevector(*(const LAS i32x4*)(p), *(const LAS i32x4*)((p) + 1024), 0, 1, 2, 3, 4, 5, 6, 7)
#define PG8_LDA(dst, b, h) do { _Pragma("unroll") for (int m = 0; m < 4; ++m) dst[m] = PG8_LD32(lds + PG8_SA(b, h) + aoff + m * 2048); } while (0)
#define PG8_LDB(dst, b, h) do { _Pragma("unroll") for (int n = 0; n < 2; ++n) dst[n] = PG8_LD32(lds + PG8_SB(b, h) + boff + n * 2048); } while (0)
#define PG8_LO(v) __builtin_bit_cast(bf16x8, __builtin_shufflevector((v), (v), 0, 1, 2, 3))
#define PG8_HI(v) __builtin_bit_cast(bf16x8, __builtin_shufflevector((v), (v), 4, 5, 6, 7))
#define PG8_MMA(ai, bj, At, Bt) do { __builtin_amdgcn_s_setprio(1); _Pragma("unroll") for (int m = 0; m < 4; ++m) _Pragma("unroll") for (int n = 0; n < 2; ++n) { \
        if constexpr (FP8) asm volatile("v_mfma_f32_16x16x128_f8f6f4 %0, %1, %2, %0" : "+v"(acc[ai][bj][m][n]) : "v"(Bt[n]), "v"(At[m])); \
        else { acc[ai][bj][m][n] = __builtin_amdgcn_mfma_f32_16x16x32_bf16(PG8_LO(Bt[n]), PG8_LO(At[m]), acc[ai][bj][m][n], 0, 0, 0); \
               acc[ai][bj][m][n] = __builtin_amdgcn_mfma_f32_16x16x32_bf16(PG8_HI(Bt[n]), PG8_HI(At[m]), acc[ai][bj][m][n], 0, 0, 0); } } \
        __builtin_amdgcn_s_setprio(0); } while (0)
#define PG8_WAIT_V(n) asm volatile("s_waitcnt vmcnt(" #n ")" ::: "memory")
#define PG8_WAIT_L(n) asm volatile("s_waitcnt lgkmcnt(" #n ")" ::: "memory")
#define PG8_BAR __builtin_amdgcn_s_barrier()
#define PG8_SCHED __builtin_amdgcn_sched_barrier(0)
    Unit cur, nxt; int ui = 0;
    if (!S.next(0, cur)) return;
    f32x4 acc[2][2][4][2];
#pragma unroll
    for (int a = 0; a < 2; ++a)
#pragma unroll
        for (int b = 0; b < 2; ++b)
#pragma unroll
            for (int m = 0; m < 4; ++m)
#pragma unroll
                for (int n = 0; n < 2; ++n) acc[a][b][m][n] = (f32x4){0.f, 0.f, 0.f, 0.f};
    i32x8 At[4], B0[2], B1[2];
    unsigned cO0[2], cO1[2], nO0[2], nO1[2];
#pragma unroll
    for (int i = 0; i < 2; ++i) { cO0[i] = S.a_off(0, cur, Rl[i]) + Cb[i]; cO1[i] = S.a_off(0, cur, HALF + Rl[i]) + Cb[i]; }
    const char* cB = S.b_base(cur);
    PG8_STAGE(PG8_SB(0, 0), cB, voffB); PG8_STAGE(PG8_SB(0, 1), cB + hstepB, voffB); PG8_STAGE(PG8_SA(0, 0), Abase, cO0); PG8_STAGE(PG8_SA(0, 1), Abase, cO1);
    if (wr == 1) PG8_BAR;
    PG8_WAIT_V(2); PG8_BAR;
    PG8_STAGE(PG8_SB(1, 0), cB + kstep, voffB); PG8_STAGE(PG8_SA(1, 0), Abase + kstep, cO0); PG8_STAGE(PG8_SB(1, 1), cB + hstepB + kstep, voffB);
    PG8_WAIT_V(6); PG8_BAR;
    for (;;) {
        const bool has_next = S.next(ui + 1, nxt);
        const char* nB = cB;
#pragma unroll
        for (int i = 0; i < 2; ++i) { nO0[i] = cO0[i]; nO1[i] = cO1[i]; }
        if (has_next) { nB = S.b_base(nxt);
#pragma unroll
            for (int i = 0; i < 2; ++i) { nO0[i] = S.a_off(ui + 1, nxt, Rl[i]) + Cb[i]; nO1[i] = S.a_off(ui + 1, nxt, HALF + Rl[i]) + Cb[i]; } }
#pragma nounroll
        for (int t = 0; t < nt; t += 2) {
            const bool last = (t == nt - 2);
            const char* a1 = Abase + (size_t)(t + 1) * kstep;
            const char* a2 = last ? Abase : Abase + (size_t)(t + 2) * kstep; const char* b2 = last ? nB : cB + (size_t)(t + 2) * kstep;
            const char* a3 = a2 + kstep; const char* b3 = b2 + kstep;
            unsigned o0[2], o1[2];
#pragma unroll
            for (int i = 0; i < 2; ++i) { o0[i] = last ? nO0[i] : cO0[i]; o1[i] = last ? nO1[i] : cO1[i]; }
            PG8_LDB(B0, 0, 0); PG8_LDB(B1, 0, 1); PG8_SCHED; PG8_LDA(At, 0, 0); PG8_STAGE(PG8_SA(1, 1), a1, cO1);
            PG8_WAIT_V(8); PG8_WAIT_L(0); PG8_BAR; PG8_MMA(0, 0, At, B0); PG8_MMA(0, 1, At, B1); PG8_BAR; PG8_SCHED;
            PG8_LDA(At, 0, 1); PG8_STAGE(PG8_SB(0, 0), b2, voffB); PG8_STAGE(PG8_SB(0, 1), b2 + hstepB, voffB); PG8_STAGE(PG8_SA(0, 0), a2, o0);
            PG8_WAIT_V(8); PG8_WAIT_L(0); PG8_BAR; PG8_MMA(1, 0, At, B0); PG8_MMA(1, 1, At, B1); PG8_BAR; PG8_SCHED;
            PG8_LDB(B0, 1, 0); PG8_LDB(B1, 1, 1); PG8_SCHED; PG8_LDA(At, 1, 0); PG8_STAGE(PG8_SA(0, 1), a2, o1);
            PG8_WAIT_V(8); PG8_WAIT_L(0); PG8_BAR; PG8_MMA(0, 0, At, B0); PG8_MMA(0, 1, At, B1); PG8_BAR; PG8_SCHED;
            PG8_LDA(At, 1, 1); PG8_STAGE(PG8_SB(1, 0), b3, voffB); PG8_STAGE(PG8_SB(1, 1), b3 + hstepB, voffB); PG8_STAGE(PG8_SA(1, 0), a3, o0);
            PG8_WAIT_V(8); PG8_WAIT_L(0); PG8_BAR; PG8_MMA(1, 0, At, B0); PG8_MMA(1, 1, At, B1); PG8_BAR; PG8_SCHED;
        }
        if (wr == 0) PG8_BAR;
        if constexpr (FP8) asm volatile("s_nop 15\n\ts_nop 15" ::: "memory");
        E(acc, cur, ui, wr, wc, fr, fq);
        if (!has_next) break;
#pragma unroll
        for (int a = 0; a < 2; ++a)
#pragma unroll
            for (int b = 0; b < 2; ++b)
#pragma unroll
                for (int m = 0; m < 4; ++m)
#pragma unroll
                    for (int n = 0; n < 2; ++n) acc[a][b][m][n] = (f32x4){0.f, 0.f, 0.f, 0.f};
        cur = nxt; cB = nB; ++ui;
#pragma unroll
        for (int i = 0; i < 2; ++i) { cO0[i] = nO0[i]; cO1[i] = nO1[i]; }
        if (wr == 1) PG8_BAR;
    }
    PG8_WAIT_V(0);
    PG8_BAR;
#undef PG8_SA
#undef PG8_SB
#undef PG8_STAGE
#undef PG8_LDA
#undef PG8_LDB
#undef PG8_MMA
#undef PG8_LO
#undef PG8_HI
#undef PG8_LD32
#undef PG8_WAIT_V
#undef PG8_WAIT_L
#undef PG8_BAR
#undef PG8_SCHED
}

struct DenseSched {
    int nM, nN, G, c, K2; const char* B; int reps;
    __device__ __forceinline__ bool next(int i, Unit& u) const { const int rounds = (nM * nN + G - 1) / G; if (i >= rounds * reps) return false; return static_next(nM, nN, G, c, i % rounds, u); }
    __device__ __forceinline__ const char* b_base(const Unit& u) const { return B + (size_t)u.pn * BM * K2; }
    __device__ __forceinline__ unsigned a_off(int, const Unit& u, int r) const { return (unsigned)(u.pm * BM + r) * (unsigned)K2; }
};
struct MoeSched {
    int NT, nN, G, c, K2; const char* B; size_t estride; bool gather;
    const LAS int* tile_e; const LAS unsigned* rowtab; int reps;
    __device__ __forceinline__ int rounds() const { return (NT * nN + G - 1) / G; }
    __device__ __forceinline__ bool next(int i, Unit& u) const { const int r = rounds(); if (i >= r * reps) return false; return static_next(NT, nN, G, c, i % r, u); }
    __device__ __forceinline__ const char* b_base(const Unit& u) const { return B + (size_t)tile_e[u.pm] * estride + (size_t)u.pn * BM * K2; }
    __device__ __forceinline__ unsigned a_off(int ui, const Unit& u, int r) const { return gather ? rowtab[(ui % rounds()) * 256 + r] : (unsigned)(u.pm * BM + r) * (unsigned)K2; }
};

struct EpiProj {
    static constexpr bool PERM = true;
    bf16* O;
    __device__ __forceinline__ void operator()(const f32x4 (&acc)[2][2][4][2], const Unit& u, int, int wr, int wc, int fr, int fq) const {
        const int row0 = u.pm * BM + 16 * ((u.pm >> 4) + 1) + wr * 64 + fr, col0 = u.pn * BM + wc * 32 + 8 * fq;
#pragma unroll
        for (int ai = 0; ai < 2; ++ai)
#pragma unroll
            for (int m = 0; m < 4; ++m) { bf16* rowp = O + (size_t)(row0 + ai * HALF + m * 16) * INW + col0;
#pragma unroll
                for (int bj = 0; bj < 2; ++bj) { const f32x4 v0 = acc[ai][bj][m][0], v1 = acc[ai][bj][m][1];
                    u32x4 w; w.x = cvt_pk_bf16(v0[0], v0[1]); w.y = cvt_pk_bf16(v0[2], v0[3]); w.z = cvt_pk_bf16(v1[0], v1[1]); w.w = cvt_pk_bf16(v1[2], v1[3]);
                    *(u32x4*)(rowp + bj * HALF) = w; } }
    }
};
struct EpiResid {
    static constexpr bool PERM = true;
    const float* X; const float* G2; bf16* H1; unsigned char* HN2;
    __device__ __forceinline__ void operator()(const f32x4 (&acc)[2][2][4][2], const Unit& u, int, int wr, int wc, int fr, int fq) const {
        const int row0 = u.pm * BM + wr * 64 + fr, col0 = u.pn * BM + wc * 32 + 8 * fq;
        f32x4 gv[2][2];
#pragma unroll
        for (int bj = 0; bj < 2; ++bj)
#pragma unroll
            for (int n = 0; n < 2; ++n) gv[bj][n] = *(const f32x4*)(G2 + col0 + bj * HALF + 4 * n);
#pragma unroll
        for (int ai = 0; ai < 2; ++ai)
#pragma unroll
            for (int m = 0; m < 4; ++m) { const size_t off = (size_t)(row0 + ai * HALF + m * 16) * D + col0;
#pragma unroll
                for (int bj = 0; bj < 2; ++bj) { const f32x4 v0 = acc[ai][bj][m][0] + *(const f32x4*)(X + off + bj * HALF), v1 = acc[ai][bj][m][1] + *(const f32x4*)(X + off + bj * HALF + 4);
                    u32x4 w; w.x = cvt_pk_bf16(v0[0], v0[1]); w.y = cvt_pk_bf16(v0[2], v0[3]); w.z = cvt_pk_bf16(v1[0], v1[1]); w.w = cvt_pk_bf16(v1[2], v1[3]);
                    *(u32x4*)(H1 + off + bj * HALF) = w;
                    const f32x4 t0 = v0 * gv[bj][0], t1 = v1 * gv[bj][1];
                    u32x2 e; e.x = pk4_fp8(clamp448(t0[0]), clamp448(t0[1]), clamp448(t0[2]), clamp448(t0[3])); e.y = pk4_fp8(clamp448(t1[0]), clamp448(t1[1]), clamp448(t1[2]), clamp448(t1[3]));
                    *(u32x2*)(HN2 + off + bj * HALF) = e; }
                asm volatile("" ::: "memory"); }
    }
};
struct EpiGateUp {
    static constexpr bool PERM = true;
    unsigned char* H; const LAS float* rstd; int rounds;
    __device__ __forceinline__ void operator()(const f32x4 (&acc)[2][2][4][2], const Unit& u, int ui_, int wr, int wc, int fr, int fq) const {
        const int ui = ui_ % rounds;
        const int r0 = wr * 64 + fr, col0 = u.pn * HALF + wc * 32 + 8 * fq;
#pragma unroll
        for (int ai = 0; ai < 2; ++ai)
#pragma unroll
            for (int m = 0; m < 4; ++m) { const int r = r0 + ai * HALF + m * 16; const float rs = rstd[ui * 256 + r];
                float h[8];
#pragma unroll
                for (int n = 0; n < 2; ++n)
#pragma unroll
                    for (int j = 0; j < 4; ++j) { const float g = acc[ai][0][m][n][j] * rs, up = acc[ai][1][m][n][j] * rs; h[n * 4 + j] = g * sigmoidf_(g) * up; }
#pragma unroll
                for (int j = 0; j < 8; ++j) h[j] = clamp448(h[j] * HID_SCALE);
                u32x2 w; w.x = pk4_fp8(h[0], h[1], h[2], h[3]); w.y = pk4_fp8(h[4], h[5], h[6], h[7]);
                *(u32x2*)(H + (size_t)(u.pm * BM + r) * EFF + col0) = w; }
    }
};
struct EpiDown {
    static constexpr bool PERM = true;
    unsigned char* C; const LAS int* slot; const LAS float* gate; int rounds;
    __device__ __forceinline__ void operator()(const f32x4 (&acc)[2][2][4][2], const Unit& u, int ui_, int wr, int wc, int fr, int fq) const {
        const int ui = ui_ % rounds;
        const int r0 = wr * 64 + fr, col0 = u.pn * BM + wc * 32 + 8 * fq;
#pragma unroll
        for (int ai = 0; ai < 2; ++ai)
#pragma unroll
            for (int m = 0; m < 4; ++m) { const int r = r0 + ai * HALF + m * 16; const int sl = slot[ui * 256 + r]; const float gt = gate[ui * 256 + r];
                if (sl >= 0) { unsigned char* rowp = C + (size_t)sl * D + col0;
#pragma unroll
                    for (int bj = 0; bj < 2; ++bj) { const f32x4 v0 = acc[ai][bj][m][0] * gt, v1 = acc[ai][bj][m][1] * gt;
                        u32x2 w; w.x = pk4_fp8(clamp448(v0[0]), clamp448(v0[1]), clamp448(v0[2]), clamp448(v0[3])); w.y = pk4_fp8(clamp448(v1[0]), clamp448(v1[1]), clamp448(v1[2]), clamp448(v1[3]));
                        *(u32x2*)(rowp + bj * HALF) = w; } } }
    }
};
}

struct Frame {
    LAS unsigned char* lds; int tid, lane, wave, G, bx;
    const float *x, *meta, *g1, *w_in, *conv_w, *conv_b, *wa, *ba, *wx, *bx_, *lam, *lru_gain, *pool_w, *pool_scale, *w_out, *g2, *w_group, *b_group, *w_router, *b_router, *w_gate, *w_up, *w_down, *final_gain;
    float* out; unsigned char* ws; unsigned* ctl;
    bf16 *WinT, *WoutT, *WaT, *WxT, *PwT, *HN1, *YMIX, *PROJ, *H1; unsigned char *WguT, *WdT, *HN2, *HID, *C;
    _Float16* WrH; float* AGG; f32x4* RINFO;
};
__device__ __forceinline__ float wave_sum(float v) {
#pragma unroll
    for (int o = 1; o < 64; o <<= 1) v += __shfl_xor(v, o);
    return v;
}

__device__ __forceinline__ void transpose_tile(const float* W, int ldw, int k0, int n0, bf16* WT, int ldt, int drow0, LAS float* scr, int lane) {
    { float v[32];
#pragma unroll
      for (int i = 0; i < 32; ++i) v[i] = W[(size_t)(k0 + 2 * i + (lane >> 5)) * ldw + n0 + (lane & 31)];
#pragma unroll
      for (int i = 0; i < 32; ++i) scr[(2 * i + (lane >> 5)) * 33 + (lane & 31)] = v[i]; }
    LDS_WAIT(); asm volatile("" ::: "memory");
    const int c = lane & 7;
#pragma unroll
    for (int j = 0; j < 4; ++j) { const int n = (lane >> 3) + 8 * j; const LAS float* s = scr + (8 * c) * 33 + n;
        u32x4 o; o.x = pk2(s[0 * 33], s[1 * 33]); o.y = pk2(s[2 * 33], s[3 * 33]); o.z = pk2(s[4 * 33], s[5 * 33]); o.w = pk2(s[6 * 33], s[7 * 33]);
        *(u32x4*)(WT + (size_t)(drow0 + n) * ldt + k0 + 8 * c) = o; }
    LDS_WAIT(); asm volatile("" ::: "memory");
}
__device__ __forceinline__ void transpose_tile_fp8(const float* W, int ldw, int k0, int n0, unsigned char* WT, int ldt, int drow0, float scale, LAS float* scr, int lane) {
    { float v[64];
#pragma unroll
      for (int i = 0; i < 64; ++i) v[i] = W[(size_t)(k0 + 2 * i + (lane >> 5)) * ldw + n0 + (lane & 31)];
#pragma unroll
      for (int i = 0; i < 64; ++i) scr[(2 * i + (lane >> 5)) * 33 + (lane & 31)] = v[i]; }
    LDS_WAIT(); asm volatile("" ::: "memory");
    const int n = lane >> 1, kh = (lane & 1) * 64; const LAS float* sp = scr + kh * 33 + n;
#pragma unroll
    for (int c = 0; c < 4; ++c) { u32x4 o;
#pragma unroll
        for (int w = 0; w < 4; ++w) { const LAS float* q4 = sp + (16 * c + 4 * w) * 33; o[w] = pk4_fp8(q4[0] * scale, q4[33] * scale, q4[66] * scale, q4[99] * scale); }
        *(u32x4*)(WT + (size_t)(drow0 + n) * ldt + k0 + kh + 16 * c) = o; }
    LDS_WAIT(); asm volatile("" ::: "memory");
}
__device__ __forceinline__ void p0_prologue(Frame& F) {
    if (F.bx < INW / 8) {
        LAS float* hnm = (LAS float*)F.lds;
        LAS float* part = (LAS float*)(F.lds + 65536);
        for (int r = F.wave * 2; r < F.wave * 2 + 2; ++r) {
            const f32x4* xr = (const f32x4*)(F.meta + (size_t)r * D) + F.lane; f32x4 v[4]; float s = 0.f;
#pragma unroll
            for (int j = 0; j < 4; ++j) { v[j] = xr[64 * j]; s += (v[j].x * v[j].x + v[j].y * v[j].y) + (v[j].z * v[j].z + v[j].w * v[j].w); }
            const float rstd = rsqrtf(wave_sum(s) * (1.f / D) + RMS_EPS);
#pragma unroll
            for (int j = 0; j < 4; ++j) { const f32x4 g = ((const f32x4*)F.g1)[F.lane + 64 * j]; *(LAS f32x4*)(hnm + r * D + 4 * F.lane + 256 * j) = v[j] * rstd * g; }
        }
        __syncthreads();
        { const int cc = F.tid & 7, ks = F.tid >> 3, col = F.bx * 8 + cc; float a[16];
#pragma unroll
            for (int r = 0; r < 16; ++r) a[r] = 0.f;
            for (int k = ks * 16; k < ks * 16 + 16; ++k) { const float w = F.w_in[(size_t)k * INW + col];
#pragma unroll
                for (int r = 0; r < 16; ++r) a[r] += hnm[r * D + k] * w; }
#pragma unroll
            for (int r = 0; r < 16; ++r) part[(ks * 16 + r) * 8 + cc] = a[r]; }
        __syncthreads();
        if (F.tid < 128) { const int r = F.tid >> 3, cc = F.tid & 7; float s = 0.f;
            for (int ks = 0; ks < 64; ++ks) s += part[(ks * 16 + r) * 8 + cc];
            const bf16 h = (bf16)f2bf(s);
            for (int b = 0; b < NBATCH; ++b) F.PROJ[(size_t)(b * TT + r) * INW + F.bx * 8 + cc] = h; }
        __syncthreads();
    }
    LAS float* scr = (LAS float*)(F.lds + F.wave * 16896);
    const int gw = F.bx * 8 + F.wave, NGW = F.G * 8;
    constexpr int I_IN = 16 * 48, I_OUT = 16 * 32, I_G = NE * 8 * 16, I_D = NE * 4 * 32, I_A = 8 * 2, I_P = 4 * 2 * 4;
    constexpr int NITEMS = I_IN + I_OUT + 2 * I_G + I_D + 2 * I_A + I_P;
    for (int it = gw; it < NITEMS; it += NGW) {
        int r = it;
        if (r < I_IN) { const int kb = r / 48, nb = r % 48; transpose_tile(F.w_in, INW, 64 * kb, 32 * nb, F.WinT, D, 32 * nb, scr, F.lane); continue; } r -= I_IN;
        if (r < I_OUT) { const int kb = r / 32, nb = r % 32; transpose_tile(F.w_out, D, 64 * kb, 32 * nb, F.WoutT, D, 32 * nb, scr, F.lane); continue; } r -= I_OUT;
        if (r < 2 * I_G) { const int up = r >= I_G; if (up) r -= I_G; const int e = r >> 7, kb = (r >> 4) & 7, nb = r & 15, n0 = 32 * nb;
            transpose_tile_fp8((up ? F.w_up : F.w_gate) + (size_t)e * D * EFF, EFF, 128 * kb, n0, F.WguT + (size_t)e * 1024 * D, D, (n0 >> 7) * 256 + up * 128 + (n0 & 127), WGU_SCALE, scr, F.lane); continue; } r -= 2 * I_G;
        if (r < I_D) { const int e = r >> 7, kb = (r >> 5) & 3, nb = r & 31; transpose_tile_fp8(F.w_down + (size_t)e * EFF * D, D, 128 * kb, 32 * nb, F.WdT + (size_t)e * D * EFF, EFF, 32 * nb, WD_SCALE, scr, F.lane); continue; } r -= I_D;
        if (r < 2 * I_A) { const int x = r >= I_A; if (x) r -= I_A; const int h = r >> 1, nb = r & 1; transpose_tile((x ? F.wx : F.wa) + (size_t)h * 4096, 64, 0, 32 * nb, (x ? F.WxT : F.WaT) + (size_t)h * 4096, 64, 32 * nb, scr, F.lane); continue; } r -= 2 * I_A;
        { const int g = r >> 3, kb = (r >> 2) & 1, nb = r & 3; transpose_tile(F.pool_w + (size_t)g * 16384, 128, 64 * kb, 32 * nb, F.PwT + (size_t)g * 16384, 128, 32 * nb, scr, F.lane); }
    }
    for (int i = F.bx * 512 + F.tid; i < NROUTE * D; i += F.G * 512) { const int n = i >> 10, k = i & 1023;
        const float w = n < 4 ? F.w_group[k * 4 + n] : F.w_router[k * 32 + (n - 4)]; F.WrH[i] = (_Float16)(w * 256.0f); }
    { f32x4 g[4];
#pragma unroll
      for (int j = 0; j < 4; ++j) g[j] = ((const f32x4*)F.g1)[F.lane + 64 * j];
      for (int m = gw * 4; m < M; m += NGW * 4) {
        f32x4 v[4][4];
#pragma unroll
        for (int r = 0; r < 4; ++r)
#pragma unroll
            for (int j = 0; j < 4; ++j) v[r][j] = ((const f32x4*)(F.x + (size_t)(m + r) * D))[F.lane + 64 * j];
#pragma unroll
        for (int r = 0; r < 4; ++r) { float s = 0.f;
#pragma unroll
            for (int j = 0; j < 4; ++j) s += (v[r][j].x * v[r][j].x + v[r][j].y * v[r][j].y) + (v[r][j].z * v[r][j].z + v[r][j].w * v[r][j].w);
            const float rstd = rsqrtf(wave_sum(s) * (1.f / D) + RMS_EPS);
            u32x2* o8 = (u32x2*)(F.HN1 + (size_t)(m + r) * D) + F.lane;
#pragma unroll
            for (int j = 0; j < 4; ++j) { const f32x4 y = v[r][j] * rstd * g[j]; u32x2 w; w.x = pk2(y.x, y.y); w.y = pk2(y.z, y.w); o8[64 * j] = w; } }
      } }
}

template <int CTRL> __device__ __forceinline__ float dpp_f(float old, float src) {
    return __builtin_bit_cast(float, __builtin_amdgcn_update_dpp(__builtin_bit_cast(int, old), __builtin_bit_cast(int, src), CTRL, 0xf, 0xf, false)); }
#define DPP_BCAST15 0x15F
__device__ __forceinline__ void row_scan(float& A, float& B) {
    { const float Ap = dpp_f<0x111>(1.0f, A), Bp = dpp_f<0x111>(0.0f, B); B = A * Bp + B; A = A * Ap; }
    { const float Ap = dpp_f<0x112>(1.0f, A), Bp = dpp_f<0x112>(0.0f, B); B = A * Bp + B; A = A * Ap; }
    { const float Ap = dpp_f<0x114>(1.0f, A), Bp = dpp_f<0x114>(0.0f, B); B = A * Bp + B; A = A * Ap; }
    { const float Ap = dpp_f<0x118>(1.0f, A), Bp = dpp_f<0x118>(0.0f, B); B = A * Bp + B; A = A * Ap; }
}
#define SCAN8_STR(D) "s_nop 1\n\t" \
    "v_fmac_f32_dpp %0, %0, %8 row_shr:" #D " row_mask:0xf bank_mask:0xf\n\tv_mul_f32_dpp %8, %8, %8 row_shr:" #D " row_mask:0xf bank_mask:0xf\n\t" \
    "v_fmac_f32_dpp %1, %1, %9 row_shr:" #D " row_mask:0xf bank_mask:0xf\n\tv_mul_f32_dpp %9, %9, %9 row_shr:" #D " row_mask:0xf bank_mask:0xf\n\t" \
    "v_fmac_f32_dpp %2, %2, %10 row_shr:" #D " row_mask:0xf bank_mask:0xf\n\tv_mul_f32_dpp %10, %10, %10 row_shr:" #D " row_mask:0xf bank_mask:0xf\n\t" \
    "v_fmac_f32_dpp %3, %3, %11 row_shr:" #D " row_mask:0xf bank_mask:0xf\n\tv_mul_f32_dpp %11, %11, %11 row_shr:" #D " row_mask:0xf bank_mask:0xf\n\t" \
    "v_fmac_f32_dpp %4, %4, %12 row_shr:" #D " row_mask:0xf bank_mask:0xf\n\tv_mul_f32_dpp %12, %12, %12 row_shr:" #D " row_mask:0xf bank_mask:0xf\n\t" \
    "v_fmac_f32_dpp %5, %5, %13 row_shr:" #D " row_mask:0xf bank_mask:0xf\n\tv_mul_f32_dpp %13, %13, %13 row_shr:" #D " row_mask:0xf bank_mask:0xf\n\t" \
    "v_fmac_f32_dpp %6, %6, %14 row_shr:" #D " row_mask:0xf bank_mask:0xf\n\tv_mul_f32_dpp %14, %14, %14 row_shr:" #D " row_mask:0xf bank_mask:0xf\n\t" \
    "v_fmac_f32_dpp %7, %7, %15 row_shr:" #D " row_mask:0xf bank_mask:0xf\n\tv_mul_f32_dpp %15, %15, %15 row_shr:" #D " row_mask:0xf bank_mask:0xf"
#define SCAN8(D, A, B, o) asm volatile(SCAN8_STR(D) : "+v"(B[o + 0]), "+v"(B[o + 1]), "+v"(B[o + 2]), "+v"(B[o + 3]), "+v"(B[o + 4]), "+v"(B[o + 5]), "+v"(B[o + 6]), "+v"(B[o + 7]), \
    "+v"(A[o + 0]), "+v"(A[o + 1]), "+v"(A[o + 2]), "+v"(A[o + 3]), "+v"(A[o + 4]), "+v"(A[o + 5]), "+v"(A[o + 6]), "+v"(A[o + 7]))
__device__ __forceinline__ void row_scan16(float (&A)[16], float (&B)[16]) {
    SCAN8(1, A, B, 0); SCAN8(1, A, B, 8); SCAN8(2, A, B, 0); SCAN8(2, A, B, 8); SCAN8(4, A, B, 0); SCAN8(4, A, B, 8); SCAN8(8, A, B, 0); SCAN8(8, A, B, 8);
}
struct LruW { LAS float* cst; const bf16 *waP, *wxP; };
__device__ __forceinline__ void lru_setup(const Frame& F, LruW& L, LAS unsigned char* wbase) {
    const int hd = F.wave; L.cst = (LAS float*)wbase;
    for (int i = F.lane; i < 512; i += 64) { const int t = i >> 6, ch = hd * 64 + (i & 63); float v;
        if (t < 4) v = F.conv_w[t * LW + ch]; else if (t == 4) v = F.conv_b[ch]; else if (t == 5) v = F.ba[ch]; else if (t == 6) v = F.bx_[ch];
        else { const float lm = F.lam[ch]; v = 8.0f * (fminf(lm, 0.f) - log1pf(__expf(-fabsf(lm)))); }
        L.cst[i] = v; }
    const int i = F.lane & 15, qw = F.lane >> 4; const size_t o = (size_t)hd * 4096 + (size_t)(8 * (i >> 2) + (i & 3)) * 64 + 8 * qw;
    L.waP = F.WaT + o; L.wxP = F.WxT + o;
    LDS_WAIT();
}
struct LruRaw { u32x4 u[2][4]; u32x4 ug[2]; };
template <bool WITH_UG>
__device__ __forceinline__ void lru_load(const Frame& F, int b, int tt0, LruRaw& R) {
    const int hd = F.wave, row = F.lane & 15, q = F.lane >> 4, tt = tt0 + row;
    const bf16* prow = F.PROJ + (size_t)(b * TT + tt) * INW + hd * 64 + 8 * q;
#pragma unroll
    for (int kb = 0; kb < 2; ++kb) {
#pragma unroll
        for (int k = 0; k < 4; ++k) { R.u[kb][k] = (u32x4){0u, 0u, 0u, 0u}; if (tt - 3 + k >= 0) R.u[kb][k] = *(const u32x4*)(prow + (ptrdiff_t)(k - 3) * INW + 32 * kb); }
        if (WITH_UG) R.ug[kb] = *(const u32x4*)(prow + LW + 32 * kb);
    }
}
__device__ __forceinline__ void lru_conv(const Frame& F, const LruW& L, const LruRaw& R, float (&xc)[16], bf16x8 (&xf)[2]) {
    const int q = F.lane >> 4;
#pragma unroll
    for (int kb = 0; kb < 2; ++kb) {
        const LAS float* cs = L.cst + 32 * kb + 8 * q;
        f32x2 x2[4];
        { const f32x4 c0 = *(const LAS f32x4*)(cs + 256), c1 = *(const LAS f32x4*)(cs + 260); x2[0] = (f32x2){c0.x, c0.y}; x2[1] = (f32x2){c0.z, c0.w}; x2[2] = (f32x2){c1.x, c1.y}; x2[3] = (f32x2){c1.z, c1.w}; }
#pragma unroll
        for (int k = 0; k < 4; ++k) {
            const u32x4 u = R.u[kb][k];
            const f32x4 w0 = *(const LAS f32x4*)(cs + 64 * k), w1 = *(const LAS f32x4*)(cs + 64 * k + 4);
            x2[0] = (f32x2){w0.x, w0.y} * (f32x2){bflo(u.x), bfhi(u.x)} + x2[0]; x2[1] = (f32x2){w0.z, w0.w} * (f32x2){bflo(u.y), bfhi(u.y)} + x2[1];
            x2[2] = (f32x2){w1.x, w1.y} * (f32x2){bflo(u.z), bfhi(u.z)} + x2[2]; x2[3] = (f32x2){w1.z, w1.w} * (f32x2){bflo(u.w), bfhi(u.w)} + x2[3];
        }
#pragma unroll
        for (int i = 0; i < 4; ++i) { xc[8 * kb + 2 * i] = x2[i].x; xc[8 * kb + 2 * i + 1] = x2[i].y; }
        asm volatile("" : "+v"(xc[8 * kb + 0]), "+v"(xc[8 * kb + 1]), "+v"(xc[8 * kb + 2]), "+v"(xc[8 * kb + 3]), "+v"(xc[8 * kb + 4]), "+v"(xc[8 * kb + 5]), "+v"(xc[8 * kb + 6]), "+v"(xc[8 * kb + 7]));
        u32x4 p; p.x = pk2(xc[8 * kb + 0], xc[8 * kb + 1]); p.y = pk2(xc[8 * kb + 2], xc[8 * kb + 3]); p.z = pk2(xc[8 * kb + 4], xc[8 * kb + 5]); p.w = pk2(xc[8 * kb + 6], xc[8 * kb + 7]);
        xf[kb] = __builtin_bit_cast(bf16x8, p);
    }
}
template <bool WPF  >
__device__ __forceinline__ void lru_gates(const Frame& F, const LruW& L, const float (&xc)[16], const bf16x8 (&xf)[2], float (&Av)[16], float (&Bv)[16]) {
    const int q = F.lane >> 4;
    bf16x8 wa[2], wx[2];
#pragma unroll
    for (int kk = 0; kk < 2; ++kk) { wa[kk] = *(const bf16x8*)(L.waP + 32 * kk); wx[kk] = *(const bf16x8*)(L.wxP + 32 * kk); }
#pragma unroll
    for (int nb = 0; nb < 4; ++nb) {
        const int kb = nb >> 1, hf = nb & 1;
        bf16x8 wan[2], wxn[2];
        if (!WPF && nb > 0) { const int o = (32 * kb + 4 * hf) * 64;
#pragma unroll
            for (int kk = 0; kk < 2; ++kk) { wa[kk] = *(const bf16x8*)(L.waP + o + 32 * kk); wx[kk] = *(const bf16x8*)(L.wxP + o + 32 * kk); } }
        if (WPF && nb < 3) { const int o = (32 * ((nb + 1) >> 1) + 4 * ((nb + 1) & 1)) * 64;
#pragma unroll
            for (int kk = 0; kk < 2; ++kk) { wan[kk] = *(const bf16x8*)(L.waP + o + 32 * kk); wxn[kk] = *(const bf16x8*)(L.wxP + o + 32 * kk); } }
        asm volatile("" ::: "memory");
        f32x4 ra = (f32x4){0.f, 0.f, 0.f, 0.f}, rx = ra;
#pragma unroll
        for (int kk = 0; kk < 2; ++kk) { ra = __builtin_amdgcn_mfma_f32_16x16x32_bf16(wa[kk], xf[kk], ra, 0, 0, 0); rx = __builtin_amdgcn_mfma_f32_16x16x32_bf16(wx[kk], xf[kk], rx, 0, 0, 0); }
        const LAS float* cs = L.cst + 32 * kb + 8 * q + 4 * hf;
        const f32x4 ba4 = *(const LAS f32x4*)(cs + 320), bx4 = *(const LAS f32x4*)(cs + 384), lm4 = *(const LAS f32x4*)(cs + 448);
#pragma unroll
        for (int j = 0; j < 4; ++j) { const int c = 8 * kb + 4 * hf + j;
            const float r = sigmoidf_(ra[j] + ba4[j]), ig = sigmoidf_(rx[j] + bx4[j]);
            const float a = __expf(lm4[j] * r);
            Av[c] = a; Bv[c] = __builtin_amdgcn_sqrtf(fmaf(-a, a, 1.0f)) * (ig * xc[c]); }
        if (WPF && nb < 3) {
#pragma unroll
            for (int kk = 0; kk < 2; ++kk) { wa[kk] = wan[kk]; wx[kk] = wxn[kk]; } }
    }
    row_scan16(Av, Bv);
}
__device__ __forceinline__ void p2_aggregates(Frame& F) {
    LruW L; lru_setup(F, L, F.lds + F.wave * 2048);
    const int row = F.lane & 15, q = F.lane >> 4;
    for (int ch = F.bx; ch < 256; ch += F.G) {
        const int b = ch >> 5, ci = ch & 31; float Ac[16], Bc[16];
#pragma unroll
        for (int c = 0; c < 16; ++c) { Ac[c] = 1.f; Bc[c] = 0.f; }
        const int blk0 = (ci == 0 ? -1 : 0);
        LruRaw R; lru_load<false>(F, b, NMETA + 128 * ci + 16 * blk0, R);
        for (int blk = blk0; blk < 8; ++blk) {
            float xc[16]; bf16x8 xf[2]; lru_conv(F, L, R, xc, xf);
            if (blk < 7) lru_load<false>(F, b, NMETA + 128 * ci + 16 * (blk + 1), R);
            asm volatile("" ::: "memory");
            float Av[16], Bv[16];
            lru_gates<true>(F, L, xc, xf, Av, Bv);
#pragma unroll
            for (int c = 0; c < 16; ++c) { Bc[c] = Av[c] * Bc[c] + Bv[c]; Ac[c] *= Av[c]; }
        }
        if (row == 15) {
#pragma unroll
            for (int kb = 0; kb < 2; ++kb) { float* o = F.AGG + ((size_t)ch * LW + F.wave * 64 + 32 * kb + 8 * q) * 2;
#pragma unroll
                for (int j = 0; j < 8; j += 2) *(f32x4*)(o + 2 * j) = (f32x4){Ac[8 * kb + j], Bc[8 * kb + j], Ac[8 * kb + j + 1], Bc[8 * kb + j + 1]}; }
        }
    }
}

constexpr int YT_STRIDE = 520;
constexpr int US_STRIDE = 264;
constexpr int PW_STRIDE = 136;
template <int G> __device__ __forceinline__ void pool_z(const LAS bf16* ub  , bf16x8 (&zf)[4]) {
    constexpr int W = 2 << G;
    asm volatile("" : "+v"(ub));
#pragma unroll
    for (int kb = 0; kb < 4; ++kb) {
        const LAS bf16* p = ub + 15 * US_STRIDE + 32 * kb; const u32x4 c = *(const LAS u32x4*)p; float cur[8], s[8];
        cur[0] = bflo(c.x); cur[1] = bfhi(c.x); cur[2] = bflo(c.y); cur[3] = bfhi(c.y); cur[4] = bflo(c.z); cur[5] = bfhi(c.z); cur[6] = bflo(c.w); cur[7] = bfhi(c.w);
#pragma unroll
        for (int j = 0; j < 8; ++j) s[j] = cur[j];
#pragma unroll
        for (int d = 1; d < W; ++d) { const u32x4 u = *(const LAS u32x4*)(ub + (15 - d) * US_STRIDE + 32 * kb);
            s[0] += bflo(u.x); s[1] += bfhi(u.x); s[2] += bflo(u.y); s[3] += bfhi(u.y); s[4] += bflo(u.z); s[5] += bfhi(u.z); s[6] += bflo(u.w); s[7] += bfhi(u.w);
            if ((d & 3) == 3) asm volatile("" : "+v"(s[0]), "+v"(s[1]), "+v"(s[2]), "+v"(s[3]), "+v"(s[4]), "+v"(s[5]), "+v"(s[6]), "+v"(s[7]) :: "memory"); }
        asm volatile("" : "+v"(s[0]), "+v"(s[1]), "+v"(s[2]), "+v"(s[3]), "+v"(s[4]), "+v"(s[5]), "+v"(s[6]), "+v"(s[7]) :: "memory");
        u32x4 pz; pz.x = pk2(s[0] * (1.0f / W) - cur[0], s[1] * (1.0f / W) - cur[1]); pz.y = pk2(s[2] * (1.0f / W) - cur[2], s[3] * (1.0f / W) - cur[3]);
        pz.z = pk2(s[4] * (1.0f / W) - cur[4], s[5] * (1.0f / W) - cur[5]); pz.w = pk2(s[6] * (1.0f / W) - cur[6], s[7] * (1.0f / W) - cur[7]);
        asm volatile("" : "+v"(pz) :: "memory");
        zf[kb] = __builtin_bit_cast(bf16x8, pz);
    }
}
__device__ __forceinline__ void p3_mixer(Frame& F) {
    LAS bf16* Y = (LAS bf16*)F.lds;
    LAS unsigned char* wbase = F.lds + 66560 + F.wave * 2048;
    LAS float* SSQ = (LAS float*)(F.lds + 66560 + 16384);
    LAS float* RSTD = SSQ + 512;
    LAS bf16* US = (LAS bf16*)F.lds;
    const int row = F.lane & 15, q = F.lane >> 4;
    for (int ch = F.bx; ch < 256; ch += F.G) {
        const int b = ch >> 5, ci = ch & 31; const int m0 = ch * 128;
#ifndef P3_NO_LRU
        {
        LruW L; lru_setup(F, L, wbase);
        float H[16];
        { float Ar[16], Br[16];
#pragma unroll
            for (int c = 0; c < 16; ++c) { Ar[c] = 1.f; Br[c] = 0.f; }
#pragma unroll
            for (int t = 0; t < 2; ++t) { const int k = 2 * row + t;
                if (k < ci) {
#pragma unroll
                    for (int kb = 0; kb < 2; ++kb) { const float* o = F.AGG + ((size_t)(b * 32 + k) * LW + F.wave * 64 + 32 * kb + 8 * q) * 2;
#pragma unroll
                        for (int j = 0; j < 8; j += 2) { const f32x4 v = *(const f32x4*)(o + 2 * j); const int c = 8 * kb + j;
                            Br[c] = v.x * Br[c] + v.y; Ar[c] *= v.x; Br[c + 1] = v.z * Br[c + 1] + v.w; Ar[c + 1] *= v.z; } } } }
            row_scan16(Ar, Br);
#pragma unroll
            for (int c = 0; c < 16; ++c) H[c] = dpp_f<DPP_BCAST15>(0.f, Br[c]); }
        if (ci == 0) {
            float Av[16], Bv[16]; LruRaw Rm; lru_load<false>(F, b, 0, Rm); { float xc[16]; bf16x8 xf[2]; lru_conv(F, L, Rm, xc, xf); lru_gates<false>(F, L, xc, xf, Av, Bv); }
#pragma unroll
            for (int c = 0; c < 16; ++c) H[c] = dpp_f<DPP_BCAST15>(0.f, Av[c] * H[c] + Bv[c]);
        }

        for (int half = 0; half < 2; ++half) {
            for (int blk = 0; blk < 4; ++blk) {
                const int rb = 16 * blk; float Av[16], Bv[16];
                u32x4 ug[2];
                { LruRaw R; lru_load<true>(F, b, NMETA + 128 * ci + 64 * half + rb, R); ug[0] = R.ug[0]; ug[1] = R.ug[1];
                  float xc[16]; bf16x8 xf[2]; lru_conv(F, L, R, xc, xf);
                  asm volatile("" ::: "memory");
                  lru_gates<false>(F, L, xc, xf, Av, Bv); }
                float ss = 0.f;
#pragma unroll
                for (int kb = 0; kb < 2; ++kb) { float y[8];
#pragma unroll
                    for (int j = 0; j < 8; ++j) { const int c = 8 * kb + j;
                        const float h = Av[c] * H[c] + Bv[c];
                        const unsigned w = ug[kb][j >> 1]; const float g = (j & 1) ? bfhi(w) : bflo(w);
                        const float gl = g * sigmoidf_(1.5957691216f * (g + 0.044715f * g * g * g));
                        y[j] = h * gl; ss += y[j] * y[j];
                        H[c] = dpp_f<DPP_BCAST15>(0.f, h); }
                    u32x4 p; p.x = pk2(y[0], y[1]); p.y = pk2(y[2], y[3]); p.z = pk2(y[4], y[5]); p.w = pk2(y[6], y[7]);
                    *(LAS u32x4*)(Y + (rb + row) * YT_STRIDE + F.wave * 64 + 32 * kb + 8 * q) = p;
                    asm volatile("" : "+v"(ss) :: "memory"); }
                ss += __shfl_xor(ss, 16); ss += __shfl_xor(ss, 32);
                if (q == 0) SSQ[(rb + row) * 8 + F.wave] = ss;
            }
            __syncthreads();
            if (F.tid < 64) { float s = 0.f;
#pragma unroll
                for (int w = 0; w < 8; ++w) s += SSQ[F.tid * 8 + w];
                RSTD[F.tid] = rsqrtf(s * (1.0f / LW) + RMS_EPS); }
            __syncthreads();
#pragma unroll
            for (int s = 0; s < 8; ++s) { const int p = F.tid + 512 * s, rw = p >> 6, cp = p & 63; const float rs = RSTD[rw];
                const u32x4 v = *(const LAS u32x4*)(Y + rw * YT_STRIDE + 8 * cp); const f32x4 g0 = *(const f32x4*)(F.lru_gain + 8 * cp), g1 = *(const f32x4*)(F.lru_gain + 8 * cp + 4);
                u32x4 o; o.x = pk2(bflo(v.x) * rs * g0.x, bfhi(v.x) * rs * g0.y); o.y = pk2(bflo(v.y) * rs * g0.z, bfhi(v.y) * rs * g0.w);
                o.z = pk2(bflo(v.z) * rs * g1.x, bfhi(v.z) * rs * g1.y); o.w = pk2(bflo(v.w) * rs * g1.z, bfhi(v.w) * rs * g1.w);
                *(u32x4*)(F.YMIX + (size_t)(m0 + 64 * half + rw) * D + 8 * cp) = o; }
            __syncthreads();
        }
        }
#endif
#ifndef P3_NO_POOL
        {
            bf16x8 zf[4][4];
            const int T0 = b * TT + NMETA + 128 * ci - 15;
#pragma unroll
            for (int gp = 0; gp < 2; ++gp) {
                for (int i = F.tid; i < 143 * 32; i += 512) { const int ri = i >> 5, cpc = i & 31;
                    *(LAS u32x4*)(US + ri * US_STRIDE + 8 * cpc) = *(const u32x4*)(F.PROJ + (size_t)(T0 + ri) * INW + 1024 + 256 * gp + 8 * cpc); }
                __syncthreads();
                const LAS bf16* urow = US + (16 * F.wave + row) * US_STRIDE + 8 * q;
                if (gp == 0) { pool_z<0>(urow, zf[0]); pool_z<1>(urow + 128, zf[1]); } else { pool_z<2>(urow, zf[2]); pool_z<3>(urow + 128, zf[3]); }
                __syncthreads();
            }
            for (int i = F.tid; i < 4 * 128 * 16; i += 512) { const int n = i >> 4, pc = i & 15; *(LAS u32x4*)(US + n * PW_STRIDE + 8 * pc) = *(const u32x4*)(F.PwT + (size_t)n * 128 + 8 * pc); }
            __syncthreads();
            const LAS bf16* wl = US + row * PW_STRIDE + 8 * q;
            float ssq = 0.f;
#pragma unroll
            for (int g = 0; g < 4; ++g) { const LAS bf16* wg = wl + g * 128 * PW_STRIDE; asm volatile("" : "+v"(wg));
#pragma unroll 2
                for (int nb = 0; nb < 8; ++nb) { f32x4 acc = (f32x4){0.f, 0.f, 0.f, 0.f}; const LAS bf16* wn = wg + 16 * nb * PW_STRIDE;
#pragma unroll
                    for (int kb = 0; kb < 4; ++kb) acc = __builtin_amdgcn_mfma_f32_16x16x32_bf16(*(const LAS bf16x8*)(wn + 32 * kb), zf[g][kb], acc, 0, 0, 0);
                    ssq += (acc[0] * acc[0] + acc[1] * acc[1]) + (acc[2] * acc[2] + acc[3] * acc[3]); } }
            ssq += __shfl_xor(ssq, 16); ssq += __shfl_xor(ssq, 32);
            const float rs = rsqrtf(ssq * (1.0f / 512.0f) + RMS_EPS);
            bf16* orow = F.YMIX + (size_t)(m0 + 16 * F.wave + row) * D + LW + 4 * q;
#pragma unroll
            for (int g = 0; g < 4; ++g) { const LAS bf16* wg = wl + g * 128 * PW_STRIDE; asm volatile("" : "+v"(wg));
#pragma unroll 2
                for (int nb = 0; nb < 8; ++nb) { f32x4 acc = (f32x4){0.f, 0.f, 0.f, 0.f}; const LAS bf16* wn = wg + 16 * nb * PW_STRIDE;
#pragma unroll
                    for (int kb = 0; kb < 4; ++kb) acc = __builtin_amdgcn_mfma_f32_16x16x32_bf16(*(const LAS bf16x8*)(wn + 32 * kb), zf[g][kb], acc, 0, 0, 0);
                    const f32x4 sc = *(const f32x4*)(F.pool_scale + 128 * g + 16 * nb + 4 * q);
                    u32x2 o; o.x = pk2(acc[0] * rs * sc.x, acc[1] * rs * sc.y); o.y = pk2(acc[2] * rs * sc.z, acc[3] * rs * sc.w);
                    *(u32x2*)(orow + 128 * g + 16 * nb) = o; } }
        }
#endif
        __syncthreads();
    }
}

constexpr int WR_STRIDE = 1032;
__device__ __forceinline__ void p5_route(Frame& F, const bool dry = false) {
    LAS _Float16* WR = (LAS _Float16*)F.lds;
    LAS float* LG = (LAS float*)(F.lds + 36 * WR_STRIDE * 2) + F.wave * 16 * 40;
    LAS int* LCNT = (LAS int*)(F.lds + 36 * WR_STRIDE * 2 + 8 * 16 * 40 * 4);
    LAS float* G2 = (LAS float*)(LCNT + 64);
    const int c16 = F.lane & 15, q = F.lane >> 4;
    for (int i = F.tid; i < NROUTE * 128; i += 512) { const int n = i >> 7, k8 = i & 127; *(LAS u32x4*)(WR + n * WR_STRIDE + 8 * k8) = *(const u32x4*)(F.WrH + n * D + 8 * k8); }
    for (int i = F.tid; i < D; i += 512) G2[i] = F.g2[i];
    for (int ch = F.bx; ch < 256; ch += F.G) {
        if (F.tid < 64) LCNT[F.tid] = 0;
        __syncthreads();
        const int row = ch * 128 + 16 * F.wave + c16;
        const bf16* hrow = F.H1 + (size_t)row * D + 8 * q;
        f32x4 acc[3]; float ss = 0.f;
#pragma unroll
        for (int nb = 0; nb < 3; ++nb) acc[nb] = (f32x4){0.f, 0.f, 0.f, 0.f};
#pragma unroll 4
        for (int i = 0; i < 32; ++i) {
            const u32x4 hw = *(const u32x4*)(hrow + 32 * i);
            const f32x4 h0 = (f32x4){bflo(hw.x), bfhi(hw.x), bflo(hw.y), bfhi(hw.y)}, h1 = (f32x4){bflo(hw.z), bfhi(hw.z), bflo(hw.w), bfhi(hw.w)};
            const f32x4 g0 = *(const LAS f32x4*)(G2 + 32 * i + 8 * q), g1 = *(const LAS f32x4*)(G2 + 32 * i + 8 * q + 4);
            ss += (h0.x * h0.x + h0.y * h0.y) + (h0.z * h0.z + h0.w * h0.w) + (h1.x * h1.x + h1.y * h1.y) + (h1.z * h1.z + h1.w * h1.w);
            const f32x4 t0 = h0 * g0, t1 = h1 * g1;
            f16x8 a; a[0] = (_Float16)t0.x; a[1] = (_Float16)t0.y; a[2] = (_Float16)t0.z; a[3] = (_Float16)t0.w; a[4] = (_Float16)t1.x; a[5] = (_Float16)t1.y; a[6] = (_Float16)t1.z; a[7] = (_Float16)t1.w;
#pragma unroll
            for (int nb = 0; nb < 3; ++nb) { const int col = 16 * nb + c16; f16x8 bw;
#pragma unroll
                for (int j = 0; j < 8; ++j) bw[j] = (_Float16)0.f;
                if (col < NROUTE) bw = *(const LAS f16x8*)(WR + col * WR_STRIDE + 32 * i + 8 * q);
                acc[nb] = __builtin_amdgcn_mfma_f32_16x16x32_f16(a, bw, acc[nb], 0, 0, 0); }
        }
        ss += __shfl_xor(ss, 16); ss += __shfl_xor(ss, 32);
        const float rstd = rsqrtf(ss * (1.0f / D) + RMS_EPS);
#pragma unroll
        for (int nb = 0; nb < 3; ++nb)
#pragma unroll
            for (int j = 0; j < 4; ++j) { const int col = 16 * nb + c16; if (col < 40) LG[(4 * q + j) * 40 + col] = acc[nb][j]; }
        LDS_WAIT();
        int e0 = 0, e1 = 0, rk0 = 0, rk1 = 0; float gt0 = 0.f, gt1 = 0.f;
        if (F.lane < 16) {
            const LAS float* lg = LG + F.lane * 40; const float sc = rstd * (1.0f / 256.0f);
            float gl[4]; int gi = 0;
#pragma unroll
            for (int j = 0; j < 4; ++j) gl[j] = lg[j] * sc + F.b_group[j];
            float gm = gl[0];
#pragma unroll
            for (int j = 1; j < 4; ++j) if (gl[j] > gm) { gm = gl[j]; gi = j; }
            float den = 0.f;
#pragma unroll
            for (int j = 0; j < 4; ++j) den += __expf(gl[j] - gm);
            const float pg = 1.0f / den;
            float v0 = -3.0e38f, v1 = -3.0e38f; int i0 = 0, i1 = 0;
            for (int j = 0; j < 8; ++j) { const float v = lg[4 + gi * 8 + j] * sc + F.b_router[gi * 8 + j];
                if (v > v0) { v1 = v0; i1 = i0; v0 = v; i0 = j; } else if (v > v1) { v1 = v; i1 = j; } }
            const float ex = __expf(v1 - v0), s0 = 1.0f / (1.0f + ex);
            gt0 = pg * s0; gt1 = pg * (ex * s0); e0 = gi * 8 + i0; e1 = gi * 8 + i1;
            rk0 = __hip_atomic_fetch_add(&LCNT[e0], 1, __ATOMIC_RELAXED, __HIP_MEMORY_SCOPE_WORKGROUP); rk1 = __hip_atomic_fetch_add(&LCNT[e1], 1, __ATOMIC_RELAXED, __HIP_MEMORY_SCOPE_WORKGROUP);
        }
        __syncthreads();
        if (F.tid < 32 && !dry) LCNT[32 + F.tid] = (int)__hip_atomic_fetch_add(F.ctl + CW_CNT + 64 * F.tid, (unsigned)LCNT[F.tid], __ATOMIC_RELAXED, __HIP_MEMORY_SCOPE_AGENT);
        __syncthreads();
        if (F.lane < 16 && !dry) { const int tok = ch * 128 + 16 * F.wave + F.lane;
            F.RINFO[(size_t)e0 * ECAP + LCNT[32 + e0] + rk0] = (f32x4){__builtin_bit_cast(float, tok * 2), gt0, rstd, 0.f};
            F.RINFO[(size_t)e1 * ECAP + LCNT[32 + e1] + rk1] = (f32x4){__builtin_bit_cast(float, tok * 2 + 1), gt1, rstd, 0.f}; }
        __syncthreads();
    }
}

__device__ __forceinline__ int moe_tables(Frame& F) {
    LAS int* TE = (LAS int*)(F.lds + TAB_TE); LAS int* TR = (LAS int*)(F.lds + TAB_TR); LAS int* CNT = (LAS int*)(F.lds + TAB_CNT); LAS int* PRE = CNT + 32;
    if (F.tid < 32) CNT[F.tid] = (int)__hip_atomic_load(F.ctl + CW_CNT + 64 * F.tid, __ATOMIC_RELAXED, __HIP_MEMORY_SCOPE_AGENT);
    __syncthreads();
    if (F.tid == 0) { int s = 0; for (int e = 0; e < NE; ++e) { PRE[e] = s; s += (CNT[e] + 255) >> 8; } PRE[NE] = s; }
    __syncthreads();
    const int NT = PRE[NE];
    for (int t = F.tid; t < NT; t += 512) { int e = 0; while (e < NE - 1 && PRE[e + 1] <= t) ++e; TE[t] = e; TR[t] = (t - PRE[e]) * 256; }
    __syncthreads();
    return NT;
}
__device__ __forceinline__ void moe_unit_tables(Frame& F, const pg8::MoeSched& S, int mode) {
    LAS int* TE = (LAS int*)(F.lds + TAB_TE); LAS int* TR = (LAS int*)(F.lds + TAB_TR); LAS int* CNT = (LAS int*)(F.lds + TAB_CNT);
    LAS unsigned* ROW = (LAS unsigned*)(F.lds + TAB_ROW); LAS float* FT = (LAS float*)(F.lds + TAB_F);
    pg8::Unit u;
    for (int i = 0; i < MAXU && i < S.rounds() && S.next(i, u); ++i) {
        if (F.tid < 256) { const int e = TE[u.pm], pos = TR[u.pm] + F.tid; const bool valid = pos < CNT[e];
            f32x4 ri = (f32x4){0.f, 0.f, 0.f, 0.f}; if (valid) ri = F.RINFO[(size_t)e * ECAP + pos];
            const int slot = __builtin_bit_cast(int, ri.x);
            if (mode == 0) { ROW[i * 256 + F.tid] = valid ? (unsigned)(slot >> 1) * (unsigned)D : 0u; FT[i * 256 + F.tid] = valid ? ri.z * (1.0f / WGU_SCALE) : 0.f; }
            else { ROW[i * 256 + F.tid] = valid ? (unsigned)slot : 0xffffffffu; FT[i * 256 + F.tid] = ri.y * (C_SCALE / (WD_SCALE * HID_SCALE)); } }
    }
    __syncthreads();
}

__device__ __forceinline__ void p8_final(Frame& F) {
    const int gw = F.bx * 8 + F.wave, NGW = F.G * 8;
    f32x4 g[4];
#pragma unroll
    for (int j = 0; j < 4; ++j) g[j] = ((const f32x4*)F.final_gain)[F.lane + 64 * j];
    for (int m = gw * 2; m < M; m += NGW * 2) {
        u32x2 hb[2][4]; unsigned ca[2][4], cb[2][4];
#pragma unroll
        for (int r = 0; r < 2; ++r)
#pragma unroll
            for (int j = 0; j < 4; ++j) { hb[r][j] = ((const u32x2*)(F.H1 + (size_t)(m + r) * D))[F.lane + 64 * j];
                ca[r][j] = ((const unsigned*)(F.C + (size_t)(2 * (m + r)) * D))[F.lane + 64 * j]; cb[r][j] = ((const unsigned*)(F.C + (size_t)(2 * (m + r) + 1) * D))[F.lane + 64 * j]; }
#pragma unroll
        for (int r = 0; r < 2; ++r) { f32x4 v[4]; float s = 0.f;
#pragma unroll
            for (int j = 0; j < 4; ++j) { const f32x2 a0 = __builtin_amdgcn_cvt_pk_f32_fp8(ca[r][j], false), a1 = __builtin_amdgcn_cvt_pk_f32_fp8(ca[r][j], true), b0 = __builtin_amdgcn_cvt_pk_f32_fp8(cb[r][j], false), b1 = __builtin_amdgcn_cvt_pk_f32_fp8(cb[r][j], true);
                v[j] = (f32x4){bflo(hb[r][j].x) + (a0.x + b0.x) * (1.0f / C_SCALE), bfhi(hb[r][j].x) + (a0.y + b0.y) * (1.0f / C_SCALE), bflo(hb[r][j].y) + (a1.x + b1.x) * (1.0f / C_SCALE), bfhi(hb[r][j].y) + (a1.y + b1.y) * (1.0f / C_SCALE)};
                s += (v[j].x * v[j].x + v[j].y * v[j].y) + (v[j].z * v[j].z + v[j].w * v[j].w); }
            const float rstd = rsqrtf(wave_sum(s) * (1.f / D) + RMS_EPS);
            f32x4* o = (f32x4*)(F.out + (size_t)(m + r) * D) + F.lane;
#pragma unroll
            for (int j = 0; j < 4; ++j) o[64 * j] = v[j] * rstd * g[j]; }
    }
}

struct Args { const float* in[24]; float* out; unsigned char* ws; int ph_lo, ph_hi; };
__global__ void __launch_bounds__(512, 2) hymba_fwd(Args args) {
    extern __shared__ __attribute__((aligned(16))) unsigned char lds[];
    Frame F;
    F.lds = (LAS unsigned char*)lds; F.tid = threadIdx.x; F.lane = F.tid & 63; F.wave = __builtin_amdgcn_readfirstlane(F.tid >> 6); F.G = gridDim.x; F.bx = blockIdx.x;
    F.x = args.in[0]; F.meta = args.in[1]; F.g1 = args.in[2]; F.w_in = args.in[3]; F.conv_w = args.in[4]; F.conv_b = args.in[5]; F.wa = args.in[6]; F.ba = args.in[7]; F.wx = args.in[8]; F.bx_ = args.in[9];
    F.lam = args.in[10]; F.lru_gain = args.in[11]; F.pool_w = args.in[12]; F.pool_scale = args.in[13]; F.w_out = args.in[14]; F.g2 = args.in[15]; F.w_group = args.in[16]; F.b_group = args.in[17];
    F.w_router = args.in[18]; F.b_router = args.in[19]; F.w_gate = args.in[20]; F.w_up = args.in[21]; F.w_down = args.in[22]; F.final_gain = args.in[23];
    F.out = args.out; F.ws = args.ws; F.ctl = (unsigned*)(args.ws + WS_CTL);
    unsigned char* ws = args.ws;
    F.WinT = (bf16*)(ws + WS_WIN); F.WoutT = (bf16*)(ws + WS_WOUT); F.WaT = (bf16*)(ws + WS_WA); F.WxT = (bf16*)(ws + WS_WX); F.PwT = (bf16*)(ws + WS_PW); F.WrH = (_Float16*)(ws + WS_WR);
    F.AGG = (float*)(ws + WS_AGG); F.WguT = ws + WS_WGU; F.WdT = ws + WS_WD; F.RINFO = (f32x4*)(ws + WS_RINFO); F.HN1 = (bf16*)(ws + WS_HN1); F.YMIX = (bf16*)(ws + WS_HN1);
    F.PROJ = (bf16*)(ws + WS_PROJ); F.HN2 = ws + WS_PROJ; F.HID = ws + WS_HID; F.C = ws + WS_C; F.H1 = (bf16*)(ws + WS_H1);
    volatile LAS unsigned* MISC = (volatile LAS unsigned*)(F.lds + MISC_OFF);
    if (F.tid < 64) MISC[F.tid] = 0u;
    __syncthreads();
    XcdBarrier bar; bar.bar = F.ctl + CW_BAR; bar.x = 0; bar.st = nullptr;
    if (MK_N_LAUNCHES == 1) bar = xcd_barrier_post(F.ctl + CW_BAR, MISC + 8);
    const int lo = args.ph_lo, hi = args.ph_hi;
#ifndef PH_MASK
#define PH_MASK 0x1ff
#endif
#define IN(k) (((PH_MASK >> (k)) & 1) && lo <= (k) && (k) < hi)
#define SEAM(k) do { if (IN(k) && IN((k) + 1)) xcd_barrier(bar); } while (0)
#define REP(k) for (int rep_ = 0; rep_ <= ((REPEAT_MASK >> (k)) & 1); ++rep_)

    if (IN(0)) REP(0) { p0_prologue(F); } SEAM(0);
    if (IN(1)) { pg8::DenseSched S{M / 256, INW / 256, F.G, F.bx, D * 2, (const char*)F.WinT, 1 + ((REPEAT_MASK >> 1) & 1)}; pg8::EpiProj E{F.PROJ};
        pg8::gemm_phase(F.lds, D * 2, (const char*)F.HN1, S, E); } SEAM(1);
    if (IN(2)) REP(2) { p2_aggregates(F); } SEAM(2);
    if (IN(3)) REP(3) { p3_mixer(F); } SEAM(3);
    if (IN(4)) { pg8::DenseSched S{M / 256, D / 256, F.G, F.bx, D * 2, (const char*)F.WoutT, 1 + ((REPEAT_MASK >> 4) & 1)}; pg8::EpiResid E{F.x, F.g2, F.H1, F.HN2};
        pg8::gemm_phase(F.lds, D * 2, (const char*)F.YMIX, S, E); } SEAM(4);
    if (IN(5)) { if ((REPEAT_MASK >> 5) & 1) p5_route(F, true); p5_route(F); } SEAM(5);
    if (IN(6)) { const int NT = moe_tables(F);
        pg8::MoeSched S{NT, 4, F.G, F.bx, D, (const char*)F.WguT, (size_t)1024 * D, true, (const LAS int*)(F.lds + TAB_TE), (const LAS unsigned*)(F.lds + TAB_ROW), 1 + ((REPEAT_MASK >> 6) & 1)};
        moe_unit_tables(F, S, 0);
        pg8::EpiGateUp E{F.HID, (const LAS float*)(F.lds + TAB_F), S.rounds()};
        pg8::gemm_phase<pg8::EpiGateUp, pg8::MoeSched, true>(F.lds, D, (const char*)F.HN2, S, E); } SEAM(6);
    if (IN(7)) { const int NT = moe_tables(F);
        pg8::MoeSched S{NT, 4, F.G, F.bx, EFF, (const char*)F.WdT, (size_t)D * EFF, false, (const LAS int*)(F.lds + TAB_TE), (const LAS unsigned*)(F.lds + TAB_ROW), 1 + ((REPEAT_MASK >> 7) & 1)};
        moe_unit_tables(F, S, 1);
        pg8::EpiDown E{F.C, (const LAS int*)(F.lds + TAB_ROW), (const LAS float*)(F.lds + TAB_F), S.rounds()};
        pg8::gemm_phase<pg8::EpiDown, pg8::MoeSched, true>(F.lds, EFF, (const char*)F.HID, S, E); } SEAM(7);
    if (IN(8)) { p8_final(F); }
#undef IN
#undef SEAM
}

extern "C" void kernel_launch(void* const* d_in, const int* in_sizes, int n_in, void* d_out, int out_size, void* d_ws, size_t ws_size, hipStream_t stream) {
    static int grid = 0;
    if (grid == 0) {
        if (n_in != 24 || in_sizes[0] != M * D || out_size != M * D || ws_size < WS_END) { fprintf(stderr, "kernel_launch: unexpected shapes (n_in %d, in0 %d, out %d, ws %zu)\n", n_in, n_in > 0 ? in_sizes[0] : -1, out_size, ws_size); grid = -1; return; }
        int dev = 0, cus = 0, per_cu = 0;
        if (hipGetDevice(&dev) != hipSuccess || hipDeviceGetAttribute(&cus, hipDeviceAttributeMultiprocessorCount, dev) != hipSuccess) { grid = -1; return; }
        if (hipFuncSetAttribute((const void*)hymba_fwd, hipFuncAttributeMaxDynamicSharedMemorySize, LDS_BYTES) != hipSuccess) { fprintf(stderr, "kernel_launch: hipFuncSetAttribute failed\n"); grid = -1; return; }
        if (hipOccupancyMaxActiveBlocksPerMultiprocessor(&per_cu, (const void*)hymba_fwd, 512, LDS_BYTES) != hipSuccess || per_cu < 1) fprintf(stderr, "kernel_launch: occupancy query says %d\n", per_cu);
        (void)hipGetLastError();
        grid = cus;
    }
    if (grid < 0) return;
    if (hipMemsetAsync((char*)d_ws + WS_CTL, 0, CTL_ZERO_BYTES, stream) != hipSuccess) return;
    Args a{};
    for (int i = 0; i < 24; ++i) a.in[i] = (const float*)d_in[i];
    a.out = (float*)d_out; a.ws = (unsigned char*)d_ws;
    if (MK_N_LAUNCHES == 1) { a.ph_lo = 0; a.ph_hi = N_PHASES; hipLaunchKernelGGL(hymba_fwd, dim3(grid), dim3(512), LDS_BYTES, stream, a); }
    else for (int p = 0; p < N_PHASES; ++p) { a.ph_lo = p; a.ph_hi = p + 1; hipLaunchKernelGGL(hymba_fwd, dim3(grid), dim3(512), LDS_BYTES, stream, a); }
}
```

```cpp
#include <hip/hip_runtime.h>
#include <cstdio>
#include <cstdint>

#define GAS __attribute__((address_space(1)))
#define LAS __attribute__((address_space(3)))
typedef unsigned short bf16;
typedef short bf16x8 __attribute__((ext_vector_type(8)));
typedef _Float16 f16x8 __attribute__((ext_vector_type(8)));
typedef float f32x4 __attribute__((ext_vector_type(4)));
typedef float f32x2 __attribute__((ext_vector_type(2)));
typedef unsigned u32x4 __attribute__((ext_vector_type(4)));
typedef unsigned u32x2 __attribute__((ext_vector_type(2)));

#ifndef MK_N_LAUNCHES
#define MK_N_LAUNCHES 1
#endif
constexpr int N_PHASES = 9;
#ifndef REPEAT_MASK
#define REPEAT_MASK 0
#endif

constexpr int D = 1024, NBATCH = 8, SEQ = 4096, NMETA = 16, TT = SEQ + NMETA, M = NBATCH * SEQ;
constexpr int LW = 512, INW = 1536, NE = 32, EFF = 512, NROUTE = 36;
constexpr int ECAP = 32768;
constexpr int MAXT = 288;
constexpr int MAXU = 6;
constexpr float RMS_EPS = 1e-6f;

constexpr size_t MiB = 1u << 20;
constexpr size_t WS_CTL = 0, CTL_ZERO_BYTES = 1 * MiB;
constexpr size_t WS_WIN = 2 * MiB, WS_WOUT = 5 * MiB, WS_WA = 7 * MiB, WS_WX = 7 * MiB + 65536, WS_PW = 7 * MiB + 131072, WS_WR = 7 * MiB + 262144;
constexpr size_t WS_AGG = 8 * MiB;
constexpr size_t WS_HM = 9 * MiB;
constexpr size_t WS_WGU = 10 * MiB  , WS_WD = 42 * MiB  , WS_RINFO = 58 * MiB, WS_HN1 = 74 * MiB  ;
constexpr size_t WS_PROJ = 138 * MiB  , WS_HID = 235 * MiB  , WS_C = 272 * MiB  , WS_H1 = 400 * MiB  , WS_END = 464 * MiB;
constexpr size_t WS_AB = WS_C;
constexpr float WGU_SCALE = 64.f, WD_SCALE = 32.f, HID_SCALE = 8.f, C_SCALE = 32.f;
constexpr int CW_BAR = 4096, CW_CNT = 16384;

constexpr int LDS_BYTES = 147456;
constexpr int MISC_OFF = LDS_BYTES - 256;
constexpr int TAB_OFF = 131072 + 512;
constexpr int TAB_ROW = TAB_OFF;
constexpr int TAB_F = TAB_ROW + MAXU * 256 * 4;
constexpr int TAB_TE = TAB_F + MAXU * 256 * 4;
constexpr int TAB_TR = TAB_TE + MAXT * 4;
constexpr int TAB_CNT = TAB_TR + MAXT * 4;
static_assert(TAB_CNT + 80 * 4 <= MISC_OFF, "LDS map");

__device__ __forceinline__ unsigned f2bf(float f) { unsigned u = __builtin_bit_cast(unsigned, f); return (u + 0x7fffu + ((u >> 16) & 1u)) >> 16; }
__device__ __forceinline__ unsigned pk2(float lo, float hi) { unsigned r; asm("v_cvt_pk_bf16_f32 %0, %1, %2" : "=v"(r) : "v"(lo), "v"(hi)); return r; }
__device__ __forceinline__ float bf2f(unsigned h) { return __builtin_bit_cast(float, h << 16); }
__device__ __forceinline__ float bflo(unsigned w) { return __builtin_bit_cast(float, w << 16); }
__device__ __forceinline__ float bfhi(unsigned w) { return __builtin_bit_cast(float, w & 0xffff0000u); }
__device__ __forceinline__ float sigmoidf_(float x) { return __builtin_amdgcn_rcpf(1.0f + __expf(-x)); }
#define LDS_WAIT() asm volatile("s_waitcnt lgkmcnt(0)" ::: "memory")
typedef int i32x4 __attribute__((ext_vector_type(4)));
typedef int i32x8 __attribute__((ext_vector_type(8)));
__device__ __forceinline__ float clamp448(float v) { return fminf(fmaxf(v, -448.f), 448.f); }
__device__ __forceinline__ unsigned pk4_fp8(float a, float b, float c, float d) {
    int v = __builtin_amdgcn_cvt_pk_fp8_f32(a, b, 0, false); v = __builtin_amdgcn_cvt_pk_fp8_f32(c, d, v, true); return (unsigned)v; }

#define XB_TMO      128
#define XB_XCNT(j)  (256  + 64 * (j))
#define XB_XSUB(j)  (1280 + 64 * (j))
#define XB_XGEN(j)  (2304 + 64 * (j))
#define XB_TOP      3328
#define XB_TOPGEN   3392
#define XCD_BAR_WORDS 3456
#define XB_SPIN_CAP (1u << 18)
__device__ __forceinline__ unsigned xb_ld(unsigned* p)              { return __hip_atomic_load(p, __ATOMIC_RELAXED, __HIP_MEMORY_SCOPE_AGENT); }
__device__ __forceinline__ unsigned xb_add(unsigned* p, unsigned v) { return __hip_atomic_fetch_add(p, v, __ATOMIC_RELAXED, __HIP_MEMORY_SCOPE_AGENT); }
__device__ __forceinline__ unsigned xb_xcc_id() { return (unsigned)__builtin_amdgcn_s_getreg((3 << 11) | 20) & 0xFu; }
#define XB_SPIN(cond, bar) do { unsigned _sp = 0; while (cond) { __builtin_amdgcn_s_sleep(1); \
    if ((++_sp & 255u) == 0u) { if (xb_ld(&(bar)[XB_TMO])) break; if (_sp > XB_SPIN_CAP) { atomicAdd(&(bar)[XB_TMO], 1u); break; } } } } while (0)
struct XcdBarrier { unsigned* bar; unsigned x; volatile LAS unsigned* st; };
__device__ __forceinline__ XcdBarrier xcd_barrier_post(unsigned* bar, volatile LAS unsigned* st) {
    XcdBarrier b; b.bar = bar; b.x = xb_xcc_id(); b.st = st;
    if (threadIdx.x == 0) (void)xb_add(&bar[XB_XCNT(b.x)], 1u);
    return b;
}
__device__ __forceinline__ void xcd_barrier_complete(unsigned* bar, unsigned x, unsigned& nloc, unsigned& nx) {
    const unsigned G = gridDim.x * gridDim.y * gridDim.z;
    unsigned sum, cnt, mine, sp = 0u;
    for (;;) {
        sum = 0u; cnt = 0u; mine = 0u;
#pragma unroll
        for (unsigned j = 0; j < 16; ++j) { const unsigned c = xb_ld(&bar[XB_XCNT(j)]); sum += c; cnt += (c > 0u) ? 1u : 0u; mine = (j == x) ? c : mine; }
        if (sum == G) break;
        __builtin_amdgcn_s_sleep(1);
        if ((++sp & 255u) == 0u) { if (xb_ld(&bar[XB_TMO])) break; if (sp > XB_SPIN_CAP) { atomicAdd(&bar[XB_TMO], 1u); break; } }
    }
    nloc = mine > 0u ? mine : 1u; nx = cnt > 0u ? cnt : 1u;
}
__device__ __forceinline__ void xcd_barrier(const XcdBarrier& b) {
    asm volatile("s_waitcnt vmcnt(0)" ::: "memory");
    __syncthreads();
    if (threadIdx.x == 0) {
        unsigned* bar = b.bar;
        __builtin_amdgcn_s_waitcnt(0);
        unsigned nloc = b.st[0], nx = b.st[1];
        if (nloc == 0u) { xcd_barrier_complete(bar, b.x, nloc, nx); b.st[0] = nloc; b.st[1] = nx; }
        const unsigned old = xb_add(&bar[XB_XSUB(b.x)], 1u);
        const unsigned gen = old / nloc;
        if (old + 1u == (gen + 1u) * nloc) {
            __builtin_amdgcn_fence(__ATOMIC_RELEASE, "agent");
            asm volatile("s_waitcnt vmcnt(0)" ::: "memory");
            const unsigned og = xb_add(&bar[XB_TOP], 1u);
            const unsigned tg = og / nx;
            if (og + 1u == (tg + 1u) * nx) xb_add(&bar[XB_TOPGEN], 1u);
            else XB_SPIN(xb_ld(&bar[XB_TOPGEN]) == tg, bar);
            __builtin_amdgcn_fence(__ATOMIC_ACQUIRE, "agent");
            xb_add(&bar[XB_XGEN(b.x)], 1u);
            asm volatile("s_waitcnt vmcnt(0)" ::: "memory");
        } else {
            XB_SPIN(xb_ld(&bar[XB_XGEN(b.x)]) == gen, bar);
            __builtin_amdgcn_fence(__ATOMIC_ACQUIRE, "agent");
            asm volatile("s_waitcnt vmcnt(0)" ::: "memory");
        }
    }
    __syncthreads();
}

namespace pg8 {
constexpr int BM = 256, BK = 64, HALF = 128, HTB = HALF * BK * 2, STAGE_BYTES = 8 * HTB, NXCD = 8, WGM = 8;
__host__ __device__ __forceinline__ int lds_byte(int r, int c) { const int st = (r >> 4) * 2 + (c >> 5), rr = r & 15, cc = c & 31, ob = rr * 64 + cc * 2; return st * 1024 + (ob ^ (((ob >> 9) & 1) << 5)); }
__host__ __device__ __forceinline__ void stage_rc(int b, int& R, int& C) { const int st = b / 1024, sb = b % 1024, swz = sb ^ (((sb >> 9) & 1) << 5); R = (st >> 1) * 16 + swz / 64; C = (st & 1) * 32 + (swz % 64) / 2; }
__host__ __device__ __forceinline__ int perm32(int rho) { const int n = rho >> 4, i = rho & 15; return 8 * (i >> 2) + 4 * n + (i & 3); }
struct Unit { int pm, pn; };
__device__ __forceinline__ bool static_next(int nM, int nN, int G, int c, int i, Unit& u) {
    const int nwg = nM * nN; const long L = (long)i * G + c; if (L >= nwg) return false;
    int wgid = (int)L; { const int q = nwg / NXCD, r = nwg % NXCD, xcd = wgid % NXCD, off = wgid / NXCD; wgid = (xcd < r ? xcd * (q + 1) : r * (q + 1) + (xcd - r) * q) + off; }
    const int nig = WGM * nN, gid = wgid / nig, fm = gid * WGM, gsz = (nM - fm) < WGM ? (nM - fm) : WGM;
    u.pm = fm + ((wgid % nig) % gsz); u.pn = (wgid % nig) / gsz; return true;
}
__device__ __forceinline__ unsigned cvt_pk_bf16(float lo, float hi) { unsigned r; asm volatile("v_cvt_pk_bf16_f32 %0, %1, %2" : "=v"(r) : "v"(lo), "v"(hi)); return r; }

template <class Epi, class Sched, bool FP8 = false>
__device__ __forceinline__ void gemm_phase(LAS unsigned char* lds, const int KB, const char* Abase, const Sched& S, const Epi& E) {
    const int tid = threadIdx.x, wid = __builtin_amdgcn_readfirstlane(tid >> 6), lane = tid & 63, wr = wid >> 2, wc = wid & 3, fr = lane & 15, fq = lane >> 4;
    const int nt = KB / (BK * 2);
    int Rl[2]; unsigned Cb[2], voffB[2];
#pragma unroll
    for (int i = 0; i < 2; ++i) { int R, C; stage_rc(tid * 16 + i * 8192, R, C); const int Rb = Epi::PERM ? ((R & ~31) + perm32(R & 31)) : R;
        Rl[i] = R; Cb[i] = (unsigned)C * 2u; voffB[i] = (unsigned)(Rb * KB + C * 2); }
    const size_t kstep = (size_t)(BK * 2);
    const size_t hstepB = (size_t)HALF * KB;
    const unsigned ldsw = (unsigned)wid * 1024u;
    const int aoff = lds_byte(wr * 64 + fr, fq * 8), boff = lds_byte(wc * 32 + fr, fq * 8);
#define PG8_SA(b, h) (((b) * 2 + (h)) * HTB)
#define PG8_SB(b, h) ((4 + (b) * 2 + (h)) * HTB)
#define PG8_STAGE(bufoff, gbase, voff) do { _Pragma("unroll") for (int _i = 0; _i < 2; ++_i) \
        __builtin_amdgcn_global_load_lds((const unsigned*)((const char*)(gbase) + (voff)[_i]), (LAS unsigned*)(lds + (bufoff) + ldsw + _i * 8192), 16, 0, 0); } while (0)
#define PG8_LD32(p) __builtin_shufflevector(*(const LAS i32x4*)(p), *(const LAS i32x4*)((p) + 1024), 0, 1, 2, 3, 4, 5, 6, 7)
#define PG8_LDA(dst, b, h) do { _Pragma("unroll") for (int m = 0; m < 4; ++m) dst[m] = PG8_LD32(lds + PG8_SA(b, h) + aoff + m * 2048); } while (0)
#define PG8_LDB(dst, b, h) do { _Pragma("unroll") for (int n = 0; n < 2; ++n) dst[n] = PG8_LD32(lds + PG8_SB(b, h) + boff + n * 2048); } while (0)
#define PG8_LO(v) __builtin_bit_cast(bf16x8, __builtin_shufflevector((v), (v), 0, 1, 2, 3))
#define PG8_HI(v) __builtin_bit_cast(bf16x8, __builtin_shufflevector((v), (v), 4, 5, 6, 7))
#define PG8_MMA(ai, bj, At, Bt) do { __builtin_amdgcn_s_setprio(1); _Pragma("unroll") for (int m = 0; m < 4; ++m) _Pragma("unroll") for (int n = 0; n < 2; ++n) { \
        if constexpr (FP8) asm volatile("v_mfma_f32_16x16x128_f8f6f4 %0, %1, %2, %0" : "+v"(acc[ai][bj][m][n]) : "v"(Bt[n]), "v"(At[m])); \
        else { acc[ai][bj][m][n] = __builtin_amdgcn_mfma_f32_16x16x32_bf16(PG8_LO(Bt[n]), PG8_LO(At[m]), acc[ai][bj][m][n], 0, 0, 0); \
               acc[ai][bj][m][n] = __builtin_amdgcn_mfma_f32_16x16x32_bf16(PG8_HI(Bt[n]), PG8_HI(At[m]), acc[ai][bj][m][n], 0, 0, 0); } } \
        __builtin_amdgcn_s_setprio(0); } while (0)
#define PG8_WAIT_V(n) asm volatile("s_waitcnt vmcnt(" #n ")" ::: "memory")
#define PG8_WAIT_L(n) asm volatile("s_waitcnt lgkmcnt(" #n ")" ::: "memory")
#define PG8_BAR __builtin_amdgcn_s_barrier()
#define PG8_SCHED __builtin_amdgcn_sched_barrier(0)
    Unit cur, nxt; int ui = 0;
    if (!S.next(0, cur)) return;
    f32x4 acc[2][2][4][2];
#pragma unroll
    for (int a = 0; a < 2; ++a)
#pragma unroll
        for (int b = 0; b < 2; ++b)
#pragma unroll
            for (int m = 0; m < 4; ++m)
#pragma unroll
                for (int n = 0; n < 2; ++n) acc[a][b][m][n] = (f32x4){0.f, 0.f, 0.f, 0.f};
    i32x8 At[4], B0[2], B1[2];
    unsigned cO0[2], cO1[2], nO0[2], nO1[2];
#pragma unroll
    for (int i = 0; i < 2; ++i) { cO0[i] = S.a_off(0, cur, Rl[i]) + Cb[i]; cO1[i] = S.a_off(0, cur, HALF + Rl[i]) + Cb[i]; }
    const char* cB = S.b_base(cur);
    PG8_STAGE(PG8_SB(0, 0), cB, voffB); PG8_STAGE(PG8_SB(0, 1), cB + hstepB, voffB); PG8_STAGE(PG8_SA(0, 0), Abase, cO0); PG8_STAGE(PG8_SA(0, 1), Abase, cO1);
    if (wr == 1) PG8_BAR;
    PG8_WAIT_V(2); PG8_BAR;
    PG8_STAGE(PG8_SB(1, 0), cB + kstep, voffB); PG8_STAGE(PG8_SA(1, 0), Abase + kstep, cO0); PG8_STAGE(PG8_SB(1, 1), cB + hstepB + kstep, voffB);
    PG8_WAIT_V(6); PG8_BAR;
    for (;;) {
        const bool has_next = S.next(ui + 1, nxt);
        const char* nB = cB;
#pragma unroll
        for (int i = 0; i < 2; ++i) { nO0[i] = cO0[i]; nO1[i] = cO1[i]; }
        if (has_next) { nB = S.b_base(nxt);
#pragma unroll
            for (int i = 0; i < 2; ++i) { nO0[i] = S.a_off(ui + 1, nxt, Rl[i]) + Cb[i]; nO1[i] = S.a_off(ui + 1, nxt, HALF + Rl[i]) + Cb[i]; } }
#pragma nounroll
        for (int t = 0; t < nt; t += 2) {
            const bool last = (t == nt - 2);
            const char* a1 = Abase + (size_t)(t + 1) * kstep;
            const char* a2 = last ? Abase : Abase + (size_t)(t + 2) * kstep; const char* b2 = last ? nB : cB + (size_t)(t + 2) * kstep;
            const char* a3 = a2 + kstep; const char* b3 = b2 + kstep;
            unsigned o0[2], o1[2];
#pragma unroll
            for (int i = 0; i < 2; ++i) { o0[i] = last ? nO0[i] : cO0[i]; o1[i] = last ? nO1[i] : cO1[i]; }
            PG8_LDB(B0, 0, 0); PG8_LDB(B1, 0, 1); PG8_SCHED; PG8_LDA(At, 0, 0); PG8_STAGE(PG8_SA(1, 1), a1, cO1);
            PG8_WAIT_V(8); PG8_WAIT_L(0); PG8_BAR; PG8_MMA(0, 0, At, B0); PG8_MMA(0, 1, At, B1); PG8_BAR; PG8_SCHED;
            PG8_LDA(At, 0, 1); PG8_STAGE(PG8_SB(0, 0), b2, voffB); PG8_STAGE(PG8_SB(0, 1), b2 + hstepB, voffB); PG8_STAGE(PG8_SA(0, 0), a2, o0);
            PG8_WAIT_V(8); PG8_WAIT_L(0); PG8_BAR; PG8_MMA(1, 0, At, B0); PG8_MMA(1, 1, At, B1); PG8_BAR; PG8_SCHED;
            PG8_LDB(B0, 1, 0); PG8_LDB(B1, 1, 1); PG8_SCHED; PG8_LDA(At, 1, 0); PG8_STAGE(PG8_SA(0, 1), a2, o1);
            PG8_WAIT_V(8); PG8_WAIT_L(0); PG8_BAR; PG8_MMA(0, 0, At, B0); PG8_MMA(0, 1, At, B1); PG8_BAR; PG8_SCHED;
            PG8_LDA(At, 1, 1); PG8_STAGE(PG8_SB(1, 0), b3, voffB); PG8_STAGE(PG8_SB(1, 1), b3 + hstepB, voffB); PG8_STAGE(PG8_SA(1, 0), a3, o0);
            PG8_WAIT_V(8); PG8_WAIT_L(0); PG8_BAR; PG8_MMA(1, 0, At, B0); PG8_MMA(1, 1, At, B1); PG8_BAR; PG8_SCHED;
        }
        if (wr == 0) PG8_BAR;
        if constexpr (FP8) asm volatile("s_nop 15\n\ts_nop 15" ::: "memory");
        E(acc, cur, ui, wr, wc, fr, fq);
        if (!has_next) break;
#pragma unroll
        for (int a = 0; a < 2; ++a)
#pragma unroll
            for (int b = 0; b < 2; ++b)
#pragma unroll
                for (int m = 0; m < 4; ++m)
#pragma unroll
                    for (int n = 0; n < 2; ++n) acc[a][b][m][n] = (f32x4){0.f, 0.f, 0.f, 0.f};
        cur = nxt; cB = nB; ++ui;
#pragma unroll
        for (int i = 0; i < 2; ++i) { cO0[i] = nO0[i]; cO1[i] = nO1[i]; }
        if (wr == 1) PG8_BAR;
    }
    PG8_WAIT_V(0);
    PG8_BAR;
#undef PG8_SA
#undef PG8_SB
#undef PG8_STAGE
#undef PG8_LDA
#undef PG8_LDB
#undef PG8_MMA
#undef PG8_LO
#undef PG8_HI
#undef PG8_LD32
#undef PG8_WAIT_V
#undef PG8_WAIT_L
#undef PG8_BAR
#undef PG8_SCHED
}

struct DenseSched {
    int nM, nN, G, c, K2; const char* B; int reps;
    __device__ __forceinline__ bool next(int i, Unit& u) const { const int rounds = (nM * nN + G - 1) / G; if (i >= rounds * reps) return false; return static_next(nM, nN, G, c, i % rounds, u); }
    __device__ __forceinline__ const char* b_base(const Unit& u) const { return B + (size_t)u.pn * BM * K2; }
    __device__ __forceinline__ unsigned a_off(int, const Unit& u, int r) const { return (unsigned)(u.pm * BM + r) * (unsigned)K2; }
};
struct MoeSched {
    int NT, nN, G, c, K2; const char* B; size_t estride; bool gather;
    const LAS int* tile_e; const LAS unsigned* rowtab; int reps;
    __device__ __forceinline__ int rounds() const { return (NT * nN + G - 1) / G; }
    __device__ __forceinline__ bool next(int i, Unit& u) const { const int r = rounds(); if (i >= r * reps) return false; return static_next(NT, nN, G, c, i % r, u); }
    __device__ __forceinline__ const char* b_base(const Unit& u) const { return B + (size_t)tile_e[u.pm] * estride + (size_t)u.pn * BM * K2; }
    __device__ __forceinline__ unsigned a_off(int ui, const Unit& u, int r) const { return gather ? rowtab[(ui % rounds()) * 256 + r] : (unsigned)(u.pm * BM + r) * (unsigned)K2; }
};

struct EpiProj {
    static constexpr bool PERM = true;
    bf16* O;
    __device__ __forceinline__ void operator()(const f32x4 (&acc)[2][2][4][2], const Unit& u, int, int wr, int wc, int fr, int fq) const {
        const int row0 = u.pm * BM + 16 * ((u.pm >> 4) + 1) + wr * 64 + fr, col0 = u.pn * BM + wc * 32 + 8 * fq;
#pragma unroll
        for (int ai = 0; ai < 2; ++ai)
#pragma unroll
            for (int m = 0; m < 4; ++m) { bf16* rowp = O + (size_t)(row0 + ai * HALF + m * 16) * INW + col0;
#pragma unroll
                for (int bj = 0; bj < 2; ++bj) { const f32x4 v0 = acc[ai][bj][m][0], v1 = acc[ai][bj][m][1];
                    u32x4 w; w.x = cvt_pk_bf16(v0[0], v0[1]); w.y = cvt_pk_bf16(v0[2], v0[3]); w.z = cvt_pk_bf16(v1[0], v1[1]); w.w = cvt_pk_bf16(v1[2], v1[3]);
                    *(u32x4*)(rowp + bj * HALF) = w; } }
    }
};
struct EpiResid {
    static constexpr bool PERM = true;
    const float* X; const float* G2; bf16* H1; unsigned char* HN2;
    __device__ __forceinline__ void operator()(const f32x4 (&acc)[2][2][4][2], const Unit& u, int, int wr, int wc, int fr, int fq) const {
        const int row0 = u.pm * BM + wr * 64 + fr, col0 = u.pn * BM + wc * 32 + 8 * fq;
        f32x4 gv[2][2];
#pragma unroll
        for (int bj = 0; bj < 2; ++bj)
#pragma unroll
            for (int n = 0; n < 2; ++n) gv[bj][n] = *(const f32x4*)(G2 + col0 + bj * HALF + 4 * n);
#pragma unroll
        for (int ai = 0; ai < 2; ++ai) {
#pragma unroll
            for (int m = 0; m < 4; ++m) { const size_t off = (size_t)(row0 + ai * HALF + m * 16) * D + col0;
#pragma unroll
                for (int bj = 0; bj < 2; ++bj) { const f32x4 v0 = acc[ai][bj][m][0] + *(const f32x4*)(X + off + bj * HALF), v1 = acc[ai][bj][m][1] + *(const f32x4*)(X + off + bj * HALF + 4);
                    u32x4 w; w.x = cvt_pk_bf16(v0[0], v0[1]); w.y = cvt_pk_bf16(v0[2], v0[3]); w.z = cvt_pk_bf16(v1[0], v1[1]); w.w = cvt_pk_bf16(v1[2], v1[3]);
                    *(u32x4*)(H1 + off + bj * HALF) = w;
                    const f32x4 t0 = v0 * gv[bj][0], t1 = v1 * gv[bj][1];
                    u32x2 e; e.x = pk4_fp8(clamp448(t0[0]), clamp448(t0[1]), clamp448(t0[2]), clamp448(t0[3])); e.y = pk4_fp8(clamp448(t1[0]), clamp448(t1[1]), clamp448(t1[2]), clamp448(t1[3]));
                    *(u32x2*)(HN2 + off + bj * HALF) = e; } }
            asm volatile("" ::: "memory"); }
    }
};
struct EpiGateUp {
    static constexpr bool PERM = true;
    unsigned char* H; const LAS float* rstd; int rounds;
    __device__ __forceinline__ void operator()(const f32x4 (&acc)[2][2][4][2], const Unit& u, int ui_, int wr, int wc, int fr, int fq) const {
        const int ui = ui_ % rounds;
        const int r0 = wr * 64 + fr, col0 = u.pn * HALF + wc * 32 + 8 * fq;
#pragma unroll
        for (int ai = 0; ai < 2; ++ai)
#pragma unroll
            for (int m = 0; m < 4; ++m) { const int r = r0 + ai * HALF + m * 16; const float rs = rstd[ui * 256 + r];
                float h[8];
#pragma unroll
                for (int n = 0; n < 2; ++n)
#pragma unroll
                    for (int j = 0; j < 4; ++j) { const float g = acc[ai][0][m][n][j] * rs, up = acc[ai][1][m][n][j] * rs; h[n * 4 + j] = g * sigmoidf_(g) * up; }
#pragma unroll
                for (int j = 0; j < 8; ++j) h[j] = clamp448(h[j] * HID_SCALE);
                u32x2 w; w.x = pk4_fp8(h[0], h[1], h[2], h[3]); w.y = pk4_fp8(h[4], h[5], h[6], h[7]);
                *(u32x2*)(H + (size_t)(u.pm * BM + r) * EFF + col0) = w; }
    }
};
struct EpiDown {
    static constexpr bool PERM = true;
    unsigned char* C; const LAS int* slot; const LAS float* gate; int rounds;
    __device__ __forceinline__ void operator()(const f32x4 (&acc)[2][2][4][2], const Unit& u, int ui_, int wr, int wc, int fr, int fq) const {
        const int ui = ui_ % rounds;
        const int r0 = wr * 64 + fr, col0 = u.pn * BM + wc * 32 + 8 * fq;
#pragma unroll
        for (int ai = 0; ai < 2; ++ai)
#pragma unroll
            for (int m = 0; m < 4; ++m) { const int r = r0 + ai * HALF + m * 16; const int sl = slot[ui * 256 + r]; const float gt = gate[ui * 256 + r];
                if (sl >= 0) { unsigned char* rowp = C + (size_t)sl * D + col0;
#pragma unroll
                    for (int bj = 0; bj < 2; ++bj) { const f32x4 v0 = acc[ai][bj][m][0] * gt, v1 = acc[ai][bj][m][1] * gt;
                        u32x2 w; w.x = pk4_fp8(clamp448(v0[0]), clamp448(v0[1]), clamp448(v0[2]), clamp448(v0[3])); w.y = pk4_fp8(clamp448(v1[0]), clamp448(v1[1]), clamp448(v1[2]), clamp448(v1[3]));
                        *(u32x2*)(rowp + bj * HALF) = w; } } }
    }
};
}

struct Frame {
    LAS unsigned char* lds; int tid, lane, wave, G, bx;
    const float *x, *meta, *g1, *w_in, *conv_w, *conv_b, *wa, *ba, *wx, *bx_, *lam, *lru_gain, *pool_w, *pool_scale, *w_out, *g2, *w_group, *b_group, *w_router, *b_router, *w_gate, *w_up, *w_down, *final_gain;
    float* out; unsigned char* ws; unsigned* ctl;
    bf16 *WinT, *WoutT, *WaT, *WxT, *PwT, *HN1, *YMIX, *PROJ, *H1; unsigned char *WguT, *WdT, *HN2, *HID, *C;
    _Float16* WrH; float* AGG; float* HM; f32x4* AB; f32x4* RINFO;
};
__device__ __forceinline__ float wave_sum(float v) {
#pragma unroll
    for (int o = 1; o < 64; o <<= 1) v += __shfl_xor(v, o);
    return v;
}

__device__ __forceinline__ void transpose_tile(const float* W, int ldw, int k0, int n0, bf16* WT, int ldt, int drow0, LAS float* scr, int lane) {
    { float v[32];
#pragma unroll
      for (int i = 0; i < 32; ++i) v[i] = W[(size_t)(k0 + 2 * i + (lane >> 5)) * ldw + n0 + (lane & 31)];
#pragma unroll
      for (int i = 0; i < 32; ++i) scr[(2 * i + (lane >> 5)) * 33 + (lane & 31)] = v[i]; }
    LDS_WAIT(); asm volatile("" ::: "memory");
    const int c = lane & 7;
#pragma unroll
    for (int j = 0; j < 4; ++j) { const int n = (lane >> 3) + 8 * j; const LAS float* s = scr + (8 * c) * 33 + n;
        u32x4 o; o.x = pk2(s[0 * 33], s[1 * 33]); o.y = pk2(s[2 * 33], s[3 * 33]); o.z = pk2(s[4 * 33], s[5 * 33]); o.w = pk2(s[6 * 33], s[7 * 33]);
        *(u32x4*)(WT + (size_t)(drow0 + n) * ldt + k0 + 8 * c) = o; }
    LDS_WAIT(); asm volatile("" ::: "memory");
}
__device__ __forceinline__ void transpose_tile_fp8(const float* W, int ldw, int k0, int n0, unsigned char* WT, int ldt, int drow0, float scale, LAS float* scr, int lane) {
    { float v[64];
#pragma unroll
      for (int i = 0; i < 64; ++i) v[i] = W[(size_t)(k0 + 2 * i + (lane >> 5)) * ldw + n0 + (lane & 31)];
#pragma unroll
      for (int i = 0; i < 64; ++i) scr[(2 * i + (lane >> 5)) * 33 + (lane & 31)] = v[i]; }
    LDS_WAIT(); asm volatile("" ::: "memory");
    const int n = lane >> 1, kh = (lane & 1) * 64; const LAS float* sp = scr + kh * 33 + n;
#pragma unroll
    for (int c = 0; c < 4; ++c) { u32x4 o;
#pragma unroll
        for (int w = 0; w < 4; ++w) { const LAS float* q4 = sp + (16 * c + 4 * w) * 33; o[w] = pk4_fp8(q4[0] * scale, q4[33] * scale, q4[66] * scale, q4[99] * scale); }
        *(u32x4*)(WT + (size_t)(drow0 + n) * ldt + k0 + kh + 16 * c) = o; }
    LDS_WAIT(); asm volatile("" ::: "memory");
}
__device__ __forceinline__ void p0_prologue(Frame& F) {
    if (F.bx < INW / 8) {
        LAS float* hnm = (LAS float*)F.lds;
        LAS float* part = (LAS float*)(F.lds + 65536);
        for (int r = F.wave * 2; r < F.wave * 2 + 2; ++r) {
            const f32x4* xr = (const f32x4*)(F.meta + (size_t)r * D) + F.lane; f32x4 v[4]; float s = 0.f;
#pragma unroll
            for (int j = 0; j < 4; ++j) { v[j] = xr[64 * j]; s += (v[j].x * v[j].x + v[j].y * v[j].y) + (v[j].z * v[j].z + v[j].w * v[j].w); }
            const float rstd = rsqrtf(wave_sum(s) * (1.f / D) + RMS_EPS);
#pragma unroll
            for (int j = 0; j < 4; ++j) { const f32x4 g = ((const f32x4*)F.g1)[F.lane + 64 * j]; *(LAS f32x4*)(hnm + r * D + 4 * F.lane + 256 * j) = v[j] * rstd * g; }
        }
        __syncthreads();
        { const int cc = F.tid & 7, ks = F.tid >> 3, col = F.bx * 8 + cc; float a[16];
#pragma unroll
            for (int r = 0; r < 16; ++r) a[r] = 0.f;
            for (int k = ks * 16; k < ks * 16 + 16; ++k) { const float w = F.w_in[(size_t)k * INW + col];
#pragma unroll
                for (int r = 0; r < 16; ++r) a[r] += hnm[r * D + k] * w; }
#pragma unroll
            for (int r = 0; r < 16; ++r) part[(ks * 16 + r) * 8 + cc] = a[r]; }
        __syncthreads();
        if (F.tid < 128) { const int r = F.tid >> 3, cc = F.tid & 7; float s = 0.f;
            for (int ks = 0; ks < 64; ++ks) s += part[(ks * 16 + r) * 8 + cc];
            const bf16 h = (bf16)f2bf(s);
            for (int b = 0; b < NBATCH; ++b) F.PROJ[(size_t)(b * TT + r) * INW + F.bx * 8 + cc] = h; }
        __syncthreads();
    }
    LAS float* scr = (LAS float*)(F.lds + F.wave * 16896);
    const int gw = F.bx * 8 + F.wave, NGW = F.G * 8;
    constexpr int I_IN = 16 * 48, I_OUT = 16 * 32, I_G = NE * 8 * 16, I_D = NE * 4 * 32, I_A = 8 * 2, I_P = 4 * 2 * 4;
    constexpr int NITEMS = I_IN + I_OUT + 2 * I_G + I_D + 2 * I_A + I_P;
    for (int it = gw; it < NITEMS; it += NGW) {
        int r = it;
        if (r < I_IN) { const int kb = r / 48, nb = r % 48; transpose_tile(F.w_in, INW, 64 * kb, 32 * nb, F.WinT, D, 32 * nb, scr, F.lane); continue; } r -= I_IN;
        if (r < I_OUT) { const int kb = r / 32, nb = r % 32; transpose_tile(F.w_out, D, 64 * kb, 32 * nb, F.WoutT, D, 32 * nb, scr, F.lane); continue; } r -= I_OUT;
        if (r < 2 * I_G) { const int up = r >= I_G; if (up) r -= I_G; const int e = r >> 7, kb = (r >> 4) & 7, nb = r & 15, n0 = 32 * nb;
            transpose_tile_fp8((up ? F.w_up : F.w_gate) + (size_t)e * D * EFF, EFF, 128 * kb, n0, F.WguT + (size_t)e * 1024 * D, D, (n0 >> 7) * 256 + up * 128 + (n0 & 127), WGU_SCALE, scr, F.lane); continue; } r -= 2 * I_G;
        if (r < I_D) { const int e = r >> 7, kb = (r >> 5) & 3, nb = r & 31; transpose_tile_fp8(F.w_down + (size_t)e * EFF * D, D, 128 * kb, 32 * nb, F.WdT + (size_t)e * D * EFF, EFF, 32 * nb, WD_SCALE, scr, F.lane); continue; } r -= I_D;
        if (r < 2 * I_A) { const int x = r >= I_A; if (x) r -= I_A; const int h = r >> 1, nb = r & 1; transpose_tile((x ? F.wx : F.wa) + (size_t)h * 4096, 64, 0, 32 * nb, (x ? F.WxT : F.WaT) + (size_t)h * 4096, 64, 32 * nb, scr, F.lane); continue; } r -= 2 * I_A;
        { const int g = r >> 3, kb = (r >> 2) & 1, nb = r & 3; transpose_tile(F.pool_w + (size_t)g * 16384, 128, 64 * kb, 32 * nb, F.PwT + (size_t)g * 16384, 128, 32 * nb, scr, F.lane); }
    }
    for (int i = F.bx * 512 + F.tid; i < NROUTE * D; i += F.G * 512) { const int n = i >> 10, k = i & 1023;
        const float w = n < 4 ? F.w_group[k * 4 + n] : F.w_router[k * 32 + (n - 4)]; F.WrH[i] = (_Float16)(w * 256.0f); }
    { f32x4 g[4];
#pragma unroll
      for (int j = 0; j < 4; ++j) g[j] = ((const f32x4*)F.g1)[F.lane + 64 * j];
      for (int m = gw * 4; m < M; m += NGW * 4) {
        f32x4 v[4][4];
#pragma unroll
        for (int r = 0; r < 4; ++r)
#pragma unroll
            for (int j = 0; j < 4; ++j) v[r][j] = ((const f32x4*)(F.x + (size_t)(m + r) * D))[F.lane + 64 * j];
#pragma unroll
        for (int r = 0; r < 4; ++r) { float s = 0.f;
#pragma unroll
            for (int j = 0; j < 4; ++j) s += (v[r][j].x * v[r][j].x + v[r][j].y * v[r][j].y) + (v[r][j].z * v[r][j].z + v[r][j].w * v[r][j].w);
            const float rstd = rsqrtf(wave_sum(s) * (1.f / D) + RMS_EPS);
            u32x2* o8 = (u32x2*)(F.HN1 + (size_t)(m + r) * D) + F.lane;
#pragma unroll
            for (int j = 0; j < 4; ++j) { const f32x4 y = v[r][j] * rstd * g[j]; u32x2 w; w.x = pk2(y.x, y.y); w.y = pk2(y.z, y.w); o8[64 * j] = w; } }
      } }
}

template <int CTRL> __device__ __forceinline__ float dpp_f(float old, float src) {
    return __builtin_bit_cast(float, __builtin_amdgcn_update_dpp(__builtin_bit_cast(int, old), __builtin_bit_cast(int, src), CTRL, 0xf, 0xf, false)); }
#define DPP_BCAST15 0x15F
__device__ __forceinline__ void row_scan(float& A, float& B) {
    { const float Ap = dpp_f<0x111>(1.0f, A), Bp = dpp_f<0x111>(0.0f, B); B = A * Bp + B; A = A * Ap; }
    { const float Ap = dpp_f<0x112>(1.0f, A), Bp = dpp_f<0x112>(0.0f, B); B = A * Bp + B; A = A * Ap; }
    { const float Ap = dpp_f<0x114>(1.0f, A), Bp = dpp_f<0x114>(0.0f, B); B = A * Bp + B; A = A * Ap; }
    { const float Ap = dpp_f<0x118>(1.0f, A), Bp = dpp_f<0x118>(0.0f, B); B = A * Bp + B; A = A * Ap; }
}
#define SCAN8_STR(D) "s_nop 1\n\t" \
    "v_fmac_f32_dpp %0, %0, %8 row_shr:" #D " row_mask:0xf bank_mask:0xf\n\tv_mul_f32_dpp %8, %8, %8 row_shr:" #D " row_mask:0xf bank_mask:0xf\n\t" \
    "v_fmac_f32_dpp %1, %1, %9 row_shr:" #D " row_mask:0xf bank_mask:0xf\n\tv_mul_f32_dpp %9, %9, %9 row_shr:" #D " row_mask:0xf bank_mask:0xf\n\t" \
    "v_fmac_f32_dpp %2, %2, %10 row_shr:" #D " row_mask:0xf bank_mask:0xf\n\tv_mul_f32_dpp %10, %10, %10 row_shr:" #D " row_mask:0xf bank_mask:0xf\n\t" \
    "v_fmac_f32_dpp %3, %3, %11 row_shr:" #D " row_mask:0xf bank_mask:0xf\n\tv_mul_f32_dpp %11, %11, %11 row_shr:" #D " row_mask:0xf bank_mask:0xf\n\t" \
    "v_fmac_f32_dpp %4, %4, %12 row_shr:" #D " row_mask:0xf bank_mask:0xf\n\tv_mul_f32_dpp %12, %12, %12 row_shr:" #D " row_mask:0xf bank_mask:0xf\n\t" \
    "v_fmac_f32_dpp %5, %5, %13 row_shr:" #D " row_mask:0xf bank_mask:0xf\n\tv_mul_f32_dpp %13, %13, %13 row_shr:" #D " row_mask:0xf bank_mask:0xf\n\t" \
    "v_fmac_f32_dpp %6, %6, %14 row_shr:" #D " row_mask:0xf bank_mask:0xf\n\tv_mul_f32_dpp %14, %14, %14 row_shr:" #D " row_mask:0xf bank_mask:0xf\n\t" \
    "v_fmac_f32_dpp %7, %7, %15 row_shr:" #D " row_mask:0xf bank_mask:0xf\n\tv_mul_f32_dpp %15, %15, %15 row_shr:" #D " row_mask:0xf bank_mask:0xf"
#define SCAN8(D, A, B, o) asm volatile(SCAN8_STR(D) : "+v"(B[o + 0]), "+v"(B[o + 1]), "+v"(B[o + 2]), "+v"(B[o + 3]), "+v"(B[o + 4]), "+v"(B[o + 5]), "+v"(B[o + 6]), "+v"(B[o + 7]), \
    "+v"(A[o + 0]), "+v"(A[o + 1]), "+v"(A[o + 2]), "+v"(A[o + 3]), "+v"(A[o + 4]), "+v"(A[o + 5]), "+v"(A[o + 6]), "+v"(A[o + 7]))
__device__ __forceinline__ void row_scan16(float (&A)[16], float (&B)[16]) {
    SCAN8(1, A, B, 0); SCAN8(1, A, B, 8); SCAN8(2, A, B, 0); SCAN8(2, A, B, 8); SCAN8(4, A, B, 0); SCAN8(4, A, B, 8); SCAN8(8, A, B, 0); SCAN8(8, A, B, 8);
}
struct LruW { LAS float* cst; const bf16 *waP, *wxP; };
__device__ __forceinline__ void lru_setup(const Frame& F, LruW& L, LAS unsigned char* wbase) {
    const int hd = F.wave; L.cst = (LAS float*)wbase;
    for (int i = F.lane; i < 512; i += 64) { const int t = i >> 6, ch = hd * 64 + (i & 63); float v;
        if (t < 4) v = F.conv_w[t * LW + ch]; else if (t == 4) v = F.conv_b[ch]; else if (t == 5) v = F.ba[ch]; else if (t == 6) v = F.bx_[ch];
        else { const float lm = F.lam[ch]; v = 8.0f * (fminf(lm, 0.f) - log1pf(__expf(-fabsf(lm)))); }
        L.cst[i] = v; }
    const int i = F.lane & 15, qw = F.lane >> 4; const size_t o = (size_t)hd * 4096 + (size_t)(8 * (i >> 2) + (i & 3)) * 64 + 8 * qw;
    L.waP = F.WaT + o; L.wxP = F.WxT + o;
    LDS_WAIT();
}
struct LruRaw { u32x4 u[2][4]; u32x4 ug[2]; };
template <bool WITH_UG>
__device__ __forceinline__ void lru_load(const Frame& F, int b, int tt0, LruRaw& R) {
    const int hd = F.wave, row = F.lane & 15, q = F.lane >> 4, tt = tt0 + row;
    const bf16* prow = F.PROJ + (size_t)(b * TT + tt) * INW + hd * 64 + 8 * q;
#pragma unroll
    for (int kb = 0; kb < 2; ++kb) {
#pragma unroll
        for (int k = 0; k < 4; ++k) { R.u[kb][k] = (u32x4){0u, 0u, 0u, 0u}; if (tt - 3 + k >= 0) R.u[kb][k] = *(const u32x4*)(prow + (ptrdiff_t)(k - 3) * INW + 32 * kb); }
        if (WITH_UG) R.ug[kb] = *(const u32x4*)(prow + LW + 32 * kb);
    }
}
__device__ __forceinline__ void lru_conv(const Frame& F, const LruW& L, const LruRaw& R, float (&xc)[16], bf16x8 (&xf)[2]) {
    const int q = F.lane >> 4;
#pragma unroll
    for (int kb = 0; kb < 2; ++kb) {
        const LAS float* cs = L.cst + 32 * kb + 8 * q;
        f32x2 x2[4];
        { const f32x4 c0 = *(const LAS f32x4*)(cs + 256), c1 = *(const LAS f32x4*)(cs + 260); x2[0] = (f32x2){c0.x, c0.y}; x2[1] = (f32x2){c0.z, c0.w}; x2[2] = (f32x2){c1.x, c1.y}; x2[3] = (f32x2){c1.z, c1.w}; }
#pragma unroll
        for (int k = 0; k < 4; ++k) {
            const u32x4 u = R.u[kb][k];
            const f32x4 w0 = *(const LAS f32x4*)(cs + 64 * k), w1 = *(const LAS f32x4*)(cs + 64 * k + 4);
            x2[0] = (f32x2){w0.x, w0.y} * (f32x2){bflo(u.x), bfhi(u.x)} + x2[0]; x2[1] = (f32x2){w0.z, w0.w} * (f32x2){bflo(u.y), bfhi(u.y)} + x2[1];
            x2[2] = (f32x2){w1.x, w1.y} * (f32x2){bflo(u.z), bfhi(u.z)} + x2[2]; x2[3] = (f32x2){w1.z, w1.w} * (f32x2){bflo(u.w), bfhi(u.w)} + x2[3];
        }
#pragma unroll
        for (int i = 0; i < 4; ++i) { xc[8 * kb + 2 * i] = x2[i].x; xc[8 * kb + 2 * i + 1] = x2[i].y; }
        asm volatile("" : "+v"(xc[8 * kb + 0]), "+v"(xc[8 * kb + 1]), "+v"(xc[8 * kb + 2]), "+v"(xc[8 * kb + 3]), "+v"(xc[8 * kb + 4]), "+v"(xc[8 * kb + 5]), "+v"(xc[8 * kb + 6]), "+v"(xc[8 * kb + 7]));
        u32x4 p; p.x = pk2(xc[8 * kb + 0], xc[8 * kb + 1]); p.y = pk2(xc[8 * kb + 2], xc[8 * kb + 3]); p.z = pk2(xc[8 * kb + 4], xc[8 * kb + 5]); p.w = pk2(xc[8 * kb + 6], xc[8 * kb + 7]);
        xf[kb] = __builtin_bit_cast(bf16x8, p);
    }
}
template <bool WPF  >
__device__ __forceinline__ void lru_gates(const Frame& F, const LruW& L, const float (&xc)[16], const bf16x8 (&xf)[2], float (&Av)[16], float (&Bv)[16]) {
    const int q = F.lane >> 4;
    bf16x8 wa[2], wx[2];
#pragma unroll
    for (int kk = 0; kk < 2; ++kk) { wa[kk] = *(const bf16x8*)(L.waP + 32 * kk); wx[kk] = *(const bf16x8*)(L.wxP + 32 * kk); }
#pragma unroll
    for (int nb = 0; nb < 4; ++nb) {
        const int kb = nb >> 1, hf = nb & 1;
        bf16x8 wan[2], wxn[2];
        if (!WPF && nb > 0) { const int o = (32 * kb + 4 * hf) * 64;
#pragma unroll
            for (int kk = 0; kk < 2; ++kk) { wa[kk] = *(const bf16x8*)(L.waP + o + 32 * kk); wx[kk] = *(const bf16x8*)(L.wxP + o + 32 * kk); } }
        if (WPF && nb < 3) { const int o = (32 * ((nb + 1) >> 1) + 4 * ((nb + 1) & 1)) * 64;
#pragma unroll
            for (int kk = 0; kk < 2; ++kk) { wan[kk] = *(const bf16x8*)(L.waP + o + 32 * kk); wxn[kk] = *(const bf16x8*)(L.wxP + o + 32 * kk); } }
        asm volatile("" ::: "memory");
        f32x4 ra = (f32x4){0.f, 0.f, 0.f, 0.f}, rx = ra;
#pragma unroll
        for (int kk = 0; kk < 2; ++kk) { ra = __builtin_amdgcn_mfma_f32_16x16x32_bf16(wa[kk], xf[kk], ra, 0, 0, 0); rx = __builtin_amdgcn_mfma_f32_16x16x32_bf16(wx[kk], xf[kk], rx, 0, 0, 0); }
        const LAS float* cs = L.cst + 32 * kb + 8 * q + 4 * hf;
        const f32x4 ba4 = *(const LAS f32x4*)(cs + 320), bx4 = *(const LAS f32x4*)(cs + 384), lm4 = *(const LAS f32x4*)(cs + 448);
#pragma unroll
        for (int j = 0; j < 4; ++j) { const int c = 8 * kb + 4 * hf + j;
            const float r = sigmoidf_(ra[j] + ba4[j]), ig = sigmoidf_(rx[j] + bx4[j]);
            const float a = __expf(lm4[j] * r);
            Av[c] = a; Bv[c] = __builtin_amdgcn_sqrtf(fmaf(-a, a, 1.0f)) * (ig * xc[c]); }
        if (WPF && nb < 3) {
#pragma unroll
            for (int kk = 0; kk < 2; ++kk) { wa[kk] = wan[kk]; wx[kk] = wxn[kk]; } }
    }
    row_scan16(Av, Bv);
}
__device__ __forceinline__ void p2_aggregates(Frame& F) {
    LruW L; lru_setup(F, L, F.lds + F.wave * 2048);
    const int row = F.lane & 15, q = F.lane >> 4;
    for (int ch = F.bx; ch < 256; ch += F.G) {
        const int b = ch >> 5, ci = ch & 31; float Ac[16], Bc[16];
#pragma unroll
        for (int c = 0; c < 16; ++c) { Ac[c] = 1.f; Bc[c] = 0.f; }
        const int blk0 = (ci == 0 ? -1 : 0);
        LruRaw R; lru_load<false>(F, b, NMETA + 128 * ci + 16 * blk0, R);
        for (int blk = blk0; blk < 8; ++blk) {
            float xc[16]; bf16x8 xf[2]; lru_conv(F, L, R, xc, xf);
            if (blk < 7) lru_load<false>(F, b, NMETA + 128 * ci + 16 * (blk + 1), R);
            asm volatile("" ::: "memory");
            float Av[16], Bv[16];
            lru_gates<true>(F, L, xc, xf, Av, Bv);
            if (blk >= 0) { f32x4* ab = F.AB + ((size_t)((ch * 8 + blk) * 8 + F.wave) * 8) * 64 + F.lane;
#pragma unroll
                for (int j = 0; j < 4; ++j) { ab[64 * j] = (f32x4){Av[4 * j], Av[4 * j + 1], Av[4 * j + 2], Av[4 * j + 3]}; ab[64 * (4 + j)] = (f32x4){Bv[4 * j], Bv[4 * j + 1], Bv[4 * j + 2], Bv[4 * j + 3]}; } }
            else if (row == 15) {
#pragma unroll
                for (int kb = 0; kb < 2; ++kb) { float* o = F.HM + (size_t)b * LW + F.wave * 64 + 32 * kb + 8 * q;
                    *(f32x4*)o = (f32x4){Bv[8 * kb], Bv[8 * kb + 1], Bv[8 * kb + 2], Bv[8 * kb + 3]}; *(f32x4*)(o + 4) = (f32x4){Bv[8 * kb + 4], Bv[8 * kb + 5], Bv[8 * kb + 6], Bv[8 * kb + 7]}; } }
#pragma unroll
            for (int c = 0; c < 16; ++c) { Bc[c] = Av[c] * Bc[c] + Bv[c]; Ac[c] *= Av[c]; }
        }
        if (row == 15) {
#pragma unroll
            for (int kb = 0; kb < 2; ++kb) { float* o = F.AGG + ((size_t)ch * LW + F.wave * 64 + 32 * kb + 8 * q) * 2;
#pragma unroll
                for (int j = 0; j < 8; j += 2) *(f32x4*)(o + 2 * j) = (f32x4){Ac[8 * kb + j], Bc[8 * kb + j], Ac[8 * kb + j + 1], Bc[8 * kb + j + 1]}; }
        }
    }
}

constexpr int YT_STRIDE = 520;
constexpr int US_STRIDE = 264;
constexpr int PW_STRIDE = 136;
template <int G> __device__ __forceinline__ void pool_z(const LAS bf16* ub  , bf16x8 (&zf)[4]) {
    constexpr int W = 2 << G;
    asm volatile("" : "+v"(ub));
#pragma unroll
    for (int kb = 0; kb < 4; ++kb) {
        const LAS bf16* p = ub + 15 * US_STRIDE + 32 * kb; const u32x4 c = *(const LAS u32x4*)p; float cur[8], s[8];
        cur[0] = bflo(c.x); cur[1] = bfhi(c.x); cur[2] = bflo(c.y); cur[3] = bfhi(c.y); cur[4] = bflo(c.z); cur[5] = bfhi(c.z); cur[6] = bflo(c.w); cur[7] = bfhi(c.w);
#pragma unroll
        for (int j = 0; j < 8; ++j) s[j] = cur[j];
#pragma unroll
        for (int d = 1; d < W; ++d) { const u32x4 u = *(const LAS u32x4*)(ub + (15 - d) * US_STRIDE + 32 * kb);
            s[0] += bflo(u.x); s[1] += bfhi(u.x); s[2] += bflo(u.y); s[3] += bfhi(u.y); s[4] += bflo(u.z); s[5] += bfhi(u.z); s[6] += bflo(u.w); s[7] += bfhi(u.w);
            if ((d & 3) == 3) asm volatile("" : "+v"(s[0]), "+v"(s[1]), "+v"(s[2]), "+v"(s[3]), "+v"(s[4]), "+v"(s[5]), "+v"(s[6]), "+v"(s[7]) :: "memory"); }
        asm volatile("" : "+v"(s[0]), "+v"(s[1]), "+v"(s[2]), "+v"(s[3]), "+v"(s[4]), "+v"(s[5]), "+v"(s[6]), "+v"(s[7]) :: "memory");
        u32x4 pz; pz.x = pk2(s[0] * (1.0f / W) - cur[0], s[1] * (1.0f / W) - cur[1]); pz.y = pk2(s[2] * (1.0f / W) - cur[2], s[3] * (1.0f / W) - cur[3]);
        pz.z = pk2(s[4] * (1.0f / W) - cur[4], s[5] * (1.0f / W) - cur[5]); pz.w = pk2(s[6] * (1.0f / W) - cur[6], s[7] * (1.0f / W) - cur[7]);
        asm volatile("" : "+v"(pz) :: "memory");
        zf[kb] = __builtin_bit_cast(bf16x8, pz);
    }
}
__device__ __forceinline__ void p3_mixer(Frame& F) {
    LAS bf16* Y = (LAS bf16*)F.lds;
    LAS unsigned char* wbase = F.lds + 66560 + F.wave * 2048;
    LAS float* SSQ = (LAS float*)(F.lds + 66560 + 16384);
    LAS float* RSTD = SSQ + 512;
    LAS bf16* US = (LAS bf16*)F.lds;
    const int row = F.lane & 15, q = F.lane >> 4;
    for (int ch = F.bx; ch < 256; ch += F.G) {
        const int b = ch >> 5, ci = ch & 31; const int m0 = ch * 128;
#ifndef P3_NO_LRU
        {
        float H[16];
        { float Ar[16], Br[16];
#pragma unroll
            for (int c = 0; c < 16; ++c) { Ar[c] = 1.f; Br[c] = 0.f; }
#pragma unroll
            for (int t = 0; t < 2; ++t) { const int k = 2 * row + t;
                if (k < ci) {
#pragma unroll
                    for (int kb = 0; kb < 2; ++kb) { const float* o = F.AGG + ((size_t)(b * 32 + k) * LW + F.wave * 64 + 32 * kb + 8 * q) * 2;
#pragma unroll
                        for (int j = 0; j < 8; j += 2) { const f32x4 v = *(const f32x4*)(o + 2 * j); const int c = 8 * kb + j;
                            Br[c] = v.x * Br[c] + v.y; Ar[c] *= v.x; Br[c + 1] = v.z * Br[c + 1] + v.w; Ar[c + 1] *= v.z; } } } }
            row_scan16(Ar, Br);
#pragma unroll
            for (int c = 0; c < 16; ++c) H[c] = dpp_f<DPP_BCAST15>(0.f, Br[c]); }
        if (ci == 0) {
#pragma unroll
            for (int kb = 0; kb < 2; ++kb) { const float* o = F.HM + (size_t)b * LW + F.wave * 64 + 32 * kb + 8 * q; const f32x4 h0 = *(const f32x4*)o, h1 = *(const f32x4*)(o + 4);
                H[8 * kb] = h0.x; H[8 * kb + 1] = h0.y; H[8 * kb + 2] = h0.z; H[8 * kb + 3] = h0.w; H[8 * kb + 4] = h1.x; H[8 * kb + 5] = h1.y; H[8 * kb + 6] = h1.z; H[8 * kb + 7] = h1.w; }
        }
        f32x4 abv[8]; u32x4 ug[2];
        { const f32x4* ab = F.AB + ((size_t)((ch * 8 + 0) * 8 + F.wave) * 8) * 64 + F.lane;
#pragma unroll
          for (int j = 0; j < 8; ++j) abv[j] = ab[64 * j];
          const bf16* prow = F.PROJ + (size_t)(b * TT + NMETA + 128 * ci + row) * INW + LW + F.wave * 64 + 8 * q; ug[0] = *(const u32x4*)prow; ug[1] = *(const u32x4*)(prow + 32); }
        for (int half = 0; half < 2; ++half) {
            for (int blk = 0; blk < 4; ++blk) {
                const int rb = 16 * blk, gb = half * 4 + blk;
                float Av[16], Bv[16]; u32x4 ugc[2] = {ug[0], ug[1]};
#pragma unroll
                for (int j = 0; j < 4; ++j) { Av[4 * j] = abv[j].x; Av[4 * j + 1] = abv[j].y; Av[4 * j + 2] = abv[j].z; Av[4 * j + 3] = abv[j].w; Bv[4 * j] = abv[4 + j].x; Bv[4 * j + 1] = abv[4 + j].y; Bv[4 * j + 2] = abv[4 + j].z; Bv[4 * j + 3] = abv[4 + j].w; }
                if (gb < 7) { const f32x4* ab = F.AB + ((size_t)((ch * 8 + gb + 1) * 8 + F.wave) * 8) * 64 + F.lane;
#pragma unroll
                    for (int j = 0; j < 8; ++j) abv[j] = ab[64 * j];
                    const bf16* prow = F.PROJ + (size_t)(b * TT + NMETA + 128 * ci + 16 * (gb + 1) + row) * INW + LW + F.wave * 64 + 8 * q; ug[0] = *(const u32x4*)prow; ug[1] = *(const u32x4*)(prow + 32); }
                asm volatile("" ::: "memory");
                float ss = 0.f;
#pragma unroll
                for (int kb = 0; kb < 2; ++kb) { float y[8];
#pragma unroll
                    for (int j = 0; j < 8; ++j) { const int c = 8 * kb + j;
                        const float h = Av[c] * H[c] + Bv[c];
                        const unsigned w = ugc[kb][j >> 1]; const float g = (j & 1) ? bfhi(w) : bflo(w);
                        const float gl = g * sigmoidf_(1.5957691216f * (g + 0.044715f * g * g * g));
                        y[j] = h * gl; ss += y[j] * y[j];
                        H[c] = dpp_f<DPP_BCAST15>(0.f, h); }
                    u32x4 p; p.x = pk2(y[0], y[1]); p.y = pk2(y[2], y[3]); p.z = pk2(y[4], y[5]); p.w = pk2(y[6], y[7]);
                    *(LAS u32x4*)(Y + (rb + row) * YT_STRIDE + F.wave * 64 + 32 * kb + 8 * q) = p;
                    asm volatile("" : "+v"(ss) :: "memory"); }
                ss += __shfl_xor(ss, 16); ss += __shfl_xor(ss, 32);
                if (q == 0) SSQ[(rb + row) * 8 + F.wave] = ss;
            }
            __syncthreads();
            if (F.tid < 64) { float s = 0.f;
#pragma unroll
                for (int w = 0; w < 8; ++w) s += SSQ[F.tid * 8 + w];
                RSTD[F.tid] = rsqrtf(s * (1.0f / LW) + RMS_EPS); }
            __syncthreads();
#pragma unroll
            for (int s = 0; s < 8; ++s) { const int p = F.tid + 512 * s, rw = p >> 6, cp = p & 63; const float rs = RSTD[rw];
                const u32x4 v = *(const LAS u32x4*)(Y + rw * YT_STRIDE + 8 * cp); const f32x4 g0 = *(const f32x4*)(F.lru_gain + 8 * cp), g1 = *(const f32x4*)(F.lru_gain + 8 * cp + 4);
                u32x4 o; o.x = pk2(bflo(v.x) * rs * g0.x, bfhi(v.x) * rs * g0.y); o.y = pk2(bflo(v.y) * rs * g0.z, bfhi(v.y) * rs * g0.w);
                o.z = pk2(bflo(v.z) * rs * g1.x, bfhi(v.z) * rs * g1.y); o.w = pk2(bflo(v.w) * rs * g1.z, bfhi(v.w) * rs * g1.w);
                *(u32x4*)(F.YMIX + (size_t)(m0 + 64 * half + rw) * D + 8 * cp) = o; }
            __syncthreads();
        }
        }
#endif
#ifndef P3_NO_POOL
        {
            bf16x8 zf[4][4];
            const int T0 = b * TT + NMETA + 128 * ci - 15;
#pragma unroll
            for (int gp = 0; gp < 2; ++gp) {
                for (int i = F.tid; i < 143 * 32; i += 512) { const int ri = i >> 5, cpc = i & 31;
                    *(LAS u32x4*)(US + ri * US_STRIDE + 8 * cpc) = *(const u32x4*)(F.PROJ + (size_t)(T0 + ri) * INW + 1024 + 256 * gp + 8 * cpc); }
                __syncthreads();
                const LAS bf16* urow = US + (16 * F.wave + row) * US_STRIDE + 8 * q;
                if (gp == 0) { pool_z<0>(urow, zf[0]); pool_z<1>(urow + 128, zf[1]); } else { pool_z<2>(urow, zf[2]); pool_z<3>(urow + 128, zf[3]); }
                __syncthreads();
            }
            for (int i = F.tid; i < 4 * 128 * 16; i += 512) { const int n = i >> 4, pc = i & 15; *(LAS u32x4*)(US + n * PW_STRIDE + 8 * pc) = *(const u32x4*)(F.PwT + (size_t)n * 128 + 8 * pc); }
            __syncthreads();
            const LAS bf16* wl = US + row * PW_STRIDE + 8 * q;
            float ssq = 0.f;
#pragma unroll
            for (int g = 0; g < 4; ++g) { const LAS bf16* wg = wl + g * 128 * PW_STRIDE; asm volatile("" : "+v"(wg));
#pragma unroll 2
                for (int nb = 0; nb < 8; ++nb) { f32x4 acc = (f32x4){0.f, 0.f, 0.f, 0.f}; const LAS bf16* wn = wg + 16 * nb * PW_STRIDE;
#pragma unroll
                    for (int kb = 0; kb < 4; ++kb) acc = __builtin_amdgcn_mfma_f32_16x16x32_bf16(*(const LAS bf16x8*)(wn + 32 * kb), zf[g][kb], acc, 0, 0, 0);
                    ssq += (acc[0] * acc[0] + acc[1] * acc[1]) + (acc[2] * acc[2] + acc[3] * acc[3]); } }
            ssq += __shfl_xor(ssq, 16); ssq += __shfl_xor(ssq, 32);
            const float rs = rsqrtf(ssq * (1.0f / 512.0f) + RMS_EPS);
            bf16* orow = F.YMIX + (size_t)(m0 + 16 * F.wave + row) * D + LW + 4 * q;
#pragma unroll
            for (int g = 0; g < 4; ++g) { const LAS bf16* wg = wl + g * 128 * PW_STRIDE; asm volatile("" : "+v"(wg));
#pragma unroll 2
                for (int nb = 0; nb < 8; ++nb) { f32x4 acc = (f32x4){0.f, 0.f, 0.f, 0.f}; const LAS bf16* wn = wg + 16 * nb * PW_STRIDE;
#pragma unroll
                    for (int kb = 0; kb < 4; ++kb) acc = __builtin_amdgcn_mfma_f32_16x16x32_bf16(*(const LAS bf16x8*)(wn + 32 * kb), zf[g][kb], acc, 0, 0, 0);
                    const f32x4 sc = *(const f32x4*)(F.pool_scale + 128 * g + 16 * nb + 4 * q);
                    u32x2 o; o.x = pk2(acc[0] * rs * sc.x, acc[1] * rs * sc.y); o.y = pk2(acc[2] * rs * sc.z, acc[3] * rs * sc.w);
                    *(u32x2*)(orow + 128 * g + 16 * nb) = o; } }
        }
#endif
        __syncthreads();
    }
}

constexpr int WR_STRIDE = 1032;
__device__ __forceinline__ void p5_route(Frame& F, const bool dry = false) {
    LAS _Float16* WR = (LAS _Float16*)F.lds;
    LAS float* LG = (LAS float*)(F.lds + 36 * WR_STRIDE * 2) + F.wave * 16 * 40;
    LAS int* LCNT = (LAS int*)(F.lds + 36 * WR_STRIDE * 2 + 8 * 16 * 40 * 4);
    LAS float* G2 = (LAS float*)(LCNT + 64);
    const int c16 = F.lane & 15, q = F.lane >> 4;
    for (int i = F.tid; i < NROUTE * 128; i += 512) { const int n = i >> 7, k8 = i & 127; *(LAS u32x4*)(WR + n * WR_STRIDE + 8 * k8) = *(const u32x4*)(F.WrH + n * D + 8 * k8); }
    for (int i = F.tid; i < D; i += 512) G2[i] = F.g2[i];
    for (int ch = F.bx; ch < 256; ch += F.G) {
        if (F.tid < 64) LCNT[F.tid] = 0;
        __syncthreads();
        const int row = ch * 128 + 16 * F.wave + c16;
        const bf16* hrow = F.H1 + (size_t)row * D + 8 * q;
        f32x4 acc[3]; float ss = 0.f;
#pragma unroll
        for (int nb = 0; nb < 3; ++nb) acc[nb] = (f32x4){0.f, 0.f, 0.f, 0.f};
#pragma unroll 4
        for (int i = 0; i < 32; ++i) {
            const u32x4 hw = *(const u32x4*)(hrow + 32 * i);
            const f32x4 h0 = (f32x4){bflo(hw.x), bfhi(hw.x), bflo(hw.y), bfhi(hw.y)}, h1 = (f32x4){bflo(hw.z), bfhi(hw.z), bflo(hw.w), bfhi(hw.w)};
            const f32x4 g0 = *(const LAS f32x4*)(G2 + 32 * i + 8 * q), g1 = *(const LAS f32x4*)(G2 + 32 * i + 8 * q + 4);
            ss += (h0.x * h0.x + h0.y * h0.y) + (h0.z * h0.z + h0.w * h0.w) + (h1.x * h1.x + h1.y * h1.y) + (h1.z * h1.z + h1.w * h1.w);
            const f32x4 t0 = h0 * g0, t1 = h1 * g1;
            f16x8 a; a[0] = (_Float16)t0.x; a[1] = (_Float16)t0.y; a[2] = (_Float16)t0.z; a[3] = (_Float16)t0.w; a[4] = (_Float16)t1.x; a[5] = (_Float16)t1.y; a[6] = (_Float16)t1.z; a[7] = (_Float16)t1.w;
#pragma unroll
            for (int nb = 0; nb < 3; ++nb) { const int col = 16 * nb + c16; f16x8 bw;
#pragma unroll
                for (int j = 0; j < 8; ++j) bw[j] = (_Float16)0.f;
                if (col < NROUTE) bw = *(const LAS f16x8*)(WR + col * WR_STRIDE + 32 * i + 8 * q);
                acc[nb] = __builtin_amdgcn_mfma_f32_16x16x32_f16(a, bw, acc[nb], 0, 0, 0); }
        }
        ss += __shfl_xor(ss, 16); ss += __shfl_xor(ss, 32);
        const float rstd = rsqrtf(ss * (1.0f / D) + RMS_EPS);
#pragma unroll
        for (int nb = 0; nb < 3; ++nb)
#pragma unroll
            for (int j = 0; j < 4; ++j) { const int col = 16 * nb + c16; if (col < 40) LG[(4 * q + j) * 40 + col] = acc[nb][j]; }
        LDS_WAIT();
        int e0 = 0, e1 = 0, rk0 = 0, rk1 = 0; float gt0 = 0.f, gt1 = 0.f;
        if (F.lane < 16) {
            const LAS float* lg = LG + F.lane * 40; const float sc = rstd * (1.0f / 256.0f);
            float gl[4]; int gi = 0;
#pragma unroll
            for (int j = 0; j < 4; ++j) gl[j] = lg[j] * sc + F.b_group[j];
            float gm = gl[0];
#pragma unroll
            for (int j = 1; j < 4; ++j) if (gl[j] > gm) { gm = gl[j]; gi = j; }
            float den = 0.f;
#pragma unroll
            for (int j = 0; j < 4; ++j) den += __expf(gl[j] - gm);
            const float pg = 1.0f / den;
            float v0 = -3.0e38f, v1 = -3.0e38f; int i0 = 0, i1 = 0;
            for (int j = 0; j < 8; ++j) { const float v = lg[4 + gi * 8 + j] * sc + F.b_router[gi * 8 + j];
                if (v > v0) { v1 = v0; i1 = i0; v0 = v; i0 = j; } else if (v > v1) { v1 = v; i1 = j; } }
            const float ex = __expf(v1 - v0), s0 = 1.0f / (1.0f + ex);
            gt0 = pg * s0; gt1 = pg * (ex * s0); e0 = gi * 8 + i0; e1 = gi * 8 + i1;
            rk0 = __hip_atomic_fetch_add(&LCNT[e0], 1, __ATOMIC_RELAXED, __HIP_MEMORY_SCOPE_WORKGROUP); rk1 = __hip_atomic_fetch_add(&LCNT[e1], 1, __ATOMIC_RELAXED, __HIP_MEMORY_SCOPE_WORKGROUP);
        }
        __syncthreads();
        if (F.tid < 32 && !dry) LCNT[32 + F.tid] = (int)__hip_atomic_fetch_add(F.ctl + CW_CNT + 64 * F.tid, (unsigned)LCNT[F.tid], __ATOMIC_RELAXED, __HIP_MEMORY_SCOPE_AGENT);
        __syncthreads();
        if (F.lane < 16 && !dry) { const int tok = ch * 128 + 16 * F.wave + F.lane;
            F.RINFO[(size_t)e0 * ECAP + LCNT[32 + e0] + rk0] = (f32x4){__builtin_bit_cast(float, tok * 2), gt0, rstd, 0.f};
            F.RINFO[(size_t)e1 * ECAP + LCNT[32 + e1] + rk1] = (f32x4){__builtin_bit_cast(float, tok * 2 + 1), gt1, rstd, 0.f}; }
        __syncthreads();
    }
}

__device__ __forceinline__ int moe_tables(Frame& F) {
    LAS int* TE = (LAS int*)(F.lds + TAB_TE); LAS int* TR = (LAS int*)(F.lds + TAB_TR); LAS int* CNT = (LAS int*)(F.lds + TAB_CNT); LAS int* PRE = CNT + 32;
    if (F.tid < 32) CNT[F.tid] = (int)__hip_atomic_load(F.ctl + CW_CNT + 64 * F.tid, __ATOMIC_RELAXED, __HIP_MEMORY_SCOPE_AGENT);
    __syncthreads();
    if (F.tid == 0) { int s = 0; for (int e = 0; e < NE; ++e) { PRE[e] = s; s += (CNT[e] + 255) >> 8; } PRE[NE] = s; }
    __syncthreads();
    const int NT = PRE[NE];
    for (int t = F.tid; t < NT; t += 512) { int e = 0; while (e < NE - 1 && PRE[e + 1] <= t) ++e; TE[t] = e; TR[t] = (t - PRE[e]) * 256; }
    __syncthreads();
    return NT;
}
__device__ __forceinline__ void moe_unit_tables(Frame& F, const pg8::MoeSched& S, int mode) {
    LAS int* TE = (LAS int*)(F.lds + TAB_TE); LAS int* TR = (LAS int*)(F.lds + TAB_TR); LAS int* CNT = (LAS int*)(F.lds + TAB_CNT);
    LAS unsigned* ROW = (LAS unsigned*)(F.lds + TAB_ROW); LAS float* FT = (LAS float*)(F.lds + TAB_F);
    const int nu = S.rounds() < MAXU ? S.rounds() : MAXU;
    f32x4 ri[MAXU / 2]; bool valid[MAXU / 2]; int ok[MAXU / 2];
#pragma unroll
    for (int t = 0; t < MAXU / 2; ++t) { const int idx = F.tid + 512 * t, i = idx >> 8, r = idx & 255; pg8::Unit u;
        ri[t] = (f32x4){0.f, 0.f, 0.f, 0.f}; valid[t] = false; ok[t] = (i < nu) && S.next(i, u);
        if (ok[t]) { const int e = TE[u.pm], pos = TR[u.pm] + r; valid[t] = pos < CNT[e]; if (valid[t]) ri[t] = F.RINFO[(size_t)e * ECAP + pos]; } }
#pragma unroll
    for (int t = 0; t < MAXU / 2; ++t) if (ok[t]) { const int idx = F.tid + 512 * t; const int slot = __builtin_bit_cast(int, ri[t].x);
        if (mode == 0) { ROW[idx] = valid[t] ? (unsigned)(slot >> 1) * (unsigned)D : 0u; FT[idx] = valid[t] ? ri[t].z * (1.0f / WGU_SCALE) : 0.f; }
        else { ROW[idx] = valid[t] ? (unsigned)slot : 0xffffffffu; FT[idx] = ri[t].y * (C_SCALE / (WD_SCALE * HID_SCALE)); } }
    __syncthreads();
}

__device__ __forceinline__ void p8_final(Frame& F) {
    const int gw = F.bx * 8 + F.wave, NGW = F.G * 8;
    f32x4 g[4];
#pragma unroll
    for (int j = 0; j < 4; ++j) g[j] = ((const f32x4*)F.final_gain)[F.lane + 64 * j];
    for (int m = gw * 2; m < M; m += NGW * 2) {
        u32x2 hb[2][4]; unsigned ca[2][4], cb[2][4];
#pragma unroll
        for (int r = 0; r < 2; ++r)
#pragma unroll
            for (int j = 0; j < 4; ++j) { hb[r][j] = ((const u32x2*)(F.H1 + (size_t)(m + r) * D))[F.lane + 64 * j];
                ca[r][j] = ((const unsigned*)(F.C + (size_t)(2 * (m + r)) * D))[F.lane + 64 * j]; cb[r][j] = ((const unsigned*)(F.C + (size_t)(2 * (m + r) + 1) * D))[F.lane + 64 * j]; }
#pragma unroll
        for (int r = 0; r < 2; ++r) { f32x4 v[4]; float s = 0.f;
#pragma unroll
            for (int j = 0; j < 4; ++j) { const f32x2 a0 = __builtin_amdgcn_cvt_pk_f32_fp8(ca[r][j], false), a1 = __builtin_amdgcn_cvt_pk_f32_fp8(ca[r][j], true), b0 = __builtin_amdgcn_cvt_pk_f32_fp8(cb[r][j], false), b1 = __builtin_amdgcn_cvt_pk_f32_fp8(cb[r][j], true);
                v[j] = (f32x4){bflo(hb[r][j].x) + (a0.x + b0.x) * (1.0f / C_SCALE), bfhi(hb[r][j].x) + (a0.y + b0.y) * (1.0f / C_SCALE), bflo(hb[r][j].y) + (a1.x + b1.x) * (1.0f / C_SCALE), bfhi(hb[r][j].y) + (a1.y + b1.y) * (1.0f / C_SCALE)};
                s += (v[j].x * v[j].x + v[j].y * v[j].y) + (v[j].z * v[j].z + v[j].w * v[j].w); }
            const float rstd = rsqrtf(wave_sum(s) * (1.f / D) + RMS_EPS);
            f32x4* o = (f32x4*)(F.out + (size_t)(m + r) * D) + F.lane;
#pragma unroll
            for (int j = 0; j < 4; ++j) o[64 * j] = v[j] * rstd * g[j]; }
    }
}

struct Args { const float* in[24]; float* out; unsigned char* ws; int ph_lo, ph_hi; };
__global__ void __launch_bounds__(512, 2) hymba_fwd(Args args) {
    extern __shared__ __attribute__((aligned(16))) unsigned char lds[];
    Frame F;
    F.lds = (LAS unsigned char*)lds; F.tid = threadIdx.x; F.lane = F.tid & 63; F.wave = __builtin_amdgcn_readfirstlane(F.tid >> 6); F.G = gridDim.x; F.bx = blockIdx.x;
    F.x = args.in[0]; F.meta = args.in[1]; F.g1 = args.in[2]; F.w_in = args.in[3]; F.conv_w = args.in[4]; F.conv_b = args.in[5]; F.wa = args.in[6]; F.ba = args.in[7]; F.wx = args.in[8]; F.bx_ = args.in[9];
    F.lam = args.in[10]; F.lru_gain = args.in[11]; F.pool_w = args.in[12]; F.pool_scale = args.in[13]; F.w_out = args.in[14]; F.g2 = args.in[15]; F.w_group = args.in[16]; F.b_group = args.in[17];
    F.w_router = args.in[18]; F.b_router = args.in[19]; F.w_gate = args.in[20]; F.w_up = args.in[21]; F.w_down = args.in[22]; F.final_gain = args.in[23];
    F.out = args.out; F.ws = args.ws; F.ctl = (unsigned*)(args.ws + WS_CTL);
    unsigned char* ws = args.ws;
    F.WinT = (bf16*)(ws + WS_WIN); F.WoutT = (bf16*)(ws + WS_WOUT); F.WaT = (bf16*)(ws + WS_WA); F.WxT = (bf16*)(ws + WS_WX); F.PwT = (bf16*)(ws + WS_PW); F.WrH = (_Float16*)(ws + WS_WR);
    F.AGG = (float*)(ws + WS_AGG); F.HM = (float*)(ws + WS_HM); F.AB = (f32x4*)(ws + WS_AB); F.WguT = ws + WS_WGU; F.WdT = ws + WS_WD; F.RINFO = (f32x4*)(ws + WS_RINFO); F.HN1 = (bf16*)(ws + WS_HN1); F.YMIX = (bf16*)(ws + WS_HN1);
    F.PROJ = (bf16*)(ws + WS_PROJ); F.HN2 = ws + WS_PROJ; F.HID = ws + WS_HID; F.C = ws + WS_C; F.H1 = (bf16*)(ws + WS_H1);
    volatile LAS unsigned* MISC = (volatile LAS unsigned*)(F.lds + MISC_OFF);
    if (F.tid < 64) MISC[F.tid] = 0u;
    __syncthreads();
    XcdBarrier bar; bar.bar = F.ctl + CW_BAR; bar.x = 0; bar.st = nullptr;
    if (MK_N_LAUNCHES == 1) bar = xcd_barrier_post(F.ctl + CW_BAR, MISC + 8);
    const int lo = args.ph_lo, hi = args.ph_hi;
#ifndef PH_MASK
#define PH_MASK 0x1ff
#endif
#define IN(k) (((PH_MASK >> (k)) & 1) && lo <= (k) && (k) < hi)
#define SEAM(k) do { if (IN(k) && IN((k) + 1)) xcd_barrier(bar); } while (0)
#define REP(k) for (int rep_ = 0; rep_ <= ((REPEAT_MASK >> (k)) & 1); ++rep_)

    if (IN(0)) REP(0) { p0_prologue(F); } SEAM(0);
    if (IN(1)) { pg8::DenseSched S{M / 256, INW / 256, F.G, F.bx, D * 2, (const char*)F.WinT, 1 + ((REPEAT_MASK >> 1) & 1)}; pg8::EpiProj E{F.PROJ};
        pg8::gemm_phase(F.lds, D * 2, (const char*)F.HN1, S, E); } SEAM(1);
    if (IN(2)) REP(2) { p2_aggregates(F); } SEAM(2);
    if (IN(3)) REP(3) { p3_mixer(F); } SEAM(3);
    if (IN(4)) { pg8::DenseSched S{M / 256, D / 256, F.G, F.bx, D * 2, (const char*)F.WoutT, 1 + ((REPEAT_MASK >> 4) & 1)}; pg8::EpiResid E{F.x, F.g2, F.H1, F.HN2};
        pg8::gemm_phase(F.lds, D * 2, (const char*)F.YMIX, S, E); } SEAM(4);
    if (IN(5)) { if ((REPEAT_MASK >> 5) & 1) p5_route(F, true); p5_route(F); } SEAM(5);
    if (IN(6)) { const int NT = moe_tables(F);
        pg8::MoeSched S{NT, 4, F.G, F.bx, D, (const char*)F.WguT, (size_t)1024 * D, true, (const LAS int*)(F.lds + TAB_TE), (const LAS unsigned*)(F.lds + TAB_ROW), 1 + ((REPEAT_MASK >> 6) & 1)};
        moe_unit_tables(F, S, 0);
        pg8::EpiGateUp E{F.HID, (const LAS float*)(F.lds + TAB_F), S.rounds()};
        pg8::gemm_phase<pg8::EpiGateUp, pg8::MoeSched, true>(F.lds, D, (const char*)F.HN2, S, E); } SEAM(6);
    if (IN(7)) { const int NT = moe_tables(F);
        pg8::MoeSched S{NT, 4, F.G, F.bx, EFF, (const char*)F.WdT, (size_t)D * EFF, false, (const LAS int*)(F.lds + TAB_TE), (const LAS unsigned*)(F.lds + TAB_ROW), 1 + ((REPEAT_MASK >> 7) & 1)};
        moe_unit_tables(F, S, 1);
        pg8::EpiDown E{F.C, (const LAS int*)(F.lds + TAB_ROW), (const LAS float*)(F.lds + TAB_F), S.rounds()};
        pg8::gemm_phase<pg8::EpiDown, pg8::MoeSched, true>(F.lds, EFF, (const char*)F.HID, S, E); } SEAM(7);
    if (IN(8)) { p8_final(F); }
#undef IN
#undef SEAM
}

extern "C" void kernel_launch(void* const* d_in, const int* in_sizes, int n_in, void* d_out, int out_size, void* d_ws, size_t ws_size, hipStream_t stream) {
    static int grid = 0;
    if (grid == 0) {
        if (n_in != 24 || in_sizes[0] != M * D || out_size != M * D || ws_size < WS_END) { fprintf(stderr, "kernel_launch: unexpected shapes (n_in %d, in0 %d, out %d, ws %zu)\n", n_in, n_in > 0 ? in_sizes[0] : -1, out_size, ws_size); grid = -1; return; }
        int dev = 0, cus = 0, per_cu = 0;
        if (hipGetDevice(&dev) != hipSuccess || hipDeviceGetAttribute(&cus, hipDeviceAttributeMultiprocessorCount, dev) != hipSuccess) { grid = -1; return; }
        if (hipFuncSetAttribute((const void*)hymba_fwd, hipFuncAttributeMaxDynamicSharedMemorySize, LDS_BYTES) != hipSuccess) { fprintf(stderr, "kernel_launch: hipFuncSetAttribute failed\n"); grid = -1; return; }
        if (hipOccupancyMaxActiveBlocksPerMultiprocessor(&per_cu, (const void*)hymba_fwd, 512, LDS_BYTES) != hipSuccess || per_cu < 1) fprintf(stderr, "kernel_launch: occupancy query says %d\n", per_cu);
        (void)hipGetLastError();
        grid = cus;
    }
    if (grid < 0) return;
    if (hipMemsetAsync((char*)d_ws + WS_CTL, 0, CTL_ZERO_BYTES, stream) != hipSuccess) return;
    Args a{};
    for (int i = 0; i < 24; ++i) a.in[i] = (const float*)d_in[i];
    a.out = (float*)d_out; a.ws = (unsigned char*)d_ws;
    if (MK_N_LAUNCHES == 1) { a.ph_lo = 0; a.ph_hi = N_PHASES; hipLaunchKernelGGL(hymba_fwd, dim3(grid), dim3(512), LDS_BYTES, stream, a); }
    else for (int p = 0; p < N_PHASES; ++p) { a.ph_lo = p; a.ph_hi = p + 1; hipLaunchKernelGGL(hymba_fwd, dim3(grid), dim3(512), LDS_BYTES, stream, a); }
}
```

```cpp
#include <hip/hip_runtime.h>
#include <cstdio>
#include <cstdint>

#define GAS __attribute__((address_space(1)))
#define LAS __attribute__((address_space(3)))
typedef unsigned short bf16;
typedef short bf16x8 __attribute__((ext_vector_type(8)));
typedef _Float16 f16x8 __attribute__((ext_vector_type(8)));
typedef float f32x4 __attribute__((ext_vector_type(4)));
typedef float f32x2 __attribute__((ext_vector_type(2)));
typedef unsigned u32x4 __attribute__((ext_vector_type(4)));
typedef unsigned u32x2 __attribute__((ext_vector_type(2)));

#ifndef MK_N_LAUNCHES
#define MK_N_LAUNCHES 1
#endif
constexpr int N_PHASES = 9;
#ifndef REPEAT_MASK
#define REPEAT_MASK 0
#endif

constexpr int D = 1024, NBATCH = 8, SEQ = 4096, NMETA = 16, TT = SEQ + NMETA, M = NBATCH * SEQ;
constexpr int LW = 512, INW = 1536, NE = 32, EFF = 512, NROUTE = 36;
constexpr int ECAP = 32768;
constexpr int MAXT = 288;
constexpr int MAXU = 6;
constexpr float RMS_EPS = 1e-6f;

constexpr size_t MiB = 1u << 20;
constexpr size_t WS_CTL = 0, CTL_ZERO_BYTES = 1 * MiB;
constexpr size_t WS_WIN = 2 * MiB, WS_WOUT = 5 * MiB, WS_WA = 7 * MiB, WS_WX = 7 * MiB + 65536, WS_PW = 7 * MiB + 131072, WS_WR = 7 * MiB + 262144;
constexpr size_t WS_AGG = 8 * MiB;
constexpr size_t WS_HM = 9 * MiB;
constexpr size_t WS_WGU = 10 * MiB  , WS_WD = 42 * MiB  , WS_RINFO = 58 * MiB, WS_HN1 = 74 * MiB  ;
constexpr size_t WS_PROJ = 138 * MiB  , WS_HID = 235 * MiB  , WS_C = 272 * MiB  , WS_H1 = 400 * MiB  , WS_END = 464 * MiB;
constexpr size_t WS_AB = WS_C;
constexpr float WGU_SCALE = 64.f, WD_SCALE = 32.f, HID_SCALE = 8.f, C_SCALE = 32.f;
constexpr int CW_BAR = 4096, CW_CNT = 16384;

constexpr int LDS_BYTES = 147456;
constexpr int MISC_OFF = LDS_BYTES - 256;
constexpr int TAB_OFF = 131072 + 512;
constexpr int TAB_ROW = TAB_OFF;
constexpr int TAB_F = TAB_ROW + MAXU * 256 * 4;
constexpr int TAB_TE = TAB_F + MAXU * 256 * 4;
constexpr int TAB_TR = TAB_TE + MAXT * 4;
constexpr int TAB_CNT = TAB_TR + MAXT * 4;
static_assert(TAB_CNT + 80 * 4 <= MISC_OFF, "LDS map");

__device__ __forceinline__ unsigned f2bf(float f) { unsigned u = __builtin_bit_cast(unsigned, f); return (u + 0x7fffu + ((u >> 16) & 1u)) >> 16; }
__device__ __forceinline__ unsigned pk2(float lo, float hi) { unsigned r; asm("v_cvt_pk_bf16_f32 %0, %1, %2" : "=v"(r) : "v"(lo), "v"(hi)); return r; }
__device__ __forceinline__ float bf2f(unsigned h) { return __builtin_bit_cast(float, h << 16); }
__device__ __forceinline__ float bflo(unsigned w) { return __builtin_bit_cast(float, w << 16); }
__device__ __forceinline__ float bfhi(unsigned w) { return __builtin_bit_cast(float, w & 0xffff0000u); }
__device__ __forceinline__ float sigmoidf_(float x) { return __builtin_amdgcn_rcpf(1.0f + __expf(-x)); }
#define LDS_WAIT() asm volatile("s_waitcnt lgkmcnt(0)" ::: "memory")
typedef _Float16 f16x2 __attribute__((ext_vector_type(2)));
__device__ __forceinline__ unsigned pkh2(float lo, float hi) { return __builtin_bit_cast(unsigned, __builtin_convertvector((f32x2){lo, hi}, f16x2)); }
__device__ __forceinline__ float h2lo(unsigned w) { return (float)__builtin_bit_cast(f16x2, w).x; }
__device__ __forceinline__ float h2hi(unsigned w) { return (float)__builtin_bit_cast(f16x2, w).y; }
typedef int i32x4 __attribute__((ext_vector_type(4)));
typedef int i32x8 __attribute__((ext_vector_type(8)));
__device__ __forceinline__ float clamp448(float v) { return fminf(fmaxf(v, -448.f), 448.f); }
__device__ __forceinline__ unsigned pk4_fp8(float a, float b, float c, float d) {
    int v = __builtin_amdgcn_cvt_pk_fp8_f32(a, b, 0, false); v = __builtin_amdgcn_cvt_pk_fp8_f32(c, d, v, true); return (unsigned)v; }

#define XB_TMO      128
#define XB_XCNT(j)  (256  + 64 * (j))
#define XB_XSUB(j)  (1280 + 64 * (j))
#define XB_XGEN(j)  (2304 + 64 * (j))
#define XB_TOP      3328
#define XB_TOPGEN   3392
#define XCD_BAR_WORDS 3456
#define XB_SPIN_CAP (1u << 18)
__device__ __forceinline__ unsigned xb_ld(unsigned* p)              { return __hip_atomic_load(p, __ATOMIC_RELAXED, __HIP_MEMORY_SCOPE_AGENT); }
__device__ __forceinline__ unsigned xb_add(unsigned* p, unsigned v) { return __hip_atomic_fetch_add(p, v, __ATOMIC_RELAXED, __HIP_MEMORY_SCOPE_AGENT); }
__device__ __forceinline__ unsigned xb_xcc_id() { return (unsigned)__builtin_amdgcn_s_getreg((3 << 11) | 20) & 0xFu; }
#define XB_SPIN(cond, bar) do { unsigned _sp = 0; while (cond) { __builtin_amdgcn_s_sleep(1); \
    if ((++_sp & 255u) == 0u) { if (xb_ld(&(bar)[XB_TMO])) break; if (_sp > XB_SPIN_CAP) { atomicAdd(&(bar)[XB_TMO], 1u); break; } } } } while (0)
struct XcdBarrier { unsigned* bar; unsigned x; volatile LAS unsigned* st; };
__device__ __forceinline__ XcdBarrier xcd_barrier_post(unsigned* bar, volatile LAS unsigned* st) {
    XcdBarrier b; b.bar = bar; b.x = xb_xcc_id(); b.st = st;
    if (threadIdx.x == 0) (void)xb_add(&bar[XB_XCNT(b.x)], 1u);
    return b;
}
__device__ __forceinline__ void xcd_barrier_complete(unsigned* bar, unsigned x, unsigned& nloc, unsigned& nx) {
    const unsigned G = gridDim.x * gridDim.y * gridDim.z;
    unsigned sum, cnt, mine, sp = 0u;
    for (;;) {
        sum = 0u; cnt = 0u; mine = 0u;
#pragma unroll
        for (unsigned j = 0; j < 16; ++j) { const unsigned c = xb_ld(&bar[XB_XCNT(j)]); sum += c; cnt += (c > 0u) ? 1u : 0u; mine = (j == x) ? c : mine; }
        if (sum == G) break;
        __builtin_amdgcn_s_sleep(1);
        if ((++sp & 255u) == 0u) { if (xb_ld(&bar[XB_TMO])) break; if (sp > XB_SPIN_CAP) { atomicAdd(&bar[XB_TMO], 1u); break; } }
    }
    nloc = mine > 0u ? mine : 1u; nx = cnt > 0u ? cnt : 1u;
}
__device__ __forceinline__ void xcd_barrier(const XcdBarrier& b) {
    asm volatile("s_waitcnt vmcnt(0)" ::: "memory");
    __syncthreads();
    if (threadIdx.x == 0) {
        unsigned* bar = b.bar;
        __builtin_amdgcn_s_waitcnt(0);
        unsigned nloc = b.st[0], nx = b.st[1];
        if (nloc == 0u) { xcd_barrier_complete(bar, b.x, nloc, nx); b.st[0] = nloc; b.st[1] = nx; }
        const unsigned old = xb_add(&bar[XB_XSUB(b.x)], 1u);
        const unsigned gen = old / nloc;
        if (old + 1u == (gen + 1u) * nloc) {
            __builtin_amdgcn_fence(__ATOMIC_RELEASE, "agent");
            asm volatile("s_waitcnt vmcnt(0)" ::: "memory");
            const unsigned og = xb_add(&bar[XB_TOP], 1u);
            const unsigned tg = og / nx;
            if (og + 1u == (tg + 1u) * nx) xb_add(&bar[XB_TOPGEN], 1u);
            else XB_SPIN(xb_ld(&bar[XB_TOPGEN]) == tg, bar);
            __builtin_amdgcn_fence(__ATOMIC_ACQUIRE, "agent");
            xb_add(&bar[XB_XGEN(b.x)], 1u);
            asm volatile("s_waitcnt vmcnt(0)" ::: "memory");
        } else {
            XB_SPIN(xb_ld(&bar[XB_XGEN(b.x)]) == gen, bar);
            __builtin_amdgcn_fence(__ATOMIC_ACQUIRE, "agent");
            asm volatile("s_waitcnt vmcnt(0)" ::: "memory");
        }
    }
    __syncthreads();
}

namespace pg8 {
constexpr int BM = 256, BK = 64, HALF = 128, HTB = HALF * BK * 2, STAGE_BYTES = 8 * HTB, NXCD = 8, WGM = 8;
__host__ __device__ __forceinline__ int lds_byte(int r, int c) { const int st = (r >> 4) * 2 + (c >> 5), rr = r & 15, cc = c & 31, ob = rr * 64 + cc * 2; return st * 1024 + (ob ^ (((ob >> 9) & 1) << 5)); }
__host__ __device__ __forceinline__ void stage_rc(int b, int& R, int& C) { const int st = b / 1024, sb = b % 1024, swz = sb ^ (((sb >> 9) & 1) << 5); R = (st >> 1) * 16 + swz / 64; C = (st & 1) * 32 + (swz % 64) / 2; }
__host__ __device__ __forceinline__ int perm32(int rho) { const int n = rho >> 4, i = rho & 15; return 8 * (i >> 2) + 4 * n + (i & 3); }
struct Unit { int pm, pn; };
__device__ __forceinline__ bool static_next(int nM, int nN, int G, int c, int i, Unit& u) {
    const int nwg = nM * nN; const long L = (long)i * G + c; if (L >= nwg) return false;
    int wgid = (int)L; { const int q = nwg / NXCD, r = nwg % NXCD, xcd = wgid % NXCD, off = wgid / NXCD; wgid = (xcd < r ? xcd * (q + 1) : r * (q + 1) + (xcd - r) * q) + off; }
    const int nig = WGM * nN, gid = wgid / nig, fm = gid * WGM, gsz = (nM - fm) < WGM ? (nM - fm) : WGM;
    u.pm = fm + ((wgid % nig) % gsz); u.pn = (wgid % nig) / gsz; return true;
}
__device__ __forceinline__ unsigned cvt_pk_bf16(float lo, float hi) { unsigned r; asm volatile("v_cvt_pk_bf16_f32 %0, %1, %2" : "=v"(r) : "v"(lo), "v"(hi)); return r; }

template <class Epi, class Sched, bool FP8 = false>
__device__ __forceinline__ void gemm_phase(LAS unsigned char* lds, const int KB, const char* Abase, const Sched& S, const Epi& E) {
    const int tid = threadIdx.x, wid = __builtin_amdgcn_readfirstlane(tid >> 6), lane = tid & 63, wr = wid >> 2, wc = wid & 3, fr = lane & 15, fq = lane >> 4;
    const int nt = KB / (BK * 2);
    int Rl[2]; unsigned Cb[2], voffB[2];
#pragma unroll
    for (int i = 0; i < 2; ++i) { int R, C; stage_rc(tid * 16 + i * 8192, R, C); const int Rb = Epi::PERM ? ((R & ~31) + perm32(R & 31)) : R;
        Rl[i] = R; Cb[i] = (unsigned)C * 2u; voffB[i] = (unsigned)(Rb * KB + C * 2); }
    const size_t kstep = (size_t)(BK * 2);
    const size_t hstepB = (size_t)HALF * KB;
    const unsigned ldsw = (unsigned)wid * 1024u;
    const int aoff = lds_byte(wr * 64 + fr, fq * 8), boff = lds_byte(wc * 32 + fr, fq * 8);
#define PG8_SA(b, h) (((b) * 2 + (h)) * HTB)
#define PG8_SB(b, h) ((4 + (b) * 2 + (h)) * HTB)
#define PG8_STAGE(bufoff, gbase, voff) do { _Pragma("unroll") for (int _i = 0; _i < 2; ++_i) \
        __builtin_amdgcn_global_load_lds((const unsigned*)((const char*)(gbase) + (voff)[_i]), (LAS unsigned*)(lds + (bufoff) + ldsw + _i * 8192), 16, 0, 0); } while (0)
#define PG8_LD32(p) __builtin_shufflevector(*(const LAS i32x4*)(p), *(const LAS i32x4*)((p) + 1024), 0, 1, 2, 3, 4, 5, 6, 7)
#define PG8_LDA(dst, b, h) do { _Pragma("unroll") for (int m = 0; m < 4; ++m) dst[m] = PG8_LD32(lds + PG8_SA(b, h) + aoff + m * 2048); } while (0)
#define PG8_LDB(dst, b, h) do { _Pragma("unroll") for (int n = 0; n < 2; ++n) dst[n] = PG8_LD32(lds + PG8_SB(b, h) + boff + n * 2048); } while (0)
#define PG8_LO(v) __builtin_bit_cast(bf16x8, __builtin_shufflevector((v), (v), 0, 1, 2, 3))
#define PG8_HI(v) __builtin_bit_cast(bf16x8, __builtin_shufflevector((v), (v), 4, 5, 6, 7))
#define PG8_MMA(ai, bj, At, Bt) do { __builtin_amdgcn_s_setprio(1); _Pragma("unroll") for (int m = 0; m < 4; ++m) _Pragma("unroll") for (int n = 0; n < 2; ++n) { \
        if constexpr (FP8) asm volatile("v_mfma_f32_16x16x128_f8f6f4 %0, %1, %2, %0" : "+v"(acc[ai][bj][m][n]) : "v"(Bt[n]), "v"(At[m])); \
        else { acc[ai][bj][m][n] = __builtin_amdgcn_mfma_f32_16x16x32_bf16(PG8_LO(Bt[n]), PG8_LO(At[m]), acc[ai][bj][m][n], 0, 0, 0); \
               acc[ai][bj][m][n] = __builtin_amdgcn_mfma_f32_16x16x32_bf16(PG8_HI(Bt[n]), PG8_HI(At[m]), acc[ai][bj][m][n], 0, 0, 0); } } \
        __builtin_amdgcn_s_setprio(0); } while (0)
#define PG8_WAIT_V(n) asm volatile("s_waitcnt vmcnt(" #n ")" ::: "memory")
#define PG8_WAIT_L(n) asm volatile("s_waitcnt lgkmcnt(" #n ")" ::: "memory")
#define PG8_BAR __builtin_amdgcn_s_barrier()
#define PG8_SCHED __builtin_amdgcn_sched_barrier(0)
    Unit cur, nxt; int ui = 0;
    if (!S.next(0, cur)) return;
    f32x4 acc[2][2][4][2];
#pragma unroll
    for (int a = 0; a < 2; ++a)
#pragma unroll
        for (int b = 0; b < 2; ++b)
#pragma unroll
            for (int m = 0; m < 4; ++m)
#pragma unroll
                for (int n = 0; n < 2; ++n) acc[a][b][m][n] = (f32x4){0.f, 0.f, 0.f, 0.f};
    i32x8 At[4], B0[2], B1[2];
    unsigned cO0[2], cO1[2], nO0[2], nO1[2];
#pragma unroll
    for (int i = 0; i < 2; ++i) { cO0[i] = S.a_off(0, cur, Rl[i]) + Cb[i]; cO1[i] = S.a_off(0, cur, HALF + Rl[i]) + Cb[i]; }
    const char* cB = S.b_base(cur);
    PG8_STAGE(PG8_SB(0, 0), cB, voffB); PG8_STAGE(PG8_SB(0, 1), cB + hstepB, voffB); PG8_STAGE(PG8_SA(0, 0), Abase, cO0); PG8_STAGE(PG8_SA(0, 1), Abase, cO1);
    if (wr == 1) PG8_BAR;
    PG8_WAIT_V(2); PG8_BAR;
    PG8_STAGE(PG8_SB(1, 0), cB + kstep, voffB); PG8_STAGE(PG8_SA(1, 0), Abase + kstep, cO0); PG8_STAGE(PG8_SB(1, 1), cB + hstepB + kstep, voffB);
    PG8_WAIT_V(6); PG8_BAR;
    for (;;) {
        const bool has_next = S.next(ui + 1, nxt);
        const char* nB = cB;
#pragma unroll
        for (int i = 0; i < 2; ++i) { nO0[i] = cO0[i]; nO1[i] = cO1[i]; }
        if (has_next) { nB = S.b_base(nxt);
#pragma unroll
            for (int i = 0; i < 2; ++i) { nO0[i] = S.a_off(ui + 1, nxt, Rl[i]) + Cb[i]; nO1[i] = S.a_off(ui + 1, nxt, HALF + Rl[i]) + Cb[i]; } }
#pragma nounroll
        for (int t = 0; t < nt; t += 2) {
            const bool last = (t == nt - 2);
            const char* a1 = Abase + (size_t)(t + 1) * kstep;
            const char* a2 = last ? Abase : Abase + (size_t)(t + 2) * kstep; const char* b2 = last ? nB : cB + (size_t)(t + 2) * kstep;
            const char* a3 = a2 + kstep; const char* b3 = b2 + kstep;
            unsigned o0[2], o1[2];
#pragma unroll
            for (int i = 0; i < 2; ++i) { o0[i] = last ? nO0[i] : cO0[i]; o1[i] = last ? nO1[i] : cO1[i]; }
            PG8_LDB(B0, 0, 0); PG8_LDB(B1, 0, 1); PG8_SCHED; PG8_LDA(At, 0, 0); PG8_STAGE(PG8_SA(1, 1), a1, cO1);
            PG8_WAIT_V(8); PG8_WAIT_L(0); PG8_BAR; PG8_MMA(0, 0, At, B0); PG8_MMA(0, 1, At, B1); PG8_BAR; PG8_SCHED;
            PG8_LDA(At, 0, 1); PG8_STAGE(PG8_SB(0, 0), b2, voffB); PG8_STAGE(PG8_SB(0, 1), b2 + hstepB, voffB); PG8_STAGE(PG8_SA(0, 0), a2, o0);
            PG8_WAIT_V(8); PG8_WAIT_L(0); PG8_BAR; PG8_MMA(1, 0, At, B0); PG8_MMA(1, 1, At, B1); PG8_BAR; PG8_SCHED;
            PG8_LDB(B0, 1, 0); PG8_LDB(B1, 1, 1); PG8_SCHED; PG8_LDA(At, 1, 0); PG8_STAGE(PG8_SA(0, 1), a2, o1);
            PG8_WAIT_V(8); PG8_WAIT_L(0); PG8_BAR; PG8_MMA(0, 0, At, B0); PG8_MMA(0, 1, At, B1); PG8_BAR; PG8_SCHED;
            PG8_LDA(At, 1, 1); PG8_STAGE(PG8_SB(1, 0), b3, voffB); PG8_STAGE(PG8_SB(1, 1), b3 + hstepB, voffB); PG8_STAGE(PG8_SA(1, 0), a3, o0);
            PG8_WAIT_V(8); PG8_WAIT_L(0); PG8_BAR; PG8_MMA(1, 0, At, B0); PG8_MMA(1, 1, At, B1); PG8_BAR; PG8_SCHED;
        }
        if (wr == 0) PG8_BAR;
        if constexpr (FP8) asm volatile("s_nop 15\n\ts_nop 15" ::: "memory");
        E(acc, cur, ui, wr, wc, fr, fq);
        if (!has_next) break;
#pragma unroll
        for (int a = 0; a < 2; ++a)
#pragma unroll
            for (int b = 0; b < 2; ++b)
#pragma unroll
                for (int m = 0; m < 4; ++m)
#pragma unroll
                    for (int n = 0; n < 2; ++n) acc[a][b][m][n] = (f32x4){0.f, 0.f, 0.f, 0.f};
        cur = nxt; cB = nB; ++ui;
#pragma unroll
        for (int i = 0; i < 2; ++i) { cO0[i] = nO0[i]; cO1[i] = nO1[i]; }
        if (wr == 1) PG8_BAR;
    }
    PG8_WAIT_V(0);
    PG8_BAR;
#undef PG8_SA
#undef PG8_SB
#undef PG8_STAGE
#undef PG8_LDA
#undef PG8_LDB
#undef PG8_MMA
#undef PG8_LO
#undef PG8_HI
#undef PG8_LD32
#undef PG8_WAIT_V
#undef PG8_WAIT_L
#undef PG8_BAR
#undef PG8_SCHED
}

struct DenseSched {
    int nM, nN, G, c, K2; const char* B; int reps;
    __device__ __forceinline__ bool next(int i, Unit& u) const { const int rounds = (nM * nN + G - 1) / G; if (i >= rounds * reps) return false; return static_next(nM, nN, G, c, i % rounds, u); }
    __device__ __forceinline__ const char* b_base(const Unit& u) const { return B + (size_t)u.pn * BM * K2; }
    __device__ __forceinline__ unsigned a_off(int, const Unit& u, int r) const { return (unsigned)(u.pm * BM + r) * (unsigned)K2; }
};
struct MoeSched {
    int NT, nN, G, c, K2; const char* B; size_t estride; bool gather;
    const LAS int* tile_e; const LAS unsigned* rowtab; int reps;
    __device__ __forceinline__ int rounds() const { return (NT * nN + G - 1) / G; }
    __device__ __forceinline__ bool next(int i, Unit& u) const { const int r = rounds(); if (i >= r * reps) return false; return static_next(NT, nN, G, c, i % r, u); }
    __device__ __forceinline__ const char* b_base(const Unit& u) const { return B + (size_t)tile_e[u.pm] * estride + (size_t)u.pn * BM * K2; }
    __device__ __forceinline__ unsigned a_off(int ui, const Unit& u, int r) const { return gather ? rowtab[(ui % rounds()) * 256 + r] : (unsigned)(u.pm * BM + r) * (unsigned)K2; }
};

struct EpiProj {
    static constexpr bool PERM = true;
    bf16* O;
    __device__ __forceinline__ void operator()(const f32x4 (&acc)[2][2][4][2], const Unit& u, int, int wr, int wc, int fr, int fq) const {
        const int row0 = u.pm * BM + 16 * ((u.pm >> 4) + 1) + wr * 64 + fr, col0 = u.pn * BM + wc * 32 + 8 * fq;
#pragma unroll
        for (int ai = 0; ai < 2; ++ai)
#pragma unroll
            for (int m = 0; m < 4; ++m) { bf16* rowp = O + (size_t)(row0 + ai * HALF + m * 16) * INW + col0;
#pragma unroll
                for (int bj = 0; bj < 2; ++bj) { const f32x4 v0 = acc[ai][bj][m][0], v1 = acc[ai][bj][m][1];
                    u32x4 w; w.x = cvt_pk_bf16(v0[0], v0[1]); w.y = cvt_pk_bf16(v0[2], v0[3]); w.z = cvt_pk_bf16(v1[0], v1[1]); w.w = cvt_pk_bf16(v1[2], v1[3]);
                    *(u32x4*)(rowp + bj * HALF) = w; } }
    }
};
struct EpiResid {
    static constexpr bool PERM = true;
    const float* X; const float* G2; bf16* H1; unsigned char* HN2;
    __device__ __forceinline__ void operator()(const f32x4 (&acc)[2][2][4][2], const Unit& u, int, int wr, int wc, int fr, int fq) const {
        const int row0 = u.pm * BM + wr * 64 + fr, col0 = u.pn * BM + wc * 32 + 8 * fq;
        f32x4 gv[2][2];
#pragma unroll
        for (int bj = 0; bj < 2; ++bj)
#pragma unroll
            for (int n = 0; n < 2; ++n) gv[bj][n] = *(const f32x4*)(G2 + col0 + bj * HALF + 4 * n);
#pragma unroll
        for (int ai = 0; ai < 2; ++ai) {
#pragma unroll
            for (int m = 0; m < 4; ++m) { const size_t off = (size_t)(row0 + ai * HALF + m * 16) * D + col0;
#pragma unroll
                for (int bj = 0; bj < 2; ++bj) { const f32x4 v0 = acc[ai][bj][m][0] + *(const f32x4*)(X + off + bj * HALF), v1 = acc[ai][bj][m][1] + *(const f32x4*)(X + off + bj * HALF + 4);
                    u32x4 w; w.x = cvt_pk_bf16(v0[0], v0[1]); w.y = cvt_pk_bf16(v0[2], v0[3]); w.z = cvt_pk_bf16(v1[0], v1[1]); w.w = cvt_pk_bf16(v1[2], v1[3]);
                    *(u32x4*)(H1 + off + bj * HALF) = w;
                    const f32x4 t0 = v0 * gv[bj][0], t1 = v1 * gv[bj][1];
                    u32x2 e; e.x = pk4_fp8(clamp448(t0[0]), clamp448(t0[1]), clamp448(t0[2]), clamp448(t0[3])); e.y = pk4_fp8(clamp448(t1[0]), clamp448(t1[1]), clamp448(t1[2]), clamp448(t1[3]));
                    *(u32x2*)(HN2 + off + bj * HALF) = e; } }
            asm volatile("" ::: "memory"); }
    }
};
struct EpiGateUp {
    static constexpr bool PERM = true;
    unsigned char* H; const LAS float* rstd; int rounds;
    __device__ __forceinline__ void operator()(const f32x4 (&acc)[2][2][4][2], const Unit& u, int ui_, int wr, int wc, int fr, int fq) const {
        const int ui = ui_ % rounds;
        const int r0 = wr * 64 + fr, col0 = u.pn * HALF + wc * 32 + 8 * fq;
#pragma unroll
        for (int ai = 0; ai < 2; ++ai)
#pragma unroll
            for (int m = 0; m < 4; ++m) { const int r = r0 + ai * HALF + m * 16; const float rs = rstd[ui * 256 + r];
                float h[8];
#pragma unroll
                for (int n = 0; n < 2; ++n)
#pragma unroll
                    for (int j = 0; j < 4; ++j) { const float g = acc[ai][0][m][n][j] * rs, up = acc[ai][1][m][n][j] * rs; h[n * 4 + j] = g * sigmoidf_(g) * up; }
#pragma unroll
                for (int j = 0; j < 8; ++j) h[j] = clamp448(h[j] * HID_SCALE);
                u32x2 w; w.x = pk4_fp8(h[0], h[1], h[2], h[3]); w.y = pk4_fp8(h[4], h[5], h[6], h[7]);
                *(u32x2*)(H + (size_t)(u.pm * BM + r) * EFF + col0) = w; }
    }
};
struct EpiDown {
    static constexpr bool PERM = true;
    unsigned char* C; const LAS int* slot; const LAS float* gate; int rounds;
    __device__ __forceinline__ void operator()(const f32x4 (&acc)[2][2][4][2], const Unit& u, int ui_, int wr, int wc, int fr, int fq) const {
        const int ui = ui_ % rounds;
        const int r0 = wr * 64 + fr, col0 = u.pn * BM + wc * 32 + 8 * fq;
#pragma unroll
        for (int ai = 0; ai < 2; ++ai)
#pragma unroll
            for (int m = 0; m < 4; ++m) { const int r = r0 + ai * HALF + m * 16; const int sl = slot[ui * 256 + r]; const float gt = gate[ui * 256 + r];
                if (sl >= 0) { unsigned char* rowp = C + (size_t)sl * D + col0;
#pragma unroll
                    for (int bj = 0; bj < 2; ++bj) { const f32x4 v0 = acc[ai][bj][m][0] * gt, v1 = acc[ai][bj][m][1] * gt;
                        u32x2 w; w.x = pk4_fp8(clamp448(v0[0]), clamp448(v0[1]), clamp448(v0[2]), clamp448(v0[3])); w.y = pk4_fp8(clamp448(v1[0]), clamp448(v1[1]), clamp448(v1[2]), clamp448(v1[3]));
                        *(u32x2*)(rowp + bj * HALF) = w; } } }
    }
};
}

struct Frame {
    LAS unsigned char* lds; int tid, lane, wave, G, bx;
    const float *x, *meta, *g1, *w_in, *conv_w, *conv_b, *wa, *ba, *wx, *bx_, *lam, *lru_gain, *pool_w, *pool_scale, *w_out, *g2, *w_group, *b_group, *w_router, *b_router, *w_gate, *w_up, *w_down, *final_gain;
    float* out; unsigned char* ws; unsigned* ctl;
    bf16 *WinT, *WoutT, *WaT, *WxT, *PwT, *HN1, *YMIX, *PROJ, *H1; unsigned char *WguT, *WdT, *HN2, *HID, *C;
    _Float16* WrH; float* AGG; float* HM; u32x4* AB; f32x4* RINFO;
};
__device__ __forceinline__ float wave_sum(float v) {
#pragma unroll
    for (int o = 1; o < 64; o <<= 1) v += __shfl_xor(v, o);
    return v;
}

__device__ __forceinline__ void transpose_tile(const float* W, int ldw, int k0, int n0, bf16* WT, int ldt, int drow0, LAS float* scr, int lane) {
    { float v[32];
#pragma unroll
      for (int i = 0; i < 32; ++i) v[i] = W[(size_t)(k0 + 2 * i + (lane >> 5)) * ldw + n0 + (lane & 31)];
#pragma unroll
      for (int i = 0; i < 32; ++i) scr[(2 * i + (lane >> 5)) * 33 + (lane & 31)] = v[i]; }
    LDS_WAIT(); asm volatile("" ::: "memory");
    const int c = lane & 7;
#pragma unroll
    for (int j = 0; j < 4; ++j) { const int n = (lane >> 3) + 8 * j; const LAS float* s = scr + (8 * c) * 33 + n;
        u32x4 o; o.x = pk2(s[0 * 33], s[1 * 33]); o.y = pk2(s[2 * 33], s[3 * 33]); o.z = pk2(s[4 * 33], s[5 * 33]); o.w = pk2(s[6 * 33], s[7 * 33]);
        *(u32x4*)(WT + (size_t)(drow0 + n) * ldt + k0 + 8 * c) = o; }
    LDS_WAIT(); asm volatile("" ::: "memory");
}
__device__ __forceinline__ void transpose_tile_fp8(const float* W, int ldw, int k0, int n0, unsigned char* WT, int ldt, int drow0, float scale, LAS float* scr, int lane) {
    { float v[64];
#pragma unroll
      for (int i = 0; i < 64; ++i) v[i] = W[(size_t)(k0 + 2 * i + (lane >> 5)) * ldw + n0 + (lane & 31)];
#pragma unroll
      for (int i = 0; i < 64; ++i) scr[(2 * i + (lane >> 5)) * 33 + (lane & 31)] = v[i]; }
    LDS_WAIT(); asm volatile("" ::: "memory");
    const int n = lane >> 1, kh = (lane & 1) * 64; const LAS float* sp = scr + kh * 33 + n;
#pragma unroll
    for (int c = 0; c < 4; ++c) { u32x4 o;
#pragma unroll
        for (int w = 0; w < 4; ++w) { const LAS float* q4 = sp + (16 * c + 4 * w) * 33; o[w] = pk4_fp8(q4[0] * scale, q4[33] * scale, q4[66] * scale, q4[99] * scale); }
        *(u32x4*)(WT + (size_t)(drow0 + n) * ldt + k0 + kh + 16 * c) = o; }
    LDS_WAIT(); asm volatile("" ::: "memory");
}
__device__ __forceinline__ void p0_prologue(Frame& F) {
    if (F.bx < INW / 8) {
        LAS float* hnm = (LAS float*)F.lds;
        LAS float* part = (LAS float*)(F.lds + 65536);
        for (int r = F.wave * 2; r < F.wave * 2 + 2; ++r) {
            const f32x4* xr = (const f32x4*)(F.meta + (size_t)r * D) + F.lane; f32x4 v[4]; float s = 0.f;
#pragma unroll
            for (int j = 0; j < 4; ++j) { v[j] = xr[64 * j]; s += (v[j].x * v[j].x + v[j].y * v[j].y) + (v[j].z * v[j].z + v[j].w * v[j].w); }
            const float rstd = rsqrtf(wave_sum(s) * (1.f / D) + RMS_EPS);
#pragma unroll
            for (int j = 0; j < 4; ++j) { const f32x4 g = ((const f32x4*)F.g1)[F.lane + 64 * j]; *(LAS f32x4*)(hnm + r * D + 4 * F.lane + 256 * j) = v[j] * rstd * g; }
        }
        __syncthreads();
        { const int cc = F.tid & 7, ks = F.tid >> 3, col = F.bx * 8 + cc; float a[16];
#pragma unroll
            for (int r = 0; r < 16; ++r) a[r] = 0.f;
            for (int k = ks * 16; k < ks * 16 + 16; ++k) { const float w = F.w_in[(size_t)k * INW + col];
#pragma unroll
                for (int r = 0; r < 16; ++r) a[r] += hnm[r * D + k] * w; }
#pragma unroll
            for (int r = 0; r < 16; ++r) part[(ks * 16 + r) * 8 + cc] = a[r]; }
        __syncthreads();
        if (F.tid < 128) { const int r = F.tid >> 3, cc = F.tid & 7; float s = 0.f;
            for (int ks = 0; ks < 64; ++ks) s += part[(ks * 16 + r) * 8 + cc];
            const bf16 h = (bf16)f2bf(s);
            for (int b = 0; b < NBATCH; ++b) F.PROJ[(size_t)(b * TT + r) * INW + F.bx * 8 + cc] = h; }
        __syncthreads();
    }
    LAS float* scr = (LAS float*)(F.lds + F.wave * 16896);
    const int gw = F.bx * 8 + F.wave, NGW = F.G * 8;
    constexpr int I_IN = 16 * 48, I_OUT = 16 * 32, I_G = NE * 8 * 16, I_D = NE * 4 * 32, I_A = 8 * 2, I_P = 4 * 2 * 4;
    constexpr int NITEMS = I_IN + I_OUT + 2 * I_G + I_D + 2 * I_A + I_P;
    for (int it = gw; it < NITEMS; it += NGW) {
        int r = it;
        if (r < I_IN) { const int kb = r / 48, nb = r % 48; transpose_tile(F.w_in, INW, 64 * kb, 32 * nb, F.WinT, D, 32 * nb, scr, F.lane); continue; } r -= I_IN;
        if (r < I_OUT) { const int kb = r / 32, nb = r % 32; transpose_tile(F.w_out, D, 64 * kb, 32 * nb, F.WoutT, D, 32 * nb, scr, F.lane); continue; } r -= I_OUT;
        if (r < 2 * I_G) { const int up = r >= I_G; if (up) r -= I_G; const int e = r >> 7, kb = (r >> 4) & 7, nb = r & 15, n0 = 32 * nb;
            transpose_tile_fp8((up ? F.w_up : F.w_gate) + (size_t)e * D * EFF, EFF, 128 * kb, n0, F.WguT + (size_t)e * 1024 * D, D, (n0 >> 7) * 256 + up * 128 + (n0 & 127), WGU_SCALE, scr, F.lane); continue; } r -= 2 * I_G;
        if (r < I_D) { const int e = r >> 7, kb = (r >> 5) & 3, nb = r & 31; transpose_tile_fp8(F.w_down + (size_t)e * EFF * D, D, 128 * kb, 32 * nb, F.WdT + (size_t)e * D * EFF, EFF, 32 * nb, WD_SCALE, scr, F.lane); continue; } r -= I_D;
        if (r < 2 * I_A) { const int x = r >= I_A; if (x) r -= I_A; const int h = r >> 1, nb = r & 1; transpose_tile((x ? F.wx : F.wa) + (size_t)h * 4096, 64, 0, 32 * nb, (x ? F.WxT : F.WaT) + (size_t)h * 4096, 64, 32 * nb, scr, F.lane); continue; } r -= 2 * I_A;
        { const int g = r >> 3, kb = (r >> 2) & 1, nb = r & 3; transpose_tile(F.pool_w + (size_t)g * 16384, 128, 64 * kb, 32 * nb, F.PwT + (size_t)g * 16384, 128, 32 * nb, scr, F.lane); }
    }
    for (int i = F.bx * 512 + F.tid; i < NROUTE * D; i += F.G * 512) { const int n = i >> 10, k = i & 1023;
        const float w = n < 4 ? F.w_group[k * 4 + n] : F.w_router[k * 32 + (n - 4)]; F.WrH[i] = (_Float16)(w * 256.0f); }
    { f32x4 g[4];
#pragma unroll
      for (int j = 0; j < 4; ++j) g[j] = ((const f32x4*)F.g1)[F.lane + 64 * j];
      for (int m = gw * 4; m < M; m += NGW * 4) {
        f32x4 v[4][4];
#pragma unroll
        for (int r = 0; r < 4; ++r)
#pragma unroll
            for (int j = 0; j < 4; ++j) v[r][j] = ((const f32x4*)(F.x + (size_t)(m + r) * D))[F.lane + 64 * j];
#pragma unroll
        for (int r = 0; r < 4; ++r) { float s = 0.f;
#pragma unroll
            for (int j = 0; j < 4; ++j) s += (v[r][j].x * v[r][j].x + v[r][j].y * v[r][j].y) + (v[r][j].z * v[r][j].z + v[r][j].w * v[r][j].w);
            const float rstd = rsqrtf(wave_sum(s) * (1.f / D) + RMS_EPS);
            u32x2* o8 = (u32x2*)(F.HN1 + (size_t)(m + r) * D) + F.lane;
#pragma unroll
            for (int j = 0; j < 4; ++j) { const f32x4 y = v[r][j] * rstd * g[j]; u32x2 w; w.x = pk2(y.x, y.y); w.y = pk2(y.z, y.w); o8[64 * j] = w; } }
      } }
}

template <int CTRL> __device__ __forceinline__ float dpp_f(float old, float src) {
    return __builtin_bit_cast(float, __builtin_amdgcn_update_dpp(__builtin_bit_cast(int, old), __builtin_bit_cast(int, src), CTRL, 0xf, 0xf, false)); }
#define DPP_BCAST15 0x15F
__device__ __forceinline__ void row_scan(float& A, float& B) {
    { const float Ap = dpp_f<0x111>(1.0f, A), Bp = dpp_f<0x111>(0.0f, B); B = A * Bp + B; A = A * Ap; }
    { const float Ap = dpp_f<0x112>(1.0f, A), Bp = dpp_f<0x112>(0.0f, B); B = A * Bp + B; A = A * Ap; }
    { const float Ap = dpp_f<0x114>(1.0f, A), Bp = dpp_f<0x114>(0.0f, B); B = A * Bp + B; A = A * Ap; }
    { const float Ap = dpp_f<0x118>(1.0f, A), Bp = dpp_f<0x118>(0.0f, B); B = A * Bp + B; A = A * Ap; }
}
#define SCAN8_STR(D) "s_nop 1\n\t" \
    "v_fmac_f32_dpp %0, %0, %8 row_shr:" #D " row_mask:0xf bank_mask:0xf\n\tv_mul_f32_dpp %8, %8, %8 row_shr:" #D " row_mask:0xf bank_mask:0xf\n\t" \
    "v_fmac_f32_dpp %1, %1, %9 row_shr:" #D " row_mask:0xf bank_mask:0xf\n\tv_mul_f32_dpp %9, %9, %9 row_shr:" #D " row_mask:0xf bank_mask:0xf\n\t" \
    "v_fmac_f32_dpp %2, %2, %10 row_shr:" #D " row_mask:0xf bank_mask:0xf\n\tv_mul_f32_dpp %10, %10, %10 row_shr:" #D " row_mask:0xf bank_mask:0xf\n\t" \
    "v_fmac_f32_dpp %3, %3, %11 row_shr:" #D " row_mask:0xf bank_mask:0xf\n\tv_mul_f32_dpp %11, %11, %11 row_shr:" #D " row_mask:0xf bank_mask:0xf\n\t" \
    "v_fmac_f32_dpp %4, %4, %12 row_shr:" #D " row_mask:0xf bank_mask:0xf\n\tv_mul_f32_dpp %12, %12, %12 row_shr:" #D " row_mask:0xf bank_mask:0xf\n\t" \
    "v_fmac_f32_dpp %5, %5, %13 row_shr:" #D " row_mask:0xf bank_mask:0xf\n\tv_mul_f32_dpp %13, %13, %13 row_shr:" #D " row_mask:0xf bank_mask:0xf\n\t" \
    "v_fmac_f32_dpp %6, %6, %14 row_shr:" #D " row_mask:0xf bank_mask:0xf\n\tv_mul_f32_dpp %14, %14, %14 row_shr:" #D " row_mask:0xf bank_mask:0xf\n\t" \
    "v_fmac_f32_dpp %7, %7, %15 row_shr:" #D " row_mask:0xf bank_mask:0xf\n\tv_mul_f32_dpp %15, %15, %15 row_shr:" #D " row_mask:0xf bank_mask:0xf"
#define SCAN8(D, A, B, o) asm volatile(SCAN8_STR(D) : "+v"(B[o + 0]), "+v"(B[o + 1]), "+v"(B[o + 2]), "+v"(B[o + 3]), "+v"(B[o + 4]), "+v"(B[o + 5]), "+v"(B[o + 6]), "+v"(B[o + 7]), \
    "+v"(A[o + 0]), "+v"(A[o + 1]), "+v"(A[o + 2]), "+v"(A[o + 3]), "+v"(A[o + 4]), "+v"(A[o + 5]), "+v"(A[o + 6]), "+v"(A[o + 7]))
__device__ __forceinline__ void row_scan16(float (&A)[16], float (&B)[16]) {
    SCAN8(1, A, B, 0); SCAN8(1, A, B, 8); SCAN8(2, A, B, 0); SCAN8(2, A, B, 8); SCAN8(4, A, B, 0); SCAN8(4, A, B, 8); SCAN8(8, A, B, 0); SCAN8(8, A, B, 8);
}
struct LruW { LAS float* cst; const bf16 *waP, *wxP; };
__device__ __forceinline__ void lru_setup(const Frame& F, LruW& L, LAS unsigned char* wbase) {
    const int hd = F.wave; L.cst = (LAS float*)wbase;
    for (int i = F.lane; i < 512; i += 64) { const int t = i >> 6, ch = hd * 64 + (i & 63); float v;
        if (t < 4) v = F.conv_w[t * LW + ch]; else if (t == 4) v = F.conv_b[ch]; else if (t == 5) v = F.ba[ch]; else if (t == 6) v = F.bx_[ch];
        else { const float lm = F.lam[ch]; v = 8.0f * (fminf(lm, 0.f) - log1pf(__expf(-fabsf(lm)))); }
        L.cst[i] = v; }
    const int i = F.lane & 15, qw = F.lane >> 4; const size_t o = (size_t)hd * 4096 + (size_t)(8 * (i >> 2) + (i & 3)) * 64 + 8 * qw;
    L.waP = F.WaT + o; L.wxP = F.WxT + o;
    LDS_WAIT();
}
struct LruRaw { u32x4 u[2][4]; u32x4 ug[2]; };
template <bool WITH_UG>
__device__ __forceinline__ void lru_load(const Frame& F, int b, int tt0, LruRaw& R) {
    const int hd = F.wave, row = F.lane & 15, q = F.lane >> 4, tt = tt0 + row;
    const bf16* prow = F.PROJ + (size_t)(b * TT + tt) * INW + hd * 64 + 8 * q;
#pragma unroll
    for (int kb = 0; kb < 2; ++kb) {
#pragma unroll
        for (int k = 0; k < 4; ++k) { R.u[kb][k] = (u32x4){0u, 0u, 0u, 0u}; if (tt - 3 + k >= 0) R.u[kb][k] = *(const u32x4*)(prow + (ptrdiff_t)(k - 3) * INW + 32 * kb); }
        if (WITH_UG) R.ug[kb] = *(const u32x4*)(prow + LW + 32 * kb);
    }
}
__device__ __forceinline__ void lru_conv(const Frame& F, const LruW& L, const LruRaw& R, float (&xc)[16], bf16x8 (&xf)[2]) {
    const int q = F.lane >> 4;
#pragma unroll
    for (int kb = 0; kb < 2; ++kb) {
        const LAS float* cs = L.cst + 32 * kb + 8 * q;
        f32x2 x2[4];
        { const f32x4 c0 = *(const LAS f32x4*)(cs + 256), c1 = *(const LAS f32x4*)(cs + 260); x2[0] = (f32x2){c0.x, c0.y}; x2[1] = (f32x2){c0.z, c0.w}; x2[2] = (f32x2){c1.x, c1.y}; x2[3] = (f32x2){c1.z, c1.w}; }
#pragma unroll
        for (int k = 0; k < 4; ++k) {
            const u32x4 u = R.u[kb][k];
            const f32x4 w0 = *(const LAS f32x4*)(cs + 64 * k), w1 = *(const LAS f32x4*)(cs + 64 * k + 4);
            x2[0] = (f32x2){w0.x, w0.y} * (f32x2){bflo(u.x), bfhi(u.x)} + x2[0]; x2[1] = (f32x2){w0.z, w0.w} * (f32x2){bflo(u.y), bfhi(u.y)} + x2[1];
            x2[2] = (f32x2){w1.x, w1.y} * (f32x2){bflo(u.z), bfhi(u.z)} + x2[2]; x2[3] = (f32x2){w1.z, w1.w} * (f32x2){bflo(u.w), bfhi(u.w)} + x2[3];
        }
#pragma unroll
        for (int i = 0; i < 4; ++i) { xc[8 * kb + 2 * i] = x2[i].x; xc[8 * kb + 2 * i + 1] = x2[i].y; }
        asm volatile("" : "+v"(xc[8 * kb + 0]), "+v"(xc[8 * kb + 1]), "+v"(xc[8 * kb + 2]), "+v"(xc[8 * kb + 3]), "+v"(xc[8 * kb + 4]), "+v"(xc[8 * kb + 5]), "+v"(xc[8 * kb + 6]), "+v"(xc[8 * kb + 7]));
        u32x4 p; p.x = pk2(xc[8 * kb + 0], xc[8 * kb + 1]); p.y = pk2(xc[8 * kb + 2], xc[8 * kb + 3]); p.z = pk2(xc[8 * kb + 4], xc[8 * kb + 5]); p.w = pk2(xc[8 * kb + 6], xc[8 * kb + 7]);
        xf[kb] = __builtin_bit_cast(bf16x8, p);
    }
}
template <bool WPF  >
__device__ __forceinline__ void lru_gates(const Frame& F, const LruW& L, const float (&xc)[16], const bf16x8 (&xf)[2], float (&Av)[16], float (&Bv)[16]) {
    const int q = F.lane >> 4;
    bf16x8 wa[2], wx[2];
#pragma unroll
    for (int kk = 0; kk < 2; ++kk) { wa[kk] = *(const bf16x8*)(L.waP + 32 * kk); wx[kk] = *(const bf16x8*)(L.wxP + 32 * kk); }
#pragma unroll
    for (int nb = 0; nb < 4; ++nb) {
        const int kb = nb >> 1, hf = nb & 1;
        bf16x8 wan[2], wxn[2];
        if (!WPF && nb > 0) { const int o = (32 * kb + 4 * hf) * 64;
#pragma unroll
            for (int kk = 0; kk < 2; ++kk) { wa[kk] = *(const bf16x8*)(L.waP + o + 32 * kk); wx[kk] = *(const bf16x8*)(L.wxP + o + 32 * kk); } }
        if (WPF && nb < 3) { const int o = (32 * ((nb + 1) >> 1) + 4 * ((nb + 1) & 1)) * 64;
#pragma unroll
            for (int kk = 0; kk < 2; ++kk) { wan[kk] = *(const bf16x8*)(L.waP + o + 32 * kk); wxn[kk] = *(const bf16x8*)(L.wxP + o + 32 * kk); } }
        asm volatile("" ::: "memory");
        f32x4 ra = (f32x4){0.f, 0.f, 0.f, 0.f}, rx = ra;
#pragma unroll
        for (int kk = 0; kk < 2; ++kk) { ra = __builtin_amdgcn_mfma_f32_16x16x32_bf16(wa[kk], xf[kk], ra, 0, 0, 0); rx = __builtin_amdgcn_mfma_f32_16x16x32_bf16(wx[kk], xf[kk], rx, 0, 0, 0); }
        const LAS float* cs = L.cst + 32 * kb + 8 * q + 4 * hf;
        const f32x4 ba4 = *(const LAS f32x4*)(cs + 320), bx4 = *(const LAS f32x4*)(cs + 384), lm4 = *(const LAS f32x4*)(cs + 448);
#pragma unroll
        for (int j = 0; j < 4; ++j) { const int c = 8 * kb + 4 * hf + j;
            const float r = sigmoidf_(ra[j] + ba4[j]), ig = sigmoidf_(rx[j] + bx4[j]);
            const float a = __expf(lm4[j] * r);
            Av[c] = a; Bv[c] = __builtin_amdgcn_sqrtf(fmaf(-a, a, 1.0f)) * (ig * xc[c]); }
        if (WPF && nb < 3) {
#pragma unroll
            for (int kk = 0; kk < 2; ++kk) { wa[kk] = wan[kk]; wx[kk] = wxn[kk]; } }
    }
    row_scan16(Av, Bv);
}
__device__ __forceinline__ void p2_aggregates(Frame& F) {
    LruW L; lru_setup(F, L, F.lds + F.wave * 2048);
    const int row = F.lane & 15, q = F.lane >> 4;
    for (int ch = F.bx; ch < 256; ch += F.G) {
        const int b = ch >> 5, ci = ch & 31; float Ac[16], Bc[16];
#pragma unroll
        for (int c = 0; c < 16; ++c) { Ac[c] = 1.f; Bc[c] = 0.f; }
        const int blk0 = (ci == 0 ? -1 : 0);
        LruRaw R; lru_load<false>(F, b, NMETA + 128 * ci + 16 * blk0, R);
        for (int blk = blk0; blk < 8; ++blk) {
            float xc[16]; bf16x8 xf[2]; lru_conv(F, L, R, xc, xf);
            if (blk < 7) lru_load<false>(F, b, NMETA + 128 * ci + 16 * (blk + 1), R);
            asm volatile("" ::: "memory");
            float Av[16], Bv[16];
            lru_gates<true>(F, L, xc, xf, Av, Bv);
            if (blk >= 0) { u32x4* ab = F.AB + ((size_t)((ch * 8 + blk) * 8 + F.wave) * 4) * 64 + F.lane;
#pragma unroll
                for (int j = 0; j < 2; ++j) { u32x4 a, bq;
                    a.x = pkh2(Av[8 * j], Av[8 * j + 1]); a.y = pkh2(Av[8 * j + 2], Av[8 * j + 3]); a.z = pkh2(Av[8 * j + 4], Av[8 * j + 5]); a.w = pkh2(Av[8 * j + 6], Av[8 * j + 7]);
                    bq.x = pkh2(Bv[8 * j], Bv[8 * j + 1]); bq.y = pkh2(Bv[8 * j + 2], Bv[8 * j + 3]); bq.z = pkh2(Bv[8 * j + 4], Bv[8 * j + 5]); bq.w = pkh2(Bv[8 * j + 6], Bv[8 * j + 7]);
                    ab[64 * j] = a; ab[64 * (2 + j)] = bq; } }
            else if (row == 15) {
#pragma unroll
                for (int kb = 0; kb < 2; ++kb) { float* o = F.HM + (size_t)b * LW + F.wave * 64 + 32 * kb + 8 * q;
                    *(f32x4*)o = (f32x4){Bv[8 * kb], Bv[8 * kb + 1], Bv[8 * kb + 2], Bv[8 * kb + 3]}; *(f32x4*)(o + 4) = (f32x4){Bv[8 * kb + 4], Bv[8 * kb + 5], Bv[8 * kb + 6], Bv[8 * kb + 7]}; } }
#pragma unroll
            for (int c = 0; c < 16; ++c) { Bc[c] = Av[c] * Bc[c] + Bv[c]; Ac[c] *= Av[c]; }
        }
        if (row == 15) {
#pragma unroll
            for (int kb = 0; kb < 2; ++kb) { float* o = F.AGG + ((size_t)ch * LW + F.wave * 64 + 32 * kb + 8 * q) * 2;
#pragma unroll
                for (int j = 0; j < 8; j += 2) *(f32x4*)(o + 2 * j) = (f32x4){Ac[8 * kb + j], Bc[8 * kb + j], Ac[8 * kb + j + 1], Bc[8 * kb + j + 1]}; }
        }
    }
}

constexpr int YT_STRIDE = 520;
constexpr int US_STRIDE = 264;
constexpr int PW_STRIDE = 136;
template <int G> __device__ __forceinline__ void pool_z(const LAS bf16* ub  , bf16x8 (&zf)[4]) {
    constexpr int W = 2 << G;
    asm volatile("" : "+v"(ub));
#pragma unroll
    for (int kb = 0; kb < 4; ++kb) {
        const LAS bf16* p = ub + 15 * US_STRIDE + 32 * kb; const u32x4 c = *(const LAS u32x4*)p; float cur[8], s[8];
        cur[0] = bflo(c.x); cur[1] = bfhi(c.x); cur[2] = bflo(c.y); cur[3] = bfhi(c.y); cur[4] = bflo(c.z); cur[5] = bfhi(c.z); cur[6] = bflo(c.w); cur[7] = bfhi(c.w);
#pragma unroll
        for (int j = 0; j < 8; ++j) s[j] = cur[j];
#pragma unroll
        for (int d = 1; d < W; ++d) { const u32x4 u = *(const LAS u32x4*)(ub + (15 - d) * US_STRIDE + 32 * kb);
            s[0] += bflo(u.x); s[1] += bfhi(u.x); s[2] += bflo(u.y); s[3] += bfhi(u.y); s[4] += bflo(u.z); s[5] += bfhi(u.z); s[6] += bflo(u.w); s[7] += bfhi(u.w);
            if ((d & 3) == 3) asm volatile("" : "+v"(s[0]), "+v"(s[1]), "+v"(s[2]), "+v"(s[3]), "+v"(s[4]), "+v"(s[5]), "+v"(s[6]), "+v"(s[7]) :: "memory"); }
        asm volatile("" : "+v"(s[0]), "+v"(s[1]), "+v"(s[2]), "+v"(s[3]), "+v"(s[4]), "+v"(s[5]), "+v"(s[6]), "+v"(s[7]) :: "memory");
        u32x4 pz; pz.x = pk2(s[0] * (1.0f / W) - cur[0], s[1] * (1.0f / W) - cur[1]); pz.y = pk2(s[2] * (1.0f / W) - cur[2], s[3] * (1.0f / W) - cur[3]);
        pz.z = pk2(s[4] * (1.0f / W) - cur[4], s[5] * (1.0f / W) - cur[5]); pz.w = pk2(s[6] * (1.0f / W) - cur[6], s[7] * (1.0f / W) - cur[7]);
        asm volatile("" : "+v"(pz) :: "memory");
        zf[kb] = __builtin_bit_cast(bf16x8, pz);
    }
}
__device__ __forceinline__ void p3_mixer(Frame& F) {
    LAS bf16* Y = (LAS bf16*)F.lds;
    LAS unsigned char* wbase = F.lds + 66560 + F.wave * 2048;
    LAS float* SSQ = (LAS float*)(F.lds + 66560 + 16384);
    LAS float* RSTD = SSQ + 512;
    LAS bf16* US = (LAS bf16*)F.lds;
    const int row = F.lane & 15, q = F.lane >> 4;
    for (int ch = F.bx; ch < 256; ch += F.G) {
        const int b = ch >> 5, ci = ch & 31; const int m0 = ch * 128;
#ifndef P3_NO_LRU
        {
        float H[16];
        { float Ar[16], Br[16];
#pragma unroll
            for (int c = 0; c < 16; ++c) { Ar[c] = 1.f; Br[c] = 0.f; }
#pragma unroll
            for (int t = 0; t < 2; ++t) { const int k = 2 * row + t;
                if (k < ci) {
#pragma unroll
                    for (int kb = 0; kb < 2; ++kb) { const float* o = F.AGG + ((size_t)(b * 32 + k) * LW + F.wave * 64 + 32 * kb + 8 * q) * 2;
#pragma unroll
                        for (int j = 0; j < 8; j += 2) { const f32x4 v = *(const f32x4*)(o + 2 * j); const int c = 8 * kb + j;
                            Br[c] = v.x * Br[c] + v.y; Ar[c] *= v.x; Br[c + 1] = v.z * Br[c + 1] + v.w; Ar[c + 1] *= v.z; } } } }
            row_scan16(Ar, Br);
#pragma unroll
            for (int c = 0; c < 16; ++c) H[c] = dpp_f<DPP_BCAST15>(0.f, Br[c]); }
        if (ci == 0) {
#pragma unroll
            for (int kb = 0; kb < 2; ++kb) { const float* o = F.HM + (size_t)b * LW + F.wave * 64 + 32 * kb + 8 * q; const f32x4 h0 = *(const f32x4*)o, h1 = *(const f32x4*)(o + 4);
                H[8 * kb] = h0.x; H[8 * kb + 1] = h0.y; H[8 * kb + 2] = h0.z; H[8 * kb + 3] = h0.w; H[8 * kb + 4] = h1.x; H[8 * kb + 5] = h1.y; H[8 * kb + 6] = h1.z; H[8 * kb + 7] = h1.w; }
        }
        u32x4 abv[4]; u32x4 ug[2];
        { const u32x4* ab = F.AB + ((size_t)((ch * 8 + 0) * 8 + F.wave) * 4) * 64 + F.lane;
#pragma unroll
          for (int j = 0; j < 4; ++j) abv[j] = ab[64 * j];
          const bf16* prow = F.PROJ + (size_t)(b * TT + NMETA + 128 * ci + row) * INW + LW + F.wave * 64 + 8 * q; ug[0] = *(const u32x4*)prow; ug[1] = *(const u32x4*)(prow + 32); }
        for (int half = 0; half < 2; ++half) {
            for (int blk = 0; blk < 4; ++blk) {
                const int rb = 16 * blk, gb = half * 4 + blk;
                float Av[16], Bv[16]; u32x4 ugc[2] = {ug[0], ug[1]};
#pragma unroll
                for (int j = 0; j < 2; ++j)
#pragma unroll
                    for (int i = 0; i < 4; ++i) { Av[8 * j + 2 * i] = h2lo(abv[j][i]); Av[8 * j + 2 * i + 1] = h2hi(abv[j][i]); Bv[8 * j + 2 * i] = h2lo(abv[2 + j][i]); Bv[8 * j + 2 * i + 1] = h2hi(abv[2 + j][i]); }
                if (gb < 7) { const u32x4* ab = F.AB + ((size_t)((ch * 8 + gb + 1) * 8 + F.wave) * 4) * 64 + F.lane;
#pragma unroll
                    for (int j = 0; j < 4; ++j) abv[j] = ab[64 * j];
                    const bf16* prow = F.PROJ + (size_t)(b * TT + NMETA + 128 * ci + 16 * (gb + 1) + row) * INW + LW + F.wave * 64 + 8 * q; ug[0] = *(const u32x4*)prow; ug[1] = *(const u32x4*)(prow + 32); }
                asm volatile("" ::: "memory");
                float ss = 0.f;
#pragma unroll
                for (int kb = 0; kb < 2; ++kb) { float y[8];
#pragma unroll
                    for (int j = 0; j < 8; ++j) { const int c = 8 * kb + j;
                        const float h = Av[c] * H[c] + Bv[c];
                        const unsigned w = ugc[kb][j >> 1]; const float g = (j & 1) ? bfhi(w) : bflo(w);
                        const float gl = g * sigmoidf_(1.5957691216f * (g + 0.044715f * g * g * g));
                        y[j] = h * gl; ss += y[j] * y[j];
                        H[c] = dpp_f<DPP_BCAST15>(0.f, h); }
                    u32x4 p; p.x = pk2(y[0], y[1]); p.y = pk2(y[2], y[3]); p.z = pk2(y[4], y[5]); p.w = pk2(y[6], y[7]);
                    *(LAS u32x4*)(Y + (rb + row) * YT_STRIDE + F.wave * 64 + 32 * kb + 8 * q) = p;
                    asm volatile("" : "+v"(ss) :: "memory"); }
                ss += __shfl_xor(ss, 16); ss += __shfl_xor(ss, 32);
                if (q == 0) SSQ[(rb + row) * 8 + F.wave] = ss;
            }
            __syncthreads();
            if (F.tid < 64) { float s = 0.f;
#pragma unroll
                for (int w = 0; w < 8; ++w) s += SSQ[F.tid * 8 + w];
                RSTD[F.tid] = rsqrtf(s * (1.0f / LW) + RMS_EPS); }
            __syncthreads();
#pragma unroll
            for (int s = 0; s < 8; ++s) { const int p = F.tid + 512 * s, rw = p >> 6, cp = p & 63; const float rs = RSTD[rw];
                const u32x4 v = *(const LAS u32x4*)(Y + rw * YT_STRIDE + 8 * cp); const f32x4 g0 = *(const f32x4*)(F.lru_gain + 8 * cp), g1 = *(const f32x4*)(F.lru_gain + 8 * cp + 4);
                u32x4 o; o.x = pk2(bflo(v.x) * rs * g0.x, bfhi(v.x) * rs * g0.y); o.y = pk2(bflo(v.y) * rs * g0.z, bfhi(v.y) * rs * g0.w);
                o.z = pk2(bflo(v.z) * rs * g1.x, bfhi(v.z) * rs * g1.y); o.w = pk2(bflo(v.w) * rs * g1.z, bfhi(v.w) * rs * g1.w);
                *(u32x4*)(F.YMIX + (size_t)(m0 + 64 * half + rw) * D + 8 * cp) = o; }
            __syncthreads();
        }
        }
#endif
#ifndef P3_NO_POOL
        {
            bf16x8 zf[4][4];
            const int T0 = b * TT + NMETA + 128 * ci - 15;
#pragma unroll
            for (int gp = 0; gp < 2; ++gp) {
                for (int i = F.tid; i < 143 * 32; i += 512) { const int ri = i >> 5, cpc = i & 31;
                    *(LAS u32x4*)(US + ri * US_STRIDE + 8 * cpc) = *(const u32x4*)(F.PROJ + (size_t)(T0 + ri) * INW + 1024 + 256 * gp + 8 * cpc); }
                __syncthreads();
                const LAS bf16* urow = US + (16 * F.wave + row) * US_STRIDE + 8 * q;
                if (gp == 0) { pool_z<0>(urow, zf[0]); pool_z<1>(urow + 128, zf[1]); } else { pool_z<2>(urow, zf[2]); pool_z<3>(urow + 128, zf[3]); }
                __syncthreads();
            }
            for (int i = F.tid; i < 4 * 128 * 16; i += 512) { const int n = i >> 4, pc = i & 15; *(LAS u32x4*)(US + n * PW_STRIDE + 8 * pc) = *(const u32x4*)(F.PwT + (size_t)n * 128 + 8 * pc); }
            __syncthreads();
            const LAS bf16* wl = US + row * PW_STRIDE + 8 * q;
            float ssq = 0.f;
#pragma unroll
            for (int g = 0; g < 4; ++g) { const LAS bf16* wg = wl + g * 128 * PW_STRIDE; asm volatile("" : "+v"(wg));
#pragma unroll 2
                for (int nb = 0; nb < 8; ++nb) { f32x4 acc = (f32x4){0.f, 0.f, 0.f, 0.f}; const LAS bf16* wn = wg + 16 * nb * PW_STRIDE;
#pragma unroll
                    for (int kb = 0; kb < 4; ++kb) acc = __builtin_amdgcn_mfma_f32_16x16x32_bf16(*(const LAS bf16x8*)(wn + 32 * kb), zf[g][kb], acc, 0, 0, 0);
                    ssq += (acc[0] * acc[0] + acc[1] * acc[1]) + (acc[2] * acc[2] + acc[3] * acc[3]); } }
            ssq += __shfl_xor(ssq, 16); ssq += __shfl_xor(ssq, 32);
            const float rs = rsqrtf(ssq * (1.0f / 512.0f) + RMS_EPS);
            bf16* orow = F.YMIX + (size_t)(m0 + 16 * F.wave + row) * D + LW + 4 * q;
#pragma unroll
            for (int g = 0; g < 4; ++g) { const LAS bf16* wg = wl + g * 128 * PW_STRIDE; asm volatile("" : "+v"(wg));
#pragma unroll 2
                for (int nb = 0; nb < 8; ++nb) { f32x4 acc = (f32x4){0.f, 0.f, 0.f, 0.f}; const LAS bf16* wn = wg + 16 * nb * PW_STRIDE;
#pragma unroll
                    for (int kb = 0; kb < 4; ++kb) acc = __builtin_amdgcn_mfma_f32_16x16x32_bf16(*(const LAS bf16x8*)(wn + 32 * kb), zf[g][kb], acc, 0, 0, 0);
                    const f32x4 sc = *(const f32x4*)(F.pool_scale + 128 * g + 16 * nb + 4 * q);
                    u32x2 o; o.x = pk2(acc[0] * rs * sc.x, acc[1] * rs * sc.y); o.y = pk2(acc[2] * rs * sc.z, acc[3] * rs * sc.w);
                    *(u32x2*)(orow + 128 * g + 16 * nb) = o; } }
        }
#endif
        __syncthreads();
    }
}

constexpr int WR_STRIDE = 1032;
__device__ __forceinline__ void p5_route(Frame& F, const bool dry = false) {
    LAS _Float16* WR = (LAS _Float16*)F.lds;
    LAS float* LG = (LAS float*)(F.lds + 36 * WR_STRIDE * 2) + F.wave * 16 * 40;
    LAS int* LCNT = (LAS int*)(F.lds + 36 * WR_STRIDE * 2 + 8 * 16 * 40 * 4);
    LAS float* G2 = (LAS float*)(LCNT + 64);
    const int c16 = F.lane & 15, q = F.lane >> 4;
    for (int i = F.tid; i < NROUTE * 128; i += 512) { const int n = i >> 7, k8 = i & 127; *(LAS u32x4*)(WR + n * WR_STRIDE + 8 * k8) = *(const u32x4*)(F.WrH + n * D + 8 * k8); }
    for (int i = F.tid; i < D; i += 512) G2[i] = F.g2[i];
    for (int ch = F.bx; ch < 256; ch += F.G) {
        if (F.tid < 64) LCNT[F.tid] = 0;
        __syncthreads();
        const int row = ch * 128 + 16 * F.wave + c16;
        const bf16* hrow = F.H1 + (size_t)row * D + 8 * q;
        f32x4 acc[3]; float ss = 0.f;
#pragma unroll
        for (int nb = 0; nb < 3; ++nb) acc[nb] = (f32x4){0.f, 0.f, 0.f, 0.f};
#pragma unroll 4
        for (int i = 0; i < 32; ++i) {
            const u32x4 hw = *(const u32x4*)(hrow + 32 * i);
            const f32x4 h0 = (f32x4){bflo(hw.x), bfhi(hw.x), bflo(hw.y), bfhi(hw.y)}, h1 = (f32x4){bflo(hw.z), bfhi(hw.z), bflo(hw.w), bfhi(hw.w)};
            const f32x4 g0 = *(const LAS f32x4*)(G2 + 32 * i + 8 * q), g1 = *(const LAS f32x4*)(G2 + 32 * i + 8 * q + 4);
            ss += (h0.x * h0.x + h0.y * h0.y) + (h0.z * h0.z + h0.w * h0.w) + (h1.x * h1.x + h1.y * h1.y) + (h1.z * h1.z + h1.w * h1.w);
            const f32x4 t0 = h0 * g0, t1 = h1 * g1;
            f16x8 a; a[0] = (_Float16)t0.x; a[1] = (_Float16)t0.y; a[2] = (_Float16)t0.z; a[3] = (_Float16)t0.w; a[4] = (_Float16)t1.x; a[5] = (_Float16)t1.y; a[6] = (_Float16)t1.z; a[7] = (_Float16)t1.w;
#pragma unroll
            for (int nb = 0; nb < 3; ++nb) { const int col = 16 * nb + c16; f16x8 bw;
#pragma unroll
                for (int j = 0; j < 8; ++j) bw[j] = (_Float16)0.f;
                if (col < NROUTE) bw = *(const LAS f16x8*)(WR + col * WR_STRIDE + 32 * i + 8 * q);
                acc[nb] = __builtin_amdgcn_mfma_f32_16x16x32_f16(a, bw, acc[nb], 0, 0, 0); }
        }
        ss += __shfl_xor(ss, 16); ss += __shfl_xor(ss, 32);
        const float rstd = rsqrtf(ss * (1.0f / D) + RMS_EPS);
#pragma unroll
        for (int nb = 0; nb < 3; ++nb)
#pragma unroll
            for (int j = 0; j < 4; ++j) { const int col = 16 * nb + c16; if (col < 40) LG[(4 * q + j) * 40 + col] = acc[nb][j]; }
        LDS_WAIT();
        int e0 = 0, e1 = 0, rk0 = 0, rk1 = 0; float gt0 = 0.f, gt1 = 0.f;
        if (F.lane < 16) {
            const LAS float* lg = LG + F.lane * 40; const float sc = rstd * (1.0f / 256.0f);
            float gl[4]; int gi = 0;
#pragma unroll
            for (int j = 0; j < 4; ++j) gl[j] = lg[j] * sc + F.b_group[j];
            float gm = gl[0];
#pragma unroll
            for (int j = 1; j < 4; ++j) if (gl[j] > gm) { gm = gl[j]; gi = j; }
            float den = 0.f;
#pragma unroll
            for (int j = 0; j < 4; ++j) den += __expf(gl[j] - gm);
            const float pg = 1.0f / den;
            float v0 = -3.0e38f, v1 = -3.0e38f; int i0 = 0, i1 = 0;
            for (int j = 0; j < 8; ++j) { const float v = lg[4 + gi * 8 + j] * sc + F.b_router[gi * 8 + j];
                if (v > v0) { v1 = v0; i1 = i0; v0 = v; i0 = j; } else if (v > v1) { v1 = v; i1 = j; } }
            const float ex = __expf(v1 - v0), s0 = 1.0f / (1.0f + ex);
            gt0 = pg * s0; gt1 = pg * (ex * s0); e0 = gi * 8 + i0; e1 = gi * 8 + i1;
            rk0 = __hip_atomic_fetch_add(&LCNT[e0], 1, __ATOMIC_RELAXED, __HIP_MEMORY_SCOPE_WORKGROUP); rk1 = __hip_atomic_fetch_add(&LCNT[e1], 1, __ATOMIC_RELAXED, __HIP_MEMORY_SCOPE_WORKGROUP);
        }
        __syncthreads();
        if (F.tid < 32 && !dry) LCNT[32 + F.tid] = (int)__hip_atomic_fetch_add(F.ctl + CW_CNT + 64 * F.tid, (unsigned)LCNT[F.tid], __ATOMIC_RELAXED, __HIP_MEMORY_SCOPE_AGENT);
        __syncthreads();
        if (F.lane < 16 && !dry) { const int tok = ch * 128 + 16 * F.wave + F.lane;
            F.RINFO[(size_t)e0 * ECAP + LCNT[32 + e0] + rk0] = (f32x4){__builtin_bit_cast(float, tok * 2), gt0, rstd, 0.f};
            F.RINFO[(size_t)e1 * ECAP + LCNT[32 + e1] + rk1] = (f32x4){__builtin_bit_cast(float, tok * 2 + 1), gt1, rstd, 0.f}; }
        __syncthreads();
    }
}

__device__ __forceinline__ int moe_tables(Frame& F) {
    LAS int* TE = (LAS int*)(F.lds + TAB_TE); LAS int* TR = (LAS int*)(F.lds + TAB_TR); LAS int* CNT = (LAS int*)(F.lds + TAB_CNT); LAS int* PRE = CNT + 32;
    if (F.tid < 32) CNT[F.tid] = (int)__hip_atomic_load(F.ctl + CW_CNT + 64 * F.tid, __ATOMIC_RELAXED, __HIP_MEMORY_SCOPE_AGENT);
    __syncthreads();
    if (F.tid == 0) { int s = 0; for (int e = 0; e < NE; ++e) { PRE[e] = s; s += (CNT[e] + 255) >> 8; } PRE[NE] = s; }
    __syncthreads();
    const int NT = PRE[NE];
    for (int t = F.tid; t < NT; t += 512) { int e = 0; while (e < NE - 1 && PRE[e + 1] <= t) ++e; TE[t] = e; TR[t] = (t - PRE[e]) * 256; }
    __syncthreads();
    return NT;
}
__device__ __forceinline__ void moe_unit_tables(Frame& F, const pg8::MoeSched& S, int mode) {
    LAS int* TE = (LAS int*)(F.lds + TAB_TE); LAS int* TR = (LAS int*)(F.lds + TAB_TR); LAS int* CNT = (LAS int*)(F.lds + TAB_CNT);
    LAS unsigned* ROW = (LAS unsigned*)(F.lds + TAB_ROW); LAS float* FT = (LAS float*)(F.lds + TAB_F);
    const int nu = S.rounds() < MAXU ? S.rounds() : MAXU;
    f32x4 ri[MAXU / 2]; bool valid[MAXU / 2]; int ok[MAXU / 2];
#pragma unroll
    for (int t = 0; t < MAXU / 2; ++t) { const int idx = F.tid + 512 * t, i = idx >> 8, r = idx & 255; pg8::Unit u;
        ri[t] = (f32x4){0.f, 0.f, 0.f, 0.f}; valid[t] = false; ok[t] = (i < nu) && S.next(i, u);
        if (ok[t]) { const int e = TE[u.pm], pos = TR[u.pm] + r; valid[t] = pos < CNT[e]; if (valid[t]) ri[t] = F.RINFO[(size_t)e * ECAP + pos]; } }
#pragma unroll
    for (int t = 0; t < MAXU / 2; ++t) if (ok[t]) { const int idx = F.tid + 512 * t; const int slot = __builtin_bit_cast(int, ri[t].x);
        if (mode == 0) { ROW[idx] = valid[t] ? (unsigned)(slot >> 1) * (unsigned)D : 0u; FT[idx] = valid[t] ? ri[t].z * (1.0f / WGU_SCALE) : 0.f; }
        else { ROW[idx] = valid[t] ? (unsigned)slot : 0xffffffffu; FT[idx] = ri[t].y * (C_SCALE / (WD_SCALE * HID_SCALE)); } }
    __syncthreads();
}

__device__ __forceinline__ void p8_final(Frame& F) {
    const int gw = F.bx * 8 + F.wave, NGW = F.G * 8;
    f32x4 g[4];
#pragma unroll
    for (int j = 0; j < 4; ++j) g[j] = ((const f32x4*)F.final_gain)[F.lane + 64 * j];
    for (int m = gw * 2; m < M; m += NGW * 2) {
        u32x2 hb[2][4]; unsigned ca[2][4], cb[2][4];
#pragma unroll
        for (int r = 0; r < 2; ++r)
#pragma unroll
            for (int j = 0; j < 4; ++j) { hb[r][j] = ((const u32x2*)(F.H1 + (size_t)(m + r) * D))[F.lane + 64 * j];
                ca[r][j] = ((const unsigned*)(F.C + (size_t)(2 * (m + r)) * D))[F.lane + 64 * j]; cb[r][j] = ((const unsigned*)(F.C + (size_t)(2 * (m + r) + 1) * D))[F.lane + 64 * j]; }
#pragma unroll
        for (int r = 0; r < 2; ++r) { f32x4 v[4]; float s = 0.f;
#pragma unroll
            for (int j = 0; j < 4; ++j) { const f32x2 a0 = __builtin_amdgcn_cvt_pk_f32_fp8(ca[r][j], false), a1 = __builtin_amdgcn_cvt_pk_f32_fp8(ca[r][j], true), b0 = __builtin_amdgcn_cvt_pk_f32_fp8(cb[r][j], false), b1 = __builtin_amdgcn_cvt_pk_f32_fp8(cb[r][j], true);
                v[j] = (f32x4){bflo(hb[r][j].x) + (a0.x + b0.x) * (1.0f / C_SCALE), bfhi(hb[r][j].x) + (a0.y + b0.y) * (1.0f / C_SCALE), bflo(hb[r][j].y) + (a1.x + b1.x) * (1.0f / C_SCALE), bfhi(hb[r][j].y) + (a1.y + b1.y) * (1.0f / C_SCALE)};
                s += (v[j].x * v[j].x + v[j].y * v[j].y) + (v[j].z * v[j].z + v[j].w * v[j].w); }
            const float rstd = rsqrtf(wave_sum(s) * (1.f / D) + RMS_EPS);
            f32x4* o = (f32x4*)(F.out + (size_t)(m + r) * D) + F.lane;
#pragma unroll
            for (int j = 0; j < 4; ++j) o[64 * j] = v[j] * rstd * g[j]; }
    }
}

struct Args { const float* in[24]; float* out; unsigned char* ws; int ph_lo, ph_hi; };
__global__ void __launch_bounds__(512, 2) hymba_fwd(Args args) {
    extern __shared__ __attribute__((aligned(16))) unsigned char lds[];
    Frame F;
    F.lds = (LAS unsigned char*)lds; F.tid = threadIdx.x; F.lane = F.tid & 63; F.wave = __builtin_amdgcn_readfirstlane(F.tid >> 6); F.G = gridDim.x; F.bx = blockIdx.x;
    F.x = args.in[0]; F.meta = args.in[1]; F.g1 = args.in[2]; F.w_in = args.in[3]; F.conv_w = args.in[4]; F.conv_b = args.in[5]; F.wa = args.in[6]; F.ba = args.in[7]; F.wx = args.in[8]; F.bx_ = args.in[9];
    F.lam = args.in[10]; F.lru_gain = args.in[11]; F.pool_w = args.in[12]; F.pool_scale = args.in[13]; F.w_out = args.in[14]; F.g2 = args.in[15]; F.w_group = args.in[16]; F.b_group = args.in[17];
    F.w_router = args.in[18]; F.b_router = args.in[19]; F.w_gate = args.in[20]; F.w_up = args.in[21]; F.w_down = args.in[22]; F.final_gain = args.in[23];
    F.out = args.out; F.ws = args.ws; F.ctl = (unsigned*)(args.ws + WS_CTL);
    unsigned char* ws = args.ws;
    F.WinT = (bf16*)(ws + WS_WIN); F.WoutT = (bf16*)(ws + WS_WOUT); F.WaT = (bf16*)(ws + WS_WA); F.WxT = (bf16*)(ws + WS_WX); F.PwT = (bf16*)(ws + WS_PW); F.WrH = (_Float16*)(ws + WS_WR);
    F.AGG = (float*)(ws + WS_AGG); F.HM = (float*)(ws + WS_HM); F.AB = (u32x4*)(ws + WS_AB); F.WguT = ws + WS_WGU; F.WdT = ws + WS_WD; F.RINFO = (f32x4*)(ws + WS_RINFO); F.HN1 = (bf16*)(ws + WS_HN1); F.YMIX = (bf16*)(ws + WS_HN1);
    F.PROJ = (bf16*)(ws + WS_PROJ); F.HN2 = ws + WS_PROJ; F.HID = ws + WS_HID; F.C = ws + WS_C; F.H1 = (bf16*)(ws + WS_H1);
    volatile LAS unsigned* MISC = (volatile LAS unsigned*)(F.lds + MISC_OFF);
    if (F.tid < 64) MISC[F.tid] = 0u;
    __syncthreads();
    XcdBarrier bar; bar.bar = F.ctl + CW_BAR; bar.x = 0; bar.st = nullptr;
    if (MK_N_LAUNCHES == 1) bar = xcd_barrier_post(F.ctl + CW_BAR, MISC + 8);
    const int lo = args.ph_lo, hi = args.ph_hi;
#ifndef PH_MASK
#define PH_MASK 0x1ff
#endif
#define IN(k) (((PH_MASK >> (k)) & 1) && lo <= (k) && (k) < hi)
#define SEAM(k) do { if (IN(k) && IN((k) + 1)) xcd_barrier(bar); } while (0)
#define REP(k) for (int rep_ = 0; rep_ <= ((REPEAT_MASK >> (k)) & 1); ++rep_)

    if (IN(0)) REP(0) { p0_prologue(F); } SEAM(0);
    if (IN(1)) { pg8::DenseSched S{M / 256, INW / 256, F.G, F.bx, D * 2, (const char*)F.WinT, 1 + ((REPEAT_MASK >> 1) & 1)}; pg8::EpiProj E{F.PROJ};
        pg8::gemm_phase(F.lds, D * 2, (const char*)F.HN1, S, E); } SEAM(1);
    if (IN(2)) REP(2) { p2_aggregates(F); } SEAM(2);
    if (IN(3)) REP(3) { p3_mixer(F); } SEAM(3);
    if (IN(4)) { pg8::DenseSched S{M / 256, D / 256, F.G, F.bx, D * 2, (const char*)F.WoutT, 1 + ((REPEAT_MASK >> 4) & 1)}; pg8::EpiResid E{F.x, F.g2, F.H1, F.HN2};
        pg8::gemm_phase(F.lds, D * 2, (const char*)F.YMIX, S, E); } SEAM(4);
    if (IN(5)) { if ((REPEAT_MASK >> 5) & 1) p5_route(F, true); p5_route(F); } SEAM(5);
    if (IN(6)) { const int NT = moe_tables(F);
        pg8::MoeSched S{NT, 4, F.G, F.bx, D, (const char*)F.WguT, (size_t)1024 * D, true, (const LAS int*)(F.lds + TAB_TE), (const LAS unsigned*)(F.lds + TAB_ROW), 1 + ((REPEAT_MASK >> 6) & 1)};
        moe_unit_tables(F, S, 0);
        pg8::EpiGateUp E{F.HID, (const LAS float*)(F.lds + TAB_F), S.rounds()};
        pg8::gemm_phase<pg8::EpiGateUp, pg8::MoeSched, true>(F.lds, D, (const char*)F.HN2, S, E); } SEAM(6);
    if (IN(7)) { const int NT = moe_tables(F);
        pg8::MoeSched S{NT, 4, F.G, F.bx, EFF, (const char*)F.WdT, (size_t)D * EFF, false, (const LAS int*)(F.lds + TAB_TE), (const LAS unsigned*)(F.lds + TAB_ROW), 1 + ((REPEAT_MASK >> 7) & 1)};
        moe_unit_tables(F, S, 1);
        pg8::EpiDown E{F.C, (const LAS int*)(F.lds + TAB_ROW), (const LAS float*)(F.lds + TAB_F), S.rounds()};
        pg8::gemm_phase<pg8::EpiDown, pg8::MoeSched, true>(F.lds, EFF, (const char*)F.HID, S, E); } SEAM(7);
    if (IN(8)) { p8_final(F); }
#undef IN
#undef SEAM
}

extern "C" void kernel_launch(void* const* d_in, const int* in_sizes, int n_in, void* d_out, int out_size, void* d_ws, size_t ws_size, hipStream_t stream) {
    static int grid = 0;
    if (grid == 0) {
        if (n_in != 24 || in_sizes[0] != M * D || out_size != M * D || ws_size < WS_END) { fprintf(stderr, "kernel_launch: unexpected shapes (n_in %d, in0 %d, out %d, ws %zu)\n", n_in, n_in > 0 ? in_sizes[0] : -1, out_size, ws_size); grid = -1; return; }
        int dev = 0, cus = 0, per_cu = 0;
        if (hipGetDevice(&dev) != hipSuccess || hipDeviceGetAttribute(&cus, hipDeviceAttributeMultiprocessorCount, dev) != hipSuccess) { grid = -1; return; }
        if (hipFuncSetAttribute((const void*)hymba_fwd, hipFuncAttributeMaxDynamicSharedMemorySize, LDS_BYTES) != hipSuccess) { fprintf(stderr, "kernel_launch: hipFuncSetAttribute failed\n"); grid = -1; return; }
        if (hipOccupancyMaxActiveBlocksPerMultiprocessor(&per_cu, (const void*)hymba_fwd, 512, LDS_BYTES) != hipSuccess || per_cu < 1) fprintf(stderr, "kernel_launch: occupancy query says %d\n", per_cu);
        (void)hipGetLastError();
        grid = cus;
    }
    if (grid < 0) return;
    if (hipMemsetAsync((char*)d_ws + WS_CTL, 0, CTL_ZERO_BYTES, stream) != hipSuccess) return;
    Args a{};
    for (int i = 0; i < 24; ++i) a.in[i] = (const float*)d_in[i];
    a.out = (float*)d_out; a.ws = (unsigned char*)d_ws;
    if (MK_N_LAUNCHES == 1) { a.ph_lo = 0; a.ph_hi = N_PHASES; hipLaunchKernelGGL(hymba_fwd, dim3(grid), dim3(512), LDS_BYTES, stream, a); }
    else for (int p = 0; p < N_PHASES; ++p) { a.ph_lo = p; a.ph_hi = p + 1; hipLaunchKernelGGL(hymba_fwd, dim3(grid), dim3(512), LDS_BYTES, stream, a); }
}
```

```cpp
#include <hip/hip_runtime.h>
#include <cstdio>
#include <cstdint>

#define GAS __attribute__((address_space(1)))
#define LAS __attribute__((address_space(3)))
typedef unsigned short bf16;
typedef short bf16x8 __attribute__((ext_vector_type(8)));
typedef _Float16 f16x8 __attribute__((ext_vector_type(8)));
typedef float f32x4 __attribute__((ext_vector_type(4)));
typedef float f32x2 __attribute__((ext_vector_type(2)));
typedef unsigned u32x4 __attribute__((ext_vector_type(4)));
typedef unsigned u32x2 __attribute__((ext_vector_type(2)));

#ifndef MK_N_LAUNCHES
#define MK_N_LAUNCHES 1
#endif
constexpr int N_PHASES = 9;
#ifndef REPEAT_MASK
#define REPEAT_MASK 0
#endif

constexpr int D = 1024, NBATCH = 8, SEQ = 4096, NMETA = 16, TT = SEQ + NMETA, M = NBATCH * SEQ;
constexpr int LW = 512, INW = 1536, NE = 32, EFF = 512, NROUTE = 36;
constexpr int ECAP = 32768;
constexpr int MAXT = 288;
constexpr int MAXU = 6;
constexpr float RMS_EPS = 1e-6f;

constexpr size_t MiB = 1u << 20;
constexpr size_t WS_CTL = 0, CTL_ZERO_BYTES = 1 * MiB;
constexpr size_t WS_WIN = 2 * MiB, WS_WOUT = 5 * MiB, WS_WA = 7 * MiB, WS_WX = 7 * MiB + 65536, WS_PW = 7 * MiB + 131072, WS_WR = 7 * MiB + 262144;
constexpr size_t WS_AGG = 8 * MiB;
constexpr size_t WS_HM = 9 * MiB;
constexpr size_t WS_WGU = 10 * MiB  , WS_WD = 42 * MiB  , WS_RINFO = 58 * MiB, WS_HN1 = 74 * MiB  ;
constexpr size_t WS_PROJ = 138 * MiB  , WS_HID = 235 * MiB  , WS_C = 272 * MiB  , WS_H1 = 400 * MiB  , WS_END = 464 * MiB;
constexpr size_t WS_AB = WS_C;
constexpr float WGU_SCALE = 64.f, WD_SCALE = 32.f, HID_SCALE = 8.f, C_SCALE = 32.f;
constexpr int CW_BAR = 4096, CW_CNT = 16384;

constexpr int LDS_BYTES = 147456;
constexpr int MISC_OFF = LDS_BYTES - 256;
constexpr int TAB_OFF = 131072 + 512;
constexpr int TAB_ROW = TAB_OFF;
constexpr int TAB_F = TAB_ROW + MAXU * 256 * 4;
constexpr int TAB_TE = TAB_F + MAXU * 256 * 4;
constexpr int TAB_TR = TAB_TE + MAXT * 4;
constexpr int TAB_CNT = TAB_TR + MAXT * 4;
static_assert(TAB_CNT + 80 * 4 <= MISC_OFF, "LDS map");

__device__ __forceinline__ unsigned f2bf(float f) { unsigned u = __builtin_bit_cast(unsigned, f); return (u + 0x7fffu + ((u >> 16) & 1u)) >> 16; }
typedef __bf16 bf16x2_t __attribute__((ext_vector_type(2)));
__device__ __forceinline__ unsigned pk2(float lo, float hi) { return __builtin_bit_cast(unsigned, __builtin_convertvector((f32x2){lo, hi}, bf16x2_t)); }
__device__ __forceinline__ float bf2f(unsigned h) { return __builtin_bit_cast(float, h << 16); }
__device__ __forceinline__ float bflo(unsigned w) { return __builtin_bit_cast(float, w << 16); }
__device__ __forceinline__ float bfhi(unsigned w) { return __builtin_bit_cast(float, w & 0xffff0000u); }
__device__ __forceinline__ float sigmoidf_(float x) { return __builtin_amdgcn_rcpf(1.0f + __expf(-x)); }
#define LDS_WAIT() asm volatile("s_waitcnt lgkmcnt(0)" ::: "memory")
typedef _Float16 f16x2 __attribute__((ext_vector_type(2)));
__device__ __forceinline__ unsigned pkh2(float lo, float hi) { return __builtin_bit_cast(unsigned, __builtin_convertvector((f32x2){lo, hi}, f16x2)); }
__device__ __forceinline__ float h2lo(unsigned w) { return (float)__builtin_bit_cast(f16x2, w).x; }
__device__ __forceinline__ float h2hi(unsigned w) { return (float)__builtin_bit_cast(f16x2, w).y; }
typedef int i32x4 __attribute__((ext_vector_type(4)));
typedef int i32x8 __attribute__((ext_vector_type(8)));
__device__ __forceinline__ float clamp448(float v) { return fminf(fmaxf(v, -448.f), 448.f); }
__device__ __forceinline__ unsigned pk4_fp8(float a, float b, float c, float d) {
    int v = __builtin_amdgcn_cvt_pk_fp8_f32(a, b, 0, false); v = __builtin_amdgcn_cvt_pk_fp8_f32(c, d, v, true); return (unsigned)v; }

#define XB_TMO      128
#define XB_XCNT(j)  (256  + 64 * (j))
#define XB_XSUB(j)  (1280 + 64 * (j))
#define XB_XGEN(j)  (2304 + 64 * (j))
#define XB_TOP      3328
#define XB_TOPGEN   3392
#define XCD_BAR_WORDS 3456
#define XB_SPIN_CAP (1u << 18)
__device__ __forceinline__ unsigned xb_ld(unsigned* p)              { return __hip_atomic_load(p, __ATOMIC_RELAXED, __HIP_MEMORY_SCOPE_AGENT); }
__device__ __forceinline__ unsigned xb_add(unsigned* p, unsigned v) { return __hip_atomic_fetch_add(p, v, __ATOMIC_RELAXED, __HIP_MEMORY_SCOPE_AGENT); }
__device__ __forceinline__ unsigned xb_xcc_id() { return (unsigned)__builtin_amdgcn_s_getreg((3 << 11) | 20) & 0xFu; }
#define XB_SPIN(cond, bar) do { unsigned _sp = 0; while (cond) { __builtin_amdgcn_s_sleep(1); \
    if ((++_sp & 255u) == 0u) { if (xb_ld(&(bar)[XB_TMO])) break; if (_sp > XB_SPIN_CAP) { atomicAdd(&(bar)[XB_TMO], 1u); break; } } } } while (0)
struct XcdBarrier { unsigned* bar; unsigned x; volatile LAS unsigned* st; };
__device__ __forceinline__ XcdBarrier xcd_barrier_post(unsigned* bar, volatile LAS unsigned* st) {
    XcdBarrier b; b.bar = bar; b.x = xb_xcc_id(); b.st = st;
    if (threadIdx.x == 0) (void)xb_add(&bar[XB_XCNT(b.x)], 1u);
    return b;
}
__device__ __forceinline__ void xcd_barrier_complete(unsigned* bar, unsigned x, unsigned& nloc, unsigned& nx) {
    const unsigned G = gridDim.x * gridDim.y * gridDim.z;
    unsigned sum, cnt, mine, sp = 0u;
    for (;;) {
        sum = 0u; cnt = 0u; mine = 0u;
#pragma unroll
        for (unsigned j = 0; j < 16; ++j) { const unsigned c = xb_ld(&bar[XB_XCNT(j)]); sum += c; cnt += (c > 0u) ? 1u : 0u; mine = (j == x) ? c : mine; }
        if (sum == G) break;
        __builtin_amdgcn_s_sleep(1);
        if ((++sp & 255u) == 0u) { if (xb_ld(&bar[XB_TMO])) break; if (sp > XB_SPIN_CAP) { atomicAdd(&bar[XB_TMO], 1u); break; } }
    }
    nloc = mine > 0u ? mine : 1u; nx = cnt > 0u ? cnt : 1u;
}
__device__ __forceinline__ void xcd_barrier(const XcdBarrier& b) {
    asm volatile("s_waitcnt vmcnt(0)" ::: "memory");
    __syncthreads();
    if (threadIdx.x == 0) {
        unsigned* bar = b.bar;
        __builtin_amdgcn_s_waitcnt(0);
        unsigned nloc = b.st[0], nx = b.st[1];
        if (nloc == 0u) { xcd_barrier_complete(bar, b.x, nloc, nx); b.st[0] = nloc; b.st[1] = nx; }
        const unsigned old = xb_add(&bar[XB_XSUB(b.x)], 1u);
        const unsigned gen = old / nloc;
        if (old + 1u == (gen + 1u) * nloc) {
            __builtin_amdgcn_fence(__ATOMIC_RELEASE, "agent");
            asm volatile("s_waitcnt vmcnt(0)" ::: "memory");
            const unsigned og = xb_add(&bar[XB_TOP], 1u);
            const unsigned tg = og / nx;
            if (og + 1u == (tg + 1u) * nx) xb_add(&bar[XB_TOPGEN], 1u);
            else XB_SPIN(xb_ld(&bar[XB_TOPGEN]) == tg, bar);
            __builtin_amdgcn_fence(__ATOMIC_ACQUIRE, "agent");
            xb_add(&bar[XB_XGEN(b.x)], 1u);
            asm volatile("s_waitcnt vmcnt(0)" ::: "memory");
        } else {
            XB_SPIN(xb_ld(&bar[XB_XGEN(b.x)]) == gen, bar);
            __builtin_amdgcn_fence(__ATOMIC_ACQUIRE, "agent");
            asm volatile("s_waitcnt vmcnt(0)" ::: "memory");
        }
    }
    __syncthreads();
}

namespace pg8 {
constexpr int BM = 256, BK = 64, HALF = 128, HTB = HALF * BK * 2, STAGE_BYTES = 8 * HTB, NXCD = 8, WGM = 8;
__host__ __device__ __forceinline__ int lds_byte(int r, int c) { const int st = (r >> 4) * 2 + (c >> 5), rr = r & 15, cc = c & 31, ob = rr * 64 + cc * 2; return st * 1024 + (ob ^ (((ob >> 9) & 1) << 5)); }
__host__ __device__ __forceinline__ void stage_rc(int b, int& R, int& C) { const int st = b / 1024, sb = b % 1024, swz = sb ^ (((sb >> 9) & 1) << 5); R = (st >> 1) * 16 + swz / 64; C = (st & 1) * 32 + (swz % 64) / 2; }
__host__ __device__ __forceinline__ int perm32(int rho) { const int n = rho >> 4, i = rho & 15; return 8 * (i >> 2) + 4 * n + (i & 3); }
struct Unit { int pm, pn; };
__device__ __forceinline__ bool static_next(int nM, int nN, int G, int c, int i, Unit& u) {
    const int nwg = nM * nN; const long L = (long)i * G + c; if (L >= nwg) return false;
    int wgid = (int)L; { const int q = nwg / NXCD, r = nwg % NXCD, xcd = wgid % NXCD, off = wgid / NXCD; wgid = (xcd < r ? xcd * (q + 1) : r * (q + 1) + (xcd - r) * q) + off; }
    const int nig = WGM * nN, gid = wgid / nig, fm = gid * WGM, gsz = (nM - fm) < WGM ? (nM - fm) : WGM;
    u.pm = fm + ((wgid % nig) % gsz); u.pn = (wgid % nig) / gsz; return true;
}
__device__ __forceinline__ unsigned cvt_pk_bf16(float lo, float hi) { return pk2(lo, hi); }

template <class Epi, class Sched, bool FP8 = false>
__device__ __forceinline__ void gemm_phase(LAS unsigned char* lds, const int KB, const char* Abase, const Sched& S, const Epi& E) {
    const int tid = threadIdx.x, wid = __builtin_amdgcn_readfirstlane(tid >> 6), lane = tid & 63, wr = wid >> 2, wc = wid & 3, fr = lane & 15, fq = lane >> 4;
    const int nt = KB / (BK * 2);
    int Rl[2]; unsigned Cb[2], voffB[2];
#pragma unroll
    for (int i = 0; i < 2; ++i) { int R, C; stage_rc(tid * 16 + i * 8192, R, C); const int Rb = Epi::PERM ? ((R & ~31) + perm32(R & 31)) : R;
        Rl[i] = R; Cb[i] = (unsigned)C * 2u; voffB[i] = (unsigned)(Rb * KB + C * 2); }
    const size_t kstep = (size_t)(BK * 2);
    const size_t hstepB = (size_t)HALF * KB;
    const unsigned ldsw = (unsigned)wid * 1024u;
    const int aoff = lds_byte(wr * 64 + fr, fq * 8), boff = lds_byte(wc * 32 + fr, fq * 8);
#define PG8_SA(b, h) (((b) * 2 + (h)) * HTB)
#define PG8_SB(b, h) ((4 + (b) * 2 + (h)) * HTB)
#define PG8_STAGE(bufoff, gbase, voff) do { _Pragma("unroll") for (int _i = 0; _i < 2; ++_i) \
        __builtin_amdgcn_global_load_lds((const unsigned*)((const char*)(gbase) + (voff)[_i]), (LAS unsigned*)(lds + (bufoff) + ldsw + _i * 8192), 16, 0, 0); } while (0)
#define PG8_LD32(p) __builtin_shufflevector(*(const LAS i32x4*)(p), *(const LAS i32x4*)((p) + 1024), 0, 1, 2, 3, 4, 5, 6, 7)
#define PG8_LDA(dst, b, h) do { _Pragma("unroll") for (int m = 0; m < 4; ++m) dst[m] = PG8_LD32(lds + PG8_SA(b, h) + aoff + m * 2048); } while (0)
#define PG8_LDB(dst, b, h) do { _Pragma("unroll") for (int n = 0; n < 2; ++n) dst[n] = PG8_LD32(lds + PG8_SB(b, h) + boff + n * 2048); } while (0)
#define PG8_LO(v) __builtin_bit_cast(bf16x8, __builtin_shufflevector((v), (v), 0, 1, 2, 3))
#define PG8_HI(v) __builtin_bit_cast(bf16x8, __builtin_shufflevector((v), (v), 4, 5, 6, 7))
#define PG8_MMA(ai, bj, At, Bt) do { __builtin_amdgcn_s_setprio(1); _Pragma("unroll") for (int m = 0; m < 4; ++m) _Pragma("unroll") for (int n = 0; n < 2; ++n) { \
        if constexpr (FP8) asm volatile("v_mfma_f32_16x16x128_f8f6f4 %0, %1, %2, %0" : "+v"(acc[ai][bj][m][n]) : "v"(Bt[n]), "v"(At[m])); \
        else { acc[ai][bj][m][n] = __builtin_amdgcn_mfma_f32_16x16x32_bf16(PG8_LO(Bt[n]), PG8_LO(At[m]), acc[ai][bj][m][n], 0, 0, 0); \
               acc[ai][bj][m][n] = __builtin_amdgcn_mfma_f32_16x16x32_bf16(PG8_HI(Bt[n]), PG8_HI(At[m]), acc[ai][bj][m][n], 0, 0, 0); } } \
        __builtin_amdgcn_s_setprio(0); } while (0)
#define PG8_WAIT_V(n) asm volatile("s_waitcnt vmcnt(" #n ")" ::: "memory")
#define PG8_WAIT_L(n) asm volatile("s_waitcnt lgkmcnt(" #n ")" ::: "memory")
#define PG8_BAR __builtin_amdgcn_s_barrier()
#define PG8_SCHED __builtin_amdgcn_sched_barrier(0)
    Unit cur, nxt; int ui = 0;
    if (!S.next(0, cur)) return;
    f32x4 acc[2][2][4][2];
#pragma unroll
    for (int a = 0; a < 2; ++a)
#pragma unroll
        for (int b = 0; b < 2; ++b)
#pragma unroll
            for (int m = 0; m < 4; ++m)
#pragma unroll
                for (int n = 0; n < 2; ++n) acc[a][b][m][n] = (f32x4){0.f, 0.f, 0.f, 0.f};
    i32x8 At[4], B0[2], B1[2];
    unsigned cO0[2], cO1[2], nO0[2], nO1[2];
#pragma unroll
    for (int i = 0; i < 2; ++i) { cO0[i] = S.a_off(0, cur, Rl[i]) + Cb[i]; cO1[i] = S.a_off(0, cur, HALF + Rl[i]) + Cb[i]; }
    const char* cB = S.b_base(cur);
    PG8_STAGE(PG8_SB(0, 0), cB, voffB); PG8_STAGE(PG8_SB(0, 1), cB + hstepB, voffB); PG8_STAGE(PG8_SA(0, 0), Abase, cO0); PG8_STAGE(PG8_SA(0, 1), Abase, cO1);
    if (wr == 1) PG8_BAR;
    PG8_WAIT_V(2); PG8_BAR;
    PG8_STAGE(PG8_SB(1, 0), cB + kstep, voffB); PG8_STAGE(PG8_SA(1, 0), Abase + kstep, cO0); PG8_STAGE(PG8_SB(1, 1), cB + hstepB + kstep, voffB);
    PG8_WAIT_V(6); PG8_BAR;
    for (;;) {
        const bool has_next = S.next(ui + 1, nxt);
        const char* nB = cB;
#pragma unroll
        for (int i = 0; i < 2; ++i) { nO0[i] = cO0[i]; nO1[i] = cO1[i]; }
        if (has_next) { nB = S.b_base(nxt);
#pragma unroll
            for (int i = 0; i < 2; ++i) { nO0[i] = S.a_off(ui + 1, nxt, Rl[i]) + Cb[i]; nO1[i] = S.a_off(ui + 1, nxt, HALF + Rl[i]) + Cb[i]; } }
#pragma nounroll
        for (int t = 0; t < nt; t += 2) {
            const bool last = (t == nt - 2);
            const char* a1 = Abase + (size_t)(t + 1) * kstep;
            const char* a2 = last ? Abase : Abase + (size_t)(t + 2) * kstep; const char* b2 = last ? nB : cB + (size_t)(t + 2) * kstep;
            const char* a3 = a2 + kstep; const char* b3 = b2 + kstep;
            unsigned o0[2], o1[2];
#pragma unroll
            for (int i = 0; i < 2; ++i) { o0[i] = last ? nO0[i] : cO0[i]; o1[i] = last ? nO1[i] : cO1[i]; }
            PG8_LDB(B0, 0, 0); PG8_LDB(B1, 0, 1); PG8_SCHED; PG8_LDA(At, 0, 0); PG8_STAGE(PG8_SA(1, 1), a1, cO1);
            PG8_WAIT_V(8); PG8_WAIT_L(0); PG8_BAR; PG8_MMA(0, 0, At, B0); PG8_MMA(0, 1, At, B1); PG8_BAR; PG8_SCHED;
            PG8_LDA(At, 0, 1); PG8_STAGE(PG8_SB(0, 0), b2, voffB); PG8_STAGE(PG8_SB(0, 1), b2 + hstepB, voffB); PG8_STAGE(PG8_SA(0, 0), a2, o0);
            PG8_WAIT_V(8); PG8_WAIT_L(0); PG8_BAR; PG8_MMA(1, 0, At, B0); PG8_MMA(1, 1, At, B1); PG8_BAR; PG8_SCHED;
            PG8_LDB(B0, 1, 0); PG8_LDB(B1, 1, 1); PG8_SCHED; PG8_LDA(At, 1, 0); PG8_STAGE(PG8_SA(0, 1), a2, o1);
            PG8_WAIT_V(8); PG8_WAIT_L(0); PG8_BAR; PG8_MMA(0, 0, At, B0); PG8_MMA(0, 1, At, B1); PG8_BAR; PG8_SCHED;
            PG8_LDA(At, 1, 1); PG8_STAGE(PG8_SB(1, 0), b3, voffB); PG8_STAGE(PG8_SB(1, 1), b3 + hstepB, voffB); PG8_STAGE(PG8_SA(1, 0), a3, o0);
            PG8_WAIT_V(8); PG8_WAIT_L(0); PG8_BAR; PG8_MMA(1, 0, At, B0); PG8_MMA(1, 1, At, B1); PG8_BAR; PG8_SCHED;
        }
        if (wr == 0) PG8_BAR;
        if constexpr (FP8) asm volatile("s_nop 15\n\ts_nop 15" ::: "memory");
        E(acc, cur, ui, wr, wc, fr, fq);
        if (!has_next) break;
#pragma unroll
        for (int a = 0; a < 2; ++a)
#pragma unroll
            for (int b = 0; b < 2; ++b)
#pragma unroll
                for (int m = 0; m < 4; ++m)
#pragma unroll
                    for (int n = 0; n < 2; ++n) acc[a][b][m][n] = (f32x4){0.f, 0.f, 0.f, 0.f};
        cur = nxt; cB = nB; ++ui;
#pragma unroll
        for (int i = 0; i < 2; ++i) { cO0[i] = nO0[i]; cO1[i] = nO1[i]; }
        if (wr == 1) PG8_BAR;
    }
    PG8_WAIT_V(0);
    PG8_BAR;
#undef PG8_SA
#undef PG8_SB
#undef PG8_STAGE
#undef PG8_LDA
#undef PG8_LDB
#undef PG8_MMA
#undef PG8_LO
#undef PG8_HI
#undef PG8_LD32
#undef PG8_WAIT_V
#undef PG8_WAIT_L
#undef PG8_BAR
#undef PG8_SCHED
}

struct DenseSched {
    int nM, nN, G, c, K2; const char* B; int reps;
    __device__ __forceinline__ bool next(int i, Unit& u) const { const int rounds = (nM * nN + G - 1) / G; if (i >= rounds * reps) return false; return static_next(nM, nN, G, c, i % rounds, u); }
    __device__ __forceinline__ const char* b_base(const Unit& u) const { return B + (size_t)u.pn * BM * K2; }
    __device__ __forceinline__ unsigned a_off(int, const Unit& u, int r) const { return (unsigned)(u.pm * BM + r) * (unsigned)K2; }
};
struct MoeSched {
    int NT, nN, G, c, K2; const char* B; size_t estride; bool gather;
    const LAS int* tile_e; const LAS unsigned* rowtab; int reps;
    __device__ __forceinline__ int rounds() const { return (NT * nN + G - 1) / G; }
    __device__ __forceinline__ bool next(int i, Unit& u) const { const int r = rounds(); if (i >= r * reps) return false; return static_next(NT, nN, G, c, i % r, u); }
    __device__ __forceinline__ const char* b_base(const Unit& u) const { return B + (size_t)tile_e[u.pm] * estride + (size_t)u.pn * BM * K2; }
    __device__ __forceinline__ unsigned a_off(int ui, const Unit& u, int r) const { return gather ? rowtab[(ui % rounds()) * 256 + r] : (unsigned)(u.pm * BM + r) * (unsigned)K2; }
};

struct EpiProj {
    static constexpr bool PERM = true;
    bf16* O;
    __device__ __forceinline__ void operator()(const f32x4 (&acc)[2][2][4][2], const Unit& u, int, int wr, int wc, int fr, int fq) const {
        const int row0 = u.pm * BM + 16 * ((u.pm >> 4) + 1) + wr * 64 + fr, col0 = u.pn * BM + wc * 32 + 8 * fq;
#pragma unroll
        for (int ai = 0; ai < 2; ++ai)
#pragma unroll
            for (int m = 0; m < 4; ++m) { bf16* rowp = O + (size_t)(row0 + ai * HALF + m * 16) * INW + col0;
#pragma unroll
                for (int bj = 0; bj < 2; ++bj) { const f32x4 v0 = acc[ai][bj][m][0], v1 = acc[ai][bj][m][1];
                    u32x4 w; w.x = cvt_pk_bf16(v0[0], v0[1]); w.y = cvt_pk_bf16(v0[2], v0[3]); w.z = cvt_pk_bf16(v1[0], v1[1]); w.w = cvt_pk_bf16(v1[2], v1[3]);
                    *(u32x4*)(rowp + bj * HALF) = w; } }
    }
};
struct EpiResid {
    static constexpr bool PERM = true;
    const float* X; const float* G2; bf16* H1; unsigned char* HN2;
    __device__ __forceinline__ void operator()(const f32x4 (&acc)[2][2][4][2], const Unit& u, int, int wr, int wc, int fr, int fq) const {
        const int row0 = u.pm * BM + wr * 64 + fr, col0 = u.pn * BM + wc * 32 + 8 * fq;
        f32x4 gv[2][2];
#pragma unroll
        for (int bj = 0; bj < 2; ++bj)
#pragma unroll
            for (int n = 0; n < 2; ++n) gv[bj][n] = *(const f32x4*)(G2 + col0 + bj * HALF + 4 * n);
#pragma unroll
        for (int ai = 0; ai < 2; ++ai) {
#pragma unroll
            for (int m = 0; m < 4; ++m) { const size_t off = (size_t)(row0 + ai * HALF + m * 16) * D + col0;
#pragma unroll
                for (int bj = 0; bj < 2; ++bj) { const f32x4 v0 = acc[ai][bj][m][0] + *(const f32x4*)(X + off + bj * HALF), v1 = acc[ai][bj][m][1] + *(const f32x4*)(X + off + bj * HALF + 4);
                    u32x4 w; w.x = cvt_pk_bf16(v0[0], v0[1]); w.y = cvt_pk_bf16(v0[2], v0[3]); w.z = cvt_pk_bf16(v1[0], v1[1]); w.w = cvt_pk_bf16(v1[2], v1[3]);
                    *(u32x4*)(H1 + off + bj * HALF) = w;
                    const f32x4 t0 = v0 * gv[bj][0], t1 = v1 * gv[bj][1];
                    u32x2 e; e.x = pk4_fp8(clamp448(t0[0]), clamp448(t0[1]), clamp448(t0[2]), clamp448(t0[3])); e.y = pk4_fp8(clamp448(t1[0]), clamp448(t1[1]), clamp448(t1[2]), clamp448(t1[3]));
                    *(u32x2*)(HN2 + off + bj * HALF) = e; } }
            asm volatile("" ::: "memory"); }
    }
};
struct EpiGateUp {
    static constexpr bool PERM = true;
    unsigned char* H; const LAS float* rstd; int rounds;
    __device__ __forceinline__ void operator()(const f32x4 (&acc)[2][2][4][2], const Unit& u, int ui_, int wr, int wc, int fr, int fq) const {
        const int ui = ui_ % rounds;
        const int r0 = wr * 64 + fr, col0 = u.pn * HALF + wc * 32 + 8 * fq;
#pragma unroll
        for (int ai = 0; ai < 2; ++ai)
#pragma unroll
            for (int m = 0; m < 4; ++m) { const int r = r0 + ai * HALF + m * 16; const float rs = rstd[ui * 256 + r];
                float h[8];
#pragma unroll
                for (int n = 0; n < 2; ++n)
#pragma unroll
                    for (int j = 0; j < 4; ++j) { const float g = acc[ai][0][m][n][j] * rs, up = acc[ai][1][m][n][j] * rs; h[n * 4 + j] = g * sigmoidf_(g) * up; }
#pragma unroll
                for (int j = 0; j < 8; ++j) h[j] = clamp448(h[j] * HID_SCALE);
                u32x2 w; w.x = pk4_fp8(h[0], h[1], h[2], h[3]); w.y = pk4_fp8(h[4], h[5], h[6], h[7]);
                *(u32x2*)(H + (size_t)(u.pm * BM + r) * EFF + col0) = w; }
    }
};
struct EpiDown {
    static constexpr bool PERM = true;
    unsigned char* C; const LAS int* slot; const LAS float* gate; int rounds;
    __device__ __forceinline__ void operator()(const f32x4 (&acc)[2][2][4][2], const Unit& u, int ui_, int wr, int wc, int fr, int fq) const {
        const int ui = ui_ % rounds;
        const int r0 = wr * 64 + fr, col0 = u.pn * BM + wc * 32 + 8 * fq;
#pragma unroll
        for (int ai = 0; ai < 2; ++ai)
#pragma unroll
            for (int m = 0; m < 4; ++m) { const int r = r0 + ai * HALF + m * 16; const int sl = slot[ui * 256 + r]; const float gt = gate[ui * 256 + r];
                if (sl >= 0) { unsigned char* rowp = C + (size_t)sl * D + col0;
#pragma unroll
                    for (int bj = 0; bj < 2; ++bj) { const f32x4 v0 = acc[ai][bj][m][0] * gt, v1 = acc[ai][bj][m][1] * gt;
                        u32x2 w; w.x = pk4_fp8(clamp448(v0[0]), clamp448(v0[1]), clamp448(v0[2]), clamp448(v0[3])); w.y = pk4_fp8(clamp448(v1[0]), clamp448(v1[1]), clamp448(v1[2]), clamp448(v1[3]));
                        *(u32x2*)(rowp + bj * HALF) = w; } } }
    }
};
}

struct Frame {
    LAS unsigned char* lds; int tid, lane, wave, G, bx;
    const float *x, *meta, *g1, *w_in, *conv_w, *conv_b, *wa, *ba, *wx, *bx_, *lam, *lru_gain, *pool_w, *pool_scale, *w_out, *g2, *w_group, *b_group, *w_router, *b_router, *w_gate, *w_up, *w_down, *final_gain;
    float* out; unsigned char* ws; unsigned* ctl;
    bf16 *WinT, *WoutT, *WaT, *WxT, *PwT, *HN1, *YMIX, *PROJ, *H1; unsigned char *WguT, *WdT, *HN2, *HID, *C;
    _Float16* WrH; float* AGG; float* HM; u32x4* AB; f32x4* RINFO;
};
__device__ __forceinline__ float wave_sum(float v) {
#pragma unroll
    for (int o = 1; o < 64; o <<= 1) v += __shfl_xor(v, o);
    return v;
}

__device__ __forceinline__ void transpose_tile(const float* W, int ldw, int k0, int n0, bf16* WT, int ldt, int drow0, LAS float* scr, int lane) {
    { float v[32];
#pragma unroll
      for (int i = 0; i < 32; ++i) v[i] = W[(size_t)(k0 + 2 * i + (lane >> 5)) * ldw + n0 + (lane & 31)];
#pragma unroll
      for (int i = 0; i < 32; ++i) scr[(2 * i + (lane >> 5)) * 33 + (lane & 31)] = v[i]; }
    LDS_WAIT(); asm volatile("" ::: "memory");
    const int c = lane & 7;
#pragma unroll
    for (int j = 0; j < 4; ++j) { const int n = (lane >> 3) + 8 * j; const LAS float* s = scr + (8 * c) * 33 + n;
        u32x4 o; o.x = pk2(s[0 * 33], s[1 * 33]); o.y = pk2(s[2 * 33], s[3 * 33]); o.z = pk2(s[4 * 33], s[5 * 33]); o.w = pk2(s[6 * 33], s[7 * 33]);
        *(u32x4*)(WT + (size_t)(drow0 + n) * ldt + k0 + 8 * c) = o; }
    LDS_WAIT(); asm volatile("" ::: "memory");
}
__device__ __forceinline__ void transpose_tile_fp8(const float* W, int ldw, int k0, int n0, unsigned char* WT, int ldt, int drow0, float scale, LAS float* scr, int lane) {
    { float v[64];
#pragma unroll
      for (int i = 0; i < 64; ++i) v[i] = W[(size_t)(k0 + 2 * i + (lane >> 5)) * ldw + n0 + (lane & 31)];
#pragma unroll
      for (int i = 0; i < 64; ++i) scr[(2 * i + (lane >> 5)) * 33 + (lane & 31)] = v[i]; }
    LDS_WAIT(); asm volatile("" ::: "memory");
    const int n = lane >> 1, kh = (lane & 1) * 64; const LAS float* sp = scr + kh * 33 + n;
#pragma unroll
    for (int c = 0; c < 4; ++c) { u32x4 o;
#pragma unroll
        for (int w = 0; w < 4; ++w) { const LAS float* q4 = sp + (16 * c + 4 * w) * 33; o[w] = pk4_fp8(q4[0] * scale, q4[33] * scale, q4[66] * scale, q4[99] * scale); }
        *(u32x4*)(WT + (size_t)(drow0 + n) * ldt + k0 + kh + 16 * c) = o; }
    LDS_WAIT(); asm volatile("" ::: "memory");
}
__device__ __forceinline__ void p0_prologue(Frame& F) {
    if (F.bx < INW / 8) {
        LAS float* hnm = (LAS float*)F.lds;
        LAS float* part = (LAS float*)(F.lds + 65536);
        for (int r = F.wave * 2; r < F.wave * 2 + 2; ++r) {
            const f32x4* xr = (const f32x4*)(F.meta + (size_t)r * D) + F.lane; f32x4 v[4]; float s = 0.f;
#pragma unroll
            for (int j = 0; j < 4; ++j) { v[j] = xr[64 * j]; s += (v[j].x * v[j].x + v[j].y * v[j].y) + (v[j].z * v[j].z + v[j].w * v[j].w); }
            const float rstd = rsqrtf(wave_sum(s) * (1.f / D) + RMS_EPS);
#pragma unroll
            for (int j = 0; j < 4; ++j) { const f32x4 g = ((const f32x4*)F.g1)[F.lane + 64 * j]; *(LAS f32x4*)(hnm + r * D + 4 * F.lane + 256 * j) = v[j] * rstd * g; }
        }
        __syncthreads();
        { const int cc = F.tid & 7, ks = F.tid >> 3, col = F.bx * 8 + cc; float a[16];
#pragma unroll
            for (int r = 0; r < 16; ++r) a[r] = 0.f;
            for (int k = ks * 16; k < ks * 16 + 16; ++k) { const float w = F.w_in[(size_t)k * INW + col];
#pragma unroll
                for (int r = 0; r < 16; ++r) a[r] += hnm[r * D + k] * w; }
#pragma unroll
            for (int r = 0; r < 16; ++r) part[(ks * 16 + r) * 8 + cc] = a[r]; }
        __syncthreads();
        if (F.tid < 128) { const int r = F.tid >> 3, cc = F.tid & 7; float s = 0.f;
            for (int ks = 0; ks < 64; ++ks) s += part[(ks * 16 + r) * 8 + cc];
            const bf16 h = (bf16)f2bf(s);
            for (int b = 0; b < NBATCH; ++b) F.PROJ[(size_t)(b * TT + r) * INW + F.bx * 8 + cc] = h; }
        __syncthreads();
    }
    LAS float* scr = (LAS float*)(F.lds + F.wave * 16896);
    const int gw = F.bx * 8 + F.wave, NGW = F.G * 8;
    constexpr int I_IN = 16 * 48, I_OUT = 16 * 32, I_G = NE * 8 * 16, I_D = NE * 4 * 32, I_A = 8 * 2, I_P = 4 * 2 * 4;
    constexpr int NITEMS = I_IN + I_OUT + 2 * I_G + I_D + 2 * I_A + I_P;
    for (int it = gw; it < NITEMS; it += NGW) {
        int r = it;
        if (r < I_IN) { const int kb = r / 48, nb = r % 48; transpose_tile(F.w_in, INW, 64 * kb, 32 * nb, F.WinT, D, 32 * nb, scr, F.lane); continue; } r -= I_IN;
        if (r < I_OUT) { const int kb = r / 32, nb = r % 32; transpose_tile(F.w_out, D, 64 * kb, 32 * nb, F.WoutT, D, 32 * nb, scr, F.lane); continue; } r -= I_OUT;
        if (r < 2 * I_G) { const int up = r >= I_G; if (up) r -= I_G; const int e = r >> 7, kb = (r >> 4) & 7, nb = r & 15, n0 = 32 * nb;
            transpose_tile_fp8((up ? F.w_up : F.w_gate) + (size_t)e * D * EFF, EFF, 128 * kb, n0, F.WguT + (size_t)e * 1024 * D, D, (n0 >> 7) * 256 + up * 128 + (n0 & 127), WGU_SCALE, scr, F.lane); continue; } r -= 2 * I_G;
        if (r < I_D) { const int e = r >> 7, kb = (r >> 5) & 3, nb = r & 31; transpose_tile_fp8(F.w_down + (size_t)e * EFF * D, D, 128 * kb, 32 * nb, F.WdT + (size_t)e * D * EFF, EFF, 32 * nb, WD_SCALE, scr, F.lane); continue; } r -= I_D;
        if (r < 2 * I_A) { const int x = r >= I_A; if (x) r -= I_A; const int h = r >> 1, nb = r & 1; transpose_tile((x ? F.wx : F.wa) + (size_t)h * 4096, 64, 0, 32 * nb, (x ? F.WxT : F.WaT) + (size_t)h * 4096, 64, 32 * nb, scr, F.lane); continue; } r -= 2 * I_A;
        { const int g = r >> 3, kb = (r >> 2) & 1, nb = r & 3; transpose_tile(F.pool_w + (size_t)g * 16384, 128, 64 * kb, 32 * nb, F.PwT + (size_t)g * 16384, 128, 32 * nb, scr, F.lane); }
    }
    for (int i = F.bx * 512 + F.tid; i < NROUTE * D; i += F.G * 512) { const int n = i >> 10, k = i & 1023;
        const float w = n < 4 ? F.w_group[k * 4 + n] : F.w_router[k * 32 + (n - 4)]; F.WrH[i] = (_Float16)(w * 256.0f); }
    { f32x4 g[4];
#pragma unroll
      for (int j = 0; j < 4; ++j) g[j] = ((const f32x4*)F.g1)[F.lane + 64 * j];
      for (int m = gw * 4; m < M; m += NGW * 4) {
        f32x4 v[4][4];
#pragma unroll
        for (int r = 0; r < 4; ++r)
#pragma unroll
            for (int j = 0; j < 4; ++j) v[r][j] = ((const f32x4*)(F.x + (size_t)(m + r) * D))[F.lane + 64 * j];
#pragma unroll
        for (int r = 0; r < 4; ++r) { float s = 0.f;
#pragma unroll
            for (int j = 0; j < 4; ++j) s += (v[r][j].x * v[r][j].x + v[r][j].y * v[r][j].y) + (v[r][j].z * v[r][j].z + v[r][j].w * v[r][j].w);
            const float rstd = rsqrtf(wave_sum(s) * (1.f / D) + RMS_EPS);
            u32x2* o8 = (u32x2*)(F.HN1 + (size_t)(m + r) * D) + F.lane;
#pragma unroll
            for (int j = 0; j < 4; ++j) { const f32x4 y = v[r][j] * rstd * g[j]; u32x2 w; w.x = pk2(y.x, y.y); w.y = pk2(y.z, y.w); o8[64 * j] = w; } }
      } }
}

template <int CTRL> __device__ __forceinline__ float dpp_f(float old, float src) {
    return __builtin_bit_cast(float, __builtin_amdgcn_update_dpp(__builtin_bit_cast(int, old), __builtin_bit_cast(int, src), CTRL, 0xf, 0xf, false)); }
#define DPP_BCAST15 0x15F
__device__ __forceinline__ void row_scan(float& A, float& B) {
    { const float Ap = dpp_f<0x111>(1.0f, A), Bp = dpp_f<0x111>(0.0f, B); B = A * Bp + B; A = A * Ap; }
    { const float Ap = dpp_f<0x112>(1.0f, A), Bp = dpp_f<0x112>(0.0f, B); B = A * Bp + B; A = A * Ap; }
    { const float Ap = dpp_f<0x114>(1.0f, A), Bp = dpp_f<0x114>(0.0f, B); B = A * Bp + B; A = A * Ap; }
    { const float Ap = dpp_f<0x118>(1.0f, A), Bp = dpp_f<0x118>(0.0f, B); B = A * Bp + B; A = A * Ap; }
}
#define SCAN8_STR(D) "s_nop 1\n\t" \
    "v_fmac_f32_dpp %0, %0, %8 row_shr:" #D " row_mask:0xf bank_mask:0xf\n\tv_mul_f32_dpp %8, %8, %8 row_shr:" #D " row_mask:0xf bank_mask:0xf\n\t" \
    "v_fmac_f32_dpp %1, %1, %9 row_shr:" #D " row_mask:0xf bank_mask:0xf\n\tv_mul_f32_dpp %9, %9, %9 row_shr:" #D " row_mask:0xf bank_mask:0xf\n\t" \
    "v_fmac_f32_dpp %2, %2, %10 row_shr:" #D " row_mask:0xf bank_mask:0xf\n\tv_mul_f32_dpp %10, %10, %10 row_shr:" #D " row_mask:0xf bank_mask:0xf\n\t" \
    "v_fmac_f32_dpp %3, %3, %11 row_shr:" #D " row_mask:0xf bank_mask:0xf\n\tv_mul_f32_dpp %11, %11, %11 row_shr:" #D " row_mask:0xf bank_mask:0xf\n\t" \
    "v_fmac_f32_dpp %4, %4, %12 row_shr:" #D " row_mask:0xf bank_mask:0xf\n\tv_mul_f32_dpp %12, %12, %12 row_shr:" #D " row_mask:0xf bank_mask:0xf\n\t" \
    "v_fmac_f32_dpp %5, %5, %13 row_shr:" #D " row_mask:0xf bank_mask:0xf\n\tv_mul_f32_dpp %13, %13, %13 row_shr:" #D " row_mask:0xf bank_mask:0xf\n\t" \
    "v_fmac_f32_dpp %6, %6, %14 row_shr:" #D " row_mask:0xf bank_mask:0xf\n\tv_mul_f32_dpp %14, %14, %14 row_shr:" #D " row_mask:0xf bank_mask:0xf\n\t" \
    "v_fmac_f32_dpp %7, %7, %15 row_shr:" #D " row_mask:0xf bank_mask:0xf\n\tv_mul_f32_dpp %15, %15, %15 row_shr:" #D " row_mask:0xf bank_mask:0xf"
#define SCAN8(D, A, B, o) asm volatile(SCAN8_STR(D) : "+v"(B[o + 0]), "+v"(B[o + 1]), "+v"(B[o + 2]), "+v"(B[o + 3]), "+v"(B[o + 4]), "+v"(B[o + 5]), "+v"(B[o + 6]), "+v"(B[o + 7]), \
    "+v"(A[o + 0]), "+v"(A[o + 1]), "+v"(A[o + 2]), "+v"(A[o + 3]), "+v"(A[o + 4]), "+v"(A[o + 5]), "+v"(A[o + 6]), "+v"(A[o + 7]))
__device__ __forceinline__ void row_scan16(float (&A)[16], float (&B)[16]) {
    SCAN8(1, A, B, 0); SCAN8(1, A, B, 8); SCAN8(2, A, B, 0); SCAN8(2, A, B, 8); SCAN8(4, A, B, 0); SCAN8(4, A, B, 8); SCAN8(8, A, B, 0); SCAN8(8, A, B, 8);
}
struct LruW { LAS float* cst; const bf16 *waP, *wxP; };
__device__ __forceinline__ void lru_setup(const Frame& F, LruW& L, LAS unsigned char* wbase) {
    const int hd = F.wave; L.cst = (LAS float*)wbase;
    for (int i = F.lane; i < 512; i += 64) { const int t = i >> 6, ch = hd * 64 + (i & 63); float v;
        if (t < 4) v = F.conv_w[t * LW + ch]; else if (t == 4) v = F.conv_b[ch]; else if (t == 5) v = F.ba[ch]; else if (t == 6) v = F.bx_[ch];
        else { const float lm = F.lam[ch]; v = 8.0f * (fminf(lm, 0.f) - log1pf(__expf(-fabsf(lm)))); }
        L.cst[i] = v; }
    const int i = F.lane & 15, qw = F.lane >> 4; const size_t o = (size_t)hd * 4096 + (size_t)(8 * (i >> 2) + (i & 3)) * 64 + 8 * qw;
    L.waP = F.WaT + o; L.wxP = F.WxT + o;
    LDS_WAIT();
}
struct LruRaw { u32x4 u[2][4]; u32x4 ug[2]; };
template <bool WITH_UG>
__device__ __forceinline__ void lru_load(const Frame& F, int b, int tt0, LruRaw& R) {
    const int hd = F.wave, row = F.lane & 15, q = F.lane >> 4, tt = tt0 + row;
    const bf16* prow = F.PROJ + (size_t)(b * TT + tt) * INW + hd * 64 + 8 * q;
#pragma unroll
    for (int kb = 0; kb < 2; ++kb) {
#pragma unroll
        for (int k = 0; k < 4; ++k) { R.u[kb][k] = (u32x4){0u, 0u, 0u, 0u}; if (tt - 3 + k >= 0) R.u[kb][k] = *(const u32x4*)(prow + (ptrdiff_t)(k - 3) * INW + 32 * kb); }
        if (WITH_UG) R.ug[kb] = *(const u32x4*)(prow + LW + 32 * kb);
    }
}
__device__ __forceinline__ void lru_conv(const Frame& F, const LruW& L, const LruRaw& R, float (&xc)[16], bf16x8 (&xf)[2]) {
    const int q = F.lane >> 4;
#pragma unroll
    for (int kb = 0; kb < 2; ++kb) {
        const LAS float* cs = L.cst + 32 * kb + 8 * q;
        f32x2 x2[4];
        { const f32x4 c0 = *(const LAS f32x4*)(cs + 256), c1 = *(const LAS f32x4*)(cs + 260); x2[0] = (f32x2){c0.x, c0.y}; x2[1] = (f32x2){c0.z, c0.w}; x2[2] = (f32x2){c1.x, c1.y}; x2[3] = (f32x2){c1.z, c1.w}; }
#pragma unroll
        for (int k = 0; k < 4; ++k) {
            const u32x4 u = R.u[kb][k];
            const f32x4 w0 = *(const LAS f32x4*)(cs + 64 * k), w1 = *(const LAS f32x4*)(cs + 64 * k + 4);
            x2[0] = (f32x2){w0.x, w0.y} * (f32x2){bflo(u.x), bfhi(u.x)} + x2[0]; x2[1] = (f32x2){w0.z, w0.w} * (f32x2){bflo(u.y), bfhi(u.y)} + x2[1];
            x2[2] = (f32x2){w1.x, w1.y} * (f32x2){bflo(u.z), bfhi(u.z)} + x2[2]; x2[3] = (f32x2){w1.z, w1.w} * (f32x2){bflo(u.w), bfhi(u.w)} + x2[3];
        }
#pragma unroll
        for (int i = 0; i < 4; ++i) { xc[8 * kb + 2 * i] = x2[i].x; xc[8 * kb + 2 * i + 1] = x2[i].y; }
        asm volatile("" : "+v"(xc[8 * kb + 0]), "+v"(xc[8 * kb + 1]), "+v"(xc[8 * kb + 2]), "+v"(xc[8 * kb + 3]), "+v"(xc[8 * kb + 4]), "+v"(xc[8 * kb + 5]), "+v"(xc[8 * kb + 6]), "+v"(xc[8 * kb + 7]));
        u32x4 p; p.x = pk2(xc[8 * kb + 0], xc[8 * kb + 1]); p.y = pk2(xc[8 * kb + 2], xc[8 * kb + 3]); p.z = pk2(xc[8 * kb + 4], xc[8 * kb + 5]); p.w = pk2(xc[8 * kb + 6], xc[8 * kb + 7]);
        xf[kb] = __builtin_bit_cast(bf16x8, p);
    }
}
template <bool WPF  >
__device__ __forceinline__ void lru_gates(const Frame& F, const LruW& L, const float (&xc)[16], const bf16x8 (&xf)[2], float (&Av)[16], float (&Bv)[16]) {
    const int q = F.lane >> 4;
    bf16x8 wa[2], wx[2];
#pragma unroll
    for (int kk = 0; kk < 2; ++kk) { wa[kk] = *(const bf16x8*)(L.waP + 32 * kk); wx[kk] = *(const bf16x8*)(L.wxP + 32 * kk); }
#pragma unroll
    for (int nb = 0; nb < 4; ++nb) {
        const int kb = nb >> 1, hf = nb & 1;
        bf16x8 wan[2], wxn[2];
        if (!WPF && nb > 0) { const int o = (32 * kb + 4 * hf) * 64;
#pragma unroll
            for (int kk = 0; kk < 2; ++kk) { wa[kk] = *(const bf16x8*)(L.waP + o + 32 * kk); wx[kk] = *(const bf16x8*)(L.wxP + o + 32 * kk); } }
        if (WPF && nb < 3) { const int o = (32 * ((nb + 1) >> 1) + 4 * ((nb + 1) & 1)) * 64;
#pragma unroll
            for (int kk = 0; kk < 2; ++kk) { wan[kk] = *(const bf16x8*)(L.waP + o + 32 * kk); wxn[kk] = *(const bf16x8*)(L.wxP + o + 32 * kk); } }
        asm volatile("" ::: "memory");
        f32x4 ra = (f32x4){0.f, 0.f, 0.f, 0.f}, rx = ra;
#pragma unroll
        for (int kk = 0; kk < 2; ++kk) { ra = __builtin_amdgcn_mfma_f32_16x16x32_bf16(wa[kk], xf[kk], ra, 0, 0, 0); rx = __builtin_amdgcn_mfma_f32_16x16x32_bf16(wx[kk], xf[kk], rx, 0, 0, 0); }
        const LAS float* cs = L.cst + 32 * kb + 8 * q + 4 * hf;
        const f32x4 ba4 = *(const LAS f32x4*)(cs + 320), bx4 = *(const LAS f32x4*)(cs + 384), lm4 = *(const LAS f32x4*)(cs + 448);
#pragma unroll
        for (int j = 0; j < 4; ++j) { const int c = 8 * kb + 4 * hf + j;
            const float r = sigmoidf_(ra[j] + ba4[j]), ig = sigmoidf_(rx[j] + bx4[j]);
            const float a = __expf(lm4[j] * r);
            Av[c] = a; Bv[c] = __builtin_amdgcn_sqrtf(fmaf(-a, a, 1.0f)) * (ig * xc[c]); }
        if (WPF && nb < 3) {
#pragma unroll
            for (int kk = 0; kk < 2; ++kk) { wa[kk] = wan[kk]; wx[kk] = wxn[kk]; } }
    }
    row_scan16(Av, Bv);
}
__device__ __forceinline__ void p2_aggregates(Frame& F) {
    LruW L; lru_setup(F, L, F.lds + F.wave * 2048);
    const int row = F.lane & 15, q = F.lane >> 4;
    for (int ch = F.bx; ch < 256; ch += F.G) {
        const int b = ch >> 5, ci = ch & 31; float Ac[16], Bc[16];
#pragma unroll
        for (int c = 0; c < 16; ++c) { Ac[c] = 1.f; Bc[c] = 0.f; }
        const int blk0 = (ci == 0 ? -1 : 0);
        LruRaw R; lru_load<false>(F, b, NMETA + 128 * ci + 16 * blk0, R);
        for (int blk = blk0; blk < 8; ++blk) {
            float xc[16]; bf16x8 xf[2]; lru_conv(F, L, R, xc, xf);
            if (blk < 7) lru_load<false>(F, b, NMETA + 128 * ci + 16 * (blk + 1), R);
            asm volatile("" ::: "memory");
            float Av[16], Bv[16];
            lru_gates<true>(F, L, xc, xf, Av, Bv);
            if (blk >= 0) { u32x4* ab = F.AB + ((size_t)((ch * 8 + blk) * 8 + F.wave) * 4) * 64 + F.lane;
#pragma unroll
                for (int j = 0; j < 2; ++j) { u32x4 a, bq;
                    a.x = pkh2(Av[8 * j], Av[8 * j + 1]); a.y = pkh2(Av[8 * j + 2], Av[8 * j + 3]); a.z = pkh2(Av[8 * j + 4], Av[8 * j + 5]); a.w = pkh2(Av[8 * j + 6], Av[8 * j + 7]);
                    bq.x = pkh2(Bv[8 * j], Bv[8 * j + 1]); bq.y = pkh2(Bv[8 * j + 2], Bv[8 * j + 3]); bq.z = pkh2(Bv[8 * j + 4], Bv[8 * j + 5]); bq.w = pkh2(Bv[8 * j + 6], Bv[8 * j + 7]);
                    ab[64 * j] = a; ab[64 * (2 + j)] = bq; } }
            else if (row == 15) {
#pragma unroll
                for (int kb = 0; kb < 2; ++kb) { float* o = F.HM + (size_t)b * LW + F.wave * 64 + 32 * kb + 8 * q;
                    *(f32x4*)o = (f32x4){Bv[8 * kb], Bv[8 * kb + 1], Bv[8 * kb + 2], Bv[8 * kb + 3]}; *(f32x4*)(o + 4) = (f32x4){Bv[8 * kb + 4], Bv[8 * kb + 5], Bv[8 * kb + 6], Bv[8 * kb + 7]}; } }
#pragma unroll
            for (int c = 0; c < 16; ++c) { Bc[c] = Av[c] * Bc[c] + Bv[c]; Ac[c] *= Av[c]; }
        }
        if (row == 15) {
#pragma unroll
            for (int kb = 0; kb < 2; ++kb) { float* o = F.AGG + ((size_t)ch * LW + F.wave * 64 + 32 * kb + 8 * q) * 2;
#pragma unroll
                for (int j = 0; j < 8; j += 2) *(f32x4*)(o + 2 * j) = (f32x4){Ac[8 * kb + j], Bc[8 * kb + j], Ac[8 * kb + j + 1], Bc[8 * kb + j + 1]}; }
        }
    }
}

constexpr int YT_STRIDE = 520;
constexpr int US_STRIDE = 264;
constexpr int PW_STRIDE = 136;
template <int G> __device__ __forceinline__ void pool_z(const LAS bf16* ub  , bf16x8 (&zf)[4]) {
    constexpr int W = 2 << G;
    asm volatile("" : "+v"(ub));
#pragma unroll
    for (int kb = 0; kb < 4; ++kb) {
        const LAS bf16* p = ub + 15 * US_STRIDE + 32 * kb; const u32x4 c = *(const LAS u32x4*)p; float cur[8], s[8];
        cur[0] = bflo(c.x); cur[1] = bfhi(c.x); cur[2] = bflo(c.y); cur[3] = bfhi(c.y); cur[4] = bflo(c.z); cur[5] = bfhi(c.z); cur[6] = bflo(c.w); cur[7] = bfhi(c.w);
#pragma unroll
        for (int j = 0; j < 8; ++j) s[j] = cur[j];
#pragma unroll
        for (int d = 1; d < W; ++d) { const u32x4 u = *(const LAS u32x4*)(ub + (15 - d) * US_STRIDE + 32 * kb);
            s[0] += bflo(u.x); s[1] += bfhi(u.x); s[2] += bflo(u.y); s[3] += bfhi(u.y); s[4] += bflo(u.z); s[5] += bfhi(u.z); s[6] += bflo(u.w); s[7] += bfhi(u.w);
            if ((d & 3) == 3) asm volatile("" : "+v"(s[0]), "+v"(s[1]), "+v"(s[2]), "+v"(s[3]), "+v"(s[4]), "+v"(s[5]), "+v"(s[6]), "+v"(s[7]) :: "memory"); }
        asm volatile("" : "+v"(s[0]), "+v"(s[1]), "+v"(s[2]), "+v"(s[3]), "+v"(s[4]), "+v"(s[5]), "+v"(s[6]), "+v"(s[7]) :: "memory");
        u32x4 pz; pz.x = pk2(s[0] * (1.0f / W) - cur[0], s[1] * (1.0f / W) - cur[1]); pz.y = pk2(s[2] * (1.0f / W) - cur[2], s[3] * (1.0f / W) - cur[3]);
        pz.z = pk2(s[4] * (1.0f / W) - cur[4], s[5] * (1.0f / W) - cur[5]); pz.w = pk2(s[6] * (1.0f / W) - cur[6], s[7] * (1.0f / W) - cur[7]);
        asm volatile("" : "+v"(pz) :: "memory");
        zf[kb] = __builtin_bit_cast(bf16x8, pz);
    }
}
__device__ __forceinline__ void p3_mixer(Frame& F) {
    LAS bf16* Y = (LAS bf16*)F.lds;
    LAS unsigned char* wbase = F.lds + 66560 + F.wave * 2048;
    LAS float* SSQ = (LAS float*)(F.lds + 66560 + 16384);
    LAS float* RSTD = SSQ + 512;
    LAS bf16* US = (LAS bf16*)F.lds;
    const int row = F.lane & 15, q = F.lane >> 4;
    for (int ch = F.bx; ch < 256; ch += F.G) {
        const int b = ch >> 5, ci = ch & 31; const int m0 = ch * 128;
#ifndef P3_NO_LRU
        {
        float H[16];
        { float Ar[16], Br[16];
#pragma unroll
            for (int c = 0; c < 16; ++c) { Ar[c] = 1.f; Br[c] = 0.f; }
#pragma unroll
            for (int t = 0; t < 2; ++t) { const int k = 2 * row + t;
                if (k < ci) {
#pragma unroll
                    for (int kb = 0; kb < 2; ++kb) { const float* o = F.AGG + ((size_t)(b * 32 + k) * LW + F.wave * 64 + 32 * kb + 8 * q) * 2;
#pragma unroll
                        for (int j = 0; j < 8; j += 2) { const f32x4 v = *(const f32x4*)(o + 2 * j); const int c = 8 * kb + j;
                            Br[c] = v.x * Br[c] + v.y; Ar[c] *= v.x; Br[c + 1] = v.z * Br[c + 1] + v.w; Ar[c + 1] *= v.z; } } } }
            row_scan16(Ar, Br);
#pragma unroll
            for (int c = 0; c < 16; ++c) H[c] = dpp_f<DPP_BCAST15>(0.f, Br[c]); }
        if (ci == 0) {
#pragma unroll
            for (int kb = 0; kb < 2; ++kb) { const float* o = F.HM + (size_t)b * LW + F.wave * 64 + 32 * kb + 8 * q; const f32x4 h0 = *(const f32x4*)o, h1 = *(const f32x4*)(o + 4);
                H[8 * kb] = h0.x; H[8 * kb + 1] = h0.y; H[8 * kb + 2] = h0.z; H[8 * kb + 3] = h0.w; H[8 * kb + 4] = h1.x; H[8 * kb + 5] = h1.y; H[8 * kb + 6] = h1.z; H[8 * kb + 7] = h1.w; }
        }
        u32x4 abv[4]; u32x4 ug[2];
        { const u32x4* ab = F.AB + ((size_t)((ch * 8 + 0) * 8 + F.wave) * 4) * 64 + F.lane;
#pragma unroll
          for (int j = 0; j < 4; ++j) abv[j] = ab[64 * j];
          const bf16* prow = F.PROJ + (size_t)(b * TT + NMETA + 128 * ci + row) * INW + LW + F.wave * 64 + 8 * q; ug[0] = *(const u32x4*)prow; ug[1] = *(const u32x4*)(prow + 32); }
        for (int half = 0; half < 2; ++half) {
            for (int blk = 0; blk < 4; ++blk) {
                const int rb = 16 * blk, gb = half * 4 + blk;
                float Av[16], Bv[16]; u32x4 ugc[2] = {ug[0], ug[1]};
#pragma unroll
                for (int j = 0; j < 2; ++j)
#pragma unroll
                    for (int i = 0; i < 4; ++i) { Av[8 * j + 2 * i] = h2lo(abv[j][i]); Av[8 * j + 2 * i + 1] = h2hi(abv[j][i]); Bv[8 * j + 2 * i] = h2lo(abv[2 + j][i]); Bv[8 * j + 2 * i + 1] = h2hi(abv[2 + j][i]); }
                if (gb < 7) { const u32x4* ab = F.AB + ((size_t)((ch * 8 + gb + 1) * 8 + F.wave) * 4) * 64 + F.lane;
#pragma unroll
                    for (int j = 0; j < 4; ++j) abv[j] = ab[64 * j];
                    const bf16* prow = F.PROJ + (size_t)(b * TT + NMETA + 128 * ci + 16 * (gb + 1) + row) * INW + LW + F.wave * 64 + 8 * q; ug[0] = *(const u32x4*)prow; ug[1] = *(const u32x4*)(prow + 32); }
                asm volatile("" ::: "memory");
                float ss = 0.f;
#pragma unroll
                for (int kb = 0; kb < 2; ++kb) { float y[8];
#pragma unroll
                    for (int j = 0; j < 8; ++j) { const int c = 8 * kb + j;
                        const float h = Av[c] * H[c] + Bv[c];
                        const unsigned w = ugc[kb][j >> 1]; const float g = (j & 1) ? bfhi(w) : bflo(w);
                        const float gl = g * sigmoidf_(1.5957691216f * (g + 0.044715f * g * g * g));
                        y[j] = h * gl; ss += y[j] * y[j];
                        H[c] = dpp_f<DPP_BCAST15>(0.f, h); }
                    u32x4 p; p.x = pk2(y[0], y[1]); p.y = pk2(y[2], y[3]); p.z = pk2(y[4], y[5]); p.w = pk2(y[6], y[7]);
                    *(LAS u32x4*)(Y + (rb + row) * YT_STRIDE + F.wave * 64 + 32 * kb + 8 * q) = p;
                    asm volatile("" : "+v"(ss) :: "memory"); }
                ss += __shfl_xor(ss, 16); ss += __shfl_xor(ss, 32);
                if (q == 0) SSQ[(rb + row) * 8 + F.wave] = ss;
            }
            __syncthreads();
            if (F.tid < 64) { float s = 0.f;
#pragma unroll
                for (int w = 0; w < 8; ++w) s += SSQ[F.tid * 8 + w];
                RSTD[F.tid] = rsqrtf(s * (1.0f / LW) + RMS_EPS); }
            __syncthreads();
#pragma unroll
            for (int s = 0; s < 8; ++s) { const int p = F.tid + 512 * s, rw = p >> 6, cp = p & 63; const float rs = RSTD[rw];
                const u32x4 v = *(const LAS u32x4*)(Y + rw * YT_STRIDE + 8 * cp); const f32x4 g0 = *(const f32x4*)(F.lru_gain + 8 * cp), g1 = *(const f32x4*)(F.lru_gain + 8 * cp + 4);
                u32x4 o; o.x = pk2(bflo(v.x) * rs * g0.x, bfhi(v.x) * rs * g0.y); o.y = pk2(bflo(v.y) * rs * g0.z, bfhi(v.y) * rs * g0.w);
                o.z = pk2(bflo(v.z) * rs * g1.x, bfhi(v.z) * rs * g1.y); o.w = pk2(bflo(v.w) * rs * g1.z, bfhi(v.w) * rs * g1.w);
                *(u32x4*)(F.YMIX + (size_t)(m0 + 64 * half + rw) * D + 8 * cp) = o; }
            __syncthreads();
        }
        }
#endif
#ifndef P3_NO_POOL
        for (int prep_ = 0; prep_ <= ((REPEAT_MASK >> 9) & 1); ++prep_)
        {
            bf16x8 zf[4][4];
            const int T0 = b * TT + NMETA + 128 * ci - 15;
            u32x4 sv[9];
#define POOL_STAGE_LOAD(gp) do { _Pragma("unroll") for (int t = 0; t < 9; ++t) { const int i = F.tid + 512 * t; if (i < 143 * 32) sv[t] = *(const u32x4*)(F.PROJ + (size_t)(T0 + (i >> 5)) * INW + 1024 + 256 * (gp) + 8 * (i & 31)); } } while (0)
#define POOL_STAGE_WRITE() do { _Pragma("unroll") for (int t = 0; t < 9; ++t) { const int i = F.tid + 512 * t; if (i < 143 * 32) *(LAS u32x4*)(US + (i >> 5) * US_STRIDE + 8 * (i & 31)) = sv[t]; } } while (0)
            const LAS bf16* urow = US + (16 * F.wave + row) * US_STRIDE + 8 * q;
            POOL_STAGE_LOAD(0); POOL_STAGE_WRITE(); __syncthreads();
            POOL_STAGE_LOAD(1);
            pool_z<0>(urow, zf[0]); pool_z<1>(urow + 128, zf[1]);
            __syncthreads();
            POOL_STAGE_WRITE(); __syncthreads();
            u32x4 wv[8];
#pragma unroll
            for (int t = 0; t < 4; ++t) { const int i = F.tid + 512 * t; wv[t] = *(const u32x4*)(F.PwT + (size_t)(i >> 4) * 128 + 8 * (i & 15)); }
            pool_z<2>(urow, zf[2]); pool_z<3>(urow + 128, zf[3]);
            __syncthreads();
#pragma unroll
            for (int t = 0; t < 4; ++t) { const int i = F.tid + 512 * t; *(LAS u32x4*)(US + (i >> 4) * PW_STRIDE + 8 * (i & 15)) = wv[t]; }
#pragma unroll
            for (int t = 4; t < 12; ++t) { const int i = F.tid + 512 * t; wv[t - 4] = *(const u32x4*)(F.PwT + (size_t)(i >> 4) * 128 + 8 * (i & 15)); }
#pragma unroll
            for (int t = 4; t < 12; ++t) { const int i = F.tid + 512 * t; *(LAS u32x4*)(US + (i >> 4) * PW_STRIDE + 8 * (i & 15)) = wv[t - 4]; }
#pragma unroll
            for (int t = 12; t < 16; ++t) { const int i = F.tid + 512 * t; wv[t - 12] = *(const u32x4*)(F.PwT + (size_t)(i >> 4) * 128 + 8 * (i & 15)); }
#pragma unroll
            for (int t = 12; t < 16; ++t) { const int i = F.tid + 512 * t; *(LAS u32x4*)(US + (i >> 4) * PW_STRIDE + 8 * (i & 15)) = wv[t - 12]; }
            __syncthreads();
#undef POOL_STAGE_LOAD
#undef POOL_STAGE_WRITE
            const LAS bf16* wl = US + row * PW_STRIDE + 8 * q;
            float ssq = 0.f; u32x2 po[4][8];
#pragma unroll
            for (int g = 0; g < 4; ++g) { const LAS bf16* wg = wl + g * 128 * PW_STRIDE; asm volatile("" : "+v"(wg));
#pragma unroll
                for (int nb = 0; nb < 8; ++nb) { f32x4 acc = (f32x4){0.f, 0.f, 0.f, 0.f}; const LAS bf16* wn = wg + 16 * nb * PW_STRIDE;
#pragma unroll
                    for (int kb = 0; kb < 4; ++kb) acc = __builtin_amdgcn_mfma_f32_16x16x32_bf16(*(const LAS bf16x8*)(wn + 32 * kb), zf[g][kb], acc, 0, 0, 0);
                    ssq += (acc[0] * acc[0] + acc[1] * acc[1]) + (acc[2] * acc[2] + acc[3] * acc[3]);
                    po[g][nb].x = pk2(acc[0], acc[1]); po[g][nb].y = pk2(acc[2], acc[3]);
                    if (nb & 1) asm volatile("" : "+v"(ssq) :: "memory"); } }
            ssq += __shfl_xor(ssq, 16); ssq += __shfl_xor(ssq, 32);
            const float rs = rsqrtf(ssq * (1.0f / 512.0f) + RMS_EPS);
            bf16* orow = F.YMIX + (size_t)(m0 + 16 * F.wave + row) * D + LW + 4 * q;
#pragma unroll
            for (int g = 0; g < 4; ++g)
#pragma unroll
                for (int nb = 0; nb < 8; ++nb) { const f32x4 sc = *(const f32x4*)(F.pool_scale + 128 * g + 16 * nb + 4 * q); const u32x2 v = po[g][nb];
                    u32x2 o; o.x = pk2(bflo(v.x) * rs * sc.x, bfhi(v.x) * rs * sc.y); o.y = pk2(bflo(v.y) * rs * sc.z, bfhi(v.y) * rs * sc.w);
                    *(u32x2*)(orow + 128 * g + 16 * nb) = o; }
        }
#endif
        __syncthreads();
    }
}

constexpr int WR_STRIDE = 1032;
__device__ __forceinline__ void p5_route(Frame& F, const bool dry = false) {
    LAS _Float16* WR = (LAS _Float16*)F.lds;
    LAS float* LG = (LAS float*)(F.lds + 36 * WR_STRIDE * 2) + F.wave * 16 * 40;
    LAS int* LCNT = (LAS int*)(F.lds + 36 * WR_STRIDE * 2 + 8 * 16 * 40 * 4);
    LAS float* G2 = (LAS float*)(LCNT + 64);
    const int c16 = F.lane & 15, q = F.lane >> 4;
    for (int i = F.tid; i < NROUTE * 128; i += 512) { const int n = i >> 7, k8 = i & 127; *(LAS u32x4*)(WR + n * WR_STRIDE + 8 * k8) = *(const u32x4*)(F.WrH + n * D + 8 * k8); }
    for (int i = F.tid; i < D; i += 512) G2[i] = F.g2[i];
    for (int ch = F.bx; ch < 256; ch += F.G) {
        if (F.tid < 64) LCNT[F.tid] = 0;
        __syncthreads();
        const int row = ch * 128 + 16 * F.wave + c16;
        const bf16* hrow = F.H1 + (size_t)row * D + 8 * q;
        f32x4 acc[3]; float ss = 0.f;
#pragma unroll
        for (int nb = 0; nb < 3; ++nb) acc[nb] = (f32x4){0.f, 0.f, 0.f, 0.f};
#pragma unroll 4
        for (int i = 0; i < 32; ++i) {
            const u32x4 hw = *(const u32x4*)(hrow + 32 * i);
            const f32x4 h0 = (f32x4){bflo(hw.x), bfhi(hw.x), bflo(hw.y), bfhi(hw.y)}, h1 = (f32x4){bflo(hw.z), bfhi(hw.z), bflo(hw.w), bfhi(hw.w)};
            const f32x4 g0 = *(const LAS f32x4*)(G2 + 32 * i + 8 * q), g1 = *(const LAS f32x4*)(G2 + 32 * i + 8 * q + 4);
            ss += (h0.x * h0.x + h0.y * h0.y) + (h0.z * h0.z + h0.w * h0.w) + (h1.x * h1.x + h1.y * h1.y) + (h1.z * h1.z + h1.w * h1.w);
            const f32x4 t0 = h0 * g0, t1 = h1 * g1;
            f16x8 a; a[0] = (_Float16)t0.x; a[1] = (_Float16)t0.y; a[2] = (_Float16)t0.z; a[3] = (_Float16)t0.w; a[4] = (_Float16)t1.x; a[5] = (_Float16)t1.y; a[6] = (_Float16)t1.z; a[7] = (_Float16)t1.w;
#pragma unroll
            for (int nb = 0; nb < 3; ++nb) { const int col = 16 * nb + c16; f16x8 bw;
#pragma unroll
                for (int j = 0; j < 8; ++j) bw[j] = (_Float16)0.f;
                if (col < NROUTE) bw = *(const LAS f16x8*)(WR + col * WR_STRIDE + 32 * i + 8 * q);
                acc[nb] = __builtin_amdgcn_mfma_f32_16x16x32_f16(a, bw, acc[nb], 0, 0, 0); }
        }
        ss += __shfl_xor(ss, 16); ss += __shfl_xor(ss, 32);
        const float rstd = rsqrtf(ss * (1.0f / D) + RMS_EPS);
#pragma unroll
        for (int nb = 0; nb < 3; ++nb)
#pragma unroll
            for (int j = 0; j < 4; ++j) { const int col = 16 * nb + c16; if (col < 40) LG[(4 * q + j) * 40 + col] = acc[nb][j]; }
        LDS_WAIT();
        int e0 = 0, e1 = 0, rk0 = 0, rk1 = 0; float gt0 = 0.f, gt1 = 0.f;
        if (F.lane < 16) {
            const LAS float* lg = LG + F.lane * 40; const float sc = rstd * (1.0f / 256.0f);
            float gl[4]; int gi = 0;
#pragma unroll
            for (int j = 0; j < 4; ++j) gl[j] = lg[j] * sc + F.b_group[j];
            float gm = gl[0];
#pragma unroll
            for (int j = 1; j < 4; ++j) if (gl[j] > gm) { gm = gl[j]; gi = j; }
            float den = 0.f;
#pragma unroll
            for (int j = 0; j < 4; ++j) den += __expf(gl[j] - gm);
            const float pg = 1.0f / den;
            float v0 = -3.0e38f, v1 = -3.0e38f; int i0 = 0, i1 = 0;
            for (int j = 0; j < 8; ++j) { const float v = lg[4 + gi * 8 + j] * sc + F.b_router[gi * 8 + j];
                if (v > v0) { v1 = v0; i1 = i0; v0 = v; i0 = j; } else if (v > v1) { v1 = v; i1 = j; } }
            const float ex = __expf(v1 - v0), s0 = 1.0f / (1.0f + ex);
            gt0 = pg * s0; gt1 = pg * (ex * s0); e0 = gi * 8 + i0; e1 = gi * 8 + i1;
            rk0 = __hip_atomic_fetch_add(&LCNT[e0], 1, __ATOMIC_RELAXED, __HIP_MEMORY_SCOPE_WORKGROUP); rk1 = __hip_atomic_fetch_add(&LCNT[e1], 1, __ATOMIC_RELAXED, __HIP_MEMORY_SCOPE_WORKGROUP);
        }
        __syncthreads();
        if (F.tid < 32 && !dry) LCNT[32 + F.tid] = (int)__hip_atomic_fetch_add(F.ctl + CW_CNT + 64 * F.tid, (unsigned)LCNT[F.tid], __ATOMIC_RELAXED, __HIP_MEMORY_SCOPE_AGENT);
        __syncthreads();
        if (F.lane < 16 && !dry) { const int tok = ch * 128 + 16 * F.wave + F.lane;
            F.RINFO[(size_t)e0 * ECAP + LCNT[32 + e0] + rk0] = (f32x4){__builtin_bit_cast(float, tok * 2), gt0, rstd, 0.f};
            F.RINFO[(size_t)e1 * ECAP + LCNT[32 + e1] + rk1] = (f32x4){__builtin_bit_cast(float, tok * 2 + 1), gt1, rstd, 0.f}; }
        __syncthreads();
    }
}

__device__ __forceinline__ int moe_tables(Frame& F) {
    LAS int* TE = (LAS int*)(F.lds + TAB_TE); LAS int* TR = (LAS int*)(F.lds + TAB_TR); LAS int* CNT = (LAS int*)(F.lds + TAB_CNT); LAS int* PRE = CNT + 32;
    if (F.tid < 32) CNT[F.tid] = (int)__hip_atomic_load(F.ctl + CW_CNT + 64 * F.tid, __ATOMIC_RELAXED, __HIP_MEMORY_SCOPE_AGENT);
    __syncthreads();
    if (F.tid == 0) { int s = 0; for (int e = 0; e < NE; ++e) { PRE[e] = s; s += (CNT[e] + 255) >> 8; } PRE[NE] = s; }
    __syncthreads();
    const int NT = PRE[NE];
    for (int t = F.tid; t < NT; t += 512) { int e = 0; while (e < NE - 1 && PRE[e + 1] <= t) ++e; TE[t] = e; TR[t] = (t - PRE[e]) * 256; }
    __syncthreads();
    return NT;
}
__device__ __forceinline__ void moe_unit_tables(Frame& F, const pg8::MoeSched& S, int mode) {
    LAS int* TE = (LAS int*)(F.lds + TAB_TE); LAS int* TR = (LAS int*)(F.lds + TAB_TR); LAS int* CNT = (LAS int*)(F.lds + TAB_CNT);
    LAS unsigned* ROW = (LAS unsigned*)(F.lds + TAB_ROW); LAS float* FT = (LAS float*)(F.lds + TAB_F);
    const int nu = S.rounds() < MAXU ? S.rounds() : MAXU;
    f32x4 ri[MAXU / 2]; bool valid[MAXU / 2]; int ok[MAXU / 2];
#pragma unroll
    for (int t = 0; t < MAXU / 2; ++t) { const int idx = F.tid + 512 * t, i = idx >> 8, r = idx & 255; pg8::Unit u;
        ri[t] = (f32x4){0.f, 0.f, 0.f, 0.f}; valid[t] = false; ok[t] = (i < nu) && S.next(i, u);
        if (ok[t]) { const int e = TE[u.pm], pos = TR[u.pm] + r; valid[t] = pos < CNT[e]; if (valid[t]) ri[t] = F.RINFO[(size_t)e * ECAP + pos]; } }
#pragma unroll
    for (int t = 0; t < MAXU / 2; ++t) if (ok[t]) { const int idx = F.tid + 512 * t; const int slot = __builtin_bit_cast(int, ri[t].x);
        if (mode == 0) { ROW[idx] = valid[t] ? (unsigned)(slot >> 1) * (unsigned)D : 0u; FT[idx] = valid[t] ? ri[t].z * (1.0f / WGU_SCALE) : 0.f; }
        else { ROW[idx] = valid[t] ? (unsigned)slot : 0xffffffffu; FT[idx] = ri[t].y * (C_SCALE / (WD_SCALE * HID_SCALE)); } }
    __syncthreads();
}

__device__ __forceinline__ void p8_final(Frame& F) {
    const int gw = F.bx * 8 + F.wave, NGW = F.G * 8;
    f32x4 g[4];
#pragma unroll
    for (int j = 0; j < 4; ++j) g[j] = ((const f32x4*)F.final_gain)[F.lane + 64 * j];
    for (int m = gw * 2; m < M; m += NGW * 2) {
        u32x2 hb[2][4]; unsigned ca[2][4], cb[2][4];
#pragma unroll
        for (int r = 0; r < 2; ++r)
#pragma unroll
            for (int j = 0; j < 4; ++j) { hb[r][j] = ((const u32x2*)(F.H1 + (size_t)(m + r) * D))[F.lane + 64 * j];
                ca[r][j] = ((const unsigned*)(F.C + (size_t)(2 * (m + r)) * D))[F.lane + 64 * j]; cb[r][j] = ((const unsigned*)(F.C + (size_t)(2 * (m + r) + 1) * D))[F.lane + 64 * j]; }
#pragma unroll
        for (int r = 0; r < 2; ++r) { f32x4 v[4]; float s = 0.f;
#pragma unroll
            for (int j = 0; j < 4; ++j) { const f32x2 a0 = __builtin_amdgcn_cvt_pk_f32_fp8(ca[r][j], false), a1 = __builtin_amdgcn_cvt_pk_f32_fp8(ca[r][j], true), b0 = __builtin_amdgcn_cvt_pk_f32_fp8(cb[r][j], false), b1 = __builtin_amdgcn_cvt_pk_f32_fp8(cb[r][j], true);
                v[j] = (f32x4){bflo(hb[r][j].x) + (a0.x + b0.x) * (1.0f / C_SCALE), bfhi(hb[r][j].x) + (a0.y + b0.y) * (1.0f / C_SCALE), bflo(hb[r][j].y) + (a1.x + b1.x) * (1.0f / C_SCALE), bfhi(hb[r][j].y) + (a1.y + b1.y) * (1.0f / C_SCALE)};
                s += (v[j].x * v[j].x + v[j].y * v[j].y) + (v[j].z * v[j].z + v[j].w * v[j].w); }
            const float rstd = rsqrtf(wave_sum(s) * (1.f / D) + RMS_EPS);
            f32x4* o = (f32x4*)(F.out + (size_t)(m + r) * D) + F.lane;
#pragma unroll
            for (int j = 0; j < 4; ++j) o[64 * j] = v[j] * rstd * g[j]; }
    }
}

struct Args { const float* in[24]; float* out; unsigned char* ws; int ph_lo, ph_hi; };
__global__ void __launch_bounds__(512, 2) hymba_fwd(Args args) {
    extern __shared__ __attribute__((aligned(16))) unsigned char lds[];
    Frame F;
    F.lds = (LAS unsigned char*)lds; F.tid = threadIdx.x; F.lane = F.tid & 63; F.wave = __builtin_amdgcn_readfirstlane(F.tid >> 6); F.G = gridDim.x; F.bx = blockIdx.x;
    F.x = args.in[0]; F.meta = args.in[1]; F.g1 = args.in[2]; F.w_in = args.in[3]; F.conv_w = args.in[4]; F.conv_b = args.in[5]; F.wa = args.in[6]; F.ba = args.in[7]; F.wx = args.in[8]; F.bx_ = args.in[9];
    F.lam = args.in[10]; F.lru_gain = args.in[11]; F.pool_w = args.in[12]; F.pool_scale = args.in[13]; F.w_out = args.in[14]; F.g2 = args.in[15]; F.w_group = args.in[16]; F.b_group = args.in[17];
    F.w_router = args.in[18]; F.b_router = args.in[19]; F.w_gate = args.in[20]; F.w_up = args.in[21]; F.w_down = args.in[22]; F.final_gain = args.in[23];
    F.out = args.out; F.ws = args.ws; F.ctl = (unsigned*)(args.ws + WS_CTL);
    unsigned char* ws = args.ws;
    F.WinT = (bf16*)(ws + WS_WIN); F.WoutT = (bf16*)(ws + WS_WOUT); F.WaT = (bf16*)(ws + WS_WA); F.WxT = (bf16*)(ws + WS_WX); F.PwT = (bf16*)(ws + WS_PW); F.WrH = (_Float16*)(ws + WS_WR);
    F.AGG = (float*)(ws + WS_AGG); F.HM = (float*)(ws + WS_HM); F.AB = (u32x4*)(ws + WS_AB); F.WguT = ws + WS_WGU; F.WdT = ws + WS_WD; F.RINFO = (f32x4*)(ws + WS_RINFO); F.HN1 = (bf16*)(ws + WS_HN1); F.YMIX = (bf16*)(ws + WS_HN1);
    F.PROJ = (bf16*)(ws + WS_PROJ); F.HN2 = ws + WS_PROJ; F.HID = ws + WS_HID; F.C = ws + WS_C; F.H1 = (bf16*)(ws + WS_H1);
    volatile LAS unsigned* MISC = (volatile LAS unsigned*)(F.lds + MISC_OFF);
    if (F.tid < 64) MISC[F.tid] = 0u;
    __syncthreads();
    XcdBarrier bar; bar.bar = F.ctl + CW_BAR; bar.x = 0; bar.st = nullptr;
    if (MK_N_LAUNCHES == 1) bar = xcd_barrier_post(F.ctl + CW_BAR, MISC + 8);
    const int lo = args.ph_lo, hi = args.ph_hi;
#ifndef PH_MASK
#define PH_MASK 0x1ff
#endif
#define IN(k) (((PH_MASK >> (k)) & 1) && lo <= (k) && (k) < hi)
#define SEAM(k) do { if (IN(k) && IN((k) + 1)) xcd_barrier(bar); } while (0)
#define REP(k) for (int rep_ = 0; rep_ <= ((REPEAT_MASK >> (k)) & 1); ++rep_)

    if (IN(0)) REP(0) { p0_prologue(F); } SEAM(0);
    if (IN(1)) { pg8::DenseSched S{M / 256, INW / 256, F.G, F.bx, D * 2, (const char*)F.WinT, 1 + ((REPEAT_MASK >> 1) & 1)}; pg8::EpiProj E{F.PROJ};
        pg8::gemm_phase(F.lds, D * 2, (const char*)F.HN1, S, E); } SEAM(1);
    if (IN(2)) REP(2) { p2_aggregates(F); } SEAM(2);
    if (IN(3)) REP(3) { p3_mixer(F); } SEAM(3);
    if (IN(4)) { pg8::DenseSched S{M / 256, D / 256, F.G, F.bx, D * 2, (const char*)F.WoutT, 1 + ((REPEAT_MASK >> 4) & 1)}; pg8::EpiResid E{F.x, F.g2, F.H1, F.HN2};
        pg8::gemm_phase(F.lds, D * 2, (const char*)F.YMIX, S, E); } SEAM(4);
    if (IN(5)) { if ((REPEAT_MASK >> 5) & 1) p5_route(F, true); p5_route(F); } SEAM(5);
    if (IN(6)) { const int NT = moe_tables(F);
        pg8::MoeSched S{NT, 4, F.G, F.bx, D, (const char*)F.WguT, (size_t)1024 * D, true, (const LAS int*)(F.lds + TAB_TE), (const LAS unsigned*)(F.lds + TAB_ROW), 1 + ((REPEAT_MASK >> 6) & 1)};
        moe_unit_tables(F, S, 0);
        pg8::EpiGateUp E{F.HID, (const LAS float*)(F.lds + TAB_F), S.rounds()};
        pg8::gemm_phase<pg8::EpiGateUp, pg8::MoeSched, true>(F.lds, D, (const char*)F.HN2, S, E); } SEAM(6);
    if (IN(7)) { const int NT = moe_tables(F);
        pg8::MoeSched S{NT, 4, F.G, F.bx, EFF, (const char*)F.WdT, (size_t)D * EFF, false, (const LAS int*)(F.lds + TAB_TE), (const LAS unsigned*)(F.lds + TAB_ROW), 1 + ((REPEAT_MASK >> 7) & 1)};
        moe_unit_tables(F, S, 1);
        pg8::EpiDown E{F.C, (const LAS int*)(F.lds + TAB_ROW), (const LAS float*)(F.lds + TAB_F), S.rounds()};
        pg8::gemm_phase<pg8::EpiDown, pg8::MoeSched, true>(F.lds, EFF, (const char*)F.HID, S, E); } SEAM(7);
    if (IN(8)) { p8_final(F); }
#undef IN
#undef SEAM
}

extern "C" void kernel_launch(void* const* d_in, const int* in_sizes, int n_in, void* d_out, int out_size, void* d_ws, size_t ws_size, hipStream_t stream) {
    static int grid = 0;
    if (grid == 0) {
        if (n_in != 24 || in_sizes[0] != M * D || out_size != M * D || ws_size < WS_END) { fprintf(stderr, "kernel_launch: unexpected shapes (n_in %d, in0 %d, out %d, ws %zu)\n", n_in, n_in > 0 ? in_sizes[0] : -1, out_size, ws_size); grid = -1; return; }
        int dev = 0, cus = 0, per_cu = 0;
        if (hipGetDevice(&dev) != hipSuccess || hipDeviceGetAttribute(&cus, hipDeviceAttributeMultiprocessorCount, dev) != hipSuccess) { grid = -1; return; }
        if (hipFuncSetAttribute((const void*)hymba_fwd, hipFuncAttributeMaxDynamicSharedMemorySize, LDS_BYTES) != hipSuccess) { fprintf(stderr, "kernel_launch: hipFuncSetAttribute failed\n"); grid = -1; return; }
        if (hipOccupancyMaxActiveBlocksPerMultiprocessor(&per_cu, (const void*)hymba_fwd, 512, LDS_BYTES) != hipSuccess || per_cu < 1) fprintf(stderr, "kernel_launch: occupancy query says %d\n", per_cu);
        (void)hipGetLastError();
        grid = cus;
    }
    if (grid < 0) return;
    if (hipMemsetAsync((char*)d_ws + WS_CTL, 0, CTL_ZERO_BYTES, stream) != hipSuccess) return;
    Args a{};
    for (int i = 0; i < 24; ++i) a.in[i] = (const float*)d_in[i];
    a.out = (float*)d_out; a.ws = (unsigned char*)d_ws;
    if (MK_N_LAUNCHES == 1) { a.ph_lo = 0; a.ph_hi = N_PHASES; hipLaunchKernelGGL(hymba_fwd, dim3(grid), dim3(512), LDS_BYTES, stream, a); }
    else for (int p = 0; p < N_PHASES; ++p) { a.ph_lo = p; a.ph_hi = p + 1; hipLaunchKernelGGL(hymba_fwd, dim3(grid), dim3(512), LDS_BYTES, stream, a); }
}
```

```cpp
#include <hip/hip_runtime.h>
#include <cstdio>
#include <cstdint>

#define GAS __attribute__((address_space(1)))
#define LAS __attribute__((address_space(3)))
typedef unsigned short bf16;
typedef short bf16x8 __attribute__((ext_vector_type(8)));
typedef _Float16 f16x8 __attribute__((ext_vector_type(8)));
typedef float f32x4 __attribute__((ext_vector_type(4)));
typedef float f32x2 __attribute__((ext_vector_type(2)));
typedef unsigned u32x4 __attribute__((ext_vector_type(4)));
typedef unsigned u32x2 __attribute__((ext_vector_type(2)));

#ifndef MK_N_LAUNCHES
#define MK_N_LAUNCHES 1
#endif
constexpr int N_PHASES = 9;
#ifndef REPEAT_MASK
#define REPEAT_MASK 0
#endif

constexpr int D = 1024, NBATCH = 8, SEQ = 4096, NMETA = 16, TT = SEQ + NMETA, M = NBATCH * SEQ;
constexpr int LW = 512, INW = 1536, NE = 32, EFF = 512, NROUTE = 36;
constexpr int ECAP = 32768;
constexpr int MAXT = 288;
constexpr int MAXU = 6;
constexpr float RMS_EPS = 1e-6f;

constexpr size_t MiB = 1u << 20;
constexpr size_t WS_CTL = 0, CTL_ZERO_BYTES = 1 * MiB;
constexpr size_t WS_WIN = 2 * MiB, WS_WOUT = 5 * MiB, WS_WA = 7 * MiB, WS_WX = 7 * MiB + 65536, WS_PW = 7 * MiB + 131072, WS_WR = 7 * MiB + 262144;
constexpr size_t WS_AGG = 8 * MiB;
constexpr size_t WS_HM = 9 * MiB;
constexpr size_t WS_WGU = 10 * MiB  , WS_WD = 42 * MiB  , WS_RINFO = 58 * MiB, WS_HN1 = 74 * MiB  ;
constexpr size_t WS_PROJ = 138 * MiB  , WS_HID = 235 * MiB  , WS_C = 272 * MiB  , WS_H1 = 400 * MiB  , WS_END = 464 * MiB;
constexpr size_t WS_AB = WS_C;
constexpr float WGU_SCALE = 64.f, WD_SCALE = 32.f, HID_SCALE = 8.f, C_SCALE = 32.f;
constexpr int CW_BAR = 4096, CW_CNT = 16384;

constexpr int LDS_BYTES = 147456;
constexpr int MISC_OFF = LDS_BYTES - 256;
constexpr int TAB_OFF = 131072 + 512;
constexpr int TAB_ROW = TAB_OFF;
constexpr int TAB_F = TAB_ROW + MAXU * 256 * 4;
constexpr int TAB_TE = TAB_F + MAXU * 256 * 4;
constexpr int TAB_TR = TAB_TE + MAXT * 4;
constexpr int TAB_CNT = TAB_TR + MAXT * 4;
static_assert(TAB_CNT + 80 * 4 <= MISC_OFF, "LDS map");

__device__ __forceinline__ unsigned f2bf(float f) { unsigned u = __builtin_bit_cast(unsigned, f); return (u + 0x7fffu + ((u >> 16) & 1u)) >> 16; }
typedef __bf16 bf16x2_t __attribute__((ext_vector_type(2)));
__device__ __forceinline__ unsigned pk2(float lo, float hi) { return __builtin_bit_cast(unsigned, __builtin_convertvector((f32x2){lo, hi}, bf16x2_t)); }
__device__ __forceinline__ float bf2f(unsigned h) { return __builtin_bit_cast(float, h << 16); }
__device__ __forceinline__ float bflo(unsigned w) { return __builtin_bit_cast(float, w << 16); }
__device__ __forceinline__ float bfhi(unsigned w) { return __builtin_bit_cast(float, w & 0xffff0000u); }
__device__ __forceinline__ float sigmoidf_(float x) { return __builtin_amdgcn_rcpf(1.0f + __expf(-x)); }
#define LDS_WAIT() asm volatile("s_waitcnt lgkmcnt(0)" ::: "memory")
typedef _Float16 f16x2 __attribute__((ext_vector_type(2)));
__device__ __forceinline__ unsigned pkh2(float lo, float hi) { return __builtin_bit_cast(unsigned, __builtin_convertvector((f32x2){lo, hi}, f16x2)); }
__device__ __forceinline__ float h2lo(unsigned w) { return (float)__builtin_bit_cast(f16x2, w).x; }
__device__ __forceinline__ float h2hi(unsigned w) { return (float)__builtin_bit_cast(f16x2, w).y; }
typedef int i32x4 __attribute__((ext_vector_type(4)));
typedef int i32x8 __attribute__((ext_vector_type(8)));
__device__ __forceinline__ float clamp448(float v) { return fminf(fmaxf(v, -448.f), 448.f); }
__device__ __forceinline__ unsigned pk4_fp8(float a, float b, float c, float d) {
    int v = __builtin_amdgcn_cvt_pk_fp8_f32(a, b, 0, false); v = __builtin_amdgcn_cvt_pk_fp8_f32(c, d, v, true); return (unsigned)v; }

#define XB_TMO      128
#define XB_XCNT(j)  (256  + 64 * (j))
#define XB_XSUB(j)  (1280 + 64 * (j))
#define XB_XGEN(j)  (2304 + 64 * (j))
#define XB_TOP      3328
#define XB_TOPGEN   3392
#define XCD_BAR_WORDS 3456
#define XB_SPIN_CAP (1u << 18)
__device__ __forceinline__ unsigned xb_ld(unsigned* p)              { return __hip_atomic_load(p, __ATOMIC_RELAXED, __HIP_MEMORY_SCOPE_AGENT); }
__device__ __forceinline__ unsigned xb_add(unsigned* p, unsigned v) { return __hip_atomic_fetch_add(p, v, __ATOMIC_RELAXED, __HIP_MEMORY_SCOPE_AGENT); }
__device__ __forceinline__ unsigned xb_xcc_id() { return (unsigned)__builtin_amdgcn_s_getreg((3 << 11) | 20) & 0xFu; }
#define XB_SPIN(cond, bar) do { unsigned _sp = 0; while (cond) { __builtin_amdgcn_s_sleep(1); \
    if ((++_sp & 255u) == 0u) { if (xb_ld(&(bar)[XB_TMO])) break; if (_sp > XB_SPIN_CAP) { atomicAdd(&(bar)[XB_TMO], 1u); break; } } } } while (0)
struct XcdBarrier { unsigned* bar; unsigned x; volatile LAS unsigned* st; };
__device__ __forceinline__ XcdBarrier xcd_barrier_post(unsigned* bar, volatile LAS unsigned* st) {
    XcdBarrier b; b.bar = bar; b.x = xb_xcc_id(); b.st = st;
    if (threadIdx.x == 0) (void)xb_add(&bar[XB_XCNT(b.x)], 1u);
    return b;
}
__device__ __forceinline__ void xcd_barrier_complete(unsigned* bar, unsigned x, unsigned& nloc, unsigned& nx) {
    const unsigned G = gridDim.x * gridDim.y * gridDim.z;
    unsigned sum, cnt, mine, sp = 0u;
    for (;;) {
        sum = 0u; cnt = 0u; mine = 0u;
#pragma unroll
        for (unsigned j = 0; j < 16; ++j) { const unsigned c = xb_ld(&bar[XB_XCNT(j)]); sum += c; cnt += (c > 0u) ? 1u : 0u; mine = (j == x) ? c : mine; }
        if (sum == G) break;
        __builtin_amdgcn_s_sleep(1);
        if ((++sp & 255u) == 0u) { if (xb_ld(&bar[XB_TMO])) break; if (sp > XB_SPIN_CAP) { atomicAdd(&bar[XB_TMO], 1u); break; } }
    }
    nloc = mine > 0u ? mine : 1u; nx = cnt > 0u ? cnt : 1u;
}
__device__ __forceinline__ void xcd_barrier(const XcdBarrier& b) {
    asm volatile("s_waitcnt vmcnt(0)" ::: "memory");
    __syncthreads();
    if (threadIdx.x == 0) {
        unsigned* bar = b.bar;
        __builtin_amdgcn_s_waitcnt(0);
        unsigned nloc = b.st[0], nx = b.st[1];
        if (nloc == 0u) { xcd_barrier_complete(bar, b.x, nloc, nx); b.st[0] = nloc; b.st[1] = nx; }
        const unsigned old = xb_add(&bar[XB_XSUB(b.x)], 1u);
        const unsigned gen = old / nloc;
        if (old + 1u == (gen + 1u) * nloc) {
            __builtin_amdgcn_fence(__ATOMIC_RELEASE, "agent");
            asm volatile("s_waitcnt vmcnt(0)" ::: "memory");
            const unsigned og = xb_add(&bar[XB_TOP], 1u);
            const unsigned tg = og / nx;
            if (og + 1u == (tg + 1u) * nx) xb_add(&bar[XB_TOPGEN], 1u);
            else XB_SPIN(xb_ld(&bar[XB_TOPGEN]) == tg, bar);
            __builtin_amdgcn_fence(__ATOMIC_ACQUIRE, "agent");
            xb_add(&bar[XB_XGEN(b.x)], 1u);
            asm volatile("s_waitcnt vmcnt(0)" ::: "memory");
        } else {
            XB_SPIN(xb_ld(&bar[XB_XGEN(b.x)]) == gen, bar);
            __builtin_amdgcn_fence(__ATOMIC_ACQUIRE, "agent");
            asm volatile("s_waitcnt vmcnt(0)" ::: "memory");
        }
    }
    __syncthreads();
}

namespace pg8 {
constexpr int BM = 256, BK = 64, HALF = 128, HTB = HALF * BK * 2, STAGE_BYTES = 8 * HTB, NXCD = 8, WGM = 8;
__host__ __device__ __forceinline__ int lds_byte(int r, int c) { const int st = (r >> 4) * 2 + (c >> 5), rr = r & 15, cc = c & 31, ob = rr * 64 + cc * 2; return st * 1024 + (ob ^ (((ob >> 9) & 1) << 5)); }
__host__ __device__ __forceinline__ void stage_rc(int b, int& R, int& C) { const int st = b / 1024, sb = b % 1024, swz = sb ^ (((sb >> 9) & 1) << 5); R = (st >> 1) * 16 + swz / 64; C = (st & 1) * 32 + (swz % 64) / 2; }
__host__ __device__ __forceinline__ int perm32(int rho) { const int n = rho >> 4, i = rho & 15; return 8 * (i >> 2) + 4 * n + (i & 3); }
struct Unit { int pm, pn; };
__device__ __forceinline__ bool static_next(int nM, int nN, int G, int c, int i, Unit& u) {
    const int nwg = nM * nN; const long L = (long)i * G + c; if (L >= nwg) return false;
    int wgid = (int)L; { const int q = nwg / NXCD, r = nwg % NXCD, xcd = wgid % NXCD, off = wgid / NXCD; wgid = (xcd < r ? xcd * (q + 1) : r * (q + 1) + (xcd - r) * q) + off; }
    const int nig = WGM * nN, gid = wgid / nig, fm = gid * WGM, gsz = (nM - fm) < WGM ? (nM - fm) : WGM;
    u.pm = fm + ((wgid % nig) % gsz); u.pn = (wgid % nig) / gsz; return true;
}
__device__ __forceinline__ unsigned cvt_pk_bf16(float lo, float hi) { return pk2(lo, hi); }

template <class Epi, class Sched, bool FP8 = false>
__device__ __forceinline__ void gemm_phase(LAS unsigned char* lds, const int KB, const char* Abase, const Sched& S, const Epi& E) {
    const int tid = threadIdx.x, wid = __builtin_amdgcn_readfirstlane(tid >> 6), lane = tid & 63, wr = wid >> 2, wc = wid & 3, fr = lane & 15, fq = lane >> 4;
    const int nt = KB / (BK * 2);
    int Rl[2]; unsigned Cb[2], voffB[2];
#pragma unroll
    for (int i = 0; i < 2; ++i) { int R, C; stage_rc(tid * 16 + i * 8192, R, C); const int Rb = Epi::PERM ? ((R & ~31) + perm32(R & 31)) : R;
        Rl[i] = R; Cb[i] = (unsigned)C * 2u; voffB[i] = (unsigned)(Rb * KB + C * 2); }
    const size_t kstep = (size_t)(BK * 2);
    const size_t hstepB = (size_t)HALF * KB;
    const unsigned ldsw = (unsigned)wid * 1024u;
    const int aoff = lds_byte(wr * 64 + fr, fq * 8), boff = lds_byte(wc * 32 + fr, fq * 8);
#define PG8_SA(b, h) (((b) * 2 + (h)) * HTB)
#define PG8_SB(b, h) ((4 + (b) * 2 + (h)) * HTB)
#define PG8_STAGE(bufoff, gbase, voff) do { _Pragma("unroll") for (int _i = 0; _i < 2; ++_i) \
        __builtin_amdgcn_global_load_lds((const unsigned*)((const char*)(gbase) + (voff)[_i]), (LAS unsigned*)(lds + (bufoff) + ldsw + _i * 8192), 16, 0, 0); } while (0)
#define PG8_LD32(p) __builtin_shufflevector(*(const LAS i32x4*)(p), *(const LAS i32x4*)((p) + 1024), 0, 1, 2, 3, 4, 5, 6, 7)
#define PG8_LDA(dst, b, h) do { _Pragma("unroll") for (int m = 0; m < 4; ++m) dst[m] = PG8_LD32(lds + PG8_SA(b, h) + aoff + m * 2048); } while (0)
#define PG8_LDB(dst, b, h) do { _Pragma("unroll") for (int n = 0; n < 2; ++n) dst[n] = PG8_LD32(lds + PG8_SB(b, h) + boff + n * 2048); } while (0)
#define PG8_LO(v) __builtin_bit_cast(bf16x8, __builtin_shufflevector((v), (v), 0, 1, 2, 3))
#define PG8_HI(v) __builtin_bit_cast(bf16x8, __builtin_shufflevector((v), (v), 4, 5, 6, 7))
#define PG8_MMA(ai, bj, At, Bt) do { __builtin_amdgcn_s_setprio(1); _Pragma("unroll") for (int m = 0; m < 4; ++m) _Pragma("unroll") for (int n = 0; n < 2; ++n) { \
        if constexpr (FP8) asm volatile("v_mfma_f32_16x16x128_f8f6f4 %0, %1, %2, %0" : "+v"(acc[ai][bj][m][n]) : "v"(Bt[n]), "v"(At[m])); \
        else { acc[ai][bj][m][n] = __builtin_amdgcn_mfma_f32_16x16x32_bf16(PG8_LO(Bt[n]), PG8_LO(At[m]), acc[ai][bj][m][n], 0, 0, 0); \
               acc[ai][bj][m][n] = __builtin_amdgcn_mfma_f32_16x16x32_bf16(PG8_HI(Bt[n]), PG8_HI(At[m]), acc[ai][bj][m][n], 0, 0, 0); } } \
        __builtin_amdgcn_s_setprio(0); } while (0)
#define PG8_WAIT_V(n) asm volatile("s_waitcnt vmcnt(" #n ")" ::: "memory")
#define PG8_WAIT_L(n) asm volatile("s_waitcnt lgkmcnt(" #n ")" ::: "memory")
#define PG8_BAR __builtin_amdgcn_s_barrier()
#define PG8_SCHED __builtin_amdgcn_sched_barrier(0)
    Unit cur, nxt; int ui = 0;
    if (!S.next(0, cur)) return;
    f32x4 acc[2][2][4][2];
#pragma unroll
    for (int a = 0; a < 2; ++a)
#pragma unroll
        for (int b = 0; b < 2; ++b)
#pragma unroll
            for (int m = 0; m < 4; ++m)
#pragma unroll
                for (int n = 0; n < 2; ++n) acc[a][b][m][n] = (f32x4){0.f, 0.f, 0.f, 0.f};
    i32x8 At[4], B0[2], B1[2];
    unsigned cO0[2], cO1[2], nO0[2], nO1[2];
#pragma unroll
    for (int i = 0; i < 2; ++i) { cO0[i] = S.a_off(0, cur, Rl[i]) + Cb[i]; cO1[i] = S.a_off(0, cur, HALF + Rl[i]) + Cb[i]; }
    const char* cB = S.b_base(cur);
    PG8_STAGE(PG8_SB(0, 0), cB, voffB); PG8_STAGE(PG8_SB(0, 1), cB + hstepB, voffB); PG8_STAGE(PG8_SA(0, 0), Abase, cO0); PG8_STAGE(PG8_SA(0, 1), Abase, cO1);
    if (wr == 1) PG8_BAR;
    PG8_WAIT_V(2); PG8_BAR;
    PG8_STAGE(PG8_SB(1, 0), cB + kstep, voffB); PG8_STAGE(PG8_SA(1, 0), Abase + kstep, cO0); PG8_STAGE(PG8_SB(1, 1), cB + hstepB + kstep, voffB);
    PG8_WAIT_V(6); PG8_BAR;
    for (;;) {
        const bool has_next = S.next(ui + 1, nxt);
        const char* nB = cB;
#pragma unroll
        for (int i = 0; i < 2; ++i) { nO0[i] = cO0[i]; nO1[i] = cO1[i]; }
        if (has_next) { nB = S.b_base(nxt);
#pragma unroll
            for (int i = 0; i < 2; ++i) { nO0[i] = S.a_off(ui + 1, nxt, Rl[i]) + Cb[i]; nO1[i] = S.a_off(ui + 1, nxt, HALF + Rl[i]) + Cb[i]; } }
#pragma nounroll
        for (int t = 0; t < nt; t += 2) {
            const bool last = (t == nt - 2);
            const char* a1 = Abase + (size_t)(t + 1) * kstep;
            const char* a2 = last ? Abase : Abase + (size_t)(t + 2) * kstep; const char* b2 = last ? nB : cB + (size_t)(t + 2) * kstep;
            const char* a3 = a2 + kstep; const char* b3 = b2 + kstep;
            unsigned o0[2], o1[2];
#pragma unroll
            for (int i = 0; i < 2; ++i) { o0[i] = last ? nO0[i] : cO0[i]; o1[i] = last ? nO1[i] : cO1[i]; }
            PG8_LDB(B0, 0, 0); PG8_LDB(B1, 0, 1); PG8_SCHED; PG8_LDA(At, 0, 0); PG8_STAGE(PG8_SA(1, 1), a1, cO1);
            PG8_WAIT_V(8); PG8_WAIT_L(0); PG8_BAR; PG8_MMA(0, 0, At, B0); PG8_MMA(0, 1, At, B1); PG8_BAR; PG8_SCHED;
            PG8_LDA(At, 0, 1); PG8_STAGE(PG8_SB(0, 0), b2, voffB); PG8_STAGE(PG8_SB(0, 1), b2 + hstepB, voffB); PG8_STAGE(PG8_SA(0, 0), a2, o0);
            PG8_WAIT_V(8); PG8_WAIT_L(0); PG8_BAR; PG8_MMA(1, 0, At, B0); PG8_MMA(1, 1, At, B1); PG8_BAR; PG8_SCHED;
            PG8_LDB(B0, 1, 0); PG8_LDB(B1, 1, 1); PG8_SCHED; PG8_LDA(At, 1, 0); PG8_STAGE(PG8_SA(0, 1), a2, o1);
            PG8_WAIT_V(8); PG8_WAIT_L(0); PG8_BAR; PG8_MMA(0, 0, At, B0); PG8_MMA(0, 1, At, B1); PG8_BAR; PG8_SCHED;
            PG8_LDA(At, 1, 1); PG8_STAGE(PG8_SB(1, 0), b3, voffB); PG8_STAGE(PG8_SB(1, 1), b3 + hstepB, voffB); PG8_STAGE(PG8_SA(1, 0), a3, o0);
            PG8_WAIT_V(8); PG8_WAIT_L(0); PG8_BAR; PG8_MMA(1, 0, At, B0); PG8_MMA(1, 1, At, B1); PG8_BAR; PG8_SCHED;
        }
        if (wr == 0) PG8_BAR;
        if constexpr (FP8) asm volatile("s_nop 15\n\ts_nop 15" ::: "memory");
        E(acc, cur, ui, wr, wc, fr, fq);
        if (!has_next) break;
#pragma unroll
        for (int a = 0; a < 2; ++a)
#pragma unroll
            for (int b = 0; b < 2; ++b)
#pragma unroll
                for (int m = 0; m < 4; ++m)
#pragma unroll
                    for (int n = 0; n < 2; ++n) acc[a][b][m][n] = (f32x4){0.f, 0.f, 0.f, 0.f};
        cur = nxt; cB = nB; ++ui;
#pragma unroll
        for (int i = 0; i < 2; ++i) { cO0[i] = nO0[i]; cO1[i] = nO1[i]; }
        if (wr == 1) PG8_BAR;
    }
    PG8_WAIT_V(0);
    PG8_BAR;
#undef PG8_SA
#undef PG8_SB
#undef PG8_STAGE
#undef PG8_LDA
#undef PG8_LDB
#undef PG8_MMA
#undef PG8_LO
#undef PG8_HI
#undef PG8_LD32
#undef PG8_WAIT_V
#undef PG8_WAIT_L
#undef PG8_BAR
#undef PG8_SCHED
}

struct DenseSched {
    int nM, nN, G, c, K2; const char* B; int reps;
    __device__ __forceinline__ bool next(int i, Unit& u) const { const int rounds = (nM * nN + G - 1) / G; if (i >= rounds * reps) return false; return static_next(nM, nN, G, c, i % rounds, u); }
    __device__ __forceinline__ const char* b_base(const Unit& u) const { return B + (size_t)u.pn * BM * K2; }
    __device__ __forceinline__ unsigned a_off(int, const Unit& u, int r) const { return (unsigned)(u.pm * BM + r) * (unsigned)K2; }
};
struct MoeSched {
    int NT, nN, G, c, K2; const char* B; size_t estride; bool gather;
    const LAS int* tile_e; const LAS unsigned* rowtab; int reps;
    __device__ __forceinline__ int rounds() const { return (NT * nN + G - 1) / G; }
    __device__ __forceinline__ bool next(int i, Unit& u) const { const int r = rounds(); if (i >= r * reps) return false; return static_next(NT, nN, G, c, i % r, u); }
    __device__ __forceinline__ const char* b_base(const Unit& u) const { return B + (size_t)tile_e[u.pm] * estride + (size_t)u.pn * BM * K2; }
    __device__ __forceinline__ unsigned a_off(int ui, const Unit& u, int r) const { return gather ? rowtab[(ui % rounds()) * 256 + r] : (unsigned)(u.pm * BM + r) * (unsigned)K2; }
};

struct EpiProj {
    static constexpr bool PERM = true;
    bf16* O;
    __device__ __forceinline__ void operator()(const f32x4 (&acc)[2][2][4][2], const Unit& u, int, int wr, int wc, int fr, int fq) const {
        const int row0 = u.pm * BM + 16 * ((u.pm >> 4) + 1) + wr * 64 + fr, col0 = u.pn * BM + wc * 32 + 8 * fq;
#pragma unroll
        for (int ai = 0; ai < 2; ++ai)
#pragma unroll
            for (int m = 0; m < 4; ++m) { bf16* rowp = O + (size_t)(row0 + ai * HALF + m * 16) * INW + col0;
#pragma unroll
                for (int bj = 0; bj < 2; ++bj) { const f32x4 v0 = acc[ai][bj][m][0], v1 = acc[ai][bj][m][1];
                    u32x4 w; w.x = cvt_pk_bf16(v0[0], v0[1]); w.y = cvt_pk_bf16(v0[2], v0[3]); w.z = cvt_pk_bf16(v1[0], v1[1]); w.w = cvt_pk_bf16(v1[2], v1[3]);
                    *(u32x4*)(rowp + bj * HALF) = w; } }
    }
};
struct EpiResid {
    static constexpr bool PERM = true;
    const float* X; const float* G2; bf16* H1; unsigned char* HN2;
    __device__ __forceinline__ void operator()(const f32x4 (&acc)[2][2][4][2], const Unit& u, int, int wr, int wc, int fr, int fq) const {
        const int row0 = u.pm * BM + wr * 64 + fr, col0 = u.pn * BM + wc * 32 + 8 * fq;
        f32x4 gv[2][2];
#pragma unroll
        for (int bj = 0; bj < 2; ++bj)
#pragma unroll
            for (int n = 0; n < 2; ++n) gv[bj][n] = *(const f32x4*)(G2 + col0 + bj * HALF + 4 * n);
#pragma unroll
        for (int ai = 0; ai < 2; ++ai) { f32x4 xv[4][2][2];
#pragma unroll
            for (int m = 0; m < 4; ++m) { const size_t off = (size_t)(row0 + ai * HALF + m * 16) * D + col0;
#pragma unroll
                for (int bj = 0; bj < 2; ++bj) { xv[m][bj][0] = *(const f32x4*)(X + off + bj * HALF); xv[m][bj][1] = *(const f32x4*)(X + off + bj * HALF + 4); } }
#pragma unroll
            for (int m = 0; m < 4; ++m) { const size_t off = (size_t)(row0 + ai * HALF + m * 16) * D + col0;
#pragma unroll
                for (int bj = 0; bj < 2; ++bj) { const f32x4 v0 = acc[ai][bj][m][0] + xv[m][bj][0], v1 = acc[ai][bj][m][1] + xv[m][bj][1];
                    u32x4 w; w.x = cvt_pk_bf16(v0[0], v0[1]); w.y = cvt_pk_bf16(v0[2], v0[3]); w.z = cvt_pk_bf16(v1[0], v1[1]); w.w = cvt_pk_bf16(v1[2], v1[3]);
                    *(u32x4*)(H1 + off + bj * HALF) = w;
                    const f32x4 t0 = v0 * gv[bj][0], t1 = v1 * gv[bj][1];
                    u32x2 e; e.x = pk4_fp8(clamp448(t0[0]), clamp448(t0[1]), clamp448(t0[2]), clamp448(t0[3])); e.y = pk4_fp8(clamp448(t1[0]), clamp448(t1[1]), clamp448(t1[2]), clamp448(t1[3]));
                    *(u32x2*)(HN2 + off + bj * HALF) = e; } }
            asm volatile("" ::: "memory"); }
    }
};
struct EpiGateUp {
    static constexpr bool PERM = true;
    unsigned char* H; const LAS float* rstd; int rounds;
    __device__ __forceinline__ void operator()(const f32x4 (&acc)[2][2][4][2], const Unit& u, int ui_, int wr, int wc, int fr, int fq) const {
        const int ui = ui_ % rounds;
        const int r0 = wr * 64 + fr, col0 = u.pn * HALF + wc * 32 + 8 * fq;
#pragma unroll
        for (int ai = 0; ai < 2; ++ai)
#pragma unroll
            for (int m = 0; m < 4; ++m) { const int r = r0 + ai * HALF + m * 16; const float rs = rstd[ui * 256 + r];
                float h[8];
#pragma unroll
                for (int n = 0; n < 2; ++n)
#pragma unroll
                    for (int j = 0; j < 4; ++j) { const float g = acc[ai][0][m][n][j] * rs, up = acc[ai][1][m][n][j] * rs; h[n * 4 + j] = g * sigmoidf_(g) * up; }
#pragma unroll
                for (int j = 0; j < 8; ++j) h[j] = clamp448(h[j] * HID_SCALE);
                u32x2 w; w.x = pk4_fp8(h[0], h[1], h[2], h[3]); w.y = pk4_fp8(h[4], h[5], h[6], h[7]);
                *(u32x2*)(H + (size_t)(u.pm * BM + r) * EFF + col0) = w; }
    }
};
struct EpiDown {
    static constexpr bool PERM = true;
    unsigned char* C; const LAS int* slot; const LAS float* gate; int rounds;
    __device__ __forceinline__ void operator()(const f32x4 (&acc)[2][2][4][2], const Unit& u, int ui_, int wr, int wc, int fr, int fq) const {
        const int ui = ui_ % rounds;
        const int r0 = wr * 64 + fr, col0 = u.pn * BM + wc * 32 + 8 * fq;
#pragma unroll
        for (int ai = 0; ai < 2; ++ai)
#pragma unroll
            for (int m = 0; m < 4; ++m) { const int r = r0 + ai * HALF + m * 16; const int sl = slot[ui * 256 + r]; const float gt = gate[ui * 256 + r];
                if (sl >= 0) { unsigned char* rowp = C + (size_t)sl * D + col0;
#pragma unroll
                    for (int bj = 0; bj < 2; ++bj) { const f32x4 v0 = acc[ai][bj][m][0] * gt, v1 = acc[ai][bj][m][1] * gt;
                        u32x2 w; w.x = pk4_fp8(clamp448(v0[0]), clamp448(v0[1]), clamp448(v0[2]), clamp448(v0[3])); w.y = pk4_fp8(clamp448(v1[0]), clamp448(v1[1]), clamp448(v1[2]), clamp448(v1[3]));
                        *(u32x2*)(rowp + bj * HALF) = w; } } }
    }
};
}

struct Frame {
    LAS unsigned char* lds; int tid, lane, wave, G, bx;
    const float *x, *meta, *g1, *w_in, *conv_w, *conv_b, *wa, *ba, *wx, *bx_, *lam, *lru_gain, *pool_w, *pool_scale, *w_out, *g2, *w_group, *b_group, *w_router, *b_router, *w_gate, *w_up, *w_down, *final_gain;
    float* out; unsigned char* ws; unsigned* ctl;
    bf16 *WinT, *WoutT, *WaT, *WxT, *PwT, *HN1, *YMIX, *PROJ, *H1; unsigned char *WguT, *WdT, *HN2, *HID, *C;
    _Float16* WrH; float* AGG; float* HM; u32x4* AB; f32x4* RINFO;
};
__device__ __forceinline__ float wave_sum(float v) {
#pragma unroll
    for (int o = 1; o < 64; o <<= 1) v += __shfl_xor(v, o);
    return v;
}

__device__ __forceinline__ void transpose_tile(const float* W, int ldw, int k0, int n0, bf16* WT, int ldt, int drow0, LAS float* scr, int lane) {
    { float v[32];
#pragma unroll
      for (int i = 0; i < 32; ++i) v[i] = W[(size_t)(k0 + 2 * i + (lane >> 5)) * ldw + n0 + (lane & 31)];
#pragma unroll
      for (int i = 0; i < 32; ++i) scr[(2 * i + (lane >> 5)) * 33 + (lane & 31)] = v[i]; }
    LDS_WAIT(); asm volatile("" ::: "memory");
    const int c = lane & 7;
#pragma unroll
    for (int j = 0; j < 4; ++j) { const int n = (lane >> 3) + 8 * j; const LAS float* s = scr + (8 * c) * 33 + n;
        u32x4 o; o.x = pk2(s[0 * 33], s[1 * 33]); o.y = pk2(s[2 * 33], s[3 * 33]); o.z = pk2(s[4 * 33], s[5 * 33]); o.w = pk2(s[6 * 33], s[7 * 33]);
        *(u32x4*)(WT + (size_t)(drow0 + n) * ldt + k0 + 8 * c) = o; }
    LDS_WAIT(); asm volatile("" ::: "memory");
}
__device__ __forceinline__ void transpose_tile_fp8(const float* W, int ldw, int k0, int n0, unsigned char* WT, int ldt, int drow0, float scale, LAS float* scr, int lane) {
    { float v[64];
#pragma unroll
      for (int i = 0; i < 64; ++i) v[i] = W[(size_t)(k0 + 2 * i + (lane >> 5)) * ldw + n0 + (lane & 31)];
#pragma unroll
      for (int i = 0; i < 64; ++i) scr[(2 * i + (lane >> 5)) * 33 + (lane & 31)] = v[i]; }
    LDS_WAIT(); asm volatile("" ::: "memory");
    const int n = lane >> 1, kh = (lane & 1) * 64; const LAS float* sp = scr + kh * 33 + n;
#pragma unroll
    for (int c = 0; c < 4; ++c) { u32x4 o;
#pragma unroll
        for (int w = 0; w < 4; ++w) { const LAS float* q4 = sp + (16 * c + 4 * w) * 33; o[w] = pk4_fp8(q4[0] * scale, q4[33] * scale, q4[66] * scale, q4[99] * scale); }
        *(u32x4*)(WT + (size_t)(drow0 + n) * ldt + k0 + kh + 16 * c) = o; }
    LDS_WAIT(); asm volatile("" ::: "memory");
}
constexpr int XT_G = NE * 8 * 16, XT_D = NE * 4 * 32, XT_N = 2 * XT_G + XT_D;
struct XTile { const float* src; unsigned char* dst; unsigned lsrc, ldst; int ldw; float scale; };
__device__ __forceinline__ XTile xtile_decode(const Frame& F, int r, int lane) {
    XTile t; const int n = lane & 31, kh = 64 * (lane >> 5);
    if (r < 2 * XT_G) { const int up = r >= XT_G; if (up) r -= XT_G; const int e = r >> 7, kb = (r >> 4) & 7, nb = r & 15, n0 = 32 * nb;
        t.src = (up ? F.w_up : F.w_gate) + (size_t)e * D * EFF + (size_t)(128 * kb) * EFF + n0; t.ldw = EFF; t.lsrc = (unsigned)(kh * EFF + n);
        t.dst = F.WguT + (size_t)e * 1024 * D + (size_t)((n0 >> 7) * 256 + up * 128 + (n0 & 127)) * D + 128 * kb; t.ldst = (unsigned)(n * D + kh); t.scale = WGU_SCALE; }
    else { r -= 2 * XT_G; const int e = r >> 7, kb = (r >> 5) & 3, nb = r & 31;
        t.src = F.w_down + (size_t)e * EFF * D + (size_t)(128 * kb) * D + 32 * nb; t.ldw = D; t.lsrc = (unsigned)(kh * D + n);
        t.dst = F.WdT + (size_t)e * D * EFF + (size_t)(32 * nb) * EFF + 128 * kb; t.ldst = (unsigned)(n * EFF + kh); t.scale = WD_SCALE; }
    return t;
}
__device__ __forceinline__ void xtile_load(const XTile& t, float (&v)[64]) {
#pragma unroll
    for (int i = 0; i < 64; ++i) v[i] = (t.src + (size_t)i * t.ldw)[t.lsrc];
}
__device__ __forceinline__ void xtile_store(const XTile& t, const float (&v)[64]) {
#pragma unroll
    for (int c = 0; c < 4; ++c) { u32x4 o;
#pragma unroll
        for (int w = 0; w < 4; ++w) o[w] = pk4_fp8(v[16 * c + 4 * w] * t.scale, v[16 * c + 4 * w + 1] * t.scale, v[16 * c + 4 * w + 2] * t.scale, v[16 * c + 4 * w + 3] * t.scale);
        *(u32x4*)(t.dst + t.ldst + 16 * c) = o; }
}
__device__ __forceinline__ void p0_prologue(Frame& F) {
    if (F.bx < INW / 8) {
        LAS float* hnm = (LAS float*)F.lds;
        LAS float* part = (LAS float*)(F.lds + 65536);
        for (int r = F.wave * 2; r < F.wave * 2 + 2; ++r) {
            const f32x4* xr = (const f32x4*)(F.meta + (size_t)r * D) + F.lane; f32x4 v[4]; float s = 0.f;
#pragma unroll
            for (int j = 0; j < 4; ++j) { v[j] = xr[64 * j]; s += (v[j].x * v[j].x + v[j].y * v[j].y) + (v[j].z * v[j].z + v[j].w * v[j].w); }
            const float rstd = rsqrtf(wave_sum(s) * (1.f / D) + RMS_EPS);
#pragma unroll
            for (int j = 0; j < 4; ++j) { const f32x4 g = ((const f32x4*)F.g1)[F.lane + 64 * j]; *(LAS f32x4*)(hnm + r * D + 4 * F.lane + 256 * j) = v[j] * rstd * g; }
        }
        __syncthreads();
        { const int cc = F.tid & 7, ks = F.tid >> 3, col = F.bx * 8 + cc; float a[16];
#pragma unroll
            for (int r = 0; r < 16; ++r) a[r] = 0.f;
            for (int k = ks * 16; k < ks * 16 + 16; ++k) { const float w = F.w_in[(size_t)k * INW + col];
#pragma unroll
                for (int r = 0; r < 16; ++r) a[r] += hnm[r * D + k] * w; }
#pragma unroll
            for (int r = 0; r < 16; ++r) part[(ks * 16 + r) * 8 + cc] = a[r]; }
        __syncthreads();
        if (F.tid < 128) { const int r = F.tid >> 3, cc = F.tid & 7; float s = 0.f;
            for (int ks = 0; ks < 64; ++ks) s += part[(ks * 16 + r) * 8 + cc];
            const bf16 h = (bf16)f2bf(s);
            for (int b = 0; b < NBATCH; ++b) F.PROJ[(size_t)(b * TT + r) * INW + F.bx * 8 + cc] = h; }
        __syncthreads();
    }
    LAS float* scr = (LAS float*)(F.lds + F.wave * 16896);
    const int gw = F.bx * 8 + F.wave, NGW = F.G * 8;
    constexpr int I_IN = 16 * 48, I_OUT = 16 * 32, I_A = 8 * 2, I_P = 4 * 2 * 4;
    constexpr int NITEMS = I_IN + I_OUT + 2 * I_A + I_P;
    for (int it = gw; it < NITEMS; it += NGW) {
        int r = it;
        if (r < I_IN) { const int kb = r / 48, nb = r % 48; transpose_tile(F.w_in, INW, 64 * kb, 32 * nb, F.WinT, D, 32 * nb, scr, F.lane); continue; } r -= I_IN;
        if (r < I_OUT) { const int kb = r / 32, nb = r % 32; transpose_tile(F.w_out, D, 64 * kb, 32 * nb, F.WoutT, D, 32 * nb, scr, F.lane); continue; } r -= I_OUT;
        if (r < 2 * I_A) { const int x = r >= I_A; if (x) r -= I_A; const int h = r >> 1, nb = r & 1; transpose_tile((x ? F.wx : F.wa) + (size_t)h * 4096, 64, 0, 32 * nb, (x ? F.WxT : F.WaT) + (size_t)h * 4096, 64, 32 * nb, scr, F.lane); continue; } r -= 2 * I_A;
        { const int g = r >> 3, kb = (r >> 2) & 1, nb = r & 3; transpose_tile(F.pool_w + (size_t)g * 16384, 128, 64 * kb, 32 * nb, F.PwT + (size_t)g * 16384, 128, 32 * nb, scr, F.lane); }
    }
    for (int i = F.bx * 512 + F.tid; i < NROUTE * D; i += F.G * 512) { const int n = i >> 10, k = i & 1023;
        const float w = n < 4 ? F.w_group[k * 4 + n] : F.w_router[k * 32 + (n - 4)]; F.WrH[i] = (_Float16)(w * 256.0f); }
    { f32x4 g[4];
#pragma unroll
      for (int j = 0; j < 4; ++j) g[j] = ((const f32x4*)F.g1)[F.lane + 64 * j];
      for (int m = gw * 4; m < M; m += NGW * 4) {
        f32x4 v[4][4];
#pragma unroll
        for (int r = 0; r < 4; ++r)
#pragma unroll
            for (int j = 0; j < 4; ++j) v[r][j] = ((const f32x4*)(F.x + (size_t)(m + r) * D))[F.lane + 64 * j];
#pragma unroll
        for (int r = 0; r < 4; ++r) { float s = 0.f;
#pragma unroll
            for (int j = 0; j < 4; ++j) s += (v[r][j].x * v[r][j].x + v[r][j].y * v[r][j].y) + (v[r][j].z * v[r][j].z + v[r][j].w * v[r][j].w);
            const float rstd = rsqrtf(wave_sum(s) * (1.f / D) + RMS_EPS);
            u32x2* o8 = (u32x2*)(F.HN1 + (size_t)(m + r) * D) + F.lane;
#pragma unroll
            for (int j = 0; j < 4; ++j) { const f32x4 y = v[r][j] * rstd * g[j]; u32x2 w; w.x = pk2(y.x, y.y); w.y = pk2(y.z, y.w); o8[64 * j] = w; } }
      } }
}

template <int CTRL> __device__ __forceinline__ float dpp_f(float old, float src) {
    return __builtin_bit_cast(float, __builtin_amdgcn_update_dpp(__builtin_bit_cast(int, old), __builtin_bit_cast(int, src), CTRL, 0xf, 0xf, false)); }
#define DPP_BCAST15 0x15F
__device__ __forceinline__ void row_scan(float& A, float& B) {
    { const float Ap = dpp_f<0x111>(1.0f, A), Bp = dpp_f<0x111>(0.0f, B); B = A * Bp + B; A = A * Ap; }
    { const float Ap = dpp_f<0x112>(1.0f, A), Bp = dpp_f<0x112>(0.0f, B); B = A * Bp + B; A = A * Ap; }
    { const float Ap = dpp_f<0x114>(1.0f, A), Bp = dpp_f<0x114>(0.0f, B); B = A * Bp + B; A = A * Ap; }
    { const float Ap = dpp_f<0x118>(1.0f, A), Bp = dpp_f<0x118>(0.0f, B); B = A * Bp + B; A = A * Ap; }
}
#define SCAN8_STR(D) "s_nop 1\n\t" \
    "v_fmac_f32_dpp %0, %0, %8 row_shr:" #D " row_mask:0xf bank_mask:0xf\n\tv_mul_f32_dpp %8, %8, %8 row_shr:" #D " row_mask:0xf bank_mask:0xf\n\t" \
    "v_fmac_f32_dpp %1, %1, %9 row_shr:" #D " row_mask:0xf bank_mask:0xf\n\tv_mul_f32_dpp %9, %9, %9 row_shr:" #D " row_mask:0xf bank_mask:0xf\n\t" \
    "v_fmac_f32_dpp %2, %2, %10 row_shr:" #D " row_mask:0xf bank_mask:0xf\n\tv_mul_f32_dpp %10, %10, %10 row_shr:" #D " row_mask:0xf bank_mask:0xf\n\t" \
    "v_fmac_f32_dpp %3, %3, %11 row_shr:" #D " row_mask:0xf bank_mask:0xf\n\tv_mul_f32_dpp %11, %11, %11 row_shr:" #D " row_mask:0xf bank_mask:0xf\n\t" \
    "v_fmac_f32_dpp %4, %4, %12 row_shr:" #D " row_mask:0xf bank_mask:0xf\n\tv_mul_f32_dpp %12, %12, %12 row_shr:" #D " row_mask:0xf bank_mask:0xf\n\t" \
    "v_fmac_f32_dpp %5, %5, %13 row_shr:" #D " row_mask:0xf bank_mask:0xf\n\tv_mul_f32_dpp %13, %13, %13 row_shr:" #D " row_mask:0xf bank_mask:0xf\n\t" \
    "v_fmac_f32_dpp %6, %6, %14 row_shr:" #D " row_mask:0xf bank_mask:0xf\n\tv_mul_f32_dpp %14, %14, %14 row_shr:" #D " row_mask:0xf bank_mask:0xf\n\t" \
    "v_fmac_f32_dpp %7, %7, %15 row_shr:" #D " row_mask:0xf bank_mask:0xf\n\tv_mul_f32_dpp %15, %15, %15 row_shr:" #D " row_mask:0xf bank_mask:0xf"
#define SCAN8(D, A, B, o) asm volatile(SCAN8_STR(D) : "+v"(B[o + 0]), "+v"(B[o + 1]), "+v"(B[o + 2]), "+v"(B[o + 3]), "+v"(B[o + 4]), "+v"(B[o + 5]), "+v"(B[o + 6]), "+v"(B[o + 7]), \
    "+v"(A[o + 0]), "+v"(A[o + 1]), "+v"(A[o + 2]), "+v"(A[o + 3]), "+v"(A[o + 4]), "+v"(A[o + 5]), "+v"(A[o + 6]), "+v"(A[o + 7]))
__device__ __forceinline__ void row_scan16(float (&A)[16], float (&B)[16]) {
    SCAN8(1, A, B, 0); SCAN8(1, A, B, 8); SCAN8(2, A, B, 0); SCAN8(2, A, B, 8); SCAN8(4, A, B, 0); SCAN8(4, A, B, 8); SCAN8(8, A, B, 0); SCAN8(8, A, B, 8);
}
struct LruW { LAS float* cst; const bf16 *waP, *wxP; };
__device__ __forceinline__ void lru_setup(const Frame& F, LruW& L, LAS unsigned char* wbase) {
    const int hd = F.wave; L.cst = (LAS float*)wbase;
    for (int i = F.lane; i < 512; i += 64) { const int t = i >> 6, ch = hd * 64 + (i & 63); float v;
        if (t < 4) v = F.conv_w[t * LW + ch]; else if (t == 4) v = F.conv_b[ch]; else if (t == 5) v = F.ba[ch]; else if (t == 6) v = F.bx_[ch];
        else { const float lm = F.lam[ch]; v = 8.0f * (fminf(lm, 0.f) - log1pf(__expf(-fabsf(lm)))); }
        L.cst[i] = v; }
    const int i = F.lane & 15, qw = F.lane >> 4; const size_t o = (size_t)hd * 4096 + (size_t)(8 * (i >> 2) + (i & 3)) * 64 + 8 * qw;
    L.waP = F.WaT + o; L.wxP = F.WxT + o;
    LDS_WAIT();
}
struct LruRaw { u32x4 u[2][4]; u32x4 ug[2]; };
template <bool WITH_UG>
__device__ __forceinline__ void lru_load(const Frame& F, int b, int tt0, LruRaw& R) {
    const int hd = F.wave, row = F.lane & 15, q = F.lane >> 4, tt = tt0 + row;
    const bf16* prow = F.PROJ + (size_t)(b * TT + tt) * INW + hd * 64 + 8 * q;
#pragma unroll
    for (int kb = 0; kb < 2; ++kb) {
#pragma unroll
        for (int k = 0; k < 4; ++k) { R.u[kb][k] = (u32x4){0u, 0u, 0u, 0u}; if (tt - 3 + k >= 0) R.u[kb][k] = *(const u32x4*)(prow + (ptrdiff_t)(k - 3) * INW + 32 * kb); }
        if (WITH_UG) R.ug[kb] = *(const u32x4*)(prow + LW + 32 * kb);
    }
}
__device__ __forceinline__ void lru_conv(const Frame& F, const LruW& L, const LruRaw& R, float (&xc)[16], bf16x8 (&xf)[2]) {
    const int q = F.lane >> 4;
#pragma unroll
    for (int kb = 0; kb < 2; ++kb) {
        const LAS float* cs = L.cst + 32 * kb + 8 * q;
        f32x2 x2[4];
        { const f32x4 c0 = *(const LAS f32x4*)(cs + 256), c1 = *(const LAS f32x4*)(cs + 260); x2[0] = (f32x2){c0.x, c0.y}; x2[1] = (f32x2){c0.z, c0.w}; x2[2] = (f32x2){c1.x, c1.y}; x2[3] = (f32x2){c1.z, c1.w}; }
#pragma unroll
        for (int k = 0; k < 4; ++k) {
            const u32x4 u = R.u[kb][k];
            const f32x4 w0 = *(const LAS f32x4*)(cs + 64 * k), w1 = *(const LAS f32x4*)(cs + 64 * k + 4);
            x2[0] = (f32x2){w0.x, w0.y} * (f32x2){bflo(u.x), bfhi(u.x)} + x2[0]; x2[1] = (f32x2){w0.z, w0.w} * (f32x2){bflo(u.y), bfhi(u.y)} + x2[1];
            x2[2] = (f32x2){w1.x, w1.y} * (f32x2){bflo(u.z), bfhi(u.z)} + x2[2]; x2[3] = (f32x2){w1.z, w1.w} * (f32x2){bflo(u.w), bfhi(u.w)} + x2[3];
        }
#pragma unroll
        for (int i = 0; i < 4; ++i) { xc[8 * kb + 2 * i] = x2[i].x; xc[8 * kb + 2 * i + 1] = x2[i].y; }
        asm volatile("" : "+v"(xc[8 * kb + 0]), "+v"(xc[8 * kb + 1]), "+v"(xc[8 * kb + 2]), "+v"(xc[8 * kb + 3]), "+v"(xc[8 * kb + 4]), "+v"(xc[8 * kb + 5]), "+v"(xc[8 * kb + 6]), "+v"(xc[8 * kb + 7]));
        u32x4 p; p.x = pk2(xc[8 * kb + 0], xc[8 * kb + 1]); p.y = pk2(xc[8 * kb + 2], xc[8 * kb + 3]); p.z = pk2(xc[8 * kb + 4], xc[8 * kb + 5]); p.w = pk2(xc[8 * kb + 6], xc[8 * kb + 7]);
        xf[kb] = __builtin_bit_cast(bf16x8, p);
    }
}
template <bool WPF  >
__device__ __forceinline__ void lru_gates(const Frame& F, const LruW& L, const float (&xc)[16], const bf16x8 (&xf)[2], float (&Av)[16], float (&Bv)[16]) {
    const int q = F.lane >> 4;
    bf16x8 wa[2], wx[2];
#pragma unroll
    for (int kk = 0; kk < 2; ++kk) { wa[kk] = *(const bf16x8*)(L.waP + 32 * kk); wx[kk] = *(const bf16x8*)(L.wxP + 32 * kk); }
#pragma unroll
    for (int nb = 0; nb < 4; ++nb) {
        const int kb = nb >> 1, hf = nb & 1;
        bf16x8 wan[2], wxn[2];
        if (!WPF && nb > 0) { const int o = (32 * kb + 4 * hf) * 64;
#pragma unroll
            for (int kk = 0; kk < 2; ++kk) { wa[kk] = *(const bf16x8*)(L.waP + o + 32 * kk); wx[kk] = *(const bf16x8*)(L.wxP + o + 32 * kk); } }
        if (WPF && nb < 3) { const int o = (32 * ((nb + 1) >> 1) + 4 * ((nb + 1) & 1)) * 64;
#pragma unroll
            for (int kk = 0; kk < 2; ++kk) { wan[kk] = *(const bf16x8*)(L.waP + o + 32 * kk); wxn[kk] = *(const bf16x8*)(L.wxP + o + 32 * kk); } }
        asm volatile("" ::: "memory");
        f32x4 ra = (f32x4){0.f, 0.f, 0.f, 0.f}, rx = ra;
#pragma unroll
        for (int kk = 0; kk < 2; ++kk) { ra = __builtin_amdgcn_mfma_f32_16x16x32_bf16(wa[kk], xf[kk], ra, 0, 0, 0); rx = __builtin_amdgcn_mfma_f32_16x16x32_bf16(wx[kk], xf[kk], rx, 0, 0, 0); }
        const LAS float* cs = L.cst + 32 * kb + 8 * q + 4 * hf;
        const f32x4 ba4 = *(const LAS f32x4*)(cs + 320), bx4 = *(const LAS f32x4*)(cs + 384), lm4 = *(const LAS f32x4*)(cs + 448);
#pragma unroll
        for (int j = 0; j < 4; ++j) { const int c = 8 * kb + 4 * hf + j;
            const float r = sigmoidf_(ra[j] + ba4[j]), ig = sigmoidf_(rx[j] + bx4[j]);
            const float a = __expf(lm4[j] * r);
            Av[c] = a; Bv[c] = __builtin_amdgcn_sqrtf(fmaf(-a, a, 1.0f)) * (ig * xc[c]); }
        if (WPF && nb < 3) {
#pragma unroll
            for (int kk = 0; kk < 2; ++kk) { wa[kk] = wan[kk]; wx[kk] = wxn[kk]; } }
    }
    row_scan16(Av, Bv);
}
__device__ __forceinline__ void p2_aggregates(Frame& F) {
    LruW L; lru_setup(F, L, F.lds + F.wave * 2048);
    const int row = F.lane & 15, q = F.lane >> 4;
    int xt_done = 0;
    for (int ch = F.bx; ch < 256; ch += F.G) {
        const int b = ch >> 5, ci = ch & 31; float Ac[16], Bc[16];
#pragma unroll
        for (int c = 0; c < 16; ++c) { Ac[c] = 1.f; Bc[c] = 0.f; }
        const int blk0 = (ci == 0 ? -1 : 0);
        LruRaw R; lru_load<false>(F, b, NMETA + 128 * ci + 16 * blk0, R);
        for (int blk = blk0; blk < 8; ++blk) {
            const int xi = (F.bx * 8 + F.wave) + F.G * 8 * (xt_done + blk - blk0); const bool xt_has = xi < XT_N && (xt_done + blk - blk0) < (XT_N + F.G * 8 - 1) / (F.G * 8);
            XTile xt; float xv[64];
            if (xt_has) { xt = xtile_decode(F, xi, F.lane); xtile_load(xt, xv); }
            float xc[16]; bf16x8 xf[2]; lru_conv(F, L, R, xc, xf);
            if (blk < 7) lru_load<false>(F, b, NMETA + 128 * ci + 16 * (blk + 1), R);
            asm volatile("" ::: "memory");
            float Av[16], Bv[16];
            lru_gates<true>(F, L, xc, xf, Av, Bv);
            if (blk >= 0) { u32x4* ab = F.AB + ((size_t)((ch * 8 + blk) * 8 + F.wave) * 4) * 64 + F.lane;
#pragma unroll
                for (int j = 0; j < 2; ++j) { u32x4 a, bq;
                    a.x = pkh2(Av[8 * j], Av[8 * j + 1]); a.y = pkh2(Av[8 * j + 2], Av[8 * j + 3]); a.z = pkh2(Av[8 * j + 4], Av[8 * j + 5]); a.w = pkh2(Av[8 * j + 6], Av[8 * j + 7]);
                    bq.x = pkh2(Bv[8 * j], Bv[8 * j + 1]); bq.y = pkh2(Bv[8 * j + 2], Bv[8 * j + 3]); bq.z = pkh2(Bv[8 * j + 4], Bv[8 * j + 5]); bq.w = pkh2(Bv[8 * j + 6], Bv[8 * j + 7]);
                    ab[64 * j] = a; ab[64 * (2 + j)] = bq; } }
            else if (row == 15) {
#pragma unroll
                for (int kb = 0; kb < 2; ++kb) { float* o = F.HM + (size_t)b * LW + F.wave * 64 + 32 * kb + 8 * q;
                    *(f32x4*)o = (f32x4){Bv[8 * kb], Bv[8 * kb + 1], Bv[8 * kb + 2], Bv[8 * kb + 3]}; *(f32x4*)(o + 4) = (f32x4){Bv[8 * kb + 4], Bv[8 * kb + 5], Bv[8 * kb + 6], Bv[8 * kb + 7]}; } }
#pragma unroll
            for (int c = 0; c < 16; ++c) { Bc[c] = Av[c] * Bc[c] + Bv[c]; Ac[c] *= Av[c]; }
            if (xt_has) xtile_store(xt, xv);
        }
        xt_done += 8 - blk0;
        if (row == 15) {
#pragma unroll
            for (int kb = 0; kb < 2; ++kb) { float* o = F.AGG + ((size_t)ch * LW + F.wave * 64 + 32 * kb + 8 * q) * 2;
#pragma unroll
                for (int j = 0; j < 8; j += 2) *(f32x4*)(o + 2 * j) = (f32x4){Ac[8 * kb + j], Bc[8 * kb + j], Ac[8 * kb + j + 1], Bc[8 * kb + j + 1]}; }
        }
    }
    for (int xi = (F.bx * 8 + F.wave) + F.G * 8 * xt_done; xi < XT_N; xi += F.G * 8) { XTile xt = xtile_decode(F, xi, F.lane); float xv[64]; xtile_load(xt, xv); xtile_store(xt, xv); }
}

constexpr int YT_STRIDE = 520;
constexpr int US_STRIDE = 264;
constexpr int PW_STRIDE = 136;
template <int G> __device__ __forceinline__ void pool_z(const LAS bf16* ub  , bf16x8 (&zf)[4]) {
    constexpr int W = 2 << G;
    asm volatile("" : "+v"(ub));
#pragma unroll
    for (int kb = 0; kb < 4; ++kb) {
        const LAS bf16* p = ub + 15 * US_STRIDE + 32 * kb; const u32x4 c = *(const LAS u32x4*)p; float cur[8], s[8];
        cur[0] = bflo(c.x); cur[1] = bfhi(c.x); cur[2] = bflo(c.y); cur[3] = bfhi(c.y); cur[4] = bflo(c.z); cur[5] = bfhi(c.z); cur[6] = bflo(c.w); cur[7] = bfhi(c.w);
#pragma unroll
        for (int j = 0; j < 8; ++j) s[j] = cur[j];
#pragma unroll
        for (int d = 1; d < W; ++d) { const u32x4 u = *(const LAS u32x4*)(ub + (15 - d) * US_STRIDE + 32 * kb);
            s[0] += bflo(u.x); s[1] += bfhi(u.x); s[2] += bflo(u.y); s[3] += bfhi(u.y); s[4] += bflo(u.z); s[5] += bfhi(u.z); s[6] += bflo(u.w); s[7] += bfhi(u.w);
            if ((d & 3) == 3) asm volatile("" : "+v"(s[0]), "+v"(s[1]), "+v"(s[2]), "+v"(s[3]), "+v"(s[4]), "+v"(s[5]), "+v"(s[6]), "+v"(s[7]) :: "memory"); }
        asm volatile("" : "+v"(s[0]), "+v"(s[1]), "+v"(s[2]), "+v"(s[3]), "+v"(s[4]), "+v"(s[5]), "+v"(s[6]), "+v"(s[7]) :: "memory");
        u32x4 pz; pz.x = pk2(s[0] * (1.0f / W) - cur[0], s[1] * (1.0f / W) - cur[1]); pz.y = pk2(s[2] * (1.0f / W) - cur[2], s[3] * (1.0f / W) - cur[3]);
        pz.z = pk2(s[4] * (1.0f / W) - cur[4], s[5] * (1.0f / W) - cur[5]); pz.w = pk2(s[6] * (1.0f / W) - cur[6], s[7] * (1.0f / W) - cur[7]);
        asm volatile("" : "+v"(pz) :: "memory");
        zf[kb] = __builtin_bit_cast(bf16x8, pz);
    }
}
__device__ __forceinline__ void p3_mixer(Frame& F) {
    LAS float* SSQ = (LAS float*)F.lds;
    LAS float* RSTD = SSQ + 512;
    LAS bf16* US = (LAS bf16*)F.lds;
    const int row = F.lane & 15, q = F.lane >> 4;
    for (int ch = F.bx; ch < 256; ch += F.G) {
        const int b = ch >> 5, ci = ch & 31; const int m0 = ch * 128;
#ifndef P3_NO_LRU
        {
        float H[16];
        { float Ar[16], Br[16];
#pragma unroll
            for (int c = 0; c < 16; ++c) { Ar[c] = 1.f; Br[c] = 0.f; }
#pragma unroll
            for (int t = 0; t < 2; ++t) { const int k = 2 * row + t;
                if (k < ci) {
#pragma unroll
                    for (int kb = 0; kb < 2; ++kb) { const float* o = F.AGG + ((size_t)(b * 32 + k) * LW + F.wave * 64 + 32 * kb + 8 * q) * 2;
#pragma unroll
                        for (int j = 0; j < 8; j += 2) { const f32x4 v = *(const f32x4*)(o + 2 * j); const int c = 8 * kb + j;
                            Br[c] = v.x * Br[c] + v.y; Ar[c] *= v.x; Br[c + 1] = v.z * Br[c + 1] + v.w; Ar[c + 1] *= v.z; } } } }
            row_scan16(Ar, Br);
#pragma unroll
            for (int c = 0; c < 16; ++c) H[c] = dpp_f<DPP_BCAST15>(0.f, Br[c]); }
        if (ci == 0) {
#pragma unroll
            for (int kb = 0; kb < 2; ++kb) { const float* o = F.HM + (size_t)b * LW + F.wave * 64 + 32 * kb + 8 * q; const f32x4 h0 = *(const f32x4*)o, h1 = *(const f32x4*)(o + 4);
                H[8 * kb] = h0.x; H[8 * kb + 1] = h0.y; H[8 * kb + 2] = h0.z; H[8 * kb + 3] = h0.w; H[8 * kb + 4] = h1.x; H[8 * kb + 5] = h1.y; H[8 * kb + 6] = h1.z; H[8 * kb + 7] = h1.w; }
        }
        u32x4 abv[4]; u32x4 ug[2];
        { const u32x4* ab = F.AB + ((size_t)((ch * 8 + 0) * 8 + F.wave) * 4) * 64 + F.lane;
#pragma unroll
          for (int j = 0; j < 4; ++j) abv[j] = ab[64 * j];
          const bf16* prow = F.PROJ + (size_t)(b * TT + NMETA + 128 * ci + row) * INW + LW + F.wave * 64 + 8 * q; ug[0] = *(const u32x4*)prow; ug[1] = *(const u32x4*)(prow + 32); }
        for (int half = 0; half < 2; ++half) {
        u32x4 yp[4][2];
#pragma unroll
        for (int blk = 0; blk < 4; ++blk) { const int gb = 4 * half + blk;
                float Av[16], Bv[16]; u32x4 ugc[2] = {ug[0], ug[1]};
#pragma unroll
                for (int j = 0; j < 2; ++j)
#pragma unroll
                    for (int i = 0; i < 4; ++i) { Av[8 * j + 2 * i] = h2lo(abv[j][i]); Av[8 * j + 2 * i + 1] = h2hi(abv[j][i]); Bv[8 * j + 2 * i] = h2lo(abv[2 + j][i]); Bv[8 * j + 2 * i + 1] = h2hi(abv[2 + j][i]); }
                if (gb < 7) { const u32x4* ab = F.AB + ((size_t)((ch * 8 + gb + 1) * 8 + F.wave) * 4) * 64 + F.lane;
#pragma unroll
                    for (int j = 0; j < 4; ++j) abv[j] = ab[64 * j];
                    const bf16* prow = F.PROJ + (size_t)(b * TT + NMETA + 128 * ci + 16 * (gb + 1) + row) * INW + LW + F.wave * 64 + 8 * q; ug[0] = *(const u32x4*)prow; ug[1] = *(const u32x4*)(prow + 32); }
                asm volatile("" ::: "memory");
                float ss = 0.f;
#pragma unroll
                for (int kb = 0; kb < 2; ++kb) { float y[8];
#pragma unroll
                    for (int j = 0; j < 8; ++j) { const int c = 8 * kb + j;
                        const float h = Av[c] * H[c] + Bv[c];
                        const unsigned w = ugc[kb][j >> 1]; const float g = (j & 1) ? bfhi(w) : bflo(w);
                        const float gl = g * sigmoidf_(1.5957691216f * (g + 0.044715f * g * g * g));
                        y[j] = h * gl; ss += y[j] * y[j];
                        H[c] = dpp_f<DPP_BCAST15>(0.f, h); }
                    u32x4 p; p.x = pk2(y[0], y[1]); p.y = pk2(y[2], y[3]); p.z = pk2(y[4], y[5]); p.w = pk2(y[6], y[7]);
                    yp[blk][kb] = p;
                    asm volatile("" : "+v"(ss) :: "memory"); }
                ss += __shfl_xor(ss, 16); ss += __shfl_xor(ss, 32);
                if (q == 0) SSQ[(16 * blk + row) * 8 + F.wave] = ss;
        }
        __syncthreads();
        if (F.tid < 64) { float sm = 0.f;
#pragma unroll
            for (int w = 0; w < 8; ++w) sm += SSQ[F.tid * 8 + w];
            RSTD[F.tid] = rsqrtf(sm * (1.0f / LW) + RMS_EPS); }
        __syncthreads();
        { f32x4 g0[2], g1[2];
#pragma unroll
          for (int kb = 0; kb < 2; ++kb) { g0[kb] = *(const f32x4*)(F.lru_gain + F.wave * 64 + 32 * kb + 8 * q); g1[kb] = *(const f32x4*)(F.lru_gain + F.wave * 64 + 32 * kb + 8 * q + 4); }
#pragma unroll
          for (int blk = 0; blk < 4; ++blk) { const float rs = RSTD[16 * blk + row];
#pragma unroll
            for (int kb = 0; kb < 2; ++kb) { const u32x4 v = yp[blk][kb];
                u32x4 o; o.x = pk2(bflo(v.x) * rs * g0[kb].x, bfhi(v.x) * rs * g0[kb].y); o.y = pk2(bflo(v.y) * rs * g0[kb].z, bfhi(v.y) * rs * g0[kb].w);
                o.z = pk2(bflo(v.z) * rs * g1[kb].x, bfhi(v.z) * rs * g1[kb].y); o.w = pk2(bflo(v.w) * rs * g1[kb].z, bfhi(v.w) * rs * g1[kb].w);
                *(u32x4*)(F.YMIX + (size_t)(m0 + 64 * half + 16 * blk + row) * D + F.wave * 64 + 32 * kb + 8 * q) = o; } } }
        __syncthreads();
        }
        }
#endif
#ifndef P3_NO_POOL
        for (int prep_ = 0; prep_ <= ((REPEAT_MASK >> 9) & 1); ++prep_)
        {
            bf16x8 zf[4][4];
            const int T0 = b * TT + NMETA + 128 * ci - 15;
            u32x4 sv[9];
#define POOL_STAGE_LOAD(gp) do { _Pragma("unroll") for (int t = 0; t < 9; ++t) { const int i = F.tid + 512 * t; if (i < 143 * 32) sv[t] = *(const u32x4*)(F.PROJ + (size_t)(T0 + (i >> 5)) * INW + 1024 + 256 * (gp) + 8 * (i & 31)); } } while (0)
#define POOL_STAGE_WRITE() do { _Pragma("unroll") for (int t = 0; t < 9; ++t) { const int i = F.tid + 512 * t; if (i < 143 * 32) *(LAS u32x4*)(US + (i >> 5) * US_STRIDE + 8 * (i & 31)) = sv[t]; } } while (0)
            const LAS bf16* urow = US + (16 * F.wave + row) * US_STRIDE + 8 * q;
            POOL_STAGE_LOAD(0); POOL_STAGE_WRITE(); __syncthreads();
            pool_z<0>(urow, zf[0]);
            POOL_STAGE_LOAD(1);
            pool_z<1>(urow + 128, zf[1]);
            __syncthreads();
            POOL_STAGE_WRITE(); __syncthreads();
            u32x4 wv[8];
#pragma unroll
            for (int t = 0; t < 4; ++t) { const int i = F.tid + 512 * t; wv[t] = *(const u32x4*)(F.PwT + (size_t)(i >> 4) * 128 + 8 * (i & 15)); }
            pool_z<2>(urow, zf[2]); pool_z<3>(urow + 128, zf[3]);
            __syncthreads();
#pragma unroll
            for (int t = 0; t < 4; ++t) { const int i = F.tid + 512 * t; *(LAS u32x4*)(US + (i >> 4) * PW_STRIDE + 8 * (i & 15)) = wv[t]; }
#pragma unroll
            for (int t = 4; t < 12; ++t) { const int i = F.tid + 512 * t; wv[t - 4] = *(const u32x4*)(F.PwT + (size_t)(i >> 4) * 128 + 8 * (i & 15)); }
#pragma unroll
            for (int t = 4; t < 12; ++t) { const int i = F.tid + 512 * t; *(LAS u32x4*)(US + (i >> 4) * PW_STRIDE + 8 * (i & 15)) = wv[t - 4]; }
#pragma unroll
            for (int t = 12; t < 16; ++t) { const int i = F.tid + 512 * t; wv[t - 12] = *(const u32x4*)(F.PwT + (size_t)(i >> 4) * 128 + 8 * (i & 15)); }
#pragma unroll
            for (int t = 12; t < 16; ++t) { const int i = F.tid + 512 * t; *(LAS u32x4*)(US + (i >> 4) * PW_STRIDE + 8 * (i & 15)) = wv[t - 12]; }
            __syncthreads();
#undef POOL_STAGE_LOAD
#undef POOL_STAGE_WRITE
            const LAS bf16* wl = US + row * PW_STRIDE + 8 * q;
            float ssq = 0.f; u32x2 po[4][8];
#pragma unroll
            for (int g = 0; g < 4; ++g) { const LAS bf16* wg = wl + g * 128 * PW_STRIDE; asm volatile("" : "+v"(wg));
#pragma unroll
                for (int nb = 0; nb < 8; ++nb) { f32x4 acc = (f32x4){0.f, 0.f, 0.f, 0.f}; const LAS bf16* wn = wg + 16 * nb * PW_STRIDE;
#pragma unroll
                    for (int kb = 0; kb < 4; ++kb) acc = __builtin_amdgcn_mfma_f32_16x16x32_bf16(*(const LAS bf16x8*)(wn + 32 * kb), zf[g][kb], acc, 0, 0, 0);
                    ssq += (acc[0] * acc[0] + acc[1] * acc[1]) + (acc[2] * acc[2] + acc[3] * acc[3]);
                    po[g][nb].x = pk2(acc[0], acc[1]); po[g][nb].y = pk2(acc[2], acc[3]);
                    if (nb & 1) asm volatile("" : "+v"(ssq) :: "memory"); } }
            ssq += __shfl_xor(ssq, 16); ssq += __shfl_xor(ssq, 32);
            const float rs = rsqrtf(ssq * (1.0f / 512.0f) + RMS_EPS);
            bf16* orow = F.YMIX + (size_t)(m0 + 16 * F.wave + row) * D + LW + 4 * q;
#pragma unroll
            for (int g = 0; g < 4; ++g) { f32x4 sc[8];
#pragma unroll
                for (int nb = 0; nb < 8; ++nb) sc[nb] = *(const f32x4*)(F.pool_scale + 128 * g + 16 * nb + 4 * q);
#pragma unroll
                for (int nb = 0; nb < 8; ++nb) { const u32x2 v = po[g][nb];
                    u32x2 o; o.x = pk2(bflo(v.x) * rs * sc[nb].x, bfhi(v.x) * rs * sc[nb].y); o.y = pk2(bflo(v.y) * rs * sc[nb].z, bfhi(v.y) * rs * sc[nb].w);
                    *(u32x2*)(orow + 128 * g + 16 * nb) = o; }
                asm volatile("" ::: "memory"); }
        }
#endif
        __syncthreads();
    }
}

constexpr int WR_STRIDE = 1032;
__device__ __forceinline__ void p5_route(Frame& F, const bool dry = false) {
    LAS _Float16* WR = (LAS _Float16*)F.lds;
    LAS float* LG = (LAS float*)(F.lds + 36 * WR_STRIDE * 2) + F.wave * 16 * 40;
    LAS int* LCNT = (LAS int*)(F.lds + 36 * WR_STRIDE * 2 + 8 * 16 * 40 * 4);
    LAS float* G2 = (LAS float*)(LCNT + 64);
    const int c16 = F.lane & 15, q = F.lane >> 4;
    for (int i = F.tid; i < NROUTE * 128; i += 512) { const int n = i >> 7, k8 = i & 127; *(LAS u32x4*)(WR + n * WR_STRIDE + 8 * k8) = *(const u32x4*)(F.WrH + n * D + 8 * k8); }
    for (int i = F.tid; i < D; i += 512) G2[i] = F.g2[i];
    for (int ch = F.bx; ch < 256; ch += F.G) {
        if (F.tid < 64) LCNT[F.tid] = 0;
        __syncthreads();
        const int row = ch * 128 + 16 * F.wave + c16;
        const bf16* hrow = F.H1 + (size_t)row * D + 8 * q;
        f32x4 acc[3]; float ss = 0.f;
#pragma unroll
        for (int nb = 0; nb < 3; ++nb) acc[nb] = (f32x4){0.f, 0.f, 0.f, 0.f};
#pragma unroll 4
        for (int i = 0; i < 32; ++i) {
            const u32x4 hw = *(const u32x4*)(hrow + 32 * i);
            const f32x4 h0 = (f32x4){bflo(hw.x), bfhi(hw.x), bflo(hw.y), bfhi(hw.y)}, h1 = (f32x4){bflo(hw.z), bfhi(hw.z), bflo(hw.w), bfhi(hw.w)};
            const f32x4 g0 = *(const LAS f32x4*)(G2 + 32 * i + 8 * q), g1 = *(const LAS f32x4*)(G2 + 32 * i + 8 * q + 4);
            ss += (h0.x * h0.x + h0.y * h0.y) + (h0.z * h0.z + h0.w * h0.w) + (h1.x * h1.x + h1.y * h1.y) + (h1.z * h1.z + h1.w * h1.w);
            const f32x4 t0 = h0 * g0, t1 = h1 * g1;
            f16x8 a; a[0] = (_Float16)t0.x; a[1] = (_Float16)t0.y; a[2] = (_Float16)t0.z; a[3] = (_Float16)t0.w; a[4] = (_Float16)t1.x; a[5] = (_Float16)t1.y; a[6] = (_Float16)t1.z; a[7] = (_Float16)t1.w;
#pragma unroll
            for (int nb = 0; nb < 3; ++nb) { const int col = 16 * nb + c16; f16x8 bw;
#pragma unroll
                for (int j = 0; j < 8; ++j) bw[j] = (_Float16)0.f;
                if (col < NROUTE) bw = *(const LAS f16x8*)(WR + col * WR_STRIDE + 32 * i + 8 * q);
                acc[nb] = __builtin_amdgcn_mfma_f32_16x16x32_f16(a, bw, acc[nb], 0, 0, 0); }
        }
        ss += __shfl_xor(ss, 16); ss += __shfl_xor(ss, 32);
        const float rstd = rsqrtf(ss * (1.0f / D) + RMS_EPS);
#pragma unroll
        for (int nb = 0; nb < 3; ++nb)
#pragma unroll
            for (int j = 0; j < 4; ++j) { const int col = 16 * nb + c16; if (col < 40) LG[(4 * q + j) * 40 + col] = acc[nb][j]; }
        LDS_WAIT();
        int e0 = 0, e1 = 0, rk0 = 0, rk1 = 0; float gt0 = 0.f, gt1 = 0.f;
        if (F.lane < 16) {
            const LAS float* lg = LG + F.lane * 40; const float sc = rstd * (1.0f / 256.0f);
            float gl[4]; int gi = 0;
#pragma unroll
            for (int j = 0; j < 4; ++j) gl[j] = lg[j] * sc + F.b_group[j];
            float gm = gl[0];
#pragma unroll
            for (int j = 1; j < 4; ++j) if (gl[j] > gm) { gm = gl[j]; gi = j; }
            float den = 0.f;
#pragma unroll
            for (int j = 0; j < 4; ++j) den += __expf(gl[j] - gm);
            const float pg = 1.0f / den;
            float v0 = -3.0e38f, v1 = -3.0e38f; int i0 = 0, i1 = 0;
            for (int j = 0; j < 8; ++j) { const float v = lg[4 + gi * 8 + j] * sc + F.b_router[gi * 8 + j];
                if (v > v0) { v1 = v0; i1 = i0; v0 = v; i0 = j; } else if (v > v1) { v1 = v; i1 = j; } }
            const float ex = __expf(v1 - v0), s0 = 1.0f / (1.0f + ex);
            gt0 = pg * s0; gt1 = pg * (ex * s0); e0 = gi * 8 + i0; e1 = gi * 8 + i1;
            rk0 = __hip_atomic_fetch_add(&LCNT[e0], 1, __ATOMIC_RELAXED, __HIP_MEMORY_SCOPE_WORKGROUP); rk1 = __hip_atomic_fetch_add(&LCNT[e1], 1, __ATOMIC_RELAXED, __HIP_MEMORY_SCOPE_WORKGROUP);
        }
        __syncthreads();
        if (F.tid < 32 && !dry) LCNT[32 + F.tid] = (int)__hip_atomic_fetch_add(F.ctl + CW_CNT + 64 * F.tid, (unsigned)LCNT[F.tid], __ATOMIC_RELAXED, __HIP_MEMORY_SCOPE_AGENT);
        __syncthreads();
        if (F.lane < 16 && !dry) { const int tok = ch * 128 + 16 * F.wave + F.lane;
            F.RINFO[(size_t)e0 * ECAP + LCNT[32 + e0] + rk0] = (f32x4){__builtin_bit_cast(float, tok * 2), gt0, rstd, 0.f};
            F.RINFO[(size_t)e1 * ECAP + LCNT[32 + e1] + rk1] = (f32x4){__builtin_bit_cast(float, tok * 2 + 1), gt1, rstd, 0.f}; }
        __syncthreads();
    }
}

__device__ __forceinline__ int moe_tables(Frame& F) {
    LAS int* TE = (LAS int*)(F.lds + TAB_TE); LAS int* TR = (LAS int*)(F.lds + TAB_TR); LAS int* CNT = (LAS int*)(F.lds + TAB_CNT); LAS int* PRE = CNT + 32;
    if (F.tid < 32) CNT[F.tid] = (int)__hip_atomic_load(F.ctl + CW_CNT + 64 * F.tid, __ATOMIC_RELAXED, __HIP_MEMORY_SCOPE_AGENT);
    __syncthreads();
    if (F.tid == 0) { int s = 0; for (int e = 0; e < NE; ++e) { PRE[e] = s; s += (CNT[e] + 255) >> 8; } PRE[NE] = s; }
    __syncthreads();
    const int NT = PRE[NE];
    for (int t = F.tid; t < NT; t += 512) { int e = 0; while (e < NE - 1 && PRE[e + 1] <= t) ++e; TE[t] = e; TR[t] = (t - PRE[e]) * 256; }
    __syncthreads();
    return NT;
}
__device__ __forceinline__ void moe_unit_tables(Frame& F, const pg8::MoeSched& S, int mode) {
    LAS int* TE = (LAS int*)(F.lds + TAB_TE); LAS int* TR = (LAS int*)(F.lds + TAB_TR); LAS int* CNT = (LAS int*)(F.lds + TAB_CNT);
    LAS unsigned* ROW = (LAS unsigned*)(F.lds + TAB_ROW); LAS float* FT = (LAS float*)(F.lds + TAB_F);
    const int nu = S.rounds() < MAXU ? S.rounds() : MAXU;
    f32x4 ri[MAXU / 2]; bool valid[MAXU / 2]; int ok[MAXU / 2];
#pragma unroll
    for (int t = 0; t < MAXU / 2; ++t) { const int idx = F.tid + 512 * t, i = idx >> 8, r = idx & 255; pg8::Unit u;
        ri[t] = (f32x4){0.f, 0.f, 0.f, 0.f}; valid[t] = false; ok[t] = (i < nu) && S.next(i, u);
        if (ok[t]) { const int e = TE[u.pm], pos = TR[u.pm] + r; valid[t] = pos < CNT[e]; if (valid[t]) ri[t] = F.RINFO[(size_t)e * ECAP + pos]; } }
#pragma unroll
    for (int t = 0; t < MAXU / 2; ++t) if (ok[t]) { const int idx = F.tid + 512 * t; const int slot = __builtin_bit_cast(int, ri[t].x);
        if (mode == 0) { ROW[idx] = valid[t] ? (unsigned)(slot >> 1) * (unsigned)D : 0u; FT[idx] = valid[t] ? ri[t].z * (1.0f / WGU_SCALE) : 0.f; }
        else { ROW[idx] = valid[t] ? (unsigned)slot : 0xffffffffu; FT[idx] = ri[t].y * (C_SCALE / (WD_SCALE * HID_SCALE)); } }
    __syncthreads();
}

__device__ __forceinline__ void p8_final(Frame& F) {
    const int gw = F.bx * 8 + F.wave, NGW = F.G * 8;
    f32x4 g[4];
#pragma unroll
    for (int j = 0; j < 4; ++j) g[j] = ((const f32x4*)F.final_gain)[F.lane + 64 * j];
    for (int m = gw * 2; m < M; m += NGW * 2) {
        u32x2 hb[2][4]; unsigned ca[2][4], cb[2][4];
#pragma unroll
        for (int r = 0; r < 2; ++r)
#pragma unroll
            for (int j = 0; j < 4; ++j) { hb[r][j] = ((const u32x2*)(F.H1 + (size_t)(m + r) * D))[F.lane + 64 * j];
                ca[r][j] = ((const unsigned*)(F.C + (size_t)(2 * (m + r)) * D))[F.lane + 64 * j]; cb[r][j] = ((const unsigned*)(F.C + (size_t)(2 * (m + r) + 1) * D))[F.lane + 64 * j]; }
#pragma unroll
        for (int r = 0; r < 2; ++r) { f32x4 v[4]; float s = 0.f;
#pragma unroll
            for (int j = 0; j < 4; ++j) { const f32x2 a0 = __builtin_amdgcn_cvt_pk_f32_fp8(ca[r][j], false), a1 = __builtin_amdgcn_cvt_pk_f32_fp8(ca[r][j], true), b0 = __builtin_amdgcn_cvt_pk_f32_fp8(cb[r][j], false), b1 = __builtin_amdgcn_cvt_pk_f32_fp8(cb[r][j], true);
                v[j] = (f32x4){bflo(hb[r][j].x) + (a0.x + b0.x) * (1.0f / C_SCALE), bfhi(hb[r][j].x) + (a0.y + b0.y) * (1.0f / C_SCALE), bflo(hb[r][j].y) + (a1.x + b1.x) * (1.0f / C_SCALE), bfhi(hb[r][j].y) + (a1.y + b1.y) * (1.0f / C_SCALE)};
                s += (v[j].x * v[j].x + v[j].y * v[j].y) + (v[j].z * v[j].z + v[j].w * v[j].w); }
            const float rstd = rsqrtf(wave_sum(s) * (1.f / D) + RMS_EPS);
            f32x4* o = (f32x4*)(F.out + (size_t)(m + r) * D) + F.lane;
#pragma unroll
            for (int j = 0; j < 4; ++j) o[64 * j] = v[j] * rstd * g[j]; }
    }
}

struct Args { const float* in[24]; float* out; unsigned char* ws; int ph_lo, ph_hi; };
__global__ void __launch_bounds__(512, 2) hymba_fwd(Args args) {
    extern __shared__ __attribute__((aligned(16))) unsigned char lds[];
    Frame F;
    F.lds = (LAS unsigned char*)lds; F.tid = threadIdx.x; F.lane = F.tid & 63; F.wave = __builtin_amdgcn_readfirstlane(F.tid >> 6); F.G = gridDim.x; F.bx = blockIdx.x;
    F.x = args.in[0]; F.meta = args.in[1]; F.g1 = args.in[2]; F.w_in = args.in[3]; F.conv_w = args.in[4]; F.conv_b = args.in[5]; F.wa = args.in[6]; F.ba = args.in[7]; F.wx = args.in[8]; F.bx_ = args.in[9];
    F.lam = args.in[10]; F.lru_gain = args.in[11]; F.pool_w = args.in[12]; F.pool_scale = args.in[13]; F.w_out = args.in[14]; F.g2 = args.in[15]; F.w_group = args.in[16]; F.b_group = args.in[17];
    F.w_router = args.in[18]; F.b_router = args.in[19]; F.w_gate = args.in[20]; F.w_up = args.in[21]; F.w_down = args.in[22]; F.final_gain = args.in[23];
    F.out = args.out; F.ws = args.ws; F.ctl = (unsigned*)(args.ws + WS_CTL);
    unsigned char* ws = args.ws;
    F.WinT = (bf16*)(ws + WS_WIN); F.WoutT = (bf16*)(ws + WS_WOUT); F.WaT = (bf16*)(ws + WS_WA); F.WxT = (bf16*)(ws + WS_WX); F.PwT = (bf16*)(ws + WS_PW); F.WrH = (_Float16*)(ws + WS_WR);
    F.AGG = (float*)(ws + WS_AGG); F.HM = (float*)(ws + WS_HM); F.AB = (u32x4*)(ws + WS_AB); F.WguT = ws + WS_WGU; F.WdT = ws + WS_WD; F.RINFO = (f32x4*)(ws + WS_RINFO); F.HN1 = (bf16*)(ws + WS_HN1); F.YMIX = (bf16*)(ws + WS_HN1);
    F.PROJ = (bf16*)(ws + WS_PROJ); F.HN2 = ws + WS_PROJ; F.HID = ws + WS_HID; F.C = ws + WS_C; F.H1 = (bf16*)(ws + WS_H1);
    volatile LAS unsigned* MISC = (volatile LAS unsigned*)(F.lds + MISC_OFF);
    if (F.tid < 64) MISC[F.tid] = 0u;
    __syncthreads();
    XcdBarrier bar; bar.bar = F.ctl + CW_BAR; bar.x = 0; bar.st = nullptr;
    if (MK_N_LAUNCHES == 1) bar = xcd_barrier_post(F.ctl + CW_BAR, MISC + 8);
    const int lo = args.ph_lo, hi = args.ph_hi;
#ifndef PH_MASK
#define PH_MASK 0x1ff
#endif
#define IN(k) (((PH_MASK >> (k)) & 1) && lo <= (k) && (k) < hi)
#define SEAM(k) do { if (IN(k) && IN((k) + 1)) xcd_barrier(bar); } while (0)
#define REP(k) for (int rep_ = 0; rep_ <= ((REPEAT_MASK >> (k)) & 1); ++rep_)

    if (IN(0)) REP(0) { p0_prologue(F); } SEAM(0);
    if (IN(1)) { pg8::DenseSched S{M / 256, INW / 256, F.G, F.bx, D * 2, (const char*)F.WinT, 1 + ((REPEAT_MASK >> 1) & 1)}; pg8::EpiProj E{F.PROJ};
        pg8::gemm_phase(F.lds, D * 2, (const char*)F.HN1, S, E); } SEAM(1);
    if (IN(2)) REP(2) { p2_aggregates(F); } SEAM(2);
    if (IN(3)) REP(3) { p3_mixer(F); } SEAM(3);
    if (IN(4)) { pg8::DenseSched S{M / 256, D / 256, F.G, F.bx, D * 2, (const char*)F.WoutT, 1 + ((REPEAT_MASK >> 4) & 1)}; pg8::EpiResid E{F.x, F.g2, F.H1, F.HN2};
        pg8::gemm_phase(F.lds, D * 2, (const char*)F.YMIX, S, E); } SEAM(4);
    if (IN(5)) { if ((REPEAT_MASK >> 5) & 1) p5_route(F, true); p5_route(F); } SEAM(5);
    if (IN(6)) { const int NT = moe_tables(F);
        pg8::MoeSched S{NT, 4, F.G, F.bx, D, (const char*)F.WguT, (size_t)1024 * D, true, (const LAS int*)(F.lds + TAB_TE), (const LAS unsigned*)(F.lds + TAB_ROW), 1 + ((REPEAT_MASK >> 6) & 1)};
        moe_unit_tables(F, S, 0);
        pg8::EpiGateUp E{F.HID, (const LAS float*)(F.lds + TAB_F), S.rounds()};
        pg8::gemm_phase<pg8::EpiGateUp, pg8::MoeSched, true>(F.lds, D, (const char*)F.HN2, S, E); } SEAM(6);
    if (IN(7)) { const int NT = moe_tables(F);
        pg8::MoeSched S{NT, 4, F.G, F.bx, EFF, (const char*)F.WdT, (size_t)D * EFF, false, (const LAS int*)(F.lds + TAB_TE), (const LAS unsigned*)(F.lds + TAB_ROW), 1 + ((REPEAT_MASK >> 7) & 1)};
        moe_unit_tables(F, S, 1);
        pg8::EpiDown E{F.C, (const LAS int*)(F.lds + TAB_ROW), (const LAS float*)(F.lds + TAB_F), S.rounds()};
        pg8::gemm_phase<pg8::EpiDown, pg8::MoeSched, true>(F.lds, EFF, (const char*)F.HID, S, E); } SEAM(7);
    if (IN(8)) { p8_final(F); }
#undef IN
#undef SEAM
}

extern "C" void kernel_launch(void* const* d_in, const int* in_sizes, int n_in, void* d_out, int out_size, void* d_ws, size_t ws_size, hipStream_t stream) {
    static int grid = 0;
    if (grid == 0) {
        if (n_in != 24 || in_sizes[0] != M * D || out_size != M * D || ws_size < WS_END) { fprintf(stderr, "kernel_launch: unexpected shapes (n_in %d, in0 %d, out %d, ws %zu)\n", n_in, n_in > 0 ? in_sizes[0] : -1, out_size, ws_size); grid = -1; return; }
        int dev = 0, cus = 0, per_cu = 0;
        if (hipGetDevice(&dev) != hipSuccess || hipDeviceGetAttribute(&cus, hipDeviceAttributeMultiprocessorCount, dev) != hipSuccess) { grid = -1; return; }
        if (hipFuncSetAttribute((const void*)hymba_fwd, hipFuncAttributeMaxDynamicSharedMemorySize, LDS_BYTES) != hipSuccess) { fprintf(stderr, "kernel_launch: hipFuncSetAttribute failed\n"); grid = -1; return; }
        if (hipOccupancyMaxActiveBlocksPerMultiprocessor(&per_cu, (const void*)hymba_fwd, 512, LDS_BYTES) != hipSuccess || per_cu < 1) fprintf(stderr, "kernel_launch: occupancy query says %d\n", per_cu);
        (void)hipGetLastError();
        grid = cus;
    }
    if (grid < 0) return;
    if (hipMemsetAsync((char*)d_ws + WS_CTL, 0, CTL_ZERO_BYTES, stream) != hipSuccess) return;
    Args a{};
    for (int i = 0; i < 24; ++i) a.in[i] = (const float*)d_in[i];
    a.out = (float*)d_out; a.ws = (unsigned char*)d_ws;
    if (MK_N_LAUNCHES == 1) { a.ph_lo = 0; a.ph_hi = N_PHASES; hipLaunchKernelGGL(hymba_fwd, dim3(grid), dim3(512), LDS_BYTES, stream, a); }
    else for (int p = 0; p < N_PHASES; ++p) { a.ph_lo = p; a.ph_hi = p + 1; hipLaunchKernelGGL(hymba_fwd, dim3(grid), dim3(512), LDS_BYTES, stream, a); }
}
```

```cpp
#include <hip/hip_runtime.h>
#include <cstdio>
#include <cstdint>

#define GAS __attribute__((address_space(1)))
#define LAS __attribute__((address_space(3)))
typedef unsigned short bf16;
typedef short bf16x8 __attribute__((ext_vector_type(8)));
typedef _Float16 f16x8 __attribute__((ext_vector_type(8)));
typedef float f32x4 __attribute__((ext_vector_type(4)));
typedef float f32x2 __attribute__((ext_vector_type(2)));
typedef unsigned u32x4 __attribute__((ext_vector_type(4)));
typedef unsigned u32x2 __attribute__((ext_vector_type(2)));

#ifndef MK_N_LAUNCHES
#define MK_N_LAUNCHES 1
#endif
constexpr int N_PHASES = 9;
#ifndef REPEAT_MASK
#define REPEAT_MASK 0
#endif

constexpr int D = 1024, NBATCH = 8, SEQ = 4096, NMETA = 16, TT = SEQ + NMETA, M = NBATCH * SEQ;
constexpr int LW = 512, INW = 1536, NE = 32, EFF = 512, NROUTE = 36;
constexpr int ECAP = 32768;
constexpr int MAXT = 288;
constexpr int MAXU = 6;
constexpr float RMS_EPS = 1e-6f;

constexpr size_t MiB = 1u << 20;
constexpr size_t WS_CTL = 0, CTL_ZERO_BYTES = 1 * MiB;
constexpr size_t WS_WIN = 2 * MiB, WS_WOUT = 5 * MiB, WS_WA = 7 * MiB, WS_WX = 7 * MiB + 65536, WS_PW = 7 * MiB + 131072, WS_WR = 7 * MiB + 262144;
constexpr size_t WS_AGG = 8 * MiB;
constexpr size_t WS_RS1 = 9 * MiB + 65536;
constexpr size_t WS_HM = 9 * MiB;
constexpr size_t WS_WGU = 10 * MiB  , WS_WD = 42 * MiB  , WS_RINFO = 58 * MiB, WS_HN1 = 74 * MiB  ;
constexpr size_t WS_PROJ = 138 * MiB  , WS_HID = 235 * MiB  , WS_C = 272 * MiB  , WS_H1 = 400 * MiB  , WS_END = 464 * MiB;
constexpr size_t WS_YMIX = 336 * MiB;
constexpr size_t WS_AB = WS_C;
constexpr float WGU_SCALE = 64.f, WD_SCALE = 32.f, HID_SCALE = 8.f, C_SCALE = 32.f;
constexpr int CW_BAR = 4096, CW_CNT = 16384;

constexpr int LDS_BYTES = 147456;
constexpr int MISC_OFF = LDS_BYTES - 256;
constexpr int TAB_OFF = 131072 + 512;
constexpr int TAB_ROW = TAB_OFF;
constexpr int TAB_F = TAB_ROW + MAXU * 256 * 4;
constexpr int TAB_TE = TAB_F + MAXU * 256 * 4;
constexpr int TAB_TR = TAB_TE + MAXT * 4;
constexpr int TAB_CNT = TAB_TR + MAXT * 4;
static_assert(TAB_CNT + 80 * 4 <= MISC_OFF, "LDS map");

__device__ __forceinline__ unsigned f2bf(float f) { unsigned u = __builtin_bit_cast(unsigned, f); return (u + 0x7fffu + ((u >> 16) & 1u)) >> 16; }
typedef __bf16 bf16x2_t __attribute__((ext_vector_type(2)));
__device__ __forceinline__ unsigned pk2(float lo, float hi) { return __builtin_bit_cast(unsigned, __builtin_convertvector((f32x2){lo, hi}, bf16x2_t)); }
__device__ __forceinline__ float bf2f(unsigned h) { return __builtin_bit_cast(float, h << 16); }
__device__ __forceinline__ float bflo(unsigned w) { return __builtin_bit_cast(float, w << 16); }
__device__ __forceinline__ float bfhi(unsigned w) { return __builtin_bit_cast(float, w & 0xffff0000u); }
__device__ __forceinline__ float sigmoidf_(float x) { return __builtin_amdgcn_rcpf(1.0f + __expf(-x)); }
#define LDS_WAIT() asm volatile("s_waitcnt lgkmcnt(0)" ::: "memory")
typedef _Float16 f16x2 __attribute__((ext_vector_type(2)));
__device__ __forceinline__ unsigned pkh2(float lo, float hi) { return __builtin_bit_cast(unsigned, __builtin_convertvector((f32x2){lo, hi}, f16x2)); }
__device__ __forceinline__ float h2lo(unsigned w) { return (float)__builtin_bit_cast(f16x2, w).x; }
__device__ __forceinline__ float h2hi(unsigned w) { return (float)__builtin_bit_cast(f16x2, w).y; }
typedef int i32x4 __attribute__((ext_vector_type(4)));
typedef int i32x8 __attribute__((ext_vector_type(8)));
__device__ __forceinline__ float clamp448(float v) { return fminf(fmaxf(v, -448.f), 448.f); }
__device__ __forceinline__ unsigned pk4_fp8(float a, float b, float c, float d) {
    int v = __builtin_amdgcn_cvt_pk_fp8_f32(a, b, 0, false); v = __builtin_amdgcn_cvt_pk_fp8_f32(c, d, v, true); return (unsigned)v; }

#define XB_TMO      128
#define XB_XCNT(j)  (256  + 64 * (j))
#define XB_XSUB(j)  (1280 + 64 * (j))
#define XB_XGEN(j)  (2304 + 64 * (j))
#define XB_TOP      3328
#define XB_TOPGEN   3392
#define XCD_BAR_WORDS 3456
#define XB_SPIN_CAP (1u << 18)
__device__ __forceinline__ unsigned xb_ld(unsigned* p)              { return __hip_atomic_load(p, __ATOMIC_RELAXED, __HIP_MEMORY_SCOPE_AGENT); }
__device__ __forceinline__ unsigned xb_add(unsigned* p, unsigned v) { return __hip_atomic_fetch_add(p, v, __ATOMIC_RELAXED, __HIP_MEMORY_SCOPE_AGENT); }
__device__ __forceinline__ unsigned xb_xcc_id() { return (unsigned)__builtin_amdgcn_s_getreg((3 << 11) | 20) & 0xFu; }
#define XB_SPIN(cond, bar) do { unsigned _sp = 0; while (cond) { __builtin_amdgcn_s_sleep(1); \
    if ((++_sp & 255u) == 0u) { if (xb_ld(&(bar)[XB_TMO])) break; if (_sp > XB_SPIN_CAP) { atomicAdd(&(bar)[XB_TMO], 1u); break; } } } } while (0)
struct XcdBarrier { unsigned* bar; unsigned x; volatile LAS unsigned* st; };
__device__ __forceinline__ XcdBarrier xcd_barrier_post(unsigned* bar, volatile LAS unsigned* st) {
    XcdBarrier b; b.bar = bar; b.x = xb_xcc_id(); b.st = st;
    if (threadIdx.x == 0) (void)xb_add(&bar[XB_XCNT(b.x)], 1u);
    return b;
}
__device__ __forceinline__ void xcd_barrier_complete(unsigned* bar, unsigned x, unsigned& nloc, unsigned& nx) {
    const unsigned G = gridDim.x * gridDim.y * gridDim.z;
    unsigned sum, cnt, mine, sp = 0u;
    for (;;) {
        sum = 0u; cnt = 0u; mine = 0u;
#pragma unroll
        for (unsigned j = 0; j < 16; ++j) { const unsigned c = xb_ld(&bar[XB_XCNT(j)]); sum += c; cnt += (c > 0u) ? 1u : 0u; mine = (j == x) ? c : mine; }
        if (sum == G) break;
        __builtin_amdgcn_s_sleep(1);
        if ((++sp & 255u) == 0u) { if (xb_ld(&bar[XB_TMO])) break; if (sp > XB_SPIN_CAP) { atomicAdd(&bar[XB_TMO], 1u); break; } }
    }
    nloc = mine > 0u ? mine : 1u; nx = cnt > 0u ? cnt : 1u;
}
__device__ __forceinline__ void xcd_barrier(const XcdBarrier& b) {
    asm volatile("s_waitcnt vmcnt(0)" ::: "memory");
    __syncthreads();
    if (threadIdx.x == 0) {
        unsigned* bar = b.bar;
        __builtin_amdgcn_s_waitcnt(0);
        unsigned nloc = b.st[0], nx = b.st[1];
        if (nloc == 0u) { xcd_barrier_complete(bar, b.x, nloc, nx); b.st[0] = nloc; b.st[1] = nx; }
        const unsigned old = xb_add(&bar[XB_XSUB(b.x)], 1u);
        const unsigned gen = old / nloc;
        if (old + 1u == (gen + 1u) * nloc) {
            __builtin_amdgcn_fence(__ATOMIC_RELEASE, "agent");
            asm volatile("s_waitcnt vmcnt(0)" ::: "memory");
            const unsigned og = xb_add(&bar[XB_TOP], 1u);
            const unsigned tg = og / nx;
            if (og + 1u == (tg + 1u) * nx) xb_add(&bar[XB_TOPGEN], 1u);
            else XB_SPIN(xb_ld(&bar[XB_TOPGEN]) == tg, bar);
            __builtin_amdgcn_fence(__ATOMIC_ACQUIRE, "agent");
            xb_add(&bar[XB_XGEN(b.x)], 1u);
            asm volatile("s_waitcnt vmcnt(0)" ::: "memory");
        } else {
            XB_SPIN(xb_ld(&bar[XB_XGEN(b.x)]) == gen, bar);
            __builtin_amdgcn_fence(__ATOMIC_ACQUIRE, "agent");
            asm volatile("s_waitcnt vmcnt(0)" ::: "memory");
        }
    }
    __syncthreads();
}

namespace pg8 {
constexpr int BM = 256, BK = 64, HALF = 128, HTB = HALF * BK * 2, STAGE_BYTES = 8 * HTB, NXCD = 8, WGM = 8;
__host__ __device__ __forceinline__ int lds_byte(int r, int c) { const int st = (r >> 4) * 2 + (c >> 5), rr = r & 15, cc = c & 31, ob = rr * 64 + cc * 2; return st * 1024 + (ob ^ (((ob >> 9) & 1) << 5)); }
__host__ __device__ __forceinline__ void stage_rc(int b, int& R, int& C) { const int st = b / 1024, sb = b % 1024, swz = sb ^ (((sb >> 9) & 1) << 5); R = (st >> 1) * 16 + swz / 64; C = (st & 1) * 32 + (swz % 64) / 2; }
__host__ __device__ __forceinline__ int perm32(int rho) { const int n = rho >> 4, i = rho & 15; return 8 * (i >> 2) + 4 * n + (i & 3); }
struct Unit { int pm, pn; };
__device__ __forceinline__ bool static_next(int nM, int nN, int G, int c, int i, Unit& u) {
    const int nwg = nM * nN; const long L = (long)i * G + c; if (L >= nwg) return false;
    int wgid = (int)L; { const int q = nwg / NXCD, r = nwg % NXCD, xcd = wgid % NXCD, off = wgid / NXCD; wgid = (xcd < r ? xcd * (q + 1) : r * (q + 1) + (xcd - r) * q) + off; }
    const int nig = WGM * nN, gid = wgid / nig, fm = gid * WGM, gsz = (nM - fm) < WGM ? (nM - fm) : WGM;
    u.pm = fm + ((wgid % nig) % gsz); u.pn = (wgid % nig) / gsz; return true;
}
__device__ __forceinline__ unsigned cvt_pk_bf16(float lo, float hi) { return pk2(lo, hi); }

template <class Epi, class Sched, bool FP8 = false>
__device__ __forceinline__ void gemm_phase(LAS unsigned char* lds, const int KB, const char* Abase, const Sched& S, const Epi& E) {
    const int tid = threadIdx.x, wid = __builtin_amdgcn_readfirstlane(tid >> 6), lane = tid & 63, wr = wid >> 2, wc = wid & 3, fr = lane & 15, fq = lane >> 4;
    const int nt = KB / (BK * 2);
    int Rl[2]; unsigned Cb[2], voffB[2];
#pragma unroll
    for (int i = 0; i < 2; ++i) { int R, C; stage_rc(tid * 16 + i * 8192, R, C); const int Rb = Epi::PERM ? ((R & ~31) + perm32(R & 31)) : R;
        Rl[i] = R; Cb[i] = (unsigned)C * 2u; voffB[i] = (unsigned)(Rb * KB + C * 2); }
    const size_t kstep = (size_t)(BK * 2);
    const size_t hstepB = (size_t)HALF * KB;
    const unsigned ldsw = (unsigned)wid * 1024u;
    const int aoff = lds_byte(wr * 64 + fr, fq * 8), boff = lds_byte(wc * 32 + fr, fq * 8);
#define PG8_SA(b, h) (((b) * 2 + (h)) * HTB)
#define PG8_SB(b, h) ((4 + (b) * 2 + (h)) * HTB)
#define PG8_STAGE(bufoff, gbase, voff) do { _Pragma("unroll") for (int _i = 0; _i < 2; ++_i) \
        __builtin_amdgcn_global_load_lds((const unsigned*)((const char*)(gbase) + (voff)[_i]), (LAS unsigned*)(lds + (bufoff) + ldsw + _i * 8192), 16, 0, 0); } while (0)
#define PG8_LD32(p) __builtin_shufflevector(*(const LAS i32x4*)(p), *(const LAS i32x4*)((p) + 1024), 0, 1, 2, 3, 4, 5, 6, 7)
#define PG8_LDA(dst, b, h) do { _Pragma("unroll") for (int m = 0; m < 4; ++m) dst[m] = PG8_LD32(lds + PG8_SA(b, h) + aoff + m * 2048); } while (0)
#define PG8_LDB(dst, b, h) do { _Pragma("unroll") for (int n = 0; n < 2; ++n) dst[n] = PG8_LD32(lds + PG8_SB(b, h) + boff + n * 2048); } while (0)
#define PG8_LO(v) __builtin_bit_cast(bf16x8, __builtin_shufflevector((v), (v), 0, 1, 2, 3))
#define PG8_HI(v) __builtin_bit_cast(bf16x8, __builtin_shufflevector((v), (v), 4, 5, 6, 7))
#define PG8_MMA(ai, bj, At, Bt) do { __builtin_amdgcn_s_setprio(1); _Pragma("unroll") for (int m = 0; m < 4; ++m) _Pragma("unroll") for (int n = 0; n < 2; ++n) { \
        if constexpr (FP8) asm volatile("v_mfma_f32_16x16x128_f8f6f4 %0, %1, %2, %0" : "+v"(acc[ai][bj][m][n]) : "v"(Bt[n]), "v"(At[m])); \
        else { acc[ai][bj][m][n] = __builtin_amdgcn_mfma_f32_16x16x32_bf16(PG8_LO(Bt[n]), PG8_LO(At[m]), acc[ai][bj][m][n], 0, 0, 0); \
               acc[ai][bj][m][n] = __builtin_amdgcn_mfma_f32_16x16x32_bf16(PG8_HI(Bt[n]), PG8_HI(At[m]), acc[ai][bj][m][n], 0, 0, 0); } } \
        __builtin_amdgcn_s_setprio(0); } while (0)
#define PG8_WAIT_V(n) asm volatile("s_waitcnt vmcnt(" #n ")" ::: "memory")
#define PG8_WAIT_L(n) asm volatile("s_waitcnt lgkmcnt(" #n ")" ::: "memory")
#define PG8_BAR __builtin_amdgcn_s_barrier()
#define PG8_SCHED __builtin_amdgcn_sched_barrier(0)
    Unit cur, nxt; int ui = 0;
    if (!S.next(0, cur)) return;
    f32x4 acc[2][2][4][2];
#pragma unroll
    for (int a = 0; a < 2; ++a)
#pragma unroll
        for (int b = 0; b < 2; ++b)
#pragma unroll
            for (int m = 0; m < 4; ++m)
#pragma unroll
                for (int n = 0; n < 2; ++n) acc[a][b][m][n] = (f32x4){0.f, 0.f, 0.f, 0.f};
    i32x8 At[4], B0[2], B1[2];
    unsigned cO0[2], cO1[2], nO0[2], nO1[2];
#pragma unroll
    for (int i = 0; i < 2; ++i) { cO0[i] = S.a_off(0, cur, Rl[i]) + Cb[i]; cO1[i] = S.a_off(0, cur, HALF + Rl[i]) + Cb[i]; }
    const char* cB = S.b_base(cur);
    PG8_STAGE(PG8_SB(0, 0), cB, voffB); PG8_STAGE(PG8_SB(0, 1), cB + hstepB, voffB); PG8_STAGE(PG8_SA(0, 0), Abase, cO0); PG8_STAGE(PG8_SA(0, 1), Abase, cO1);
    if (wr == 1) PG8_BAR;
    PG8_WAIT_V(2); PG8_BAR;
    PG8_STAGE(PG8_SB(1, 0), cB + kstep, voffB); PG8_STAGE(PG8_SA(1, 0), Abase + kstep, cO0); PG8_STAGE(PG8_SB(1, 1), cB + hstepB + kstep, voffB);
    PG8_WAIT_V(6); PG8_BAR;
    for (;;) {
        const bool has_next = S.next(ui + 1, nxt);
        const char* nB = cB;
#pragma unroll
        for (int i = 0; i < 2; ++i) { nO0[i] = cO0[i]; nO1[i] = cO1[i]; }
        if (has_next) { nB = S.b_base(nxt);
#pragma unroll
            for (int i = 0; i < 2; ++i) { nO0[i] = S.a_off(ui + 1, nxt, Rl[i]) + Cb[i]; nO1[i] = S.a_off(ui + 1, nxt, HALF + Rl[i]) + Cb[i]; } }
#pragma nounroll
        for (int t = 0; t < nt; t += 2) {
            const bool last = (t == nt - 2);
            const char* a1 = Abase + (size_t)(t + 1) * kstep;
            const char* a2 = last ? Abase : Abase + (size_t)(t + 2) * kstep; const char* b2 = last ? nB : cB + (size_t)(t + 2) * kstep;
            const char* a3 = a2 + kstep; const char* b3 = b2 + kstep;
            unsigned o0[2], o1[2];
#pragma unroll
            for (int i = 0; i < 2; ++i) { o0[i] = last ? nO0[i] : cO0[i]; o1[i] = last ? nO1[i] : cO1[i]; }
            PG8_LDB(B0, 0, 0); PG8_LDB(B1, 0, 1); PG8_SCHED; PG8_LDA(At, 0, 0); PG8_STAGE(PG8_SA(1, 1), a1, cO1);
            PG8_WAIT_V(8); PG8_WAIT_L(0); PG8_BAR; PG8_MMA(0, 0, At, B0); PG8_MMA(0, 1, At, B1); PG8_BAR; PG8_SCHED;
            PG8_LDA(At, 0, 1); PG8_STAGE(PG8_SB(0, 0), b2, voffB); PG8_STAGE(PG8_SB(0, 1), b2 + hstepB, voffB); PG8_STAGE(PG8_SA(0, 0), a2, o0);
            PG8_WAIT_V(8); PG8_WAIT_L(0); PG8_BAR; PG8_MMA(1, 0, At, B0); PG8_MMA(1, 1, At, B1); PG8_BAR; PG8_SCHED;
            PG8_LDB(B0, 1, 0); PG8_LDB(B1, 1, 1); PG8_SCHED; PG8_LDA(At, 1, 0); PG8_STAGE(PG8_SA(0, 1), a2, o1);
            PG8_WAIT_V(8); PG8_WAIT_L(0); PG8_BAR; PG8_MMA(0, 0, At, B0); PG8_MMA(0, 1, At, B1); PG8_BAR; PG8_SCHED;
            PG8_LDA(At, 1, 1); PG8_STAGE(PG8_SB(1, 0), b3, voffB); PG8_STAGE(PG8_SB(1, 1), b3 + hstepB, voffB); PG8_STAGE(PG8_SA(1, 0), a3, o0);
            PG8_WAIT_V(8); PG8_WAIT_L(0); PG8_BAR; PG8_MMA(1, 0, At, B0); PG8_MMA(1, 1, At, B1); PG8_BAR; PG8_SCHED;
        }
        if (wr == 0) PG8_BAR;
        if constexpr (FP8) asm volatile("s_nop 15\n\ts_nop 15" ::: "memory");
        E(acc, cur, ui, wr, wc, fr, fq);
        if (!has_next) break;
#pragma unroll
        for (int a = 0; a < 2; ++a)
#pragma unroll
            for (int b = 0; b < 2; ++b)
#pragma unroll
                for (int m = 0; m < 4; ++m)
#pragma unroll
                    for (int n = 0; n < 2; ++n) acc[a][b][m][n] = (f32x4){0.f, 0.f, 0.f, 0.f};
        cur = nxt; cB = nB; ++ui;
#pragma unroll
        for (int i = 0; i < 2; ++i) { cO0[i] = nO0[i]; cO1[i] = nO1[i]; }
        if (wr == 1) PG8_BAR;
    }
    PG8_WAIT_V(0);
    PG8_BAR;
#undef PG8_SA
#undef PG8_SB
#undef PG8_STAGE
#undef PG8_LDA
#undef PG8_LDB
#undef PG8_MMA
#undef PG8_LO
#undef PG8_HI
#undef PG8_LD32
#undef PG8_WAIT_V
#undef PG8_WAIT_L
#undef PG8_BAR
#undef PG8_SCHED
}

struct DenseSched {
    int nM, nN, G, c, K2; const char* B; int reps;
    __device__ __forceinline__ bool next(int i, Unit& u) const { const int rounds = (nM * nN + G - 1) / G; if (i >= rounds * reps) return false; return static_next(nM, nN, G, c, i % rounds, u); }
    __device__ __forceinline__ const char* b_base(const Unit& u) const { return B + (size_t)u.pn * BM * K2; }
    __device__ __forceinline__ unsigned a_off(int, const Unit& u, int r) const { return (unsigned)(u.pm * BM + r) * (unsigned)K2; }
};
struct MoeSched {
    int NT, nN, G, c, K2; const char* B; size_t estride; bool gather;
    const LAS int* tile_e; const LAS unsigned* rowtab; int reps;
    __device__ __forceinline__ int rounds() const { return (NT * nN + G - 1) / G; }
    __device__ __forceinline__ bool next(int i, Unit& u) const { const int r = rounds(); if (i >= r * reps) return false; return static_next(NT, nN, G, c, i % r, u); }
    __device__ __forceinline__ const char* b_base(const Unit& u) const { return B + (size_t)tile_e[u.pm] * estride + (size_t)u.pn * BM * K2; }
    __device__ __forceinline__ unsigned a_off(int ui, const Unit& u, int r) const { return gather ? rowtab[(ui % rounds()) * 256 + r] : (unsigned)(u.pm * BM + r) * (unsigned)K2; }
};

struct EpiProj {
    static constexpr bool PERM = true;
    bf16* O; const float* RS;
    __device__ __forceinline__ void operator()(const f32x4 (&acc)[2][2][4][2], const Unit& u, int, int wr, int wc, int fr, int fq) const {
        const int row0 = u.pm * BM + 16 * ((u.pm >> 4) + 1) + wr * 64 + fr, col0 = u.pn * BM + wc * 32 + 8 * fq;
        float rs[2][4];
#pragma unroll
        for (int ai = 0; ai < 2; ++ai)
#pragma unroll
            for (int m = 0; m < 4; ++m) rs[ai][m] = RS[u.pm * BM + wr * 64 + fr + ai * HALF + m * 16];
#pragma unroll
        for (int ai = 0; ai < 2; ++ai)
#pragma unroll
            for (int m = 0; m < 4; ++m) { bf16* rowp = O + (size_t)(row0 + ai * HALF + m * 16) * INW + col0;
#pragma unroll
                for (int bj = 0; bj < 2; ++bj) { const f32x4 v0 = acc[ai][bj][m][0] * rs[ai][m], v1 = acc[ai][bj][m][1] * rs[ai][m];
                    u32x4 w; w.x = cvt_pk_bf16(v0[0], v0[1]); w.y = cvt_pk_bf16(v0[2], v0[3]); w.z = cvt_pk_bf16(v1[0], v1[1]); w.w = cvt_pk_bf16(v1[2], v1[3]);
                    *(u32x4*)(rowp + bj * HALF) = w; } }
    }
};
struct EpiResid {
    static constexpr bool PERM = true;
    const bf16* X; const float* G2; bf16* H1; unsigned char* HN2;
    __device__ __forceinline__ void operator()(const f32x4 (&acc)[2][2][4][2], const Unit& u, int, int wr, int wc, int fr, int fq) const {
        const int row0 = u.pm * BM + wr * 64 + fr, col0 = u.pn * BM + wc * 32 + 8 * fq;
        f32x4 gv[2][2];
#pragma unroll
        for (int bj = 0; bj < 2; ++bj)
#pragma unroll
            for (int n = 0; n < 2; ++n) gv[bj][n] = *(const f32x4*)(G2 + col0 + bj * HALF + 4 * n);
#pragma unroll
        for (int ai = 0; ai < 2; ++ai) { u32x4 xv[4][2];
#pragma unroll
            for (int m = 0; m < 4; ++m) { const size_t off = (size_t)(row0 + ai * HALF + m * 16) * D + col0;
#pragma unroll
                for (int bj = 0; bj < 2; ++bj) xv[m][bj] = *(const u32x4*)(X + off + bj * HALF); }
#pragma unroll
            for (int m = 0; m < 4; ++m) { const size_t off = (size_t)(row0 + ai * HALF + m * 16) * D + col0;
#pragma unroll
                for (int bj = 0; bj < 2; ++bj) { const u32x4 xw = xv[m][bj];
                    const f32x4 v0 = acc[ai][bj][m][0] + (f32x4){bflo(xw.x), bfhi(xw.x), bflo(xw.y), bfhi(xw.y)}, v1 = acc[ai][bj][m][1] + (f32x4){bflo(xw.z), bfhi(xw.z), bflo(xw.w), bfhi(xw.w)};
                    u32x4 w; w.x = cvt_pk_bf16(v0[0], v0[1]); w.y = cvt_pk_bf16(v0[2], v0[3]); w.z = cvt_pk_bf16(v1[0], v1[1]); w.w = cvt_pk_bf16(v1[2], v1[3]);
                    *(u32x4*)(H1 + off + bj * HALF) = w;
                    const f32x4 t0 = v0 * gv[bj][0], t1 = v1 * gv[bj][1];
                    u32x2 e; e.x = pk4_fp8(clamp448(t0[0]), clamp448(t0[1]), clamp448(t0[2]), clamp448(t0[3])); e.y = pk4_fp8(clamp448(t1[0]), clamp448(t1[1]), clamp448(t1[2]), clamp448(t1[3]));
                    *(u32x2*)(HN2 + off + bj * HALF) = e; } }
            asm volatile("" ::: "memory"); }
    }
};
struct EpiGateUp {
    static constexpr bool PERM = true;
    unsigned char* H; const LAS float* rstd; int rounds;
    __device__ __forceinline__ void operator()(const f32x4 (&acc)[2][2][4][2], const Unit& u, int ui_, int wr, int wc, int fr, int fq) const {
        const int ui = ui_ % rounds;
        const int r0 = wr * 64 + fr, col0 = u.pn * HALF + wc * 32 + 8 * fq;
#pragma unroll
        for (int ai = 0; ai < 2; ++ai)
#pragma unroll
            for (int m = 0; m < 4; ++m) { const int r = r0 + ai * HALF + m * 16; const float rs = rstd[ui * 256 + r];
                float h[8];
#pragma unroll
                for (int n = 0; n < 2; ++n)
#pragma unroll
                    for (int j = 0; j < 4; ++j) { const float g = acc[ai][0][m][n][j] * rs, up = acc[ai][1][m][n][j] * rs; h[n * 4 + j] = g * sigmoidf_(g) * up; }
#pragma unroll
                for (int j = 0; j < 8; ++j) h[j] = clamp448(h[j] * HID_SCALE);
                u32x2 w; w.x = pk4_fp8(h[0], h[1], h[2], h[3]); w.y = pk4_fp8(h[4], h[5], h[6], h[7]);
                *(u32x2*)(H + (size_t)(u.pm * BM + r) * EFF + col0) = w; }
    }
};
struct EpiDown {
    static constexpr bool PERM = true;
    unsigned char* C; const LAS int* slot; const LAS float* gate; int rounds;
    __device__ __forceinline__ void operator()(const f32x4 (&acc)[2][2][4][2], const Unit& u, int ui_, int wr, int wc, int fr, int fq) const {
        const int ui = ui_ % rounds;
        const int r0 = wr * 64 + fr, col0 = u.pn * BM + wc * 32 + 8 * fq;
#pragma unroll
        for (int ai = 0; ai < 2; ++ai)
#pragma unroll
            for (int m = 0; m < 4; ++m) { const int r = r0 + ai * HALF + m * 16; const int sl = slot[ui * 256 + r]; const float gt = gate[ui * 256 + r];
                if (sl >= 0) { unsigned char* rowp = C + (size_t)sl * D + col0;
#pragma unroll
                    for (int bj = 0; bj < 2; ++bj) { const f32x4 v0 = acc[ai][bj][m][0] * gt, v1 = acc[ai][bj][m][1] * gt;
                        u32x2 w; w.x = pk4_fp8(clamp448(v0[0]), clamp448(v0[1]), clamp448(v0[2]), clamp448(v0[3])); w.y = pk4_fp8(clamp448(v1[0]), clamp448(v1[1]), clamp448(v1[2]), clamp448(v1[3]));
                        *(u32x2*)(rowp + bj * HALF) = w; } } }
    }
};
}

struct Frame {
    LAS unsigned char* lds; int tid, lane, wave, G, bx;
    const float *x, *meta, *g1, *w_in, *conv_w, *conv_b, *wa, *ba, *wx, *bx_, *lam, *lru_gain, *pool_w, *pool_scale, *w_out, *g2, *w_group, *b_group, *w_router, *b_router, *w_gate, *w_up, *w_down, *final_gain;
    float* out; unsigned char* ws; unsigned* ctl;
    bf16 *WinT, *WoutT, *WaT, *WxT, *PwT, *HN1, *YMIX, *PROJ, *H1; unsigned char *WguT, *WdT, *HN2, *HID, *C;
    _Float16* WrH; float* AGG; float* HM; float* RS1; u32x4* AB; f32x4* RINFO;
};
__device__ __forceinline__ float wave_sum(float v) {
#pragma unroll
    for (int o = 1; o < 64; o <<= 1) v += __shfl_xor(v, o);
    return v;
}

__device__ __forceinline__ void transpose_tile(const float* W, int ldw, int k0, int n0, bf16* WT, int ldt, int drow0, LAS float* scr, int lane, const float* kscale = nullptr) {
    { float v[32];
#pragma unroll
      for (int i = 0; i < 32; ++i) v[i] = W[(size_t)(k0 + 2 * i + (lane >> 5)) * ldw + n0 + (lane & 31)];
#pragma unroll
      for (int i = 0; i < 32; ++i) scr[(2 * i + (lane >> 5)) * 33 + (lane & 31)] = v[i]; }
    LDS_WAIT(); asm volatile("" ::: "memory");
    const int c = lane & 7;
    f32x4 ks0 = (f32x4){1.f, 1.f, 1.f, 1.f}, ks1 = ks0; if (kscale) { ks0 = *(const f32x4*)(kscale + k0 + 8 * c); ks1 = *(const f32x4*)(kscale + k0 + 8 * c + 4); }
#pragma unroll
    for (int j = 0; j < 4; ++j) { const int n = (lane >> 3) + 8 * j; const LAS float* s = scr + (8 * c) * 33 + n;
        u32x4 o; o.x = pk2(s[0 * 33] * ks0.x, s[1 * 33] * ks0.y); o.y = pk2(s[2 * 33] * ks0.z, s[3 * 33] * ks0.w); o.z = pk2(s[4 * 33] * ks1.x, s[5 * 33] * ks1.y); o.w = pk2(s[6 * 33] * ks1.z, s[7 * 33] * ks1.w);
        *(u32x4*)(WT + (size_t)(drow0 + n) * ldt + k0 + 8 * c) = o; }
    LDS_WAIT(); asm volatile("" ::: "memory");
}
__device__ __forceinline__ void transpose_tile_fp8(const float* W, int ldw, int k0, int n0, unsigned char* WT, int ldt, int drow0, float scale, LAS float* scr, int lane) {
    { float v[64];
#pragma unroll
      for (int i = 0; i < 64; ++i) v[i] = W[(size_t)(k0 + 2 * i + (lane >> 5)) * ldw + n0 + (lane & 31)];
#pragma unroll
      for (int i = 0; i < 64; ++i) scr[(2 * i + (lane >> 5)) * 33 + (lane & 31)] = v[i]; }
    LDS_WAIT(); asm volatile("" ::: "memory");
    const int n = lane >> 1, kh = (lane & 1) * 64; const LAS float* sp = scr + kh * 33 + n;
#pragma unroll
    for (int c = 0; c < 4; ++c) { u32x4 o;
#pragma unroll
        for (int w = 0; w < 4; ++w) { const LAS float* q4 = sp + (16 * c + 4 * w) * 33; o[w] = pk4_fp8(q4[0] * scale, q4[33] * scale, q4[66] * scale, q4[99] * scale); }
        *(u32x4*)(WT + (size_t)(drow0 + n) * ldt + k0 + kh + 16 * c) = o; }
    LDS_WAIT(); asm volatile("" ::: "memory");
}
constexpr int XT_G = NE * 8 * 16, XT_D = NE * 4 * 32, XT_N = 2 * XT_G + XT_D;
struct XTile { const float* src; unsigned char* dst; unsigned lsrc, ldst; int ldw; float scale; };
__device__ __forceinline__ XTile xtile_decode(const Frame& F, int r, int lane) {
    XTile t; const int n = lane & 31, kh = 64 * (lane >> 5);
    if (r < 2 * XT_G) { const int up = r >= XT_G; if (up) r -= XT_G; const int e = r >> 7, kb = (r >> 4) & 7, nb = r & 15, n0 = 32 * nb;
        t.src = (up ? F.w_up : F.w_gate) + (size_t)e * D * EFF + (size_t)(128 * kb) * EFF + n0; t.ldw = EFF; t.lsrc = (unsigned)(kh * EFF + n);
        t.dst = F.WguT + (size_t)e * 1024 * D + (size_t)((n0 >> 7) * 256 + up * 128 + (n0 & 127)) * D + 128 * kb; t.ldst = (unsigned)(n * D + kh); t.scale = WGU_SCALE; }
    else { r -= 2 * XT_G; const int e = r >> 7, kb = (r >> 5) & 3, nb = r & 31;
        t.src = F.w_down + (size_t)e * EFF * D + (size_t)(128 * kb) * D + 32 * nb; t.ldw = D; t.lsrc = (unsigned)(kh * D + n);
        t.dst = F.WdT + (size_t)e * D * EFF + (size_t)(32 * nb) * EFF + 128 * kb; t.ldst = (unsigned)(n * EFF + kh); t.scale = WD_SCALE; }
    return t;
}
__device__ __forceinline__ void xtile_load(const XTile& t, float (&v)[64]) {
#pragma unroll
    for (int i = 0; i < 64; ++i) v[i] = (t.src + (size_t)i * t.ldw)[t.lsrc];
}
__device__ __forceinline__ void xtile_store(const XTile& t, const float (&v)[64]) {
#pragma unroll
    for (int c = 0; c < 4; ++c) { u32x4 o;
#pragma unroll
        for (int w = 0; w < 4; ++w) o[w] = pk4_fp8(v[16 * c + 4 * w] * t.scale, v[16 * c + 4 * w + 1] * t.scale, v[16 * c + 4 * w + 2] * t.scale, v[16 * c + 4 * w + 3] * t.scale);
        *(u32x4*)(t.dst + t.ldst + 16 * c) = o; }
}
__device__ __forceinline__ void xtile_batch(const Frame& F, int lo, int hi) {
    for (int xi = lo + F.bx * 8 + F.wave; xi < hi; xi += F.G * 8) { const XTile xt = xtile_decode(F, xi, F.lane); float xv[64]; xtile_load(xt, xv); xtile_store(xt, xv); }
}
__device__ __forceinline__ void p0_prologue(Frame& F) {
    if (F.bx < INW / 8) {
        LAS float* hnm = (LAS float*)F.lds;
        LAS float* part = (LAS float*)(F.lds + 65536);
        for (int r = F.wave * 2; r < F.wave * 2 + 2; ++r) {
            const f32x4* xr = (const f32x4*)(F.meta + (size_t)r * D) + F.lane; f32x4 v[4]; float s = 0.f;
#pragma unroll
            for (int j = 0; j < 4; ++j) { v[j] = xr[64 * j]; s += (v[j].x * v[j].x + v[j].y * v[j].y) + (v[j].z * v[j].z + v[j].w * v[j].w); }
            const float rstd = rsqrtf(wave_sum(s) * (1.f / D) + RMS_EPS);
#pragma unroll
            for (int j = 0; j < 4; ++j) { const f32x4 g = ((const f32x4*)F.g1)[F.lane + 64 * j]; *(LAS f32x4*)(hnm + r * D + 4 * F.lane + 256 * j) = v[j] * rstd * g; }
        }
        __syncthreads();
        { const int cc = F.tid & 7, ks = F.tid >> 3, col = F.bx * 8 + cc; float a[16];
#pragma unroll
            for (int r = 0; r < 16; ++r) a[r] = 0.f;
            for (int k = ks * 16; k < ks * 16 + 16; ++k) { const float w = F.w_in[(size_t)k * INW + col];
#pragma unroll
                for (int r = 0; r < 16; ++r) a[r] += hnm[r * D + k] * w; }
#pragma unroll
            for (int r = 0; r < 16; ++r) part[(ks * 16 + r) * 8 + cc] = a[r]; }
        __syncthreads();
        if (F.tid < 128) { const int r = F.tid >> 3, cc = F.tid & 7; float s = 0.f;
            for (int ks = 0; ks < 64; ++ks) s += part[(ks * 16 + r) * 8 + cc];
            const bf16 h = (bf16)f2bf(s);
            for (int b = 0; b < NBATCH; ++b) F.PROJ[(size_t)(b * TT + r) * INW + F.bx * 8 + cc] = h; }
        __syncthreads();
    }
    LAS float* scr = (LAS float*)(F.lds + F.wave * 16896);
    const int gw = F.bx * 8 + F.wave, NGW = F.G * 8;
    constexpr int I_IN = 16 * 48, I_OUT = 16 * 32, I_A = 8 * 2, I_P = 4 * 2 * 4;
    constexpr int NITEMS = I_IN + I_OUT + 2 * I_A + I_P;
    for (int it = gw; it < NITEMS; it += NGW) {
        int r = it;
        if (r < I_IN) { const int kb = r / 48, nb = r % 48; transpose_tile(F.w_in, INW, 64 * kb, 32 * nb, F.WinT, D, 32 * nb, scr, F.lane, F.g1); continue; } r -= I_IN;
        if (r < I_OUT) { const int kb = r / 32, nb = r % 32; transpose_tile(F.w_out, D, 64 * kb, 32 * nb, F.WoutT, D, 32 * nb, scr, F.lane); continue; } r -= I_OUT;
        if (r < 2 * I_A) { const int x = r >= I_A; if (x) r -= I_A; const int h = r >> 1, nb = r & 1; transpose_tile((x ? F.wx : F.wa) + (size_t)h * 4096, 64, 0, 32 * nb, (x ? F.WxT : F.WaT) + (size_t)h * 4096, 64, 32 * nb, scr, F.lane); continue; } r -= 2 * I_A;
        { const int g = r >> 3, kb = (r >> 2) & 1, nb = r & 3; transpose_tile(F.pool_w + (size_t)g * 16384, 128, 64 * kb, 32 * nb, F.PwT + (size_t)g * 16384, 128, 32 * nb, scr, F.lane); }
    }
    for (int i = F.bx * 512 + F.tid; i < NROUTE * D; i += F.G * 512) { const int n = i >> 10, k = i & 1023;
        const float w = n < 4 ? F.w_group[k * 4 + n] : F.w_router[k * 32 + (n - 4)]; F.WrH[i] = (_Float16)(w * 256.0f); }
    { f32x4 g[4];
#pragma unroll
      for (int j = 0; j < 4; ++j) g[j] = ((const f32x4*)F.g1)[F.lane + 64 * j];
      for (int m = gw * 4; m < M; m += NGW * 4) {
        f32x4 v[4][4];
#pragma unroll
        for (int r = 0; r < 4; ++r)
#pragma unroll
            for (int j = 0; j < 4; ++j) v[r][j] = ((const f32x4*)(F.x + (size_t)(m + r) * D))[F.lane + 64 * j];
#pragma unroll
        for (int r = 0; r < 4; ++r) { float s = 0.f;
#pragma unroll
            for (int j = 0; j < 4; ++j) s += (v[r][j].x * v[r][j].x + v[r][j].y * v[r][j].y) + (v[r][j].z * v[r][j].z + v[r][j].w * v[r][j].w);
            const float rstd = rsqrtf(wave_sum(s) * (1.f / D) + RMS_EPS);
            if (F.lane == 0) F.RS1[m + r] = rstd;
            u32x2* o8 = (u32x2*)(F.HN1 + (size_t)(m + r) * D) + F.lane;
#pragma unroll
            for (int j = 0; j < 4; ++j) { const f32x4 y = v[r][j]; u32x2 w; w.x = pk2(y.x, y.y); w.y = pk2(y.z, y.w); o8[64 * j] = w; } }
      } }
}

template <int CTRL> __device__ __forceinline__ float dpp_f(float old, float src) {
    return __builtin_bit_cast(float, __builtin_amdgcn_update_dpp(__builtin_bit_cast(int, old), __builtin_bit_cast(int, src), CTRL, 0xf, 0xf, false)); }
#define DPP_BCAST15 0x15F
__device__ __forceinline__ void row_scan(float& A, float& B) {
    { const float Ap = dpp_f<0x111>(1.0f, A), Bp = dpp_f<0x111>(0.0f, B); B = A * Bp + B; A = A * Ap; }
    { const float Ap = dpp_f<0x112>(1.0f, A), Bp = dpp_f<0x112>(0.0f, B); B = A * Bp + B; A = A * Ap; }
    { const float Ap = dpp_f<0x114>(1.0f, A), Bp = dpp_f<0x114>(0.0f, B); B = A * Bp + B; A = A * Ap; }
    { const float Ap = dpp_f<0x118>(1.0f, A), Bp = dpp_f<0x118>(0.0f, B); B = A * Bp + B; A = A * Ap; }
}
#define SCAN8_STR(D) "s_nop 1\n\t" \
    "v_fmac_f32_dpp %0, %0, %8 row_shr:" #D " row_mask:0xf bank_mask:0xf\n\tv_mul_f32_dpp %8, %8, %8 row_shr:" #D " row_mask:0xf bank_mask:0xf\n\t" \
    "v_fmac_f32_dpp %1, %1, %9 row_shr:" #D " row_mask:0xf bank_mask:0xf\n\tv_mul_f32_dpp %9, %9, %9 row_shr:" #D " row_mask:0xf bank_mask:0xf\n\t" \
    "v_fmac_f32_dpp %2, %2, %10 row_shr:" #D " row_mask:0xf bank_mask:0xf\n\tv_mul_f32_dpp %10, %10, %10 row_shr:" #D " row_mask:0xf bank_mask:0xf\n\t" \
    "v_fmac_f32_dpp %3, %3, %11 row_shr:" #D " row_mask:0xf bank_mask:0xf\n\tv_mul_f32_dpp %11, %11, %11 row_shr:" #D " row_mask:0xf bank_mask:0xf\n\t" \
    "v_fmac_f32_dpp %4, %4, %12 row_shr:" #D " row_mask:0xf bank_mask:0xf\n\tv_mul_f32_dpp %12, %12, %12 row_shr:" #D " row_mask:0xf bank_mask:0xf\n\t" \
    "v_fmac_f32_dpp %5, %5, %13 row_shr:" #D " row_mask:0xf bank_mask:0xf\n\tv_mul_f32_dpp %13, %13, %13 row_shr:" #D " row_mask:0xf bank_mask:0xf\n\t" \
    "v_fmac_f32_dpp %6, %6, %14 row_shr:" #D " row_mask:0xf bank_mask:0xf\n\tv_mul_f32_dpp %14, %14, %14 row_shr:" #D " row_mask:0xf bank_mask:0xf\n\t" \
    "v_fmac_f32_dpp %7, %7, %15 row_shr:" #D " row_mask:0xf bank_mask:0xf\n\tv_mul_f32_dpp %15, %15, %15 row_shr:" #D " row_mask:0xf bank_mask:0xf"
#define SCAN8(D, A, B, o) asm volatile(SCAN8_STR(D) : "+v"(B[o + 0]), "+v"(B[o + 1]), "+v"(B[o + 2]), "+v"(B[o + 3]), "+v"(B[o + 4]), "+v"(B[o + 5]), "+v"(B[o + 6]), "+v"(B[o + 7]), \
    "+v"(A[o + 0]), "+v"(A[o + 1]), "+v"(A[o + 2]), "+v"(A[o + 3]), "+v"(A[o + 4]), "+v"(A[o + 5]), "+v"(A[o + 6]), "+v"(A[o + 7]))
__device__ __forceinline__ void row_scan16(float (&A)[16], float (&B)[16]) {
    SCAN8(1, A, B, 0); SCAN8(1, A, B, 8); SCAN8(2, A, B, 0); SCAN8(2, A, B, 8); SCAN8(4, A, B, 0); SCAN8(4, A, B, 8); SCAN8(8, A, B, 0); SCAN8(8, A, B, 8);
}
struct LruW { LAS float* cst; const bf16 *waP, *wxP; };
__device__ __forceinline__ void lru_setup(const Frame& F, LruW& L, LAS unsigned char* wbase) {
    const int hd = F.wave; L.cst = (LAS float*)wbase;
    for (int i = F.lane; i < 512; i += 64) { const int t = i >> 6, ch = hd * 64 + (i & 63); float v;
        if (t < 4) v = F.conv_w[t * LW + ch]; else if (t == 4) v = F.conv_b[ch]; else if (t == 5) v = F.ba[ch]; else if (t == 6) v = F.bx_[ch];
        else { const float lm = F.lam[ch]; v = 8.0f * (fminf(lm, 0.f) - log1pf(__expf(-fabsf(lm)))); }
        L.cst[i] = v; }
    const int i = F.lane & 15, qw = F.lane >> 4; const size_t o = (size_t)hd * 4096 + (size_t)(8 * (i >> 2) + (i & 3)) * 64 + 8 * qw;
    L.waP = F.WaT + o; L.wxP = F.WxT + o;
    LDS_WAIT();
}
struct LruRaw { u32x4 u[2][4]; u32x4 ug[2]; };
template <bool WITH_UG>
__device__ __forceinline__ void lru_load(const Frame& F, int b, int tt0, LruRaw& R) {
    const int hd = F.wave, row = F.lane & 15, q = F.lane >> 4, tt = tt0 + row;
    const bf16* prow = F.PROJ + (size_t)(b * TT + tt) * INW + hd * 64 + 8 * q;
#pragma unroll
    for (int kb = 0; kb < 2; ++kb) {
#pragma unroll
        for (int k = 0; k < 4; ++k) { R.u[kb][k] = (u32x4){0u, 0u, 0u, 0u}; if (tt - 3 + k >= 0) R.u[kb][k] = *(const u32x4*)(prow + (ptrdiff_t)(k - 3) * INW + 32 * kb); }
        if (WITH_UG) R.ug[kb] = *(const u32x4*)(prow + LW + 32 * kb);
    }
}
__device__ __forceinline__ void lru_conv(const Frame& F, const LruW& L, const LruRaw& R, float (&xc)[16], bf16x8 (&xf)[2]) {
    const int q = F.lane >> 4;
#pragma unroll
    for (int kb = 0; kb < 2; ++kb) {
        const LAS float* cs = L.cst + 32 * kb + 8 * q;
        f32x2 x2[4];
        { const f32x4 c0 = *(const LAS f32x4*)(cs + 256), c1 = *(const LAS f32x4*)(cs + 260); x2[0] = (f32x2){c0.x, c0.y}; x2[1] = (f32x2){c0.z, c0.w}; x2[2] = (f32x2){c1.x, c1.y}; x2[3] = (f32x2){c1.z, c1.w}; }
#pragma unroll
        for (int k = 0; k < 4; ++k) {
            const u32x4 u = R.u[kb][k];
            const f32x4 w0 = *(const LAS f32x4*)(cs + 64 * k), w1 = *(const LAS f32x4*)(cs + 64 * k + 4);
            x2[0] = (f32x2){w0.x, w0.y} * (f32x2){bflo(u.x), bfhi(u.x)} + x2[0]; x2[1] = (f32x2){w0.z, w0.w} * (f32x2){bflo(u.y), bfhi(u.y)} + x2[1];
            x2[2] = (f32x2){w1.x, w1.y} * (f32x2){bflo(u.z), bfhi(u.z)} + x2[2]; x2[3] = (f32x2){w1.z, w1.w} * (f32x2){bflo(u.w), bfhi(u.w)} + x2[3];
        }
#pragma unroll
        for (int i = 0; i < 4; ++i) { xc[8 * kb + 2 * i] = x2[i].x; xc[8 * kb + 2 * i + 1] = x2[i].y; }
        asm volatile("" : "+v"(xc[8 * kb + 0]), "+v"(xc[8 * kb + 1]), "+v"(xc[8 * kb + 2]), "+v"(xc[8 * kb + 3]), "+v"(xc[8 * kb + 4]), "+v"(xc[8 * kb + 5]), "+v"(xc[8 * kb + 6]), "+v"(xc[8 * kb + 7]));
        u32x4 p; p.x = pk2(xc[8 * kb + 0], xc[8 * kb + 1]); p.y = pk2(xc[8 * kb + 2], xc[8 * kb + 3]); p.z = pk2(xc[8 * kb + 4], xc[8 * kb + 5]); p.w = pk2(xc[8 * kb + 6], xc[8 * kb + 7]);
        xf[kb] = __builtin_bit_cast(bf16x8, p);
    }
}
template <bool WPF  >
__device__ __forceinline__ void lru_gates(const Frame& F, const LruW& L, const float (&xc)[16], const bf16x8 (&xf)[2], float (&Av)[16], float (&Bv)[16]) {
    const int q = F.lane >> 4;
    bf16x8 wa[2], wx[2];
#pragma unroll
    for (int kk = 0; kk < 2; ++kk) { wa[kk] = *(const bf16x8*)(L.waP + 32 * kk); wx[kk] = *(const bf16x8*)(L.wxP + 32 * kk); }
#pragma unroll
    for (int nb = 0; nb < 4; ++nb) {
        const int kb = nb >> 1, hf = nb & 1;
        bf16x8 wan[2], wxn[2];
        if (!WPF && nb > 0) { const int o = (32 * kb + 4 * hf) * 64;
#pragma unroll
            for (int kk = 0; kk < 2; ++kk) { wa[kk] = *(const bf16x8*)(L.waP + o + 32 * kk); wx[kk] = *(const bf16x8*)(L.wxP + o + 32 * kk); } }
        if (WPF && nb < 3) { const int o = (32 * ((nb + 1) >> 1) + 4 * ((nb + 1) & 1)) * 64;
#pragma unroll
            for (int kk = 0; kk < 2; ++kk) { wan[kk] = *(const bf16x8*)(L.waP + o + 32 * kk); wxn[kk] = *(const bf16x8*)(L.wxP + o + 32 * kk); } }
        asm volatile("" ::: "memory");
        f32x4 ra = (f32x4){0.f, 0.f, 0.f, 0.f}, rx = ra;
#pragma unroll
        for (int kk = 0; kk < 2; ++kk) { ra = __builtin_amdgcn_mfma_f32_16x16x32_bf16(wa[kk], xf[kk], ra, 0, 0, 0); rx = __builtin_amdgcn_mfma_f32_16x16x32_bf16(wx[kk], xf[kk], rx, 0, 0, 0); }
        const LAS float* cs = L.cst + 32 * kb + 8 * q + 4 * hf;
        const f32x4 ba4 = *(const LAS f32x4*)(cs + 320), bx4 = *(const LAS f32x4*)(cs + 384), lm4 = *(const LAS f32x4*)(cs + 448);
#pragma unroll
        for (int j = 0; j < 4; ++j) { const int c = 8 * kb + 4 * hf + j;
            const float r = sigmoidf_(ra[j] + ba4[j]), ig = sigmoidf_(rx[j] + bx4[j]);
            const float a = __expf(lm4[j] * r);
            Av[c] = a; Bv[c] = __builtin_amdgcn_sqrtf(fmaf(-a, a, 1.0f)) * (ig * xc[c]); }
        if (WPF && nb < 3) {
#pragma unroll
            for (int kk = 0; kk < 2; ++kk) { wa[kk] = wan[kk]; wx[kk] = wxn[kk]; } }
    }
    row_scan16(Av, Bv);
}
__device__ __forceinline__ void p2_aggregates(Frame& F) {
    LruW L; lru_setup(F, L, F.lds + F.wave * 2048);
    const int row = F.lane & 15, q = F.lane >> 4;
    for (int ch = F.bx; ch < 256; ch += F.G) {
        const int b = ch >> 5, ci = ch & 31; float Ac[16], Bc[16];
#pragma unroll
        for (int c = 0; c < 16; ++c) { Ac[c] = 1.f; Bc[c] = 0.f; }
        const int blk0 = (ci == 0 ? -1 : 0);
        LruRaw R; lru_load<false>(F, b, NMETA + 128 * ci + 16 * blk0, R);
        for (int blk = blk0; blk < 8; ++blk) {
            float xc[16]; bf16x8 xf[2]; lru_conv(F, L, R, xc, xf);
            if (blk < 7) lru_load<false>(F, b, NMETA + 128 * ci + 16 * (blk + 1), R);
            asm volatile("" ::: "memory");
            float Av[16], Bv[16];
            lru_gates<true>(F, L, xc, xf, Av, Bv);
            if (blk >= 0) { u32x4* ab = F.AB + ((size_t)((ch * 8 + blk) * 8 + F.wave) * 4) * 64 + F.lane;
#pragma unroll
                for (int j = 0; j < 2; ++j) { u32x4 a, bq;
                    a.x = pkh2(Av[8 * j], Av[8 * j + 1]); a.y = pkh2(Av[8 * j + 2], Av[8 * j + 3]); a.z = pkh2(Av[8 * j + 4], Av[8 * j + 5]); a.w = pkh2(Av[8 * j + 6], Av[8 * j + 7]);
                    bq.x = pkh2(Bv[8 * j], Bv[8 * j + 1]); bq.y = pkh2(Bv[8 * j + 2], Bv[8 * j + 3]); bq.z = pkh2(Bv[8 * j + 4], Bv[8 * j + 5]); bq.w = pkh2(Bv[8 * j + 6], Bv[8 * j + 7]);
                    ab[64 * j] = a; ab[64 * (2 + j)] = bq; } }
            else if (row == 15) {
#pragma unroll
                for (int kb = 0; kb < 2; ++kb) { float* o = F.HM + (size_t)b * LW + F.wave * 64 + 32 * kb + 8 * q;
                    *(f32x4*)o = (f32x4){Bv[8 * kb], Bv[8 * kb + 1], Bv[8 * kb + 2], Bv[8 * kb + 3]}; *(f32x4*)(o + 4) = (f32x4){Bv[8 * kb + 4], Bv[8 * kb + 5], Bv[8 * kb + 6], Bv[8 * kb + 7]}; } }
#pragma unroll
            for (int c = 0; c < 16; ++c) { Bc[c] = Av[c] * Bc[c] + Bv[c]; Ac[c] *= Av[c]; }
        }
        if (row == 15) {
#pragma unroll
            for (int kb = 0; kb < 2; ++kb) { float* o = F.AGG + ((size_t)ch * LW + F.wave * 64 + 32 * kb + 8 * q) * 2;
#pragma unroll
                for (int j = 0; j < 8; j += 2) *(f32x4*)(o + 2 * j) = (f32x4){Ac[8 * kb + j], Bc[8 * kb + j], Ac[8 * kb + j + 1], Bc[8 * kb + j + 1]}; }
        }
    }
}

constexpr int YT_STRIDE = 520;
constexpr int US_STRIDE = 264;
constexpr int PW_STRIDE = 136;
template <int G> __device__ __forceinline__ void pool_z(const LAS bf16* ub  , bf16x8 (&zf)[4]) {
    constexpr int W = 2 << G;
    asm volatile("" : "+v"(ub));
#pragma unroll
    for (int kb = 0; kb < 4; ++kb) {
        const LAS bf16* p = ub + 15 * US_STRIDE + 32 * kb; const u32x4 c = *(const LAS u32x4*)p; float cur[8], s[8];
        cur[0] = bflo(c.x); cur[1] = bfhi(c.x); cur[2] = bflo(c.y); cur[3] = bfhi(c.y); cur[4] = bflo(c.z); cur[5] = bfhi(c.z); cur[6] = bflo(c.w); cur[7] = bfhi(c.w);
#pragma unroll
        for (int j = 0; j < 8; ++j) s[j] = cur[j];
#pragma unroll
        for (int d = 1; d < W; ++d) { const u32x4 u = *(const LAS u32x4*)(ub + (15 - d) * US_STRIDE + 32 * kb);
            s[0] += bflo(u.x); s[1] += bfhi(u.x); s[2] += bflo(u.y); s[3] += bfhi(u.y); s[4] += bflo(u.z); s[5] += bfhi(u.z); s[6] += bflo(u.w); s[7] += bfhi(u.w);
            if ((d & 3) == 3) asm volatile("" : "+v"(s[0]), "+v"(s[1]), "+v"(s[2]), "+v"(s[3]), "+v"(s[4]), "+v"(s[5]), "+v"(s[6]), "+v"(s[7]) :: "memory"); }
        asm volatile("" : "+v"(s[0]), "+v"(s[1]), "+v"(s[2]), "+v"(s[3]), "+v"(s[4]), "+v"(s[5]), "+v"(s[6]), "+v"(s[7]) :: "memory");
        u32x4 pz; pz.x = pk2(s[0] * (1.0f / W) - cur[0], s[1] * (1.0f / W) - cur[1]); pz.y = pk2(s[2] * (1.0f / W) - cur[2], s[3] * (1.0f / W) - cur[3]);
        pz.z = pk2(s[4] * (1.0f / W) - cur[4], s[5] * (1.0f / W) - cur[5]); pz.w = pk2(s[6] * (1.0f / W) - cur[6], s[7] * (1.0f / W) - cur[7]);
        asm volatile("" : "+v"(pz) :: "memory");
        zf[kb] = __builtin_bit_cast(bf16x8, pz);
    }
}
__device__ __forceinline__ void p3_mixer(Frame& F) {
    LAS float* SSQ = (LAS float*)F.lds;
    LAS float* RSTD = SSQ + 512;
    LAS bf16* US = (LAS bf16*)F.lds;
    const int row = F.lane & 15, q = F.lane >> 4;
    for (int ch = F.bx; ch < 256; ch += F.G) {
        const int b = ch >> 5, ci = ch & 31; const int m0 = ch * 128;
#ifndef P3_NO_LRU
        {
        float H[16];
        { float Ar[16], Br[16];
#pragma unroll
            for (int c = 0; c < 16; ++c) { Ar[c] = 1.f; Br[c] = 0.f; }
#pragma unroll
            for (int t = 0; t < 2; ++t) { const int k = 2 * row + t;
                if (k < ci) {
#pragma unroll
                    for (int kb = 0; kb < 2; ++kb) { const float* o = F.AGG + ((size_t)(b * 32 + k) * LW + F.wave * 64 + 32 * kb + 8 * q) * 2;
#pragma unroll
                        for (int j = 0; j < 8; j += 2) { const f32x4 v = *(const f32x4*)(o + 2 * j); const int c = 8 * kb + j;
                            Br[c] = v.x * Br[c] + v.y; Ar[c] *= v.x; Br[c + 1] = v.z * Br[c + 1] + v.w; Ar[c + 1] *= v.z; } } } }
            row_scan16(Ar, Br);
#pragma unroll
            for (int c = 0; c < 16; ++c) H[c] = dpp_f<DPP_BCAST15>(0.f, Br[c]); }
        if (ci == 0) {
#pragma unroll
            for (int kb = 0; kb < 2; ++kb) { const float* o = F.HM + (size_t)b * LW + F.wave * 64 + 32 * kb + 8 * q; const f32x4 h0 = *(const f32x4*)o, h1 = *(const f32x4*)(o + 4);
                H[8 * kb] = h0.x; H[8 * kb + 1] = h0.y; H[8 * kb + 2] = h0.z; H[8 * kb + 3] = h0.w; H[8 * kb + 4] = h1.x; H[8 * kb + 5] = h1.y; H[8 * kb + 6] = h1.z; H[8 * kb + 7] = h1.w; }
        }
        u32x4 abv[4]; u32x4 ug[2];
        { const u32x4* ab = F.AB + ((size_t)((ch * 8 + 0) * 8 + F.wave) * 4) * 64 + F.lane;
#pragma unroll
          for (int j = 0; j < 4; ++j) abv[j] = ab[64 * j];
          const bf16* prow = F.PROJ + (size_t)(b * TT + NMETA + 128 * ci + row) * INW + LW + F.wave * 64 + 8 * q; ug[0] = *(const u32x4*)prow; ug[1] = *(const u32x4*)(prow + 32); }
        for (int half = 0; half < 2; ++half) {
        u32x4 yp[4][2];
#pragma unroll
        for (int blk = 0; blk < 4; ++blk) { const int gb = 4 * half + blk;
                float Av[16], Bv[16]; u32x4 ugc[2] = {ug[0], ug[1]};
#pragma unroll
                for (int j = 0; j < 2; ++j)
#pragma unroll
                    for (int i = 0; i < 4; ++i) { Av[8 * j + 2 * i] = h2lo(abv[j][i]); Av[8 * j + 2 * i + 1] = h2hi(abv[j][i]); Bv[8 * j + 2 * i] = h2lo(abv[2 + j][i]); Bv[8 * j + 2 * i + 1] = h2hi(abv[2 + j][i]); }
                if (gb < 7) { const u32x4* ab = F.AB + ((size_t)((ch * 8 + gb + 1) * 8 + F.wave) * 4) * 64 + F.lane;
#pragma unroll
                    for (int j = 0; j < 4; ++j) abv[j] = ab[64 * j];
                    const bf16* prow = F.PROJ + (size_t)(b * TT + NMETA + 128 * ci + 16 * (gb + 1) + row) * INW + LW + F.wave * 64 + 8 * q; ug[0] = *(const u32x4*)prow; ug[1] = *(const u32x4*)(prow + 32); }
                asm volatile("" ::: "memory");
                float ss = 0.f;
#pragma unroll
                for (int kb = 0; kb < 2; ++kb) { float y[8];
#pragma unroll
                    for (int j = 0; j < 8; ++j) { const int c = 8 * kb + j;
                        const float h = Av[c] * H[c] + Bv[c];
                        const unsigned w = ugc[kb][j >> 1]; const float g = (j & 1) ? bfhi(w) : bflo(w);
                        const float gl = g * sigmoidf_(1.5957691216f * (g + 0.044715f * g * g * g));
                        y[j] = h * gl; ss += y[j] * y[j];
                        H[c] = dpp_f<DPP_BCAST15>(0.f, h); }
                    u32x4 p; p.x = pk2(y[0], y[1]); p.y = pk2(y[2], y[3]); p.z = pk2(y[4], y[5]); p.w = pk2(y[6], y[7]);
                    yp[blk][kb] = p;
                    asm volatile("" : "+v"(ss) :: "memory"); }
                ss += __shfl_xor(ss, 16); ss += __shfl_xor(ss, 32);
                if (q == 0) SSQ[(16 * blk + row) * 8 + F.wave] = ss;
        }
        __syncthreads();
        if (F.tid < 64) { float sm = 0.f;
#pragma unroll
            for (int w = 0; w < 8; ++w) sm += SSQ[F.tid * 8 + w];
            RSTD[F.tid] = rsqrtf(sm * (1.0f / LW) + RMS_EPS); }
        __syncthreads();
        { f32x4 g0[2], g1[2];
#pragma unroll
          for (int kb = 0; kb < 2; ++kb) { g0[kb] = *(const f32x4*)(F.lru_gain + F.wave * 64 + 32 * kb + 8 * q); g1[kb] = *(const f32x4*)(F.lru_gain + F.wave * 64 + 32 * kb + 8 * q + 4); }
#pragma unroll
          for (int blk = 0; blk < 4; ++blk) { const float rs = RSTD[16 * blk + row];
#pragma unroll
            for (int kb = 0; kb < 2; ++kb) { const u32x4 v = yp[blk][kb];
                u32x4 o; o.x = pk2(bflo(v.x) * rs * g0[kb].x, bfhi(v.x) * rs * g0[kb].y); o.y = pk2(bflo(v.y) * rs * g0[kb].z, bfhi(v.y) * rs * g0[kb].w);
                o.z = pk2(bflo(v.z) * rs * g1[kb].x, bfhi(v.z) * rs * g1[kb].y); o.w = pk2(bflo(v.w) * rs * g1[kb].z, bfhi(v.w) * rs * g1[kb].w);
                *(u32x4*)(F.YMIX + (size_t)(m0 + 64 * half + 16 * blk + row) * D + F.wave * 64 + 32 * kb + 8 * q) = o; } } }
        __syncthreads();
        }
        }
#endif
#ifndef P3_NO_POOL
        for (int prep_ = 0; prep_ <= ((REPEAT_MASK >> 9) & 1); ++prep_)
        {
            bf16x8 zf[4][4];
            const int T0 = b * TT + NMETA + 128 * ci - 15;
            u32x4 sv[9];
#define POOL_STAGE_LOAD(gp) do { _Pragma("unroll") for (int t = 0; t < 9; ++t) { const int i = F.tid + 512 * t; if (i < 143 * 32) sv[t] = *(const u32x4*)(F.PROJ + (size_t)(T0 + (i >> 5)) * INW + 1024 + 256 * (gp) + 8 * (i & 31)); } } while (0)
#define POOL_STAGE_WRITE() do { _Pragma("unroll") for (int t = 0; t < 9; ++t) { const int i = F.tid + 512 * t; if (i < 143 * 32) *(LAS u32x4*)(US + (i >> 5) * US_STRIDE + 8 * (i & 31)) = sv[t]; } } while (0)
            const LAS bf16* urow = US + (16 * F.wave + row) * US_STRIDE + 8 * q;
            POOL_STAGE_LOAD(0); POOL_STAGE_WRITE(); __syncthreads();
            pool_z<0>(urow, zf[0]);
            POOL_STAGE_LOAD(1);
            pool_z<1>(urow + 128, zf[1]);
            __syncthreads();
            POOL_STAGE_WRITE(); __syncthreads();
            u32x4 wv[8];
#pragma unroll
            for (int t = 0; t < 4; ++t) { const int i = F.tid + 512 * t; wv[t] = *(const u32x4*)(F.PwT + (size_t)(i >> 4) * 128 + 8 * (i & 15)); }
            pool_z<2>(urow, zf[2]); pool_z<3>(urow + 128, zf[3]);
            __syncthreads();
#pragma unroll
            for (int t = 0; t < 4; ++t) { const int i = F.tid + 512 * t; *(LAS u32x4*)(US + (i >> 4) * PW_STRIDE + 8 * (i & 15)) = wv[t]; }
#pragma unroll
            for (int t = 4; t < 12; ++t) { const int i = F.tid + 512 * t; wv[t - 4] = *(const u32x4*)(F.PwT + (size_t)(i >> 4) * 128 + 8 * (i & 15)); }
#pragma unroll
            for (int t = 4; t < 12; ++t) { const int i = F.tid + 512 * t; *(LAS u32x4*)(US + (i >> 4) * PW_STRIDE + 8 * (i & 15)) = wv[t - 4]; }
#pragma unroll
            for (int t = 12; t < 16; ++t) { const int i = F.tid + 512 * t; wv[t - 12] = *(const u32x4*)(F.PwT + (size_t)(i >> 4) * 128 + 8 * (i & 15)); }
#pragma unroll
            for (int t = 12; t < 16; ++t) { const int i = F.tid + 512 * t; *(LAS u32x4*)(US + (i >> 4) * PW_STRIDE + 8 * (i & 15)) = wv[t - 12]; }
            __syncthreads();
#undef POOL_STAGE_LOAD
#undef POOL_STAGE_WRITE
            const LAS bf16* wl = US + row * PW_STRIDE + 8 * q;
            float ssq = 0.f; u32x2 po[4][8];
#pragma unroll
            for (int g = 0; g < 4; ++g) { const LAS bf16* wg = wl + g * 128 * PW_STRIDE; asm volatile("" : "+v"(wg));
#pragma unroll
                for (int nb = 0; nb < 8; ++nb) { f32x4 acc = (f32x4){0.f, 0.f, 0.f, 0.f}; const LAS bf16* wn = wg + 16 * nb * PW_STRIDE;
#pragma unroll
                    for (int kb = 0; kb < 4; ++kb) acc = __builtin_amdgcn_mfma_f32_16x16x32_bf16(*(const LAS bf16x8*)(wn + 32 * kb), zf[g][kb], acc, 0, 0, 0);
                    ssq += (acc[0] * acc[0] + acc[1] * acc[1]) + (acc[2] * acc[2] + acc[3] * acc[3]);
                    po[g][nb].x = pk2(acc[0], acc[1]); po[g][nb].y = pk2(acc[2], acc[3]);
                    if (nb & 1) asm volatile("" : "+v"(ssq) :: "memory"); } }
            ssq += __shfl_xor(ssq, 16); ssq += __shfl_xor(ssq, 32);
            const float rs = rsqrtf(ssq * (1.0f / 512.0f) + RMS_EPS);
            bf16* orow = F.YMIX + (size_t)(m0 + 16 * F.wave + row) * D + LW + 4 * q;
#pragma unroll
            for (int g = 0; g < 4; ++g) { f32x4 sc[8];
#pragma unroll
                for (int nb = 0; nb < 8; ++nb) sc[nb] = *(const f32x4*)(F.pool_scale + 128 * g + 16 * nb + 4 * q);
#pragma unroll
                for (int nb = 0; nb < 8; ++nb) { const u32x2 v = po[g][nb];
                    u32x2 o; o.x = pk2(bflo(v.x) * rs * sc[nb].x, bfhi(v.x) * rs * sc[nb].y); o.y = pk2(bflo(v.y) * rs * sc[nb].z, bfhi(v.y) * rs * sc[nb].w);
                    *(u32x2*)(orow + 128 * g + 16 * nb) = o; }
                asm volatile("" ::: "memory"); }
        }
#endif
        __syncthreads();
    }
}

constexpr int WR_STRIDE = 1032;
__device__ __forceinline__ void p5_route(Frame& F, const bool dry = false) {
    LAS _Float16* WR = (LAS _Float16*)F.lds;
    LAS float* LG = (LAS float*)(F.lds + 36 * WR_STRIDE * 2) + F.wave * 16 * 40;
    LAS int* LCNT = (LAS int*)(F.lds + 36 * WR_STRIDE * 2 + 8 * 16 * 40 * 4);
    LAS float* G2 = (LAS float*)(LCNT + 64);
    const int c16 = F.lane & 15, q = F.lane >> 4;
    for (int i = F.tid; i < NROUTE * 128; i += 512) { const int n = i >> 7, k8 = i & 127; *(LAS u32x4*)(WR + n * WR_STRIDE + 8 * k8) = *(const u32x4*)(F.WrH + n * D + 8 * k8); }
    for (int i = F.tid; i < D; i += 512) G2[i] = F.g2[i];
    for (int ch = F.bx; ch < 256; ch += F.G) {
        if (F.tid < 64) LCNT[F.tid] = 0;
        __syncthreads();
        const int row = ch * 128 + 16 * F.wave + c16;
        const bf16* hrow = F.H1 + (size_t)row * D + 8 * q;
        f32x4 acc[3]; float ss = 0.f;
#pragma unroll
        for (int nb = 0; nb < 3; ++nb) acc[nb] = (f32x4){0.f, 0.f, 0.f, 0.f};
#pragma unroll 4
        for (int i = 0; i < 32; ++i) {
            const u32x4 hw = *(const u32x4*)(hrow + 32 * i);
            const f32x4 h0 = (f32x4){bflo(hw.x), bfhi(hw.x), bflo(hw.y), bfhi(hw.y)}, h1 = (f32x4){bflo(hw.z), bfhi(hw.z), bflo(hw.w), bfhi(hw.w)};
            const f32x4 g0 = *(const LAS f32x4*)(G2 + 32 * i + 8 * q), g1 = *(const LAS f32x4*)(G2 + 32 * i + 8 * q + 4);
            ss += (h0.x * h0.x + h0.y * h0.y) + (h0.z * h0.z + h0.w * h0.w) + (h1.x * h1.x + h1.y * h1.y) + (h1.z * h1.z + h1.w * h1.w);
            const f32x4 t0 = h0 * g0, t1 = h1 * g1;
            f16x8 a; a[0] = (_Float16)t0.x; a[1] = (_Float16)t0.y; a[2] = (_Float16)t0.z; a[3] = (_Float16)t0.w; a[4] = (_Float16)t1.x; a[5] = (_Float16)t1.y; a[6] = (_Float16)t1.z; a[7] = (_Float16)t1.w;
#pragma unroll
            for (int nb = 0; nb < 3; ++nb) { const int col = 16 * nb + c16; f16x8 bw;
#pragma unroll
                for (int j = 0; j < 8; ++j) bw[j] = (_Float16)0.f;
                if (col < NROUTE) bw = *(const LAS f16x8*)(WR + col * WR_STRIDE + 32 * i + 8 * q);
                acc[nb] = __builtin_amdgcn_mfma_f32_16x16x32_f16(a, bw, acc[nb], 0, 0, 0); }
        }
        ss += __shfl_xor(ss, 16); ss += __shfl_xor(ss, 32);
        const float rstd = rsqrtf(ss * (1.0f / D) + RMS_EPS);
#pragma unroll
        for (int nb = 0; nb < 3; ++nb)
#pragma unroll
            for (int j = 0; j < 4; ++j) { const int col = 16 * nb + c16; if (col < 40) LG[(4 * q + j) * 40 + col] = acc[nb][j]; }
        LDS_WAIT();
        int e0 = 0, e1 = 0, rk0 = 0, rk1 = 0; float gt0 = 0.f, gt1 = 0.f;
        if (F.lane < 16) {
            const LAS float* lg = LG + F.lane * 40; const float sc = rstd * (1.0f / 256.0f);
            float gl[4]; int gi = 0;
#pragma unroll
            for (int j = 0; j < 4; ++j) gl[j] = lg[j] * sc + F.b_group[j];
            float gm = gl[0];
#pragma unroll
            for (int j = 1; j < 4; ++j) if (gl[j] > gm) { gm = gl[j]; gi = j; }
            float den = 0.f;
#pragma unroll
            for (int j = 0; j < 4; ++j) den += __expf(gl[j] - gm);
            const float pg = 1.0f / den;
            float v0 = -3.0e38f, v1 = -3.0e38f; int i0 = 0, i1 = 0;
            for (int j = 0; j < 8; ++j) { const float v = lg[4 + gi * 8 + j] * sc + F.b_router[gi * 8 + j];
                if (v > v0) { v1 = v0; i1 = i0; v0 = v; i0 = j; } else if (v > v1) { v1 = v; i1 = j; } }
            const float ex = __expf(v1 - v0), s0 = 1.0f / (1.0f + ex);
            gt0 = pg * s0; gt1 = pg * (ex * s0); e0 = gi * 8 + i0; e1 = gi * 8 + i1;
            rk0 = __hip_atomic_fetch_add(&LCNT[e0], 1, __ATOMIC_RELAXED, __HIP_MEMORY_SCOPE_WORKGROUP); rk1 = __hip_atomic_fetch_add(&LCNT[e1], 1, __ATOMIC_RELAXED, __HIP_MEMORY_SCOPE_WORKGROUP);
        }
        __syncthreads();
        if (F.tid < 32 && !dry) LCNT[32 + F.tid] = (int)__hip_atomic_fetch_add(F.ctl + CW_CNT + 64 * F.tid, (unsigned)LCNT[F.tid], __ATOMIC_RELAXED, __HIP_MEMORY_SCOPE_AGENT);
        __syncthreads();
        if (F.lane < 16 && !dry) { const int tok = ch * 128 + 16 * F.wave + F.lane;
            F.RINFO[(size_t)e0 * ECAP + LCNT[32 + e0] + rk0] = (f32x4){__builtin_bit_cast(float, tok * 2), gt0, rstd, 0.f};
            F.RINFO[(size_t)e1 * ECAP + LCNT[32 + e1] + rk1] = (f32x4){__builtin_bit_cast(float, tok * 2 + 1), gt1, rstd, 0.f}; }
        __syncthreads();
    }
}

__device__ __forceinline__ int moe_tables(Frame& F) {
    LAS int* TE = (LAS int*)(F.lds + TAB_TE); LAS int* TR = (LAS int*)(F.lds + TAB_TR); LAS int* CNT = (LAS int*)(F.lds + TAB_CNT); LAS int* PRE = CNT + 32;
    if (F.tid < 32) CNT[F.tid] = (int)__hip_atomic_load(F.ctl + CW_CNT + 64 * F.tid, __ATOMIC_RELAXED, __HIP_MEMORY_SCOPE_AGENT);
    __syncthreads();
    if (F.tid == 0) { int s = 0; for (int e = 0; e < NE; ++e) { PRE[e] = s; s += (CNT[e] + 255) >> 8; } PRE[NE] = s; }
    __syncthreads();
    const int NT = PRE[NE];
    for (int t = F.tid; t < NT; t += 512) { int e = 0; while (e < NE - 1 && PRE[e + 1] <= t) ++e; TE[t] = e; TR[t] = (t - PRE[e]) * 256; }
    __syncthreads();
    return NT;
}
__device__ __forceinline__ void moe_unit_tables(Frame& F, const pg8::MoeSched& S, int mode) {
    LAS int* TE = (LAS int*)(F.lds + TAB_TE); LAS int* TR = (LAS int*)(F.lds + TAB_TR); LAS int* CNT = (LAS int*)(F.lds + TAB_CNT);
    LAS unsigned* ROW = (LAS unsigned*)(F.lds + TAB_ROW); LAS float* FT = (LAS float*)(F.lds + TAB_F);
    const int nu = S.rounds() < MAXU ? S.rounds() : MAXU;
    f32x4 ri[MAXU / 2]; bool valid[MAXU / 2]; int ok[MAXU / 2];
#pragma unroll
    for (int t = 0; t < MAXU / 2; ++t) { const int idx = F.tid + 512 * t, i = idx >> 8, r = idx & 255; pg8::Unit u;
        ri[t] = (f32x4){0.f, 0.f, 0.f, 0.f}; valid[t] = false; ok[t] = (i < nu) && S.next(i, u);
        if (ok[t]) { const int e = TE[u.pm], pos = TR[u.pm] + r; valid[t] = pos < CNT[e]; if (valid[t]) ri[t] = F.RINFO[(size_t)e * ECAP + pos]; } }
#pragma unroll
    for (int t = 0; t < MAXU / 2; ++t) if (ok[t]) { const int idx = F.tid + 512 * t; const int slot = __builtin_bit_cast(int, ri[t].x);
        if (mode == 0) { ROW[idx] = valid[t] ? (unsigned)(slot >> 1) * (unsigned)D : 0u; FT[idx] = valid[t] ? ri[t].z * (1.0f / WGU_SCALE) : 0.f; }
        else { ROW[idx] = valid[t] ? (unsigned)slot : 0xffffffffu; FT[idx] = ri[t].y * (C_SCALE / (WD_SCALE * HID_SCALE)); } }
    __syncthreads();
}

__device__ __forceinline__ void p8_final(Frame& F) {
    const int gw = F.bx * 8 + F.wave, NGW = F.G * 8;
    f32x4 g[4];
#pragma unroll
    for (int j = 0; j < 4; ++j) g[j] = ((const f32x4*)F.final_gain)[F.lane + 64 * j];
    for (int m = gw * 2; m < M; m += NGW * 2) {
        u32x2 hb[2][4]; unsigned ca[2][4], cb[2][4];
#pragma unroll
        for (int r = 0; r < 2; ++r)
#pragma unroll
            for (int j = 0; j < 4; ++j) { hb[r][j] = ((const u32x2*)(F.H1 + (size_t)(m + r) * D))[F.lane + 64 * j];
                ca[r][j] = ((const unsigned*)(F.C + (size_t)(2 * (m + r)) * D))[F.lane + 64 * j]; cb[r][j] = ((const unsigned*)(F.C + (size_t)(2 * (m + r) + 1) * D))[F.lane + 64 * j]; }
#pragma unroll
        for (int r = 0; r < 2; ++r) { f32x4 v[4]; float s = 0.f;
#pragma unroll
            for (int j = 0; j < 4; ++j) { const f32x2 a0 = __builtin_amdgcn_cvt_pk_f32_fp8(ca[r][j], false), a1 = __builtin_amdgcn_cvt_pk_f32_fp8(ca[r][j], true), b0 = __builtin_amdgcn_cvt_pk_f32_fp8(cb[r][j], false), b1 = __builtin_amdgcn_cvt_pk_f32_fp8(cb[r][j], true);
                v[j] = (f32x4){bflo(hb[r][j].x) + (a0.x + b0.x) * (1.0f / C_SCALE), bfhi(hb[r][j].x) + (a0.y + b0.y) * (1.0f / C_SCALE), bflo(hb[r][j].y) + (a1.x + b1.x) * (1.0f / C_SCALE), bfhi(hb[r][j].y) + (a1.y + b1.y) * (1.0f / C_SCALE)};
                s += (v[j].x * v[j].x + v[j].y * v[j].y) + (v[j].z * v[j].z + v[j].w * v[j].w); }
            const float rstd = rsqrtf(wave_sum(s) * (1.f / D) + RMS_EPS);
            f32x4* o = (f32x4*)(F.out + (size_t)(m + r) * D) + F.lane;
#pragma unroll
            for (int j = 0; j < 4; ++j) o[64 * j] = v[j] * rstd * g[j]; }
    }
}

struct Args { const float* in[24]; float* out; unsigned char* ws; int ph_lo, ph_hi; };
__global__ void __launch_bounds__(512, 2) hymba_fwd(Args args) {
    extern __shared__ __attribute__((aligned(16))) unsigned char lds[];
    Frame F;
    F.lds = (LAS unsigned char*)lds; F.tid = threadIdx.x; F.lane = F.tid & 63; F.wave = __builtin_amdgcn_readfirstlane(F.tid >> 6); F.G = gridDim.x; F.bx = blockIdx.x;
    F.x = args.in[0]; F.meta = args.in[1]; F.g1 = args.in[2]; F.w_in = args.in[3]; F.conv_w = args.in[4]; F.conv_b = args.in[5]; F.wa = args.in[6]; F.ba = args.in[7]; F.wx = args.in[8]; F.bx_ = args.in[9];
    F.lam = args.in[10]; F.lru_gain = args.in[11]; F.pool_w = args.in[12]; F.pool_scale = args.in[13]; F.w_out = args.in[14]; F.g2 = args.in[15]; F.w_group = args.in[16]; F.b_group = args.in[17];
    F.w_router = args.in[18]; F.b_router = args.in[19]; F.w_gate = args.in[20]; F.w_up = args.in[21]; F.w_down = args.in[22]; F.final_gain = args.in[23];
    F.out = args.out; F.ws = args.ws; F.ctl = (unsigned*)(args.ws + WS_CTL);
    unsigned char* ws = args.ws;
    F.WinT = (bf16*)(ws + WS_WIN); F.WoutT = (bf16*)(ws + WS_WOUT); F.WaT = (bf16*)(ws + WS_WA); F.WxT = (bf16*)(ws + WS_WX); F.PwT = (bf16*)(ws + WS_PW); F.WrH = (_Float16*)(ws + WS_WR);
    F.AGG = (float*)(ws + WS_AGG); F.HM = (float*)(ws + WS_HM); F.AB = (u32x4*)(ws + WS_AB); F.WguT = ws + WS_WGU; F.WdT = ws + WS_WD; F.RINFO = (f32x4*)(ws + WS_RINFO); F.HN1 = (bf16*)(ws + WS_HN1); F.YMIX = (bf16*)(ws + WS_YMIX); F.RS1 = (float*)(ws + WS_RS1);
    F.PROJ = (bf16*)(ws + WS_PROJ); F.HN2 = ws + WS_PROJ; F.HID = ws + WS_HID; F.C = ws + WS_C; F.H1 = (bf16*)(ws + WS_H1);
    volatile LAS unsigned* MISC = (volatile LAS unsigned*)(F.lds + MISC_OFF);
    if (F.tid < 64) MISC[F.tid] = 0u;
    __syncthreads();
    XcdBarrier bar; bar.bar = F.ctl + CW_BAR; bar.x = 0; bar.st = nullptr;
    if (MK_N_LAUNCHES == 1) bar = xcd_barrier_post(F.ctl + CW_BAR, MISC + 8);
    const int lo = args.ph_lo, hi = args.ph_hi;
#ifndef PH_MASK
#define PH_MASK 0x1ff
#endif
#define IN(k) (((PH_MASK >> (k)) & 1) && lo <= (k) && (k) < hi)
#define SEAM(k) do { if (IN(k) && IN((k) + 1)) xcd_barrier(bar); } while (0)
#define REP(k) for (int rep_ = 0; rep_ <= ((REPEAT_MASK >> (k)) & 1); ++rep_)

    if (IN(0)) REP(0) { p0_prologue(F); } SEAM(0);
    if (IN(1)) { pg8::DenseSched S{M / 256, INW / 256, F.G, F.bx, D * 2, (const char*)F.WinT, 1 + ((REPEAT_MASK >> 1) & 1)}; pg8::EpiProj E{F.PROJ, F.RS1};
        if (F.bx & 1) xtile_batch(F, 0, 2 * XT_G);
        pg8::gemm_phase(F.lds, D * 2, (const char*)F.HN1, S, E);
        if (!(F.bx & 1)) xtile_batch(F, 0, 2 * XT_G); } SEAM(1);
    if (IN(2)) REP(2) { p2_aggregates(F); } SEAM(2);
    if (IN(3)) REP(3) { p3_mixer(F); } SEAM(3);
    if (IN(4)) { pg8::DenseSched S{M / 256, D / 256, F.G, F.bx, D * 2, (const char*)F.WoutT, 1 + ((REPEAT_MASK >> 4) & 1)}; pg8::EpiResid E{F.HN1, F.g2, F.H1, F.HN2};
        if (F.bx & 1) xtile_batch(F, 2 * XT_G, XT_N);
        pg8::gemm_phase(F.lds, D * 2, (const char*)F.YMIX, S, E);
        if (!(F.bx & 1)) xtile_batch(F, 2 * XT_G, XT_N); } SEAM(4);
    if (IN(5)) { if ((REPEAT_MASK >> 5) & 1) p5_route(F, true); p5_route(F); } SEAM(5);
    if (IN(6)) { const int NT = moe_tables(F);
        pg8::MoeSched S{NT, 4, F.G, F.bx, D, (const char*)F.WguT, (size_t)1024 * D, true, (const LAS int*)(F.lds + TAB_TE), (const LAS unsigned*)(F.lds + TAB_ROW), 1 + ((REPEAT_MASK >> 6) & 1)};
        moe_unit_tables(F, S, 0);
        pg8::EpiGateUp E{F.HID, (const LAS float*)(F.lds + TAB_F), S.rounds()};
        pg8::gemm_phase<pg8::EpiGateUp, pg8::MoeSched, true>(F.lds, D, (const char*)F.HN2, S, E); } SEAM(6);
    if (IN(7)) { const int NT = moe_tables(F);
        pg8::MoeSched S{NT, 4, F.G, F.bx, EFF, (const char*)F.WdT, (size_t)D * EFF, false, (const LAS int*)(F.lds + TAB_TE), (const LAS unsigned*)(F.lds + TAB_ROW), 1 + ((REPEAT_MASK >> 7) & 1)};
        moe_unit_tables(F, S, 1);
        pg8::EpiDown E{F.C, (const LAS int*)(F.lds + TAB_ROW), (const LAS float*)(F.lds + TAB_F), S.rounds()};
        pg8::gemm_phase<pg8::EpiDown, pg8::MoeSched, true>(F.lds, EFF, (const char*)F.HID, S, E); } SEAM(7);
    if (IN(8)) { p8_final(F); }
#undef IN
#undef SEAM
}

extern "C" void kernel_launch(void* const* d_in, const int* in_sizes, int n_in, void* d_out, int out_size, void* d_ws, size_t ws_size, hipStream_t stream) {
    static int grid = 0;
    if (grid == 0) {
        if (n_in != 24 || in_sizes[0] != M * D || out_size != M * D || ws_size < WS_END) { fprintf(stderr, "kernel_launch: unexpected shapes (n_in %d, in0 %d, out %d, ws %zu)\n", n_in, n_in > 0 ? in_sizes[0] : -1, out_size, ws_size); grid = -1; return; }
        int dev = 0, cus = 0, per_cu = 0;
        if (hipGetDevice(&dev) != hipSuccess || hipDeviceGetAttribute(&cus, hipDeviceAttributeMultiprocessorCount, dev) != hipSuccess) { grid = -1; return; }
        if (hipFuncSetAttribute((const void*)hymba_fwd, hipFuncAttributeMaxDynamicSharedMemorySize, LDS_BYTES) != hipSuccess) { fprintf(stderr, "kernel_launch: hipFuncSetAttribute failed\n"); grid = -1; return; }
        if (hipOccupancyMaxActiveBlocksPerMultiprocessor(&per_cu, (const void*)hymba_fwd, 512, LDS_BYTES) != hipSuccess || per_cu < 1) fprintf(stderr, "kernel_launch: occupancy query says %d\n", per_cu);
        (void)hipGetLastError();
        grid = cus;
    }
    if (grid < 0) return;
    if (hipMemsetAsync((char*)d_ws + WS_CTL, 0, CTL_ZERO_BYTES, stream) != hipSuccess) return;
    Args a{};
    for (int i = 0; i < 24; ++i) a.in[i] = (const float*)d_in[i];
    a.out = (float*)d_out; a.ws = (unsigned char*)d_ws;
    if (MK_N_LAUNCHES == 1) { a.ph_lo = 0; a.ph_hi = N_PHASES; hipLaunchKernelGGL(hymba_fwd, dim3(grid), dim3(512), LDS_BYTES, stream, a); }
    else for (int p = 0; p < N_PHASES; ++p) { a.ph_lo = p; a.ph_hi = p + 1; hipLaunchKernelGGL(hymba_fwd, dim3(grid), dim3(512), LDS_BYTES, stream, a); }
}
```
